# Optimizing an MI355X kernel written in HIP

```python
import jax, jax.numpy as jnp
from jax import lax
import numpy as np

D_MODEL = 1024
BATCH = 4
SEQ = 8192
DEPTH = 4

GRID_W = 64
CTX_LEN = 256
ROPE_THETA = 10000.0
NORM_EPS = 1e-6
HEAD_DIM = 64

A_HEADS = 8
A_KV_HEADS = 2
A_WINDOW = 128
A_BLOCK = 128
B_HEADS = 8
B_Q_LORA = 384
B_KV_LORA = 256
B_NOPE = 64
B_ROPE = 32
B_V = 64
B_BLOCK = 128
C_HEADS = 16
C_KH = 8
C_KW = 16

A_WIDTH = A_HEADS * HEAD_DIM
A_KV_WIDTH = A_KV_HEADS * HEAD_DIM
B_WIDTH = B_HEADS * B_V
AB_MIX = A_WIDTH + B_WIDTH
AB_SPLITS = (
    A_WIDTH,
    A_WIDTH + A_KV_WIDTH,
    A_WIDTH + 2 * A_KV_WIDTH,
    2 * A_WIDTH + 2 * A_KV_WIDTH,
    2 * A_WIDTH + 2 * A_KV_WIDTH + B_Q_LORA,
    2 * A_WIDTH + 2 * A_KV_WIDTH + B_Q_LORA + B_KV_LORA,
    2 * A_WIDTH + 2 * A_KV_WIDTH + B_Q_LORA + B_KV_LORA + B_ROPE,
)
AB_IN = 2 * A_WIDTH + 2 * A_KV_WIDTH + B_Q_LORA + B_KV_LORA + B_ROPE + B_WIDTH
C_WIDTH = C_HEADS * HEAD_DIM
C_IN = 4 * C_WIDTH
N_EVEN = (DEPTH + 1) // 2
N_ODD = DEPTH // 2

kernel_name = "hybrid_window_mla_natten_prefix_dit"


def rms_norm(x, g):
    xf = x.astype(jnp.float32)
    y = xf * lax.rsqrt(jnp.mean(xf * xf, axis=-1, keepdims=True) + NORM_EPS)
    return (y * g.astype(jnp.float32)).astype(x.dtype)


def axial_rope_angles(n_tokens, rot_dim):
    t = jnp.arange(n_tokens, dtype=jnp.int32)
    row = (t // GRID_W).astype(jnp.float32)
    col = (t % GRID_W).astype(jnp.float32)
    pairs_per_axis = rot_dim // 4
    inv = ROPE_THETA ** (-jnp.arange(pairs_per_axis, dtype=jnp.float32) / pairs_per_axis)
    ang = jnp.concatenate([row[:, None] * inv, col[:, None] * inv], axis=-1)
    return jnp.cos(ang), jnp.sin(ang)


def apply_rope(x, cos, sin):
    d = x.shape[-1]
    xr = x.reshape(x.shape[:-1] + (d // 2, 2)).astype(jnp.float32)
    x1, x2 = xr[..., 0], xr[..., 1]
    out = jnp.stack([x1 * cos - x2 * sin, x1 * sin + x2 * cos], axis=-1)
    return out.reshape(x.shape).astype(x.dtype)


def gqa_sink_dense(q, k, v, sink):
    bn, n, _, d = q.shape
    grp = A_HEADS // A_KV_HEADS
    qg = q.reshape(bn, n, A_KV_HEADS, grp, d)
    s = jnp.einsum('bqhgd,bkhd->bhgqk', qg, k).astype(jnp.float32) * (d ** -0.5)
    s_sink = jnp.broadcast_to(sink.astype(jnp.float32).reshape(A_KV_HEADS, grp)[None, :, :, None, None], s.shape[:-1] + (1,))
    p = jax.nn.softmax(jnp.concatenate([s, s_sink], axis=-1), axis=-1)[..., :-1].astype(v.dtype)
    return jnp.einsum('bhgqk,bkhd->bqhgd', p, v).reshape(bn, n, A_HEADS * d)


def window_gqa_latent(q, k, v, kc, vc, sink):
    bn, s_len, _, d = q.shape
    nb = s_len // A_BLOCK
    grp = A_HEADS // A_KV_HEADS
    scale = d ** -0.5
    pad = [(0, 0), (A_BLOCK, A_BLOCK), (0, 0), (0, 0)]

    def band(t):
        tb = jnp.pad(t, pad).reshape(bn, nb + 2, A_BLOCK, A_KV_HEADS, d)
        w = jnp.concatenate([tb[:, :-2], tb[:, 1:-1], tb[:, 2:]], axis=2)
        return jnp.moveaxis(w, 1, 0)

    kw, vw = band(k), band(v)
    qb = jnp.moveaxis(q.reshape(bn, nb, A_BLOCK, A_KV_HEADS, grp, d), 1, 0)
    qi = jnp.arange(A_BLOCK)[:, None]
    kj = jnp.arange(3 * A_BLOCK)[None, :] - A_BLOCK
    band_ok = jnp.abs(kj - qi) <= A_WINDOW
    sink_g = sink.astype(jnp.float32).reshape(A_KV_HEADS, grp)[None, :, :, None, None]

    def block(args):
        n, qn, kn, vn = args
        kpos = n * A_BLOCK + kj
        mask = band_ok & (kpos >= 0) & (kpos < s_len)
        s_loc = jnp.einsum('bqhgd,bkhd->bhgqk', qn, kn).astype(jnp.float32) * scale
        s_loc = jnp.where(mask, s_loc, -jnp.inf)
        s_ctx = jnp.einsum('bqhgd,blhd->bhgql', qn, kc).astype(jnp.float32) * scale
        s_sink = jnp.broadcast_to(sink_g, s_loc.shape[:-1] + (1,))
        p = jax.nn.softmax(jnp.concatenate([s_loc, s_ctx, s_sink], axis=-1), axis=-1)
        p_loc = p[..., :3 * A_BLOCK].astype(vn.dtype)
        p_ctx = p[..., 3 * A_BLOCK:-1].astype(vc.dtype)
        return (jnp.einsum('bhgqk,bkhd->bqhgd', p_loc, vn)
                + jnp.einsum('bhgql,blhd->bqhgd', p_ctx, vc))

    o = lax.map(block, (jnp.arange(nb), qb, kw, vw))
    return jnp.moveaxis(o, 0, 1).reshape(bn, s_len, A_HEADS * d)


def mla_dense(qn, qr, kn, kr, v):
    scale = (B_NOPE + B_ROPE) ** -0.5
    s = (jnp.einsum('bqhd,bkhd->bhqk', qn, kn) + jnp.einsum('bqhr,bkr->bhqk', qr, kr)).astype(jnp.float32) * scale
    p = jax.nn.softmax(s, axis=-1).astype(v.dtype)
    return jnp.einsum('bhqk,bkhd->bqhd', p, v)


def mla_latent(qn, qr, kn, kr, v, kn_c, kr_c, v_c):
    bn, s_len = qn.shape[0], qn.shape[1]
    nb = s_len // B_BLOCK
    k_n = jnp.concatenate([kn_c, kn], axis=1)
    k_r = jnp.concatenate([kr_c, kr], axis=1)
    v_all = jnp.concatenate([v_c, v], axis=1)
    qn_b = jnp.moveaxis(qn.reshape(bn, nb, B_BLOCK, B_HEADS, B_NOPE), 1, 0)
    qr_b = jnp.moveaxis(qr.reshape(bn, nb, B_BLOCK, B_HEADS, B_ROPE), 1, 0)
    o = lax.map(lambda a: mla_dense(a[0], a[1], k_n, k_r, v_all), (qn_b, qr_b))
    return jnp.moveaxis(o, 0, 1).reshape(bn, s_len, B_HEADS * B_V)


def ab_project(u, in_w, qn_g, w_uq, kvn_g, w_ukv):
    bn, n, _ = u.shape
    p = u @ in_w
    qa, ka, va, za, cq, ckv, kr, zb = jnp.split(p, AB_SPLITS, axis=-1)
    qa = qa.reshape(bn, n, A_HEADS, HEAD_DIM)
    ka = ka.reshape(bn, n, A_KV_HEADS, HEAD_DIM)
    va = va.reshape(bn, n, A_KV_HEADS, HEAD_DIM)
    qb = (rms_norm(cq, qn_g) @ w_uq).reshape(bn, n, B_HEADS, B_NOPE + B_ROPE)
    kvb = (rms_norm(ckv, kvn_g) @ w_ukv).reshape(bn, n, B_HEADS, B_NOPE + B_V)
    return (qa, ka, va, za, qb[..., :B_NOPE], qb[..., B_NOPE:],
            kvb[..., :B_NOPE], kr, kvb[..., B_NOPE:], zb)


def ab_mixer(u, uc, in_w, out_w, sink, qn_g, w_uq, kvn_g, w_ukv, rope_a, rope_b, need_ctx):
    qa, ka, va, za, qbn, qbr, kbn, kbr, vb, zb = ab_project(u, in_w, qn_g, w_uq, kvn_g, w_ukv)
    qa_c, ka_c, va_c, za_c, qbn_c, qbr_c, kbn_c, kbr_c, vb_c, zb_c = ab_project(uc, in_w, qn_g, w_uq, kvn_g, w_ukv)
    cos_a, sin_a = rope_a
    cos_b, sin_b = rope_b
    qa = apply_rope(qa, cos_a[:, None, :], sin_a[:, None, :])
    ka = apply_rope(ka, cos_a[:, None, :], sin_a[:, None, :])
    qbr = apply_rope(qbr, cos_b[:, None, :], sin_b[:, None, :])
    kbr = apply_rope(kbr, cos_b, sin_b)
    oa = window_gqa_latent(qa, ka, va, ka_c, va_c, sink)
    ob = mla_latent(qbn, qbr, kbn, kbr, vb, kbn_c, kbr_c, vb_c)
    y = jnp.concatenate([oa * jax.nn.silu(za), ob * jax.nn.silu(zb)], axis=-1) @ out_w
    if not need_ctx:
        return y, None
    bn, n = uc.shape[0], uc.shape[1]
    oa_c = gqa_sink_dense(qa_c, ka_c, va_c, sink)
    ob_c = mla_dense(qbn_c, qbr_c, kbn_c, kbr_c, vb_c).reshape(bn, n, B_WIDTH)
    yc = jnp.concatenate([oa_c * jax.nn.silu(za_c), ob_c * jax.nn.silu(zb_c)], axis=-1) @ out_w
    return y, yc


def mha_dense(q, k, v):
    bn, n, h, d = q.shape
    s = jnp.einsum('bqhd,bkhd->bhqk', q, k).astype(jnp.float32) * (d ** -0.5)
    p = jax.nn.softmax(s, axis=-1).astype(v.dtype)
    return jnp.einsum('bhqk,bkhd->bqhd', p, v).reshape(bn, n, h * d)


def neighbourhood_latent(q, k, v, kc, vc, rpb):
    bn, s_len, h, d = q.shape
    rows = s_len // GRID_W
    kh = min(C_KH, rows)
    scale = d ** -0.5
    qg = jnp.moveaxis(q.reshape(bn, rows, GRID_W, h, d), 1, 0)
    kg = k.reshape(bn, rows, GRID_W, h, d)
    vg = v.reshape(bn, rows, GRID_W, h, d)
    col = jnp.arange(GRID_W)
    cs = jnp.clip(col - C_KW // 2, 0, GRID_W - C_KW)
    col_ok = (col[None, :] >= cs[:, None]) & (col[None, :] < cs[:, None] + C_KW)
    col_idx = jnp.clip(col[None, :] - col[:, None] + (C_KW - 1), 0, 2 * C_KW - 2)
    rpb_col = rpb[:, :, col_idx]
    mask = jnp.broadcast_to(col_ok[:, None, :], (GRID_W, kh, GRID_W)).reshape(GRID_W, kh * GRID_W)

    def row_block(args):
        r, qr = args
        rs = jnp.clip(r - kh // 2, 0, rows - kh)
        kr = lax.dynamic_slice_in_dim(kg, rs, kh, axis=1).reshape(bn, kh * GRID_W, h, d)
        vr = lax.dynamic_slice_in_dim(vg, rs, kh, axis=1).reshape(bn, kh * GRID_W, h, d)
        row_idx = rs + jnp.arange(kh) - r + (C_KH - 1)
        bias = jnp.take(rpb_col, row_idx, axis=1)
        bias = jnp.transpose(bias, (0, 2, 1, 3)).reshape(h, GRID_W, kh * GRID_W)
        s_loc = jnp.einsum('bqhd,bkhd->bhqk', qr, kr).astype(jnp.float32) * scale + bias.astype(jnp.float32)
        s_loc = jnp.where(mask, s_loc, -jnp.inf)
        s_ctx = jnp.einsum('bqhd,blhd->bhql', qr, kc).astype(jnp.float32) * scale
        p = jax.nn.softmax(jnp.concatenate([s_loc, s_ctx], axis=-1), axis=-1)
        p_loc = p[..., :kh * GRID_W].astype(vr.dtype)
        p_ctx = p[..., kh * GRID_W:].astype(vc.dtype)
        return jnp.einsum('bhqk,bkhd->bqhd', p_loc, vr) + jnp.einsum('bhql,blhd->bqhd', p_ctx, vc)

    o = lax.map(row_block, (jnp.arange(rows), qg))
    return jnp.moveaxis(o, 0, 1).reshape(bn, s_len, h * d)


def c_mixer(u, uc, in_w, out_w, rpb, need_ctx):
    def proj(t):
        bn, n, _ = t.shape
        q, k, v, z = jnp.split(t @ in_w, 4, axis=-1)
        shp = (bn, n, C_HEADS, HEAD_DIM)
        return q.reshape(shp), k.reshape(shp), v.reshape(shp), z
    q, k, v, z = proj(u)
    q_c, k_c, v_c, z_c = proj(uc)
    o = neighbourhood_latent(q, k, v, k_c, v_c, rpb)
    y = (o * jax.nn.silu(z)) @ out_w
    if not need_ctx:
        return y, None
    yc = (mha_dense(q_c, k_c, v_c) * jax.nn.silu(z_c)) @ out_w
    return y, yc


def setup_inputs(seed: int = 0) -> dict:
    key = jax.random.key(seed)
    ks = jax.random.split(key, 20)
    f32 = jnp.float32

    def w(k, shape, fan_in, gain=1.0):
        return jax.random.normal(k, shape, f32) * (gain * fan_in ** -0.5)

    def gain(k, shape):
        return 1.0 + 0.05 * jax.random.normal(k, shape, f32)

    return {
        "x": jax.random.normal(ks[0], (BATCH, SEQ, D_MODEL), f32),
        "c": jax.random.normal(ks[1], (BATCH, D_MODEL), f32),
        "ctx": jax.random.normal(ks[2], (BATCH, CTX_LEN, D_MODEL), f32),
        "c_ctx": jax.random.normal(ks[3], (D_MODEL,), f32),
        "ada_w": w(ks[4], (DEPTH, D_MODEL, 3 * D_MODEL), D_MODEL, 0.5),
        "ada_b": 0.02 * jax.random.normal(ks[5], (DEPTH, 3 * D_MODEL), f32),
        "norm_g": gain(ks[6], (DEPTH, D_MODEL)),
        "ab_in_w": w(ks[7], (N_EVEN, D_MODEL, AB_IN), D_MODEL),
        "ab_out_w": w(ks[8], (N_EVEN, AB_MIX, D_MODEL), AB_MIX),
        "a_sink": jax.random.normal(ks[9], (N_EVEN, A_HEADS), f32),
        "b_q_norm_g": gain(ks[10], (N_EVEN, B_Q_LORA)),
        "b_w_uq": w(ks[11], (N_EVEN, B_Q_LORA, B_HEADS * (B_NOPE + B_ROPE)), B_Q_LORA),
        "b_kv_norm_g": gain(ks[12], (N_EVEN, B_KV_LORA)),
        "b_w_ukv": w(ks[13], (N_EVEN, B_KV_LORA, B_HEADS * (B_NOPE + B_V)), B_KV_LORA),
        "c_in_w": w(ks[14], (N_ODD, D_MODEL, C_IN), D_MODEL),
        "c_out_w": w(ks[15], (N_ODD, C_WIDTH, D_MODEL), C_WIDTH),
        "c_rpb": 0.5 * jax.random.normal(ks[16], (N_ODD, C_HEADS, 2 * C_KH - 1, 2 * C_KW - 1), f32),
        "final_g": gain(ks[17], (D_MODEL,)),
    }


def reference(x, c, ctx, c_ctx, ada_w, ada_b, norm_g, ab_in_w, ab_out_w, a_sink,
              b_q_norm_g, b_w_uq, b_kv_norm_g, b_w_ukv, c_in_w, c_out_w, c_rpb, final_g):
    n_lat = x.shape[1]
    rope_a = axial_rope_angles(n_lat, HEAD_DIM)
    rope_b = axial_rope_angles(n_lat, B_ROPE)
    sc = jax.nn.silu(c)
    sc_ctx = jax.nn.silu(c_ctx)
    h, hc = x, ctx
    for layer in range(DEPTH):
        last = layer == DEPTH - 1
        mod = sc @ ada_w[layer] + ada_b[layer]
        shift, scale, gate = jnp.split(mod[:, None, :], 3, axis=-1)
        mod_c = sc_ctx @ ada_w[layer] + ada_b[layer]
        shift_c, scale_c, gate_c = jnp.split(mod_c, 3, axis=-1)
        u = rms_norm(h, norm_g[layer]) * (1 + scale) + shift
        uc = rms_norm(hc, norm_g[layer]) * (1 + scale_c) + shift_c
        if layer % 2 == 0:
            i = layer // 2
            y, yc = ab_mixer(u, uc, ab_in_w[i], ab_out_w[i], a_sink[i], b_q_norm_g[i], b_w_uq[i],
                             b_kv_norm_g[i], b_w_ukv[i], rope_a, rope_b, not last)
        else:
            i = layer // 2
            y, yc = c_mixer(u, uc, c_in_w[i], c_out_w[i], c_rpb[i], not last)
        h = h + gate * y
        if not last:
            hc = hc + gate_c * yc
    return rms_norm(h, final_g)
```

```cpp
#include <hip/hip_runtime.h>
#include <hip/hip_cooperative_groups.h>
#include <stdint.h>
#include <stdio.h>
namespace cg = cooperative_groups;

#ifndef REP_ATTN
#define REP_ATTN 1
#endif
#ifndef REP_GEMM
#define REP_GEMM 1
#endif
#ifndef MK_MULTI_LAUNCH
#define MK_MULTI_LAUNCH 0
#endif

typedef unsigned short bf16_t;
typedef short bf16x8 __attribute__((ext_vector_type(8)));
typedef float f32x16 __attribute__((ext_vector_type(16)));
typedef float f32x4 __attribute__((ext_vector_type(4)));
typedef float f32x2 __attribute__((ext_vector_type(2)));
typedef unsigned u32x4 __attribute__((ext_vector_type(4)));
typedef unsigned u32x2 __attribute__((ext_vector_type(2)));

#define DI __device__ __forceinline__
#define MFMA32(a, b, c) __builtin_amdgcn_mfma_f32_32x32x16_bf16((a), (b), (c), 0, 0, 0)

constexpr int T_LAT = 32768, T_ALL = 33792, NKEY = 8448, NT = 512;
constexpr float LOG2E = 1.4426950408889634f;
constexpr float QSCALE_A = 0.125f * LOG2E;
constexpr float QSCALE_B = 0.10206207261596575f * LOG2E;

constexpr size_t OFF_HC   = 0;
constexpr size_t OFF_UG   = OFF_HC + 1024ull * 1024 * 4;
constexpr size_t OFF_P    = OFF_UG + (size_t)T_ALL * 1024 * 2;
constexpr size_t OFF_QB   = OFF_P + (size_t)T_ALL * 2560 * 2;
constexpr size_t OFF_KB   = OFF_QB + (size_t)T_ALL * 768 * 2;
constexpr size_t OFF_VT   = OFF_KB + (size_t)T_ALL * 512 * 2;
constexpr size_t OFF_VTB  = OFF_VT + 4ull * 2 * 64 * NKEY * 2;
constexpr size_t OFF_W    = OFF_VT + 4ull * 16 * 64 * NKEY * 2;
constexpr size_t OFF_W_IN   = OFF_W;
constexpr size_t OFF_W_OUT  = OFF_W_IN + 2ull * 2560 * 1024 * 2;
constexpr size_t OFF_W_UQ   = OFF_W_OUT + 2ull * 1024 * 1024 * 2;
constexpr size_t OFF_W_UKV  = OFF_W_UQ + 2ull * 768 * 384 * 2;
constexpr size_t OFF_W_CIN  = OFF_W_UKV + 2ull * 1024 * 256 * 2;
constexpr size_t OFF_W_COUT = OFF_W_CIN + 2ull * 4096 * 1024 * 2;
constexpr size_t OFF_MOD    = OFF_W_COUT + 2ull * 1024 * 1024 * 2;
constexpr size_t OFF_ROPE   = OFF_MOD + 4ull * 5 * 3072 * 4;
constexpr size_t OFF_BAR    = OFF_ROPE + 2ull * 8192 * 32 * 4 + 2ull * 8192 * 16 * 4;
constexpr size_t OFF_END    = OFF_BAR + 16384;

struct Params {
  const float *x, *c, *ctx, *c_ctx, *ada_w, *ada_b, *norm_g, *ab_in_w, *ab_out_w, *a_sink, *b_qn_g, *b_w_uq, *b_kvn_g, *b_w_ukv,
      *c_in_w, *c_out_w, *c_rpb, *final_g;
  float* out;
  char* ws;
  int ph_begin, ph_end;
};

DI int otid() { int t = threadIdx.x; asm volatile("" : "+v"(t)); return t; }
DI int obid() { int t = blockIdx.x; asm volatile("" : "+s"(t)); return t; }
DI int ogrid() { int t = gridDim.x; asm volatile("" : "+s"(t)); return t; }
DI unsigned pack_bf16(float lo, float hi) { unsigned r; asm("v_cvt_pk_bf16_f32 %0, %1, %2" : "=v"(r) : "v"(lo), "v"(hi)); return r; }
DI float bf_lo(unsigned u) { return __uint_as_float(u << 16); }
DI float bf_hi(unsigned u) { return __uint_as_float(u & 0xffff0000u); }
DI float fexp2(float x) { return __builtin_amdgcn_exp2f(x); }
DI float silu(float z) { return z / (1.f + __expf(-z)); }

DI size_t ablk(int tok, int k) { return ((size_t)((tok >> 8) * 16 + (k >> 6)) << 14) + ((tok & 255) << 6) + (k & 63); }
DI void tok_bk(int tok, int& b, int& key) {
  if (tok < T_LAT) { b = tok >> 13; key = tok & 8191; } else { int r = tok - T_LAT; b = r >> 8; key = 8192 + (r & 255); }
}
DI const float* h_src(const Params& p, int layer, int tok) {
  if (layer == 0) return tok < T_LAT ? p.x + (size_t)tok * 1024 : p.ctx + (size_t)(tok - T_LAT) * 1024;
  return tok < T_LAT ? p.out + (size_t)tok * 1024 : (const float*)(p.ws + OFF_HC) + (size_t)(tok - T_LAT) * 1024;
}
DI float* h_dst(const Params& p, int tok) {
  return tok < T_LAT ? p.out + (size_t)tok * 1024 : (float*)(p.ws + OFF_HC) + (size_t)(tok - T_LAT) * 1024;
}

#define XB_TMO      128
#define XB_XCNT(j)  (256  + 64 * (j))
#define XB_XSUB(j)  (1280 + 64 * (j))
#define XB_XGEN(j)  (2304 + 64 * (j))
#define XB_TOP      3328
#define XB_TOPGEN   3392
#define XCD_BAR_WORDS 3456
#define XB_SPIN_CAP (1u << 22)
#define LAS __attribute__((address_space(3)))
DI unsigned xb_ld(unsigned* p) { return __hip_atomic_load(p, __ATOMIC_RELAXED, __HIP_MEMORY_SCOPE_AGENT); }
DI unsigned xb_add(unsigned* p, unsigned v) { return __hip_atomic_fetch_add(p, v, __ATOMIC_RELAXED, __HIP_MEMORY_SCOPE_AGENT); }
DI unsigned xb_xcc_id() { return (unsigned)__builtin_amdgcn_s_getreg((3 << 11) | 20) & 0xFu; }
#define XB_SPIN(cond, bar) do { unsigned _sp = 0; while (cond) { __builtin_amdgcn_s_sleep(1); \
    if ((++_sp & 255u) == 0u) { if (xb_ld(&(bar)[XB_TMO])) break; if (_sp > XB_SPIN_CAP) { atomicAdd(&(bar)[XB_TMO], 1u); break; } } } } while (0)
struct XcdBarrier { unsigned* bar; unsigned x; volatile LAS unsigned* st; };
DI XcdBarrier xcd_barrier_post(unsigned* bar, volatile LAS unsigned* st) {
  XcdBarrier b; b.bar = bar; b.x = xb_xcc_id(); b.st = st;
  if (threadIdx.x == 0) (void)xb_add(&bar[XB_XCNT(b.x)], 1u);
  return b;
}
DI void xcd_barrier_complete(unsigned* bar, unsigned x, unsigned& nloc, unsigned& nx) {
  const unsigned G = gridDim.x * gridDim.y * gridDim.z;
  unsigned sum, cnt, mine, sp = 0u;
  for (;;) {
    sum = 0u; cnt = 0u; mine = 0u;
#pragma unroll
    for (unsigned j = 0; j < 16; ++j) { const unsigned c = xb_ld(&bar[XB_XCNT(j)]); sum += c; cnt += (c > 0u) ? 1u : 0u; mine = (j == x) ? c : mine; }
    if (sum == G) break;
    __builtin_amdgcn_s_sleep(1);
    if ((++sp & 255u) == 0u) { if (xb_ld(&bar[XB_TMO])) break; if (sp > XB_SPIN_CAP) { atomicAdd(&bar[XB_TMO], 1u); break; } }
  }
  nloc = mine > 0u ? mine : 1u; nx = cnt > 0u ? cnt : 1u;
}
DI void xcd_barrier(const XcdBarrier& b) {
  asm volatile("s_waitcnt vmcnt(0)" ::: "memory");
  __syncthreads();
  if (threadIdx.x == 0) {
    unsigned* bar = b.bar;
    __builtin_amdgcn_s_waitcnt(0);
    unsigned nloc = b.st[0], nx = b.st[1];
    if (nloc == 0u) { xcd_barrier_complete(bar, b.x, nloc, nx); b.st[0] = nloc; b.st[1] = nx; }
    const unsigned old = xb_add(&bar[XB_XSUB(b.x)], 1u);
    const unsigned gen = old / nloc;
    if (old + 1u == (gen + 1u) * nloc) {
      __builtin_amdgcn_fence(__ATOMIC_RELEASE, "agent");
      asm volatile("s_waitcnt vmcnt(0)" ::: "memory");
      const unsigned og = xb_add(&bar[XB_TOP], 1u);
      const unsigned tg = og / nx;
      if (og + 1u == (tg + 1u) * nx) xb_add(&bar[XB_TOPGEN], 1u);
      else XB_SPIN(xb_ld(&bar[XB_TOPGEN]) == tg, bar);
      __builtin_amdgcn_fence(__ATOMIC_ACQUIRE, "agent");
      xb_add(&bar[XB_XGEN(b.x)], 1u);
      asm volatile("s_waitcnt vmcnt(0)" ::: "memory");
    } else {
      XB_SPIN(xb_ld(&bar[XB_XGEN(b.x)]) == gen, bar);
      __builtin_amdgcn_fence(__ATOMIC_ACQUIRE, "agent");
      asm volatile("s_waitcnt vmcnt(0)" ::: "memory");
    }
  }
  __syncthreads();
}

struct TJob { const float* src; const float* rs; bf16_t* dst; int K, N, tk, tn, perm; };
DI TJob tr_job(const Params& p, int t) {
  TJob j; j.rs = nullptr; j.perm = 0;
  const int i2 = t / 2312; t -= i2 * 2312;
  if (t < 640) { j.src = p.ab_in_w + (size_t)i2 * 1024 * 2464; j.K = 1024; j.N = 2464; j.dst = (bf16_t*)(p.ws + OFF_W_IN) + (size_t)i2 * 2560 * 1024; j.tk = t / 40; j.tn = t % 40; }
  else if ((t -= 640) < 256) { j.src = p.ab_out_w + (size_t)i2 * 1024 * 1024; j.K = 1024; j.N = 1024; j.dst = (bf16_t*)(p.ws + OFF_W_OUT) + (size_t)i2 * 1024 * 1024; j.tk = t / 16; j.tn = t % 16; }
  else if ((t -= 256) < 72) { j.src = p.b_w_uq + (size_t)i2 * 384 * 768; j.K = 384; j.N = 768; j.dst = (bf16_t*)(p.ws + OFF_W_UQ) + (size_t)i2 * 768 * 384; j.rs = p.b_qn_g + i2 * 384; j.tk = t / 12; j.tn = t % 12; }
  else if ((t -= 72) < 64) { j.src = p.b_w_ukv + (size_t)i2 * 256 * 1024; j.K = 256; j.N = 1024; j.dst = (bf16_t*)(p.ws + OFF_W_UKV) + (size_t)i2 * 1024 * 256; j.rs = p.b_kvn_g + i2 * 256; j.tk = t / 16; j.tn = t % 16; j.perm = 1; }
  else if ((t -= 64) < 1024) { j.src = p.c_in_w + (size_t)i2 * 1024 * 4096; j.K = 1024; j.N = 4096; j.dst = (bf16_t*)(p.ws + OFF_W_CIN) + (size_t)i2 * 4096 * 1024; j.tk = t / 64; j.tn = t % 64; }
  else { t -= 1024; j.src = p.c_out_w + (size_t)i2 * 1024 * 1024; j.K = 1024; j.N = 1024; j.dst = (bf16_t*)(p.ws + OFF_W_COUT) + (size_t)i2 * 1024 * 1024; j.tk = t / 16; j.tn = t % 16; }
  return j;
}
DI void tr_load(const TJob& j, int tid, float (&v)[8]) {
#pragma unroll
  for (int i = 0; i < 8; ++i) {
    const int kk = (tid >> 6) + 8 * i, n = j.tn * 64 + (tid & 63);
    float x = (n < j.N) ? j.src[(size_t)(j.tk * 64 + kk) * j.N + n] : 0.f;
    if (j.rs) x *= j.rs[j.tk * 64 + kk];
    v[i] = x;
  }
}

DI void prologue_phase(const Params& p, char* lds) {
  const int tid = otid();
  constexpr int N_MOD = 192, N_TR = 4624, N_ROPE = 768;
  for (int u = obid(); u < N_MOD + N_TR + N_ROPE; u += ogrid()) {
    if (u < N_MOD) {
      const int layer = u / 48, cb = u % 48;
      float* sl = (float*)lds;
      for (int i = tid; i < 5120; i += NT) {
        const int bb = i >> 10, k = i & 1023;
        const float cv = bb < 4 ? p.c[bb * 1024 + k] : p.c_ctx[k];
        sl[i] = silu(cv);
      }
      __syncthreads();
      const int col = cb * 64 + (tid & 63), kg = tid >> 6;
      float a0 = 0, a1 = 0, a2 = 0, a3 = 0, a4 = 0;
      const float* wp = p.ada_w + (size_t)layer * 1024 * 3072 + col;
#pragma unroll 8
      for (int k = kg * 128; k < kg * 128 + 128; ++k) {
        const float wv = wp[(size_t)k * 3072];
        a0 += sl[k] * wv; a1 += sl[1024 + k] * wv; a2 += sl[2048 + k] * wv; a3 += sl[3072 + k] * wv; a4 += sl[4096 + k] * wv;
      }
      float* red = (float*)(lds + 20480);
      red[(kg * 5 + 0) * 64 + (tid & 63)] = a0; red[(kg * 5 + 1) * 64 + (tid & 63)] = a1; red[(kg * 5 + 2) * 64 + (tid & 63)] = a2;
      red[(kg * 5 + 3) * 64 + (tid & 63)] = a3; red[(kg * 5 + 4) * 64 + (tid & 63)] = a4;
      __syncthreads();
      if (tid < 64) {
        float* mod = (float*)(p.ws + OFF_MOD);
        const float bias = p.ada_b[layer * 3072 + col];
#pragma unroll
        for (int bb = 0; bb < 5; ++bb) {
          float s = bias;
#pragma unroll
          for (int g = 0; g < 8; ++g) s += red[(g * 5 + bb) * 64 + tid];
          mod[(size_t)(layer * 5 + bb) * 3072 + col] = s;
        }
      }
      __syncthreads();
    } else if (u < N_MOD + N_TR) {
    } else {
      const int idx = (u - N_MOD - N_TR) * NT + tid;
      float* ropeA = (float*)(p.ws + OFF_ROPE);
      float* ropeB = ropeA + 2 * 8192 * 32;
      if (idx < 8192 * 32) {
        const int pos = idx >> 5, pr = idx & 31;
        const float pv = pr < 16 ? (float)(pos >> 6) : (float)(pos & 63);
        const float inv = exp2f(-(float)(pr & 15) * (13.287712379549449f / 16.f));
        const float ang = pv * inv;
        ropeA[idx] = cosf(ang); ropeA[8192 * 32 + idx] = sinf(ang);
      } else {
        const int j = idx - 8192 * 32;
        const int pos = j >> 4, pr = j & 15;
        const float pv = pr < 8 ? (float)(pos >> 6) : (float)(pos & 63);
        const float inv = exp2f(-(float)(pr & 7) * (13.287712379549449f / 8.f));
        const float ang = pv * inv;
        ropeB[j] = cosf(ang); ropeB[8192 * 16 + j] = sinf(ang);
      }
    }
  }
  {
    const int G = ogrid();
    int t = obid();
    float v[8], nv[8];
    TJob cur, nxt;
    if (t < N_TR) { cur = tr_job(p, t); tr_load(cur, tid, v); }
    int buf = 0;
    for (; t < N_TR; t += G) {
      const bool more = t + G < N_TR;
      if (more) { nxt = tr_job(p, t + G); tr_load(nxt, tid, nv); }
      float* tile = (float*)(lds + buf * 16640);
#pragma unroll
      for (int i = 0; i < 8; ++i) tile[((tid >> 6) + 8 * i) * 65 + (tid & 63)] = v[i];
      __syncthreads();
      {
        const int nn = tid & 63, k8 = (tid >> 6) * 8;
        int n = cur.tn * 64 + nn;
        if (cur.perm) n = ((n & 64) ? 512 : 0) + (n >> 7) * 64 + (n & 63);
        u32x4 w;
        w.x = pack_bf16(tile[(k8 + 0) * 65 + nn], tile[(k8 + 1) * 65 + nn]); w.y = pack_bf16(tile[(k8 + 2) * 65 + nn], tile[(k8 + 3) * 65 + nn]);
        w.z = pack_bf16(tile[(k8 + 4) * 65 + nn], tile[(k8 + 5) * 65 + nn]); w.w = pack_bf16(tile[(k8 + 6) * 65 + nn], tile[(k8 + 7) * 65 + nn]);
        *(u32x4*)(cur.dst + ((size_t)((n >> 8) * (cur.K >> 6) + cur.tk) << 14) + ((n & 255) << 6) + k8) = w;
      }
      buf ^= 1;
      if (more) {
        cur = nxt;
#pragma unroll
        for (int i = 0; i < 8; ++i) v[i] = nv[i];
      }
    }
    __syncthreads();
  }
}

DI float wave_sum(float v) {
#pragma unroll
  for (int o = 32; o >= 1; o >>= 1) v += __shfl_xor(v, o);
  return v;
}

DI void norm_phase(const Params& p, int layer) {
  const int lane = otid() & 63;
  const int wave = obid() * 8 + (otid() >> 6), nw = ogrid() * 8;
  const float* g = p.norm_g + layer * 1024;
  const float* mod = (const float*)(p.ws + OFF_MOD) + (size_t)layer * 5 * 3072;
  bf16_t* U = (bf16_t*)(p.ws + OFF_UG);
  f32x4 gv[4];
#pragma unroll
  for (int i = 0; i < 4; ++i) gv[i] = *(const f32x4*)(g + lane * 4 + 256 * i);
  for (int row = wave; row < T_ALL; row += nw) {
    const int bb = row < T_LAT ? (row >> 13) : 4;
    const float* src = h_src(p, layer, row);
    f32x4 v[4];
    float ss = 0.f;
#pragma unroll
    for (int i = 0; i < 4; ++i) {
      v[i] = *(const f32x4*)(src + lane * 4 + 256 * i);
      ss += v[i][0] * v[i][0] + v[i][1] * v[i][1] + v[i][2] * v[i][2] + v[i][3] * v[i][3];
    }
    ss = wave_sum(ss);
    const float rstd = rsqrtf(ss * (1.f / 1024.f) + 1e-6f);
    const float* mrow = mod + bb * 3072;
#pragma unroll
    for (int i = 0; i < 4; ++i) {
      const int cidx = lane * 4 + 256 * i;
      const f32x4 sh = *(const f32x4*)(mrow + cidx), sc = *(const f32x4*)(mrow + 1024 + cidx);
      f32x4 o = (v[i] * rstd) * gv[i] * (sc + 1.f) + sh;
      u32x2 w; w.x = pack_bf16(o[0], o[1]); w.y = pack_bf16(o[2], o[3]);
      *(u32x2*)(U + ablk(row, cidx)) = w;
    }
  }
}

DI void final_phase(const Params& p) {
  const int lane = otid() & 63;
  const int wave = obid() * 8 + (otid() >> 6), nw = ogrid() * 8;
  f32x4 gv[4];
#pragma unroll
  for (int i = 0; i < 4; ++i) gv[i] = *(const f32x4*)(p.final_g + lane * 4 + 256 * i);
  for (int row = wave; row < T_LAT; row += nw) {
    float* src = p.out + (size_t)row * 1024;
    f32x4 v[4];
    float ss = 0.f;
#pragma unroll
    for (int i = 0; i < 4; ++i) {
      v[i] = *(const f32x4*)(src + lane * 4 + 256 * i);
      ss += v[i][0] * v[i][0] + v[i][1] * v[i][1] + v[i][2] * v[i][2] + v[i][3] * v[i][3];
    }
    ss = wave_sum(ss);
    const float rstd = rsqrtf(ss * (1.f / 1024.f) + 1e-6f);
#pragma unroll
    for (int i = 0; i < 4; ++i) *(f32x4*)(src + lane * 4 + 256 * i) = (v[i] * rstd) * gv[i];
  }
}

enum { EPI_AB_IN = 0, EPI_QB = 1, EPI_KVB = 2, EPI_C_IN = 3, EPI_OUT = 4 };
constexpr int G_STR = 144;
constexpr int G_OPER = 256 * G_STR;
constexpr int G_STAGE = 2 * G_OPER;
constexpr int OFF_RSTD = 2 * G_STAGE;
constexpr int LDS_BYTES = OFF_RSTD + 1024;

DI void rope2(float& v0, float& v1, float& v2, float& v3, const float* cs, const float* sn) {
  const f32x2 c = *(const f32x2*)cs, s = *(const f32x2*)sn;
  const float a0 = v0 * c.x - v1 * s.x, a1 = v0 * s.x + v1 * c.x, a2 = v2 * c.y - v3 * s.y, a3 = v2 * s.y + v3 * c.y;
  v0 = a0; v1 = a1; v2 = a2; v3 = a3;
}

template <int EPI>
DI void epi_math(const Params& p, int tok, int f0, float& v0, float& v1, float& v2, float& v3, float rs) {
  const float* ropeA = (const float*)(p.ws + OFF_ROPE);
  const float* ropeB = ropeA + 2 * 8192 * 32;
  const bool lat = tok < T_LAT;
  const int pos = tok & 8191;
  if (EPI == EPI_AB_IN) {
    if (f0 < 640) {
      if (lat) { const int p0 = (f0 & 63) >> 1; rope2(v0, v1, v2, v3, ropeA + pos * 32 + p0, ropeA + 8192 * 32 + pos * 32 + p0); }
      if (f0 < 512) { v0 *= QSCALE_A; v1 *= QSCALE_A; v2 *= QSCALE_A; v3 *= QSCALE_A; }
    } else if (f0 >= 1920 && f0 < 1952) {
      if (lat) { const int p0 = (f0 - 1920) >> 1; rope2(v0, v1, v2, v3, ropeB + pos * 16 + p0, ropeB + 8192 * 16 + pos * 16 + p0); }
    }
  } else if (EPI == EPI_QB) {
    const float s = rs * QSCALE_B;
    v0 *= s; v1 *= s; v2 *= s; v3 *= s;
    const int fh = f0 % 96;
    if (fh >= 64 && lat) { const int p0 = (fh - 64) >> 1; rope2(v0, v1, v2, v3, ropeB + pos * 16 + p0, ropeB + 8192 * 16 + pos * 16 + p0); }
  } else if (EPI == EPI_KVB) {
    v0 *= rs; v1 *= rs; v2 *= rs; v3 *= rs;
  } else if (EPI == EPI_C_IN) {
    if (f0 < 1024) { v0 *= QSCALE_A; v1 *= QSCALE_A; v2 *= QSCALE_A; v3 *= QSCALE_A; }
  }
}

template <int EPI>
DI bf16_t* dst_tr(const Params& p, int tok, int col) {
  if (EPI == EPI_AB_IN) return col < 2464 ? (bf16_t*)(p.ws + OFF_P) + (size_t)tok * 2560 + col : nullptr;
  if (EPI == EPI_QB) return (bf16_t*)(p.ws + OFF_QB) + (size_t)tok * 768 + col;
  if (EPI == EPI_KVB) return (bf16_t*)(p.ws + OFF_KB) + (size_t)tok * 512 + col;
  return (bf16_t*)(p.ws + OFF_P) + (size_t)tok * 3072 + (col >= 3072 ? col - 1024 : col);
}
template <int EPI>
DI bf16_t* dst_v(const Params& p, int t0, int col) {
  int b, key; tok_bk(t0, b, key);
  if (EPI == EPI_KVB) return (bf16_t*)(p.ws + OFF_VTB) + ((size_t)(b * 8 + ((col - 512) >> 6)) * 64 + (col & 63)) * NKEY + key;
  return (bf16_t*)(p.ws + OFF_VT) + ((size_t)(b * 16 + ((col - 2048) >> 6)) * 64 + (col & 63)) * NKEY + key;
}

struct TilePf { bool pre; bool has_next; int nm0, nnt; };
template <int EPI, int TM>
DI void gemm_tile(const Params& p, int layer, const bf16_t* __restrict__ A, int lda, const bf16_t* __restrict__ Bt, int K, int m0, int nt, char* lds,
                  u32x4 (&ra)[TM / 64], u32x4 (&rb)[4], const TilePf pf) {
  constexpr int NJ = TM == 256 ? 4 : 2, NI = TM == 256 ? 2 : 1, NA = TM / 64;
  const int tid = otid(), lane = tid & 63, w = tid >> 6;
  const int wm = TM == 256 ? (w >> 2) : 0, wn = TM == 256 ? (w & 3) : w;
  const int fb = TM == 256 ? wn * 64 : wn * 32, tb = TM == 256 ? wm * 128 : 0;
  const int l31 = lane & 31, hh = lane >> 5;
  const int n0 = nt * 256;
  float* rstd = (float*)(lds + OFF_RSTD);
  const int srow = tid >> 3, scc = tid & 7;
  const bool ablocked = (lda == 0);
  const int nkb = K >> 6;
  const bf16_t* ag = ablocked ? A + ((size_t)((m0 >> 8) * 16) << 14) + (m0 & 255) * 64 + tid * 8 : A + (size_t)(m0 + srow) * lda + scc * 8;
  const size_t a_i = ablocked ? 4096 : (size_t)64 * lda, a_k = ablocked ? 16384 : 64;
  const bf16_t* bg = Bt + ((size_t)(nt * nkb) << 14) + tid * 8;

  if (EPI == EPI_QB || EPI == EPI_KVB) {
    __syncthreads();
    if (tid < 2 * TM) {
      const int r = tid >> 1, half = tid & 1;
      const bf16_t* ap = A + (size_t)(m0 + r) * lda + half * (K / 2);
      float ss = 0.f;
      for (int cidx = 0; cidx < K / 2; cidx += 8) {
        const u32x4 v = *(const u32x4*)(ap + cidx);
#pragma unroll
        for (int e = 0; e < 4; ++e) { const float a = bf_lo(v[e]), b2 = bf_hi(v[e]); ss += a * a + b2 * b2; }
      }
      ss += __shfl_xor(ss, 1);
      if (half == 0) rstd[r] = rsqrtf(ss / (float)K + 1e-6f);
    }
  }

  f32x16 acc[NI][NJ];
#pragma unroll
  for (int i = 0; i < NI; ++i)
#pragma unroll
    for (int j = 0; j < NJ; ++j)
#pragma unroll
      for (int r = 0; r < 16; ++r) acc[i][j][r] = 0.f;

  const int nk = K >> 6;
  if (!pf.pre) {
#pragma unroll
    for (int i = 0; i < NA; ++i) ra[i] = *(const u32x4*)(ag + i * a_i);
#pragma unroll
    for (int i = 0; i < 4; ++i) rb[i] = *(const u32x4*)(bg + i * 4096);
  }
#pragma unroll
  for (int i = 0; i < NA; ++i) *(u32x4*)(lds + (srow + 64 * i) * G_STR + scc * 16) = ra[i];
#pragma unroll
  for (int i = 0; i < 4; ++i) *(u32x4*)(lds + G_OPER + (srow + 64 * i) * G_STR + scc * 16) = rb[i];
#pragma unroll
  for (int i = 0; i < NA; ++i) ra[i] = *(const u32x4*)(ag + i * a_i + a_k);
#pragma unroll
  for (int i = 0; i < 4; ++i) rb[i] = *(const u32x4*)(bg + i * 4096 + 16384);
  __syncthreads();
  for (int kt = 0; kt < nk; ++kt) {
    {
      char* st = lds + ((kt + 1) & 1) * G_STAGE;
#pragma unroll
      for (int i = 0; i < NA; ++i) *(u32x4*)(st + (srow + 64 * i) * G_STR + scc * 16) = ra[i];
#pragma unroll
      for (int i = 0; i < 4; ++i) *(u32x4*)(st + G_OPER + (srow + 64 * i) * G_STR + scc * 16) = rb[i];
    }
    if (kt + 2 < nk) {
#pragma unroll
      for (int i = 0; i < NA; ++i) ra[i] = *(const u32x4*)(ag + i * a_i + (size_t)(kt + 2) * a_k);
#pragma unroll
      for (int i = 0; i < 4; ++i) rb[i] = *(const u32x4*)(bg + i * 4096 + ((size_t)(kt + 2) << 14));
    }
    __builtin_amdgcn_sched_barrier(0);
    const char* as = lds + (kt & 1) * G_STAGE;
    const char* fp = as + G_OPER + (fb + l31) * G_STR + hh * 16;
    const char* sp = as + (tb + l31) * G_STR + hh * 16;
#pragma unroll
    for (int ks = 0; ks < 4; ++ks) {
      bf16x8 f[NI], s[NJ];
#pragma unroll
      for (int i = 0; i < NI; ++i) f[i] = *(const bf16x8*)(fp + i * 32 * G_STR + ks * 32);
#pragma unroll
      for (int j = 0; j < NJ; ++j) s[j] = *(const bf16x8*)(sp + j * 32 * G_STR + ks * 32);
#pragma unroll
      for (int j = 0; j < NJ; ++j)
#pragma unroll
        for (int i = 0; i < NI; ++i) acc[i][j] = MFMA32(f[i], s[j], acc[i][j]);
    }
    __syncthreads();
  }

  auto prefetch_next = [&]() {
    if (TM == 256 && pf.has_next) {
      const bf16_t* nag = ablocked ? A + ((size_t)((pf.nm0 >> 8) * 16) << 14) + (pf.nm0 & 255) * 64 + tid * 8 : A + (size_t)(pf.nm0 + srow) * lda + scc * 8;
      const bf16_t* nbg = Bt + ((size_t)(pf.nnt * nkb) << 14) + tid * 8;
#pragma unroll
      for (int i = 0; i < NA; ++i) ra[i] = *(const u32x4*)(nag + i * a_i);
#pragma unroll
      for (int i = 0; i < 4; ++i) rb[i] = *(const u32x4*)(nbg + i * 4096);
      __builtin_amdgcn_sched_barrier(0);
    }
  };
  constexpr int SB = 528;
  constexpr int SV = TM * 2 + 16;
  constexpr int NIT = TM * 32 / NT;
  if (EPI == EPI_OUT) {
    const int bb = m0 < T_LAT ? (m0 >> 13) : 4;
#pragma unroll
    for (int h = 0; h < 2; ++h) {
      if ((TM == 256 ? (wn >> 1) : (wn >> 2)) == h) {
#pragma unroll
        for (int j = 0; j < NJ; ++j)
#pragma unroll
          for (int i = 0; i < NI; ++i)
#pragma unroll
            for (int g = 0; g < 4; ++g) {
              f32x4 v; v[0] = acc[i][j][4 * g]; v[1] = acc[i][j][4 * g + 1]; v[2] = acc[i][j][4 * g + 2]; v[3] = acc[i][j][4 * g + 3];
              *(f32x4*)(lds + (tb + j * 32 + l31) * SB + ((fb & 127) + i * 32 + 8 * g + 4 * hh) * 4) = v;
            }
      }
      if (h == 1) prefetch_next();
      __syncthreads();
      const float* gate = (const float*)(p.ws + OFF_MOD) + (size_t)(layer * 5 + bb) * 3072 + 2048 + n0 + h * 128;
#pragma unroll 4
      for (int it = 0; it < NIT; ++it) {
        const int cidx = tid + NT * it, row = cidx >> 5, ch = cidx & 31;
        const f32x4 y = *(const f32x4*)(lds + row * SB + ch * 16);
        const f32x4 gt = *(const f32x4*)(gate + ch * 4);
        const f32x4 old = *(const f32x4*)(h_src(p, layer, m0 + row) + n0 + h * 128 + ch * 4);
        *(f32x4*)(h_dst(p, m0 + row) + n0 + h * 128 + ch * 4) = old + gt * y;
      }
      __syncthreads();
    }
  } else {
    const bool vt = (EPI == EPI_KVB && nt >= 2) || (EPI == EPI_C_IN && nt >= 8 && nt < 12);
#pragma unroll
    for (int j = 0; j < NJ; ++j) {
      const int rl = tb + j * 32 + l31;
      float rs = 1.f;
      if (EPI == EPI_QB || EPI == EPI_KVB) rs = rstd[rl];
#pragma unroll
      for (int i = 0; i < NI; ++i)
#pragma unroll
        for (int g = 0; g < 4; ++g) {
          const int fl = fb + i * 32 + 8 * g + 4 * hh;
          float v0 = acc[i][j][4 * g], v1 = acc[i][j][4 * g + 1], v2 = acc[i][j][4 * g + 2], v3 = acc[i][j][4 * g + 3];
          epi_math<EPI>(p, m0 + rl, n0 + fl, v0, v1, v2, v3, rs);
          const unsigned w01 = pack_bf16(v0, v1), w23 = pack_bf16(v2, v3);
          if (!vt) {
            u32x2 wv; wv.x = w01; wv.y = w23;
            *(u32x2*)(lds + rl * SB + fl * 2) = wv;
          } else {
            *(bf16_t*)(lds + (fl + 0) * SV + rl * 2) = (bf16_t)(w01 & 0xffffu);
            *(bf16_t*)(lds + (fl + 1) * SV + rl * 2) = (bf16_t)(w01 >> 16);
            *(bf16_t*)(lds + (fl + 2) * SV + rl * 2) = (bf16_t)(w23 & 0xffffu);
            *(bf16_t*)(lds + (fl + 3) * SV + rl * 2) = (bf16_t)(w23 >> 16);
          }
        }
    }
    prefetch_next();
    __syncthreads();
#pragma unroll 4
    for (int it = 0; it < NIT; ++it) {
      const int cidx = tid + NT * it;
      if (vt) {
        const int row = cidx / (TM / 8), ch = cidx % (TM / 8);
        *(u32x4*)dst_v<EPI>(p, m0 + ch * 8, n0 + row) = *(const u32x4*)(lds + row * SV + ch * 16);
      } else {
        const int row = cidx >> 5, ch = cidx & 31;
        bf16_t* d = dst_tr<EPI>(p, m0 + row, n0 + ch * 8);
        if (d) *(u32x4*)d = *(const u32x4*)(lds + row * SB + ch * 16);
      }
    }
    __syncthreads();
  }
}

template <int EPI>
DI void gemm_phase(const Params& p, int layer, const bf16_t* A, int lda, const bf16_t* Bt, int K, int mtiles, int ntiles, bool ctx, bool reverse, char* lds) {
  const int G = ogrid();
  const int bid = reverse ? (G - 1 - obid()) : obid();
  u32x4 ra[4], rb[4];
  const bool simple = (G & 7) != 0;
  const int xcd = bid & 7, local = simple ? bid : (bid >> 3), nlocal = simple ? G : (G >> 3);
  const int mlo = simple ? 0 : ((xcd * mtiles) >> 3), cnt = simple ? mtiles : ((((xcd + 1) * mtiles) >> 3) - mlo);
  const int total = cnt * ntiles, gsize = 4 * ntiles;
  auto tile_of = [&](int j, int& m0, int& nt) {
    const int g = j / gsize, r = j - g * gsize;
    int gm = cnt - g * 4; gm = gm > 4 ? 4 : gm;
    m0 = (mlo + g * 4 + (r % gm)) * 256; nt = r / gm;
  };
  bool pre = false;
  for (int j = local; j < total; j += nlocal) {
    int m0, nt; tile_of(j, m0, nt);
    TilePf pf; pf.pre = pre; pf.has_next = (j + nlocal < total); pf.nm0 = 0; pf.nnt = 0;
    if (pf.has_next) tile_of(j + nlocal, pf.nm0, pf.nnt);
    gemm_tile<EPI, 256>(p, layer, A, lda, Bt, K, m0, nt, lds, ra, rb, pf);
    pre = pf.has_next;
  }
  if (ctx) {
    const int b2 = G - 1 - bid;
    u32x4 ra1[1];
    TilePf pf; pf.pre = false; pf.has_next = false; pf.nm0 = 0; pf.nnt = 0;
    for (int u = b2; u < 16 * ntiles; u += G) gemm_tile<EPI, 64>(p, layer, A, lda, Bt, K, T_LAT + (u & 15) * 64, u >> 4, lds, ra1, rb, pf);
  }
}

DI void vta_phase(const Params& p, char* lds) {
  const int tid = otid();
  const bf16_t* Pb = (const bf16_t*)(p.ws + OFF_P);
  for (int u = ogrid() - 1 - obid(); u < T_ALL / 64; u += ogrid()) {
    const int t0 = u * 64;
#pragma unroll
    for (int it = 0; it < 2; ++it) {
      const int cidx = tid + NT * it, row = cidx >> 4, ch = cidx & 15;
      *(u32x4*)(lds + row * 272 + ch * 16) = *(const u32x4*)(Pb + (size_t)(t0 + row) * 2560 + 640 + ch * 8);
    }
    __syncthreads();
    int b, key; tok_bk(t0, b, key);
#pragma unroll
    for (int it = 0; it < 2; ++it) {
      const int cidx = tid + NT * it, f = cidx & 127, tc = cidx >> 7;
      unsigned short e[8];
#pragma unroll
      for (int k = 0; k < 8; ++k) e[k] = *(const bf16_t*)(lds + (tc * 8 + k) * 272 + f * 2);
      u32x4 v; v.x = e[0] | ((unsigned)e[1] << 16); v.y = e[2] | ((unsigned)e[3] << 16); v.z = e[4] | ((unsigned)e[5] << 16); v.w = e[6] | ((unsigned)e[7] << 16);
      *(u32x4*)((bf16_t*)(p.ws + OFF_VT) + ((size_t)(b * 2 + (f >> 6)) * 64 + (f & 63)) * NKEY + key + tc * 8) = v;
    }
    __syncthreads();
  }
}

template <int MODE>
DI void attn_item(const Params& p, int layer, int b, int qt, int head, bool is_ctx, char* lds) {
  constexpr int DK = (MODE == 1) ? 96 : 64;
  constexpr int NKS = DK / 16;
  constexpr int KSTR = DK * 2 + 16;
  constexpr int VSTR = 144;
  constexpr int KBYTES = 64 * KSTR;
  constexpr int STAGE = KBYTES + 64 * VSTR;
  constexpr int QPB = 256;
  constexpr int NKC = DK / 8;
  constexpr int KCH = 64 * NKC;
  constexpr int OSTR = 272;
  constexpr float MASKV = -1e30f;
  float* rpbs = (float*)(lds + 4 * STAGE);
  char* ostage = lds;

  const int tid = otid(), lane = tid & 63, w = tid >> 6, l31 = lane & 31, hh = lane >> 5;
  const int i2 = layer >> 1;
  const bf16_t* Pb = (const bf16_t*)(p.ws + OFF_P);
  bf16_t* UG = (bf16_t*)(p.ws + OFF_UG);
  const bf16_t *Qp, *Kp, *Krp = nullptr, *Zp, *Vt;
  int ldq, ldk, ldz, gcol;
  if (MODE == 0) {
    Qp = Pb + head * 64; ldq = 2560; Kp = Pb + 512 + (head >> 2) * 64; ldk = 2560;
    Vt = (const bf16_t*)(p.ws + OFF_VT) + (size_t)(b * 2 + (head >> 2)) * 64 * NKEY;
    Zp = Pb + 768 + head * 64; ldz = 2560; gcol = head * 64;
  } else if (MODE == 1) {
    Qp = (const bf16_t*)(p.ws + OFF_QB) + head * 96; ldq = 768; Kp = (const bf16_t*)(p.ws + OFF_KB) + head * 64; ldk = 512; Krp = Pb + 1920;
    Vt = (const bf16_t*)(p.ws + OFF_VTB) + (size_t)(b * 8 + head) * 64 * NKEY;
    Zp = Pb + 1952 + head * 64; ldz = 2560; gcol = 512 + head * 64;
  } else {
    Qp = Pb + head * 64; ldq = 3072; Kp = Pb + 1024 + head * 64; ldk = 3072;
    Vt = (const bf16_t*)(p.ws + OFF_VT) + (size_t)(b * 16 + head) * 64 * NKEY;
    Zp = Pb + 2048 + head * 64; ldz = 3072; gcol = head * 64;
  }
  const int qtok0 = is_ctx ? T_LAT + b * 256 : b * 8192 + qt * QPB;

  int lat_lo = 0, nlat = 0;
  if (!is_ctx) {
    if (MODE == 0) {
      int lo = 4 * qt - 2; if (lo < 0) lo = 0;
      int hi = 4 * qt + 5; if (hi > 127) hi = 127;
      lat_lo = lo; nlat = hi - lo + 1;
    } else if (MODE == 1) { lat_lo = 0; nlat = 128; }
    else {
      int lo = 4 * qt - 4; lo = lo < 0 ? 0 : (lo > 120 ? 120 : lo);
      int hi = 4 * qt + 3 - 4; hi = hi < 0 ? 0 : (hi > 120 ? 120 : hi); hi += 7;
      lat_lo = lo; nlat = hi - lo + 1;
    }
  }
  const int ntiles = nlat + 4;

  const bool nat2 = (MODE == 2) && !is_ctx;
  auto tokmap = [&](int row) { return nat2 ? qtok0 + ((w >> 2) * 2 + (row >> 4)) * 64 + (w & 3) * 16 + (row & 15) : qtok0 + w * 32 + row; };
  const int qtok = tokmap(l31);
  bf16x8 qf[NKS];
#pragma unroll
  for (int ks = 0; ks < NKS; ++ks) qf[ks] = *(const bf16x8*)(Qp + (size_t)qtok * ldq + ks * 16 + hh * 8);
  if (MODE == 2 && !is_ctx) {
    for (int i = tid; i < 465; i += NT) rpbs[i] = p.c_rpb[(size_t)(i2 * 16 + head) * 465 + i] * LOG2E;
  }
  float m_ = (MODE == 0) ? p.a_sink[i2 * 8 + head] * LOG2E : MASKV;
  float l_ = (MODE == 0 && hh == 0) ? 1.f : 0.f;
  f32x16 O[2];
#pragma unroll
  for (int dh = 0; dh < 2; ++dh)
#pragma unroll
    for (int r = 0; r < 16; ++r) O[dh][r] = 0.f;

  const int k0row = tid / NKC, k0cc = tid % NKC;
  const int k1row = (tid + NT) / NKC, k1cc = (tid + NT) % NKC;
  const bool k1 = (KCH > NT) && (tid + NT < KCH);
  struct Stg { u32x4 k0, k1, v; };
  Stg R0, R1;
  R0.k1 = (u32x4){0u, 0u, 0u, 0u}; R1.k1 = R0.k1;
  auto tile_kt = [&](int i) { return i < nlat ? lat_lo + i : 128 + (i - nlat); };
  auto kload = [&](int krow0, int row, int cc) -> u32x4 {
    if (MODE == 1 && cc >= 8) return *(const u32x4*)(Krp + (size_t)(krow0 + row) * 2560 + (cc - 8) * 8);
    return *(const u32x4*)(Kp + (size_t)(krow0 + row) * ldk + cc * 8);
  };
  auto gload = [&](int i, Stg& r) {
    const int kt = tile_kt(i < ntiles ? i : ntiles - 1);
    const int krow0 = kt < 128 ? b * 8192 + kt * 64 : T_LAT + b * 256 + (kt - 128) * 64;
    r.k0 = kload(krow0, k0row, k0cc);
    if (k1) r.k1 = kload(krow0, k1row, k1cc);
    r.v = *(const u32x4*)(Vt + (size_t)(tid >> 3) * NKEY + kt * 64 + (tid & 7) * 8);
  };
  auto lstore = [&](int st, const Stg& r) {
    char* kb = lds + st * STAGE;
    *(u32x4*)(kb + k0row * KSTR + k0cc * 16) = r.k0;
    if (k1) *(u32x4*)(kb + k1row * KSTR + k1cc * 16) = r.k1;
    *(u32x4*)(kb + KBYTES + (tid >> 3) * VSTR + (tid & 7) * 16) = r.v;
  };

  const int pr = (l31 & ~12) | ((l31 & 4) << 1) | ((l31 & 8) >> 1);
  int qr = 0, qc = 0, rs0 = 0, cs = 0, csw = 0, wlo = 0, whi = 0;
  if (MODE == 2) {
    qr = qt * 4 + (w >> 2) * 2 + (l31 >> 4); qc = (w & 3) * 16 + (l31 & 15);
    rs0 = qr - 4; rs0 = rs0 < 0 ? 0 : (rs0 > 120 ? 120 : rs0);
    cs = qc - 8; cs = cs < 0 ? 0 : (cs > 48 ? 48 : cs);
    csw = (w & 3) * 16 - 8; csw = csw < 0 ? 0 : (csw > 32 ? 32 : csw);
    const int r_lo = qt * 4 + (w >> 2) * 2;
    wlo = r_lo - 4; wlo = wlo < 0 ? 0 : (wlo > 120 ? 120 : wlo);
    whi = r_lo + 1 - 4; whi = whi < 0 ? 0 : (whi > 120 ? 120 : whi); whi += 7;
  }
  const int s0w = qt * QPB + w * 32;
  const int nsup = (ntiles + 1) >> 1;
  __syncthreads();
  gload(0, R0); gload(1, R1);
  lstore(0, R0); lstore(1, R1);
  gload(2, R0); gload(3, R1);
  __syncthreads();
  auto body = [&](int it, const char* kb) {
    const char* vb = kb + KBYTES;
    const int kt = tile_kt(it);
    const bool lat_tile = it < nlat;
    bool skip = (it >= ntiles);
    if (MODE == 2 && lat_tile) skip = (kt < wlo) || (kt > whi);
    if (MODE == 0 && lat_tile) skip = (kt * 64 + 63 < s0w - 128) || (kt * 64 > s0w + 31 + 128);
    const int nsub = (MODE == 2 && lat_tile) ? 1 : 2;
    const int krb = (MODE == 2 && lat_tile) ? csw : 0;
    if (!skip) {
      f32x16 S[2];
#pragma unroll
      for (int t = 0; t < 2; ++t)
#pragma unroll
        for (int r = 0; r < 16; ++r) S[t][r] = 0.f;
#pragma unroll
      for (int ks = 0; ks < NKS; ++ks) {
        const bf16x8 a0 = *(const bf16x8*)(kb + (krb + pr) * KSTR + ks * 32 + hh * 16);
        S[0] = MFMA32(a0, qf[ks], S[0]);
        if (nsub == 2) {
          const bf16x8 a1 = *(const bf16x8*)(kb + (32 + pr) * KSTR + ks * 32 + hh * 16);
          S[1] = MFMA32(a1, qf[ks], S[1]);
        }
      }
      if (MODE == 0 && lat_tile) {
        const int s = qt * QPB + w * 32 + l31;
#pragma unroll
        for (int t = 0; t < 2; ++t)
#pragma unroll
          for (int r = 0; r < 16; ++r) {
            const int kk = kt * 64 + t * 32 + 16 * (r >> 3) + 8 * hh + (r & 7);
            const int d = kk - s;
            if (d > 128 || d < -128) S[t][r] = MASKV;
          }
      }
      if (MODE == 2 && lat_tile) {
        int ri = kt - qr + 7; ri = ri < 0 ? 0 : (ri > 14 ? 14 : ri);
        const float* brow = rpbs + ri * 31;
        const bool rok = (kt >= rs0) && (kt <= rs0 + 7);
#pragma unroll
        for (int r = 0; r < 16; ++r) {
          const int kc = csw + 16 * (r >> 3) + 8 * hh + (r & 7);
          int bi = kc - qc + 15; bi = bi < 0 ? 0 : (bi > 30 ? 30 : bi);
          const bool ok = rok && (kc >= cs) && (kc < cs + 16);
          S[0][r] = ok ? S[0][r] + brow[bi] : MASKV;
        }
      }
      float mx = S[0][0];
#pragma unroll
      for (int r = 0; r < 16; ++r) mx = fmaxf(mx, S[0][r]);
      if (nsub == 2) {
#pragma unroll
        for (int r = 0; r < 16; ++r) mx = fmaxf(mx, S[1][r]);
      }
      mx = fmaxf(mx, __shfl_xor(mx, 32));
      if (__any(mx > m_ + 8.f)) {
        const float mnew = fmaxf(m_, mx);
        const float alpha = fexp2(m_ - mnew);
        m_ = mnew;
        l_ *= alpha;
#pragma unroll
        for (int dh = 0; dh < 2; ++dh)
#pragma unroll
          for (int r = 0; r < 16; ++r) O[dh][r] *= alpha;
      }
      float rsum = 0.f;
#pragma unroll
      for (int t = 0; t < 2; ++t)
        if (t < nsub) {
#pragma unroll
          for (int r = 0; r < 16; ++r) { const float e = fexp2(S[t][r] - m_); S[t][r] = e; rsum += e; }
        }
      l_ += rsum;
#pragma unroll
      for (int t = 0; t < 2; ++t)
       if (t < nsub)
#pragma unroll
        for (int s = 0; s < 2; ++s) {
          u32x4 u;
          u.x = pack_bf16(S[t][8 * s + 0], S[t][8 * s + 1]); u.y = pack_bf16(S[t][8 * s + 2], S[t][8 * s + 3]);
          u.z = pack_bf16(S[t][8 * s + 4], S[t][8 * s + 5]); u.w = pack_bf16(S[t][8 * s + 6], S[t][8 * s + 7]);
          const bf16x8 pf = __builtin_bit_cast(bf16x8, u);
#pragma unroll
          for (int dh = 0; dh < 2; ++dh) {
            const bf16x8 v = *(const bf16x8*)(vb + (dh * 32 + l31) * VSTR + (krb + t * 32 + s * 16 + hh * 8) * 2);
            O[dh] = MFMA32(v, pf, O[dh]);
          }
        }
    }
  };
  for (int j = 0; j < nsup; ++j) {
    const char* sb = lds + (j & 1) * 2 * STAGE;
    body(2 * j, sb);
    body(2 * j + 1, sb + STAGE);
    __builtin_amdgcn_sched_barrier(0);
    {
      const int so = ((j + 1) & 1) * 2;
      lstore(so, R0); lstore(so + 1, R1);
      gload(2 * j + 4, R0); gload(2 * j + 5, R1);
    }
    __syncthreads();
  }

  {
    const float lt = l_ + __shfl_xor(l_, 32);
    const float inv = 1.f / lt;
    char* orow = ostage + (w * 32) * OSTR;
#pragma unroll
    for (int dh = 0; dh < 2; ++dh)
#pragma unroll
      for (int g = 0; g < 4; ++g) {
        f32x4 v; v[0] = O[dh][4 * g] * inv; v[1] = O[dh][4 * g + 1] * inv; v[2] = O[dh][4 * g + 2] * inv; v[3] = O[dh][4 * g + 3] * inv;
        *(f32x4*)(orow + l31 * OSTR + (dh * 32 + 8 * g + 4 * hh) * 4) = v;
      }
    __builtin_amdgcn_s_waitcnt(0xc07f);
#pragma unroll
    for (int it = 0; it < 4; ++it) {
      const int cidx = lane + 64 * it, row = cidx >> 3, ch = cidx & 7;
      const f32x4 o0 = *(const f32x4*)(orow + row * OSTR + ch * 32), o1 = *(const f32x4*)(orow + row * OSTR + ch * 32 + 16);
      const int tok = tokmap(row);
      const u32x4 z = *(const u32x4*)(Zp + (size_t)tok * ldz + ch * 8);
      u32x4 wv;
      wv.x = pack_bf16(o0[0] * silu(bf_lo(z.x)), o0[1] * silu(bf_hi(z.x)));
      wv.y = pack_bf16(o0[2] * silu(bf_lo(z.y)), o0[3] * silu(bf_hi(z.y)));
      wv.z = pack_bf16(o1[0] * silu(bf_lo(z.z)), o1[1] * silu(bf_hi(z.z)));
      wv.w = pack_bf16(o1[2] * silu(bf_lo(z.w)), o1[3] * silu(bf_hi(z.w)));
      *(u32x4*)(UG + ablk(tok, gcol + ch * 8)) = wv;
    }
  }
}

DI void mla_item2(const Params& p, int layer, int b, int qt, int head, char* lds) {
  constexpr int DK = 96, NKS = 6, KSTR = DK * 2 + 16, VSTR = 144, KBYTES = 64 * KSTR, STAGE = KBYTES + 64 * VSTR;
  constexpr int NKC = 12, KCH = 64 * NKC, OSTR = 272, QG = 2, NTILES = 132;
  constexpr float MASKV = -1e30f;
  char* ostage = lds;
  const int tid = otid(), lane = tid & 63, w = tid >> 6, l31 = lane & 31, hh = lane >> 5;
  const bf16_t* Pb = (const bf16_t*)(p.ws + OFF_P);
  bf16_t* UG = (bf16_t*)(p.ws + OFF_UG);
  const bf16_t* Qp = (const bf16_t*)(p.ws + OFF_QB) + head * 96;
  const bf16_t* Kp = (const bf16_t*)(p.ws + OFF_KB) + head * 64;
  const bf16_t* Krp = Pb + 1920;
  const bf16_t* Vt = (const bf16_t*)(p.ws + OFF_VTB) + (size_t)(b * 8 + head) * 64 * NKEY;
  const bf16_t* Zp = Pb + 1952 + head * 64;
  const int gcol = 512 + head * 64;
  const int qtok0 = b * 8192 + qt * 512;
  bf16x8 qf[QG][NKS];
#pragma unroll
  for (int qg = 0; qg < QG; ++qg)
#pragma unroll
    for (int ks = 0; ks < NKS; ++ks) qf[qg][ks] = *(const bf16x8*)(Qp + (size_t)(qtok0 + qg * 256 + w * 32 + l31) * 768 + ks * 16 + hh * 8);
  float m_[QG], l_[QG];
  f32x16 O[QG][2];
#pragma unroll
  for (int qg = 0; qg < QG; ++qg) {
    m_[qg] = MASKV; l_[qg] = 0.f;
#pragma unroll
    for (int dh = 0; dh < 2; ++dh)
#pragma unroll
      for (int r = 0; r < 16; ++r) O[qg][dh][r] = 0.f;
  }
  const int k0row = tid / NKC, k0cc = tid % NKC;
  const int k1row = (tid + NT) / NKC, k1cc = (tid + NT) % NKC;
  const bool k1 = (tid + NT < KCH);
  struct Stg { u32x4 k0, k1, v; };
  Stg R0;
  R0.k1 = (u32x4){0u, 0u, 0u, 0u};
  auto kload = [&](int krow0, int row, int cc) -> u32x4 {
    if (cc >= 8) return *(const u32x4*)(Krp + (size_t)(krow0 + row) * 2560 + (cc - 8) * 8);
    return *(const u32x4*)(Kp + (size_t)(krow0 + row) * 512 + cc * 8);
  };
  auto gload = [&](int i, Stg& r) {
    const int kt = i < NTILES ? i : NTILES - 1;
    const int krow0 = kt < 128 ? b * 8192 + kt * 64 : T_LAT + b * 256 + (kt - 128) * 64;
    r.k0 = kload(krow0, k0row, k0cc);
    if (k1) r.k1 = kload(krow0, k1row, k1cc);
    r.v = *(const u32x4*)(Vt + (size_t)(tid >> 3) * NKEY + kt * 64 + (tid & 7) * 8);
  };
  auto lstore = [&](int st, const Stg& r) {
    char* kb = lds + st * STAGE;
    *(u32x4*)(kb + k0row * KSTR + k0cc * 16) = r.k0;
    if (k1) *(u32x4*)(kb + k1row * KSTR + k1cc * 16) = r.k1;
    *(u32x4*)(kb + KBYTES + (tid >> 3) * VSTR + (tid & 7) * 16) = r.v;
  };
  const int pr = (l31 & ~12) | ((l31 & 4) << 1) | ((l31 & 8) >> 1);
  __syncthreads();
  gload(0, R0); lstore(0, R0);
  gload(1, R0);
  __syncthreads();
  auto body = [&](const char* kb) {
    const char* vb = kb + KBYTES;
    f32x16 S[QG][2];
#pragma unroll
    for (int qg = 0; qg < QG; ++qg)
#pragma unroll
      for (int t = 0; t < 2; ++t)
#pragma unroll
        for (int r = 0; r < 16; ++r) S[qg][t][r] = 0.f;
#pragma unroll
    for (int ks = 0; ks < NKS; ++ks) {
      const bf16x8 a0 = *(const bf16x8*)(kb + pr * KSTR + ks * 32 + hh * 16);
      const bf16x8 a1 = *(const bf16x8*)(kb + (32 + pr) * KSTR + ks * 32 + hh * 16);
#pragma unroll
      for (int qg = 0; qg < QG; ++qg) { S[qg][0] = MFMA32(a0, qf[qg][ks], S[qg][0]); S[qg][1] = MFMA32(a1, qf[qg][ks], S[qg][1]); }
    }
#pragma unroll
    for (int qg = 0; qg < QG; ++qg) {
      float mx = S[qg][0][0];
#pragma unroll
      for (int t = 0; t < 2; ++t)
#pragma unroll
        for (int r = 0; r < 16; ++r) mx = fmaxf(mx, S[qg][t][r]);
      mx = fmaxf(mx, __shfl_xor(mx, 32));
      if (__any(mx > m_[qg] + 8.f)) {
        const float mnew = fmaxf(m_[qg], mx);
        const float alpha = fexp2(m_[qg] - mnew);
        m_[qg] = mnew;
        l_[qg] *= alpha;
#pragma unroll
        for (int dh = 0; dh < 2; ++dh)
#pragma unroll
          for (int r = 0; r < 16; ++r) O[qg][dh][r] *= alpha;
      }
      float rsum = 0.f;
#pragma unroll
      for (int t = 0; t < 2; ++t)
#pragma unroll
        for (int r = 0; r < 16; ++r) { const float e = fexp2(S[qg][t][r] - m_[qg]); S[qg][t][r] = e; rsum += e; }
      l_[qg] += rsum;
    }
#pragma unroll
    for (int t = 0; t < 2; ++t)
#pragma unroll
      for (int s = 0; s < 2; ++s) {
        bf16x8 pf[QG];
#pragma unroll
        for (int qg = 0; qg < QG; ++qg) {
          u32x4 u;
          u.x = pack_bf16(S[qg][t][8 * s + 0], S[qg][t][8 * s + 1]); u.y = pack_bf16(S[qg][t][8 * s + 2], S[qg][t][8 * s + 3]);
          u.z = pack_bf16(S[qg][t][8 * s + 4], S[qg][t][8 * s + 5]); u.w = pack_bf16(S[qg][t][8 * s + 6], S[qg][t][8 * s + 7]);
          pf[qg] = __builtin_bit_cast(bf16x8, u);
        }
#pragma unroll
        for (int dh = 0; dh < 2; ++dh) {
          const bf16x8 v = *(const bf16x8*)(vb + (dh * 32 + l31) * VSTR + (t * 32 + s * 16 + hh * 8) * 2);
#pragma unroll
          for (int qg = 0; qg < QG; ++qg) O[qg][dh] = MFMA32(v, pf[qg], O[qg][dh]);
        }
      }
  };
  for (int j = 0; j < NTILES; ++j) {
    body(lds + (j & 1) * STAGE);
    __builtin_amdgcn_sched_barrier(0);
    lstore((j + 1) & 1, R0);
    gload(j + 2, R0);
    __syncthreads();
  }
#pragma unroll
  for (int qg = 0; qg < QG; ++qg) {
    const float lt = l_[qg] + __shfl_xor(l_[qg], 32);
    const float inv = 1.f / lt;
    char* orow = ostage + (w * 32) * OSTR;
#pragma unroll
    for (int dh = 0; dh < 2; ++dh)
#pragma unroll
      for (int g = 0; g < 4; ++g) {
        f32x4 v; v[0] = O[qg][dh][4 * g] * inv; v[1] = O[qg][dh][4 * g + 1] * inv; v[2] = O[qg][dh][4 * g + 2] * inv; v[3] = O[qg][dh][4 * g + 3] * inv;
        *(f32x4*)(orow + l31 * OSTR + (dh * 32 + 8 * g + 4 * hh) * 4) = v;
      }
    __builtin_amdgcn_s_waitcnt(0xc07f);
#pragma unroll
    for (int it = 0; it < 4; ++it) {
      const int cidx = lane + 64 * it, row = cidx >> 3, ch = cidx & 7;
      const f32x4 o0 = *(const f32x4*)(orow + row * OSTR + ch * 32), o1 = *(const f32x4*)(orow + row * OSTR + ch * 32 + 16);
      const int tok = qtok0 + qg * 256 + w * 32 + row;
      const u32x4 z = *(const u32x4*)(Zp + (size_t)tok * 2560 + ch * 8);
      u32x4 wv;
      wv.x = pack_bf16(o0[0] * silu(bf_lo(z.x)), o0[1] * silu(bf_hi(z.x)));
      wv.y = pack_bf16(o0[2] * silu(bf_lo(z.y)), o0[3] * silu(bf_hi(z.y)));
      wv.z = pack_bf16(o1[0] * silu(bf_lo(z.z)), o1[1] * silu(bf_hi(z.z)));
      wv.w = pack_bf16(o1[2] * silu(bf_lo(z.w)), o1[3] * silu(bf_hi(z.w)));
      *(u32x4*)(UG + ablk(tok, gcol + ch * 8)) = wv;
    }
    __builtin_amdgcn_s_waitcnt(0xc07f);
  }
}

DI void attn_phase_ab(const Params& p, int layer, char* lds) {
  const int G = ogrid();
  for (int v = obid(); v < 512; v += G) {
    const int xcd = v & 7, s = v >> 3;
    const int grp = (s >> 4) * 8 + xcd, qt = s & 15;
    mla_item2(p, layer, grp >> 3, qt, grp & 7, lds);
  }
  for (int v = obid(); v < 32; v += G) attn_item<1>(p, layer, v >> 3, 0, v & 7, true, lds);
  for (int v = obid(); v < 1024 + 32; v += G) {
    if (v < 1024) attn_item<0>(p, layer, v >> 8, v & 31, (v >> 5) & 7, false, lds);
    else { const int c = v - 1024; attn_item<0>(p, layer, c >> 3, 0, c & 7, true, lds); }
  }
}

DI void attn_phase_c(const Params& p, int layer, char* lds) {
  const int G = ogrid();
  const int nctx = (layer == 3) ? 0 : 64;
  for (int v = obid(); v < 2048 + nctx; v += G) {
    if (v < 2048) attn_item<2>(p, layer, v >> 9, v & 31, (v >> 5) & 15, false, lds);
    else { const int c = v - 2048; attn_item<2>(p, layer, c >> 4, 0, c & 15, true, lds); }
  }
}

__global__ void __launch_bounds__(512, 2) fwd_megakernel(Params p) {
  __shared__ __attribute__((aligned(16))) char lds[LDS_BYTES];
  __shared__ uint4 xb_words;
  if (threadIdx.x == 0) xb_words = make_uint4(0u, 0u, 0u, 0u);
  __syncthreads();
  if (obid() == 0) { unsigned* bw = (unsigned*)(p.ws + OFF_BAR); for (int i = otid(); i < 4096; i += NT) bw[i] = 0u; }
  XcdBarrier xb; xb.bar = (unsigned*)(p.ws + OFF_BAR); xb.x = 0; xb.st = (volatile LAS unsigned*)&xb_words;
  bool first = true, posted = false;
  for (int ph = p.ph_begin; ph < p.ph_end; ++ph) {
    const int layer = (ph - 1) / 5, s = (ph - 1) % 5;
    const bool even = (layer & 1) == 0;
    const int i2 = layer >> 1;
    if (ph >= 1 && ph <= 20 && s == 2 && !even) continue;
    if (!first) {
      if (!posted) { cg::this_grid().sync(); xb = xcd_barrier_post((unsigned*)(p.ws + OFF_BAR), (volatile LAS unsigned*)&xb_words); posted = true; }
      else xcd_barrier(xb);
    }
    first = false;
    if (ph == 0) prologue_phase(p, lds);
    else if (ph == 21) final_phase(p);
    else if (s == 0) norm_phase(p, layer);
    else if (s == 1) {
      const bf16_t* U = (const bf16_t*)(p.ws + OFF_UG);
      for (int rep = 0; rep < REP_GEMM; ++rep) {
        if (even) gemm_phase<EPI_AB_IN>(p, layer, U, 0, (const bf16_t*)(p.ws + OFF_W_IN) + (size_t)i2 * 2560 * 1024, 1024, 128, 10, true, false, lds);
        else gemm_phase<EPI_C_IN>(p, layer, U, 0, (const bf16_t*)(p.ws + OFF_W_CIN) + (size_t)i2 * 4096 * 1024, 1024, 128, 16, true, false, lds);
        if (rep + 1 < REP_GEMM) xcd_barrier(xb);
      }
    } else if (s == 2) {
      const bf16_t* Pb = (const bf16_t*)(p.ws + OFF_P);
      gemm_phase<EPI_QB>(p, layer, Pb + 1280, 2560, (const bf16_t*)(p.ws + OFF_W_UQ) + (size_t)i2 * 768 * 384, 384, 128, 3, true, false, lds);
      gemm_phase<EPI_KVB>(p, layer, Pb + 1664, 2560, (const bf16_t*)(p.ws + OFF_W_UKV) + (size_t)i2 * 1024 * 256, 256, 128, 4, true, true, lds);
      vta_phase(p, lds);
    } else if (s == 3) {
      for (int rep = 0; rep < REP_ATTN; ++rep) {
        if (even) attn_phase_ab(p, layer, lds); else attn_phase_c(p, layer, lds);
        if (rep + 1 < REP_ATTN) xcd_barrier(xb);
      }
    } else {
      const bf16_t* Gm = (const bf16_t*)(p.ws + OFF_UG);
      const bf16_t* W = even ? (const bf16_t*)(p.ws + OFF_W_OUT) + (size_t)i2 * 1024 * 1024 : (const bf16_t*)(p.ws + OFF_W_COUT) + (size_t)i2 * 1024 * 1024;
      gemm_phase<EPI_OUT>(p, layer, Gm, 0, W, 1024, 128, 4, layer != 3, false, lds);
    }
  }
}

extern "C" void kernel_launch(void* const* d_in, const int* in_sizes, int n_in, void* d_out, int out_size, void* d_ws, size_t ws_size,
                              hipStream_t stream) {
  static int grid_blocks = 0;
  if (!grid_blocks) {
    int dev = 0, cus = 0, per_cu = 0;
    hipGetDevice(&dev);
    hipDeviceGetAttribute(&cus, hipDeviceAttributeMultiprocessorCount, dev);
    hipOccupancyMaxActiveBlocksPerMultiprocessor(&per_cu, fwd_megakernel, NT, 0);
    per_cu = 1;
    grid_blocks = cus * per_cu;
    if (ws_size < OFF_END) fprintf(stderr, "kernel_launch: workspace too small: %zu < %zu\n", ws_size, (size_t)OFF_END);
  }
  Params p{};
  const float** f = (const float**)&p;
  for (int i = 0; i < 18; ++i) f[i] = (const float*)d_in[i];
  p.out = (float*)d_out;
  p.ws = (char*)d_ws;
#if MK_MULTI_LAUNCH
  for (int ph = 0; ph < 22; ++ph) {
    if (ph >= 1 && ph <= 20 && ((ph - 1) % 5) == 2 && (((ph - 1) / 5) & 1)) continue;
    p.ph_begin = ph; p.ph_end = ph + 1;
    hipLaunchKernelGGL(fwd_megakernel, dim3(grid_blocks), dim3(NT), 0, stream, p);
  }
#else
  p.ph_begin = 0; p.ph_end = 22;
  void* args[] = {&p};
  hipError_t e = hipLaunchCooperativeKernel((void*)fwd_megakernel, dim3(grid_blocks), dim3(NT), args, 0, stream);
  if (e != hipSuccess) fprintf(stderr, "cooperative launch failed: %s (grid %d)\n", hipGetErrorString(e), grid_blocks);
#endif
}
```

```cpp
#include <hip/hip_runtime.h>
#include <hip/hip_cooperative_groups.h>
#include <stdint.h>
#include <stdio.h>
namespace cg = cooperative_groups;

#ifndef REP_ATTN
#define REP_ATTN 1
#endif
#ifndef REP_GEMM
#define REP_GEMM 1
#endif
#ifndef MK_MULTI_LAUNCH
#define MK_MULTI_LAUNCH 0
#endif

typedef unsigned short bf16_t;
typedef short bf16x8 __attribute__((ext_vector_type(8)));
typedef float f32x16 __attribute__((ext_vector_type(16)));
typedef float f32x4 __attribute__((ext_vector_type(4)));
typedef float f32x2 __attribute__((ext_vector_type(2)));
typedef unsigned u32x4 __attribute__((ext_vector_type(4)));
typedef unsigned u32x2 __attribute__((ext_vector_type(2)));

#define DI __device__ __forceinline__
#define MFMA32(a, b, c) __builtin_amdgcn_mfma_f32_32x32x16_bf16((a), (b), (c), 0, 0, 0)

constexpr int T_LAT = 32768, T_ALL = 33792, NKEY = 8448, NT = 512;
constexpr float LOG2E = 1.4426950408889634f;
constexpr float QSCALE_A = 0.125f * LOG2E;
constexpr float QSCALE_B = 0.10206207261596575f * LOG2E;

constexpr size_t OFF_HC   = 0;
constexpr size_t OFF_UG   = OFF_HC + 1024ull * 1024 * 4;
constexpr size_t OFF_P    = OFF_UG + (size_t)T_ALL * 1024 * 2;
constexpr size_t OFF_QB   = OFF_P + (size_t)T_ALL * 2560 * 2;
constexpr size_t OFF_KB   = OFF_QB + (size_t)T_ALL * 768 * 2;
constexpr size_t OFF_VT   = OFF_KB + (size_t)T_ALL * 512 * 2;
constexpr size_t OFF_VTB  = OFF_VT + 4ull * 2 * 64 * NKEY * 2;
constexpr size_t OFF_W    = OFF_VT + 4ull * 16 * 64 * NKEY * 2;
constexpr size_t OFF_W_IN   = OFF_W;
constexpr size_t OFF_W_OUT  = OFF_W_IN + 2ull * 2560 * 1024 * 2;
constexpr size_t OFF_W_UQ   = OFF_W_OUT + 2ull * 1024 * 1024 * 2;
constexpr size_t OFF_W_UKV  = OFF_W_UQ + 2ull * 768 * 384 * 2;
constexpr size_t OFF_W_CIN  = OFF_W_UKV + 2ull * 1024 * 256 * 2;
constexpr size_t OFF_W_COUT = OFF_W_CIN + 2ull * 4096 * 1024 * 2;
constexpr size_t OFF_MOD    = OFF_W_COUT + 2ull * 1024 * 1024 * 2;
constexpr size_t OFF_ROPE   = OFF_MOD + 4ull * 5 * 3072 * 4;
constexpr size_t OFF_BAR    = OFF_ROPE + 2ull * 8192 * 32 * 4 + 2ull * 8192 * 16 * 4;
constexpr size_t OFF_END    = OFF_BAR + 16384;

struct Params {
  const float *x, *c, *ctx, *c_ctx, *ada_w, *ada_b, *norm_g, *ab_in_w, *ab_out_w, *a_sink, *b_qn_g, *b_w_uq, *b_kvn_g, *b_w_ukv,
      *c_in_w, *c_out_w, *c_rpb, *final_g;
  float* out;
  char* ws;
  int ph_begin, ph_end;
};

DI int otid() { int t = threadIdx.x; asm volatile("" : "+v"(t)); return t; }
DI int obid() { int t = blockIdx.x; asm volatile("" : "+s"(t)); return t; }
DI int ogrid() { int t = gridDim.x; asm volatile("" : "+s"(t)); return t; }
DI unsigned pack_bf16(float lo, float hi) { unsigned r; asm("v_cvt_pk_bf16_f32 %0, %1, %2" : "=v"(r) : "v"(lo), "v"(hi)); return r; }
DI float bf_lo(unsigned u) { return __uint_as_float(u << 16); }
DI float bf_hi(unsigned u) { return __uint_as_float(u & 0xffff0000u); }
DI float fexp2(float x) { return __builtin_amdgcn_exp2f(x); }
DI float silu(float z) { return z * __builtin_amdgcn_rcpf(1.f + __expf(-z)); }

DI size_t ablk(int tok, int k) { return ((size_t)((tok >> 8) * 16 + (k >> 6)) << 14) + ((tok & 255) << 6) + (k & 63); }
DI void tok_bk(int tok, int& b, int& key) {
  if (tok < T_LAT) { b = tok >> 13; key = tok & 8191; } else { int r = tok - T_LAT; b = r >> 8; key = 8192 + (r & 255); }
}
DI const float* h_src(const Params& p, int layer, int tok) {
  if (layer == 0) return tok < T_LAT ? p.x + (size_t)tok * 1024 : p.ctx + (size_t)(tok - T_LAT) * 1024;
  return tok < T_LAT ? p.out + (size_t)tok * 1024 : (const float*)(p.ws + OFF_HC) + (size_t)(tok - T_LAT) * 1024;
}
DI float* h_dst(const Params& p, int tok) {
  return tok < T_LAT ? p.out + (size_t)tok * 1024 : (float*)(p.ws + OFF_HC) + (size_t)(tok - T_LAT) * 1024;
}

#define XB_TMO      128
#define XB_XCNT(j)  (256  + 64 * (j))
#define XB_XSUB(j)  (1280 + 64 * (j))
#define XB_XGEN(j)  (2304 + 64 * (j))
#define XB_TOP      3328
#define XB_TOPGEN   3392
#define XCD_BAR_WORDS 3456
#define XB_SPIN_CAP (1u << 22)
#define LAS __attribute__((address_space(3)))
DI unsigned xb_ld(unsigned* p) { return __hip_atomic_load(p, __ATOMIC_RELAXED, __HIP_MEMORY_SCOPE_AGENT); }
DI unsigned xb_add(unsigned* p, unsigned v) { return __hip_atomic_fetch_add(p, v, __ATOMIC_RELAXED, __HIP_MEMORY_SCOPE_AGENT); }
DI unsigned xb_xcc_id() { return (unsigned)__builtin_amdgcn_s_getreg((3 << 11) | 20) & 0xFu; }
#define XB_SPIN(cond, bar) do { unsigned _sp = 0; while (cond) { __builtin_amdgcn_s_sleep(1); \
    if ((++_sp & 255u) == 0u) { if (xb_ld(&(bar)[XB_TMO])) break; if (_sp > XB_SPIN_CAP) { atomicAdd(&(bar)[XB_TMO], 1u); break; } } } } while (0)
struct XcdBarrier { unsigned* bar; unsigned x; volatile LAS unsigned* st; };
DI XcdBarrier xcd_barrier_post(unsigned* bar, volatile LAS unsigned* st) {
  XcdBarrier b; b.bar = bar; b.x = xb_xcc_id(); b.st = st;
  if (threadIdx.x == 0) (void)xb_add(&bar[XB_XCNT(b.x)], 1u);
  return b;
}
DI void xcd_barrier_complete(unsigned* bar, unsigned x, unsigned& nloc, unsigned& nx) {
  const unsigned G = gridDim.x * gridDim.y * gridDim.z;
  unsigned sum, cnt, mine, sp = 0u;
  for (;;) {
    sum = 0u; cnt = 0u; mine = 0u;
#pragma unroll
    for (unsigned j = 0; j < 16; ++j) { const unsigned c = xb_ld(&bar[XB_XCNT(j)]); sum += c; cnt += (c > 0u) ? 1u : 0u; mine = (j == x) ? c : mine; }
    if (sum == G) break;
    __builtin_amdgcn_s_sleep(1);
    if ((++sp & 255u) == 0u) { if (xb_ld(&bar[XB_TMO])) break; if (sp > XB_SPIN_CAP) { atomicAdd(&bar[XB_TMO], 1u); break; } }
  }
  nloc = mine > 0u ? mine : 1u; nx = cnt > 0u ? cnt : 1u;
}
DI void xcd_barrier(const XcdBarrier& b) {
  asm volatile("s_waitcnt vmcnt(0)" ::: "memory");
  __syncthreads();
  if (threadIdx.x == 0) {
    unsigned* bar = b.bar;
    __builtin_amdgcn_s_waitcnt(0);
    unsigned nloc = b.st[0], nx = b.st[1];
    if (nloc == 0u) { xcd_barrier_complete(bar, b.x, nloc, nx); b.st[0] = nloc; b.st[1] = nx; }
    const unsigned old = xb_add(&bar[XB_XSUB(b.x)], 1u);
    const unsigned gen = old / nloc;
    if (old + 1u == (gen + 1u) * nloc) {
      __builtin_amdgcn_fence(__ATOMIC_RELEASE, "agent");
      asm volatile("s_waitcnt vmcnt(0)" ::: "memory");
      const unsigned og = xb_add(&bar[XB_TOP], 1u);
      const unsigned tg = og / nx;
      if (og + 1u == (tg + 1u) * nx) xb_add(&bar[XB_TOPGEN], 1u);
      else XB_SPIN(xb_ld(&bar[XB_TOPGEN]) == tg, bar);
      __builtin_amdgcn_fence(__ATOMIC_ACQUIRE, "agent");
      xb_add(&bar[XB_XGEN(b.x)], 1u);
      asm volatile("s_waitcnt vmcnt(0)" ::: "memory");
    } else {
      XB_SPIN(xb_ld(&bar[XB_XGEN(b.x)]) == gen, bar);
      __builtin_amdgcn_fence(__ATOMIC_ACQUIRE, "agent");
      asm volatile("s_waitcnt vmcnt(0)" ::: "memory");
    }
  }
  __syncthreads();
}

struct TJob { const float* src; const float* rs; bf16_t* dst; int K, N, tk, tn, perm; };
DI TJob tr_job(const Params& p, int t) {
  TJob j; j.rs = nullptr; j.perm = 0;
  const int i2 = t / 2312; t -= i2 * 2312;
  if (t < 640) { j.src = p.ab_in_w + (size_t)i2 * 1024 * 2464; j.K = 1024; j.N = 2464; j.dst = (bf16_t*)(p.ws + OFF_W_IN) + (size_t)i2 * 2560 * 1024; j.tk = t / 40; j.tn = t % 40; }
  else if ((t -= 640) < 256) { j.src = p.ab_out_w + (size_t)i2 * 1024 * 1024; j.K = 1024; j.N = 1024; j.dst = (bf16_t*)(p.ws + OFF_W_OUT) + (size_t)i2 * 1024 * 1024; j.tk = t / 16; j.tn = t % 16; }
  else if ((t -= 256) < 72) { j.src = p.b_w_uq + (size_t)i2 * 384 * 768; j.K = 384; j.N = 768; j.dst = (bf16_t*)(p.ws + OFF_W_UQ) + (size_t)i2 * 768 * 384; j.rs = p.b_qn_g + i2 * 384; j.tk = t / 12; j.tn = t % 12; }
  else if ((t -= 72) < 64) { j.src = p.b_w_ukv + (size_t)i2 * 256 * 1024; j.K = 256; j.N = 1024; j.dst = (bf16_t*)(p.ws + OFF_W_UKV) + (size_t)i2 * 1024 * 256; j.rs = p.b_kvn_g + i2 * 256; j.tk = t / 16; j.tn = t % 16; j.perm = 1; }
  else if ((t -= 64) < 1024) { j.src = p.c_in_w + (size_t)i2 * 1024 * 4096; j.K = 1024; j.N = 4096; j.dst = (bf16_t*)(p.ws + OFF_W_CIN) + (size_t)i2 * 4096 * 1024; j.tk = t / 64; j.tn = t % 64; }
  else { t -= 1024; j.src = p.c_out_w + (size_t)i2 * 1024 * 1024; j.K = 1024; j.N = 1024; j.dst = (bf16_t*)(p.ws + OFF_W_COUT) + (size_t)i2 * 1024 * 1024; j.tk = t / 16; j.tn = t % 16; }
  return j;
}
DI void tr_load(const TJob& j, int tid, float (&v)[8]) {
#pragma unroll
  for (int i = 0; i < 8; ++i) {
    const int kk = (tid >> 6) + 8 * i, n = j.tn * 64 + (tid & 63);
    float x = (n < j.N) ? j.src[(size_t)(j.tk * 64 + kk) * j.N + n] : 0.f;
    if (j.rs) x *= j.rs[j.tk * 64 + kk];
    v[i] = x;
  }
}

DI void prologue_phase(const Params& p, char* lds) {
  const int tid = otid();
  constexpr int N_MOD = 192, N_TR = 4624, N_ROPE = 768;
  for (int u = obid(); u < N_MOD + N_TR + N_ROPE; u += ogrid()) {
    if (u < N_MOD) {
      const int layer = u / 48, cb = u % 48;
      float* sl = (float*)lds;
      for (int i = tid; i < 5120; i += NT) {
        const int bb = i >> 10, k = i & 1023;
        const float cv = bb < 4 ? p.c[bb * 1024 + k] : p.c_ctx[k];
        sl[i] = silu(cv);
      }
      __syncthreads();
      const int col = cb * 64 + (tid & 63), kg = tid >> 6;
      float a0 = 0, a1 = 0, a2 = 0, a3 = 0, a4 = 0;
      const float* wp = p.ada_w + (size_t)layer * 1024 * 3072 + col;
#pragma unroll 8
      for (int k = kg * 128; k < kg * 128 + 128; ++k) {
        const float wv = wp[(size_t)k * 3072];
        a0 += sl[k] * wv; a1 += sl[1024 + k] * wv; a2 += sl[2048 + k] * wv; a3 += sl[3072 + k] * wv; a4 += sl[4096 + k] * wv;
      }
      float* red = (float*)(lds + 20480);
      red[(kg * 5 + 0) * 64 + (tid & 63)] = a0; red[(kg * 5 + 1) * 64 + (tid & 63)] = a1; red[(kg * 5 + 2) * 64 + (tid & 63)] = a2;
      red[(kg * 5 + 3) * 64 + (tid & 63)] = a3; red[(kg * 5 + 4) * 64 + (tid & 63)] = a4;
      __syncthreads();
      if (tid < 64) {
        float* mod = (float*)(p.ws + OFF_MOD);
        const float bias = p.ada_b[layer * 3072 + col];
#pragma unroll
        for (int bb = 0; bb < 5; ++bb) {
          float s = bias;
#pragma unroll
          for (int g = 0; g < 8; ++g) s += red[(g * 5 + bb) * 64 + tid];
          mod[(size_t)(layer * 5 + bb) * 3072 + col] = s;
        }
      }
      __syncthreads();
    } else if (u < N_MOD + N_TR) {
    } else {
      const int idx = (u - N_MOD - N_TR) * NT + tid;
      float* ropeA = (float*)(p.ws + OFF_ROPE);
      float* ropeB = ropeA + 2 * 8192 * 32;
      if (idx < 8192 * 32) {
        const int pos = idx >> 5, pr = idx & 31;
        const float pv = pr < 16 ? (float)(pos >> 6) : (float)(pos & 63);
        const float inv = exp2f(-(float)(pr & 15) * (13.287712379549449f / 16.f));
        const float ang = pv * inv;
        ropeA[idx] = cosf(ang); ropeA[8192 * 32 + idx] = sinf(ang);
      } else {
        const int j = idx - 8192 * 32;
        const int pos = j >> 4, pr = j & 15;
        const float pv = pr < 8 ? (float)(pos >> 6) : (float)(pos & 63);
        const float inv = exp2f(-(float)(pr & 7) * (13.287712379549449f / 8.f));
        const float ang = pv * inv;
        ropeB[j] = cosf(ang); ropeB[8192 * 16 + j] = sinf(ang);
      }
    }
  }
  {
    const int G = ogrid();
    int t = obid();
    float v[8], nv[8];
    TJob cur, nxt;
    if (t < N_TR) { cur = tr_job(p, t); tr_load(cur, tid, v); }
    int buf = 0;
    for (; t < N_TR; t += G) {
      const bool more = t + G < N_TR;
      if (more) { nxt = tr_job(p, t + G); tr_load(nxt, tid, nv); }
      float* tile = (float*)(lds + buf * 16640);
#pragma unroll
      for (int i = 0; i < 8; ++i) tile[((tid >> 6) + 8 * i) * 65 + (tid & 63)] = v[i];
      __syncthreads();
      {
        const int nn = tid & 63, k8 = (tid >> 6) * 8;
        int n = cur.tn * 64 + nn;
        if (cur.perm) n = ((n & 64) ? 512 : 0) + (n >> 7) * 64 + (n & 63);
        u32x4 w;
        w.x = pack_bf16(tile[(k8 + 0) * 65 + nn], tile[(k8 + 1) * 65 + nn]); w.y = pack_bf16(tile[(k8 + 2) * 65 + nn], tile[(k8 + 3) * 65 + nn]);
        w.z = pack_bf16(tile[(k8 + 4) * 65 + nn], tile[(k8 + 5) * 65 + nn]); w.w = pack_bf16(tile[(k8 + 6) * 65 + nn], tile[(k8 + 7) * 65 + nn]);
        *(u32x4*)(cur.dst + ((size_t)((n >> 8) * (cur.K >> 6) + cur.tk) << 14) + ((n & 255) << 6) + k8) = w;
      }
      buf ^= 1;
      if (more) {
        cur = nxt;
#pragma unroll
        for (int i = 0; i < 8; ++i) v[i] = nv[i];
      }
    }
    __syncthreads();
  }
}

DI float wave_sum(float v) {
#pragma unroll
  for (int o = 32; o >= 1; o >>= 1) v += __shfl_xor(v, o);
  return v;
}

DI void norm_phase(const Params& p, int layer) {
  const int lane = otid() & 63;
  const int wave = obid() * 8 + (otid() >> 6), nw = ogrid() * 8;
  const float* g = p.norm_g + layer * 1024;
  const float* mod = (const float*)(p.ws + OFF_MOD) + (size_t)layer * 5 * 3072;
  bf16_t* U = (bf16_t*)(p.ws + OFF_UG);
  f32x4 gv[4];
#pragma unroll
  for (int i = 0; i < 4; ++i) gv[i] = *(const f32x4*)(g + lane * 4 + 256 * i);
  for (int row = wave; row < T_ALL; row += nw) {
    const int bb = row < T_LAT ? (row >> 13) : 4;
    const float* src = h_src(p, layer, row);
    f32x4 v[4];
    float ss = 0.f;
#pragma unroll
    for (int i = 0; i < 4; ++i) {
      v[i] = *(const f32x4*)(src + lane * 4 + 256 * i);
      ss += v[i][0] * v[i][0] + v[i][1] * v[i][1] + v[i][2] * v[i][2] + v[i][3] * v[i][3];
    }
    ss = wave_sum(ss);
    const float rstd = rsqrtf(ss * (1.f / 1024.f) + 1e-6f);
    const float* mrow = mod + bb * 3072;
#pragma unroll
    for (int i = 0; i < 4; ++i) {
      const int cidx = lane * 4 + 256 * i;
      const f32x4 sh = *(const f32x4*)(mrow + cidx), sc = *(const f32x4*)(mrow + 1024 + cidx);
      f32x4 o = (v[i] * rstd) * gv[i] * (sc + 1.f) + sh;
      u32x2 w; w.x = pack_bf16(o[0], o[1]); w.y = pack_bf16(o[2], o[3]);
      *(u32x2*)(U + ablk(row, cidx)) = w;
    }
  }
}

DI void final_phase(const Params& p) {
  const int lane = otid() & 63;
  const int wave = obid() * 8 + (otid() >> 6), nw = ogrid() * 8;
  f32x4 gv[4];
#pragma unroll
  for (int i = 0; i < 4; ++i) gv[i] = *(const f32x4*)(p.final_g + lane * 4 + 256 * i);
  for (int row = wave; row < T_LAT; row += nw) {
    float* src = p.out + (size_t)row * 1024;
    f32x4 v[4];
    float ss = 0.f;
#pragma unroll
    for (int i = 0; i < 4; ++i) {
      v[i] = *(const f32x4*)(src + lane * 4 + 256 * i);
      ss += v[i][0] * v[i][0] + v[i][1] * v[i][1] + v[i][2] * v[i][2] + v[i][3] * v[i][3];
    }
    ss = wave_sum(ss);
    const float rstd = rsqrtf(ss * (1.f / 1024.f) + 1e-6f);
#pragma unroll
    for (int i = 0; i < 4; ++i) *(f32x4*)(src + lane * 4 + 256 * i) = (v[i] * rstd) * gv[i];
  }
}

enum { EPI_AB_IN = 0, EPI_QB = 1, EPI_KVB = 2, EPI_C_IN = 3, EPI_OUT = 4 };
constexpr int G_STR = 144;
constexpr int G_OPER = 256 * G_STR;
constexpr int G_STAGE = 2 * G_OPER;
constexpr int OFF_RSTD = 2 * G_STAGE;
constexpr int LDS_BYTES = OFF_RSTD + 1024;

DI void rope2(float& v0, float& v1, float& v2, float& v3, const float* cs, const float* sn) {
  const f32x2 c = *(const f32x2*)cs, s = *(const f32x2*)sn;
  const float a0 = v0 * c.x - v1 * s.x, a1 = v0 * s.x + v1 * c.x, a2 = v2 * c.y - v3 * s.y, a3 = v2 * s.y + v3 * c.y;
  v0 = a0; v1 = a1; v2 = a2; v3 = a3;
}

template <int EPI>
DI void epi_math(const Params& p, int tok, int f0, float& v0, float& v1, float& v2, float& v3, float rs) {
  const float* ropeA = (const float*)(p.ws + OFF_ROPE);
  const float* ropeB = ropeA + 2 * 8192 * 32;
  const bool lat = tok < T_LAT;
  const int pos = tok & 8191;
  if (EPI == EPI_AB_IN) {
    if (f0 < 640) {
      if (lat) { const int p0 = (f0 & 63) >> 1; rope2(v0, v1, v2, v3, ropeA + pos * 32 + p0, ropeA + 8192 * 32 + pos * 32 + p0); }
      if (f0 < 512) { v0 *= QSCALE_A; v1 *= QSCALE_A; v2 *= QSCALE_A; v3 *= QSCALE_A; }
    } else if (f0 >= 1920 && f0 < 1952) {
      if (lat) { const int p0 = (f0 - 1920) >> 1; rope2(v0, v1, v2, v3, ropeB + pos * 16 + p0, ropeB + 8192 * 16 + pos * 16 + p0); }
    }
  } else if (EPI == EPI_QB) {
    const float s = rs * QSCALE_B;
    v0 *= s; v1 *= s; v2 *= s; v3 *= s;
    const int fh = f0 % 96;
    if (fh >= 64 && lat) { const int p0 = (fh - 64) >> 1; rope2(v0, v1, v2, v3, ropeB + pos * 16 + p0, ropeB + 8192 * 16 + pos * 16 + p0); }
  } else if (EPI == EPI_KVB) {
    v0 *= rs; v1 *= rs; v2 *= rs; v3 *= rs;
  } else if (EPI == EPI_C_IN) {
    if (f0 < 1024) { v0 *= QSCALE_A; v1 *= QSCALE_A; v2 *= QSCALE_A; v3 *= QSCALE_A; }
  }
}

template <int EPI>
DI bf16_t* dst_tr(const Params& p, int tok, int col) {
  if (EPI == EPI_AB_IN) return col < 2464 ? (bf16_t*)(p.ws + OFF_P) + (size_t)tok * 2560 + col : nullptr;
  if (EPI == EPI_QB) return (bf16_t*)(p.ws + OFF_QB) + (size_t)tok * 768 + col;
  if (EPI == EPI_KVB) return (bf16_t*)(p.ws + OFF_KB) + (size_t)tok * 512 + col;
  return (bf16_t*)(p.ws + OFF_P) + (size_t)tok * 3072 + (col >= 3072 ? col - 1024 : col);
}
template <int EPI>
DI bf16_t* dst_v(const Params& p, int t0, int col) {
  int b, key; tok_bk(t0, b, key);
  if (EPI == EPI_KVB) return (bf16_t*)(p.ws + OFF_VTB) + ((size_t)(b * 8 + ((col - 512) >> 6)) * 64 + (col & 63)) * NKEY + key;
  return (bf16_t*)(p.ws + OFF_VT) + ((size_t)(b * 16 + ((col - 2048) >> 6)) * 64 + (col & 63)) * NKEY + key;
}

struct TilePf { bool pre; bool has_next; int nm0, nnt; };
template <int EPI, int TM>
DI void gemm_tile(const Params& p, int layer, const bf16_t* __restrict__ A, int lda, const bf16_t* __restrict__ Bt, int K, int m0, int nt, char* lds,
                  u32x4 (&ra)[TM / 64], u32x4 (&rb)[4], const TilePf pf) {
  constexpr int NJ = TM == 256 ? 4 : 2, NI = TM == 256 ? 2 : 1, NA = TM / 64;
  const int tid = otid(), lane = tid & 63, w = tid >> 6;
  const int wm = TM == 256 ? (w >> 2) : 0, wn = TM == 256 ? (w & 3) : w;
  const int fb = TM == 256 ? wn * 64 : wn * 32, tb = TM == 256 ? wm * 128 : 0;
  const int l31 = lane & 31, hh = lane >> 5;
  const int n0 = nt * 256;
  float* rstd = (float*)(lds + OFF_RSTD);
  const int srow = tid >> 3, scc = tid & 7;
  const bool ablocked = (lda == 0);
  const int nkb = K >> 6;
  const bf16_t* ag = ablocked ? A + ((size_t)((m0 >> 8) * 16) << 14) + (m0 & 255) * 64 + tid * 8 : A + (size_t)(m0 + srow) * lda + scc * 8;
  const size_t a_i = ablocked ? 4096 : (size_t)64 * lda, a_k = ablocked ? 16384 : 64;
  const bf16_t* bg = Bt + ((size_t)(nt * nkb) << 14) + tid * 8;

  if (EPI == EPI_QB || EPI == EPI_KVB) {
    __syncthreads();
    if (tid < 2 * TM) {
      const int r = tid >> 1, half = tid & 1;
      const bf16_t* ap = A + (size_t)(m0 + r) * lda + half * (K / 2);
      float ss = 0.f;
      for (int cidx = 0; cidx < K / 2; cidx += 8) {
        const u32x4 v = *(const u32x4*)(ap + cidx);
#pragma unroll
        for (int e = 0; e < 4; ++e) { const float a = bf_lo(v[e]), b2 = bf_hi(v[e]); ss += a * a + b2 * b2; }
      }
      ss += __shfl_xor(ss, 1);
      if (half == 0) rstd[r] = rsqrtf(ss / (float)K + 1e-6f);
    }
  }

  f32x16 acc[NI][NJ];
#pragma unroll
  for (int i = 0; i < NI; ++i)
#pragma unroll
    for (int j = 0; j < NJ; ++j)
#pragma unroll
      for (int r = 0; r < 16; ++r) acc[i][j][r] = 0.f;

  const int nk = K >> 6;
  if (!pf.pre) {
#pragma unroll
    for (int i = 0; i < NA; ++i) ra[i] = *(const u32x4*)(ag + i * a_i);
#pragma unroll
    for (int i = 0; i < 4; ++i) rb[i] = *(const u32x4*)(bg + i * 4096);
  }
#pragma unroll
  for (int i = 0; i < NA; ++i) *(u32x4*)(lds + (srow + 64 * i) * G_STR + scc * 16) = ra[i];
#pragma unroll
  for (int i = 0; i < 4; ++i) *(u32x4*)(lds + G_OPER + (srow + 64 * i) * G_STR + scc * 16) = rb[i];
#pragma unroll
  for (int i = 0; i < NA; ++i) ra[i] = *(const u32x4*)(ag + i * a_i + a_k);
#pragma unroll
  for (int i = 0; i < 4; ++i) rb[i] = *(const u32x4*)(bg + i * 4096 + 16384);
  __syncthreads();
  for (int kt = 0; kt < nk; ++kt) {
    {
      char* st = lds + ((kt + 1) & 1) * G_STAGE;
#pragma unroll
      for (int i = 0; i < NA; ++i) *(u32x4*)(st + (srow + 64 * i) * G_STR + scc * 16) = ra[i];
#pragma unroll
      for (int i = 0; i < 4; ++i) *(u32x4*)(st + G_OPER + (srow + 64 * i) * G_STR + scc * 16) = rb[i];
    }
    if (kt + 2 < nk) {
#pragma unroll
      for (int i = 0; i < NA; ++i) ra[i] = *(const u32x4*)(ag + i * a_i + (size_t)(kt + 2) * a_k);
#pragma unroll
      for (int i = 0; i < 4; ++i) rb[i] = *(const u32x4*)(bg + i * 4096 + ((size_t)(kt + 2) << 14));
    }
    __builtin_amdgcn_sched_barrier(0);
    const char* as = lds + (kt & 1) * G_STAGE;
    const char* fp = as + G_OPER + (fb + l31) * G_STR + hh * 16;
    const char* sp = as + (tb + l31) * G_STR + hh * 16;
#pragma unroll
    for (int ks = 0; ks < 4; ++ks) {
      bf16x8 f[NI], s[NJ];
#pragma unroll
      for (int i = 0; i < NI; ++i) f[i] = *(const bf16x8*)(fp + i * 32 * G_STR + ks * 32);
#pragma unroll
      for (int j = 0; j < NJ; ++j) s[j] = *(const bf16x8*)(sp + j * 32 * G_STR + ks * 32);
#pragma unroll
      for (int j = 0; j < NJ; ++j)
#pragma unroll
        for (int i = 0; i < NI; ++i) acc[i][j] = MFMA32(f[i], s[j], acc[i][j]);
    }
    __syncthreads();
  }

  auto prefetch_next = [&]() {
    if (TM == 256 && pf.has_next) {
      const bf16_t* nag = ablocked ? A + ((size_t)((pf.nm0 >> 8) * 16) << 14) + (pf.nm0 & 255) * 64 + tid * 8 : A + (size_t)(pf.nm0 + srow) * lda + scc * 8;
      const bf16_t* nbg = Bt + ((size_t)(pf.nnt * nkb) << 14) + tid * 8;
#pragma unroll
      for (int i = 0; i < NA; ++i) ra[i] = *(const u32x4*)(nag + i * a_i);
#pragma unroll
      for (int i = 0; i < 4; ++i) rb[i] = *(const u32x4*)(nbg + i * 4096);
      __builtin_amdgcn_sched_barrier(0);
    }
  };
  constexpr int SB = 528;
  constexpr int SV = TM * 2 + 16;
  constexpr int NIT = TM * 32 / NT;
  if (EPI == EPI_OUT) {
    const int bb = m0 < T_LAT ? (m0 >> 13) : 4;
#pragma unroll
    for (int h = 0; h < 2; ++h) {
      if ((TM == 256 ? (wn >> 1) : (wn >> 2)) == h) {
#pragma unroll
        for (int j = 0; j < NJ; ++j)
#pragma unroll
          for (int i = 0; i < NI; ++i)
#pragma unroll
            for (int g = 0; g < 4; ++g) {
              f32x4 v; v[0] = acc[i][j][4 * g]; v[1] = acc[i][j][4 * g + 1]; v[2] = acc[i][j][4 * g + 2]; v[3] = acc[i][j][4 * g + 3];
              *(f32x4*)(lds + (tb + j * 32 + l31) * SB + ((fb & 127) + i * 32 + 8 * g + 4 * hh) * 4) = v;
            }
      }
      if (h == 1) prefetch_next();
      __syncthreads();
      const float* gate = (const float*)(p.ws + OFF_MOD) + (size_t)(layer * 5 + bb) * 3072 + 2048 + n0 + h * 128;
#pragma unroll 4
      for (int it = 0; it < NIT; ++it) {
        const int cidx = tid + NT * it, row = cidx >> 5, ch = cidx & 31;
        const f32x4 y = *(const f32x4*)(lds + row * SB + ch * 16);
        const f32x4 gt = *(const f32x4*)(gate + ch * 4);
        const f32x4 old = *(const f32x4*)(h_src(p, layer, m0 + row) + n0 + h * 128 + ch * 4);
        *(f32x4*)(h_dst(p, m0 + row) + n0 + h * 128 + ch * 4) = old + gt * y;
      }
      __syncthreads();
    }
  } else {
    const bool vt = (EPI == EPI_KVB && nt >= 2) || (EPI == EPI_C_IN && nt >= 8 && nt < 12);
#pragma unroll
    for (int j = 0; j < NJ; ++j) {
      const int rl = tb + j * 32 + l31;
      float rs = 1.f;
      if (EPI == EPI_QB || EPI == EPI_KVB) rs = rstd[rl];
#pragma unroll
      for (int i = 0; i < NI; ++i)
#pragma unroll
        for (int g = 0; g < 4; ++g) {
          const int fl = fb + i * 32 + 8 * g + 4 * hh;
          float v0 = acc[i][j][4 * g], v1 = acc[i][j][4 * g + 1], v2 = acc[i][j][4 * g + 2], v3 = acc[i][j][4 * g + 3];
          epi_math<EPI>(p, m0 + rl, n0 + fl, v0, v1, v2, v3, rs);
          const unsigned w01 = pack_bf16(v0, v1), w23 = pack_bf16(v2, v3);
          if (!vt) {
            u32x2 wv; wv.x = w01; wv.y = w23;
            *(u32x2*)(lds + rl * SB + fl * 2) = wv;
          } else {
            *(bf16_t*)(lds + (fl + 0) * SV + rl * 2) = (bf16_t)(w01 & 0xffffu);
            *(bf16_t*)(lds + (fl + 1) * SV + rl * 2) = (bf16_t)(w01 >> 16);
            *(bf16_t*)(lds + (fl + 2) * SV + rl * 2) = (bf16_t)(w23 & 0xffffu);
            *(bf16_t*)(lds + (fl + 3) * SV + rl * 2) = (bf16_t)(w23 >> 16);
          }
        }
    }
    prefetch_next();
    __syncthreads();
#pragma unroll 4
    for (int it = 0; it < NIT; ++it) {
      const int cidx = tid + NT * it;
      if (vt) {
        const int row = cidx / (TM / 8), ch = cidx % (TM / 8);
        *(u32x4*)dst_v<EPI>(p, m0 + ch * 8, n0 + row) = *(const u32x4*)(lds + row * SV + ch * 16);
      } else {
        const int row = cidx >> 5, ch = cidx & 31;
        bf16_t* d = dst_tr<EPI>(p, m0 + row, n0 + ch * 8);
        if (d) *(u32x4*)d = *(const u32x4*)(lds + row * SB + ch * 16);
      }
    }
    __syncthreads();
  }
}

template <int EPI>
DI void gemm_phase(const Params& p, int layer, const bf16_t* A, int lda, const bf16_t* Bt, int K, int mtiles, int ntiles, bool ctx, bool reverse, char* lds) {
  const int G = ogrid();
  const int bid = reverse ? (G - 1 - obid()) : obid();
  u32x4 ra[4], rb[4];
  const bool simple = (G & 7) != 0;
  const int xcd = bid & 7, local = simple ? bid : (bid >> 3), nlocal = simple ? G : (G >> 3);
  const int mlo = simple ? 0 : ((xcd * mtiles) >> 3), cnt = simple ? mtiles : ((((xcd + 1) * mtiles) >> 3) - mlo);
  const int total = cnt * ntiles, gsize = 4 * ntiles;
  auto tile_of = [&](int j, int& m0, int& nt) {
    const int g = j / gsize, r = j - g * gsize;
    int gm = cnt - g * 4; gm = gm > 4 ? 4 : gm;
    m0 = (mlo + g * 4 + (r % gm)) * 256; nt = r / gm;
  };
  bool pre = false;
  for (int j = local; j < total; j += nlocal) {
    int m0, nt; tile_of(j, m0, nt);
    TilePf pf; pf.pre = pre; pf.has_next = (j + nlocal < total); pf.nm0 = 0; pf.nnt = 0;
    if (pf.has_next) tile_of(j + nlocal, pf.nm0, pf.nnt);
    gemm_tile<EPI, 256>(p, layer, A, lda, Bt, K, m0, nt, lds, ra, rb, pf);
    pre = pf.has_next;
  }
  if (ctx) {
    const int b2 = G - 1 - bid;
    u32x4 ra1[1];
    TilePf pf; pf.pre = false; pf.has_next = false; pf.nm0 = 0; pf.nnt = 0;
    for (int u = b2; u < 16 * ntiles; u += G) gemm_tile<EPI, 64>(p, layer, A, lda, Bt, K, T_LAT + (u & 15) * 64, u >> 4, lds, ra1, rb, pf);
  }
}

DI void vta_phase(const Params& p, char* lds) {
  const int tid = otid();
  const bf16_t* Pb = (const bf16_t*)(p.ws + OFF_P);
  for (int u = ogrid() - 1 - obid(); u < T_ALL / 64; u += ogrid()) {
    const int t0 = u * 64;
#pragma unroll
    for (int it = 0; it < 2; ++it) {
      const int cidx = tid + NT * it, row = cidx >> 4, ch = cidx & 15;
      *(u32x4*)(lds + row * 272 + ch * 16) = *(const u32x4*)(Pb + (size_t)(t0 + row) * 2560 + 640 + ch * 8);
    }
    __syncthreads();
    int b, key; tok_bk(t0, b, key);
#pragma unroll
    for (int it = 0; it < 2; ++it) {
      const int cidx = tid + NT * it, f = cidx & 127, tc = cidx >> 7;
      unsigned short e[8];
#pragma unroll
      for (int k = 0; k < 8; ++k) e[k] = *(const bf16_t*)(lds + (tc * 8 + k) * 272 + f * 2);
      u32x4 v; v.x = e[0] | ((unsigned)e[1] << 16); v.y = e[2] | ((unsigned)e[3] << 16); v.z = e[4] | ((unsigned)e[5] << 16); v.w = e[6] | ((unsigned)e[7] << 16);
      *(u32x4*)((bf16_t*)(p.ws + OFF_VT) + ((size_t)(b * 2 + (f >> 6)) * 64 + (f & 63)) * NKEY + key + tc * 8) = v;
    }
    __syncthreads();
  }
}

template <int MODE>
DI void attn_item(const Params& p, int layer, int b, int qt, int head, bool is_ctx, char* lds) {
  constexpr int DK = (MODE == 1) ? 96 : 64;
  constexpr int NKS = DK / 16;
  constexpr int KSTR = DK * 2 + 16;
  constexpr int VSTR = 144;
  constexpr int KBYTES = 64 * KSTR;
  constexpr int STAGE = KBYTES + 64 * VSTR;
  constexpr int QPB = 256;
  constexpr int NKC = DK / 8;
  constexpr int KCH = 64 * NKC;
  constexpr int OSTR = 272;
  constexpr float MASKV = -1e30f;
  float* rpbs = (float*)(lds + 4 * STAGE);
  char* ostage = lds;

  const int tid = otid(), lane = tid & 63, w = tid >> 6, l31 = lane & 31, hh = lane >> 5;
  const int i2 = layer >> 1;
  const bf16_t* Pb = (const bf16_t*)(p.ws + OFF_P);
  bf16_t* UG = (bf16_t*)(p.ws + OFF_UG);
  const bf16_t *Qp, *Kp, *Krp = nullptr, *Zp, *Vt;
  int ldq, ldk, ldz, gcol;
  if (MODE == 0) {
    Qp = Pb + head * 64; ldq = 2560; Kp = Pb + 512 + (head >> 2) * 64; ldk = 2560;
    Vt = (const bf16_t*)(p.ws + OFF_VT) + (size_t)(b * 2 + (head >> 2)) * 64 * NKEY;
    Zp = Pb + 768 + head * 64; ldz = 2560; gcol = head * 64;
  } else if (MODE == 1) {
    Qp = (const bf16_t*)(p.ws + OFF_QB) + head * 96; ldq = 768; Kp = (const bf16_t*)(p.ws + OFF_KB) + head * 64; ldk = 512; Krp = Pb + 1920;
    Vt = (const bf16_t*)(p.ws + OFF_VTB) + (size_t)(b * 8 + head) * 64 * NKEY;
    Zp = Pb + 1952 + head * 64; ldz = 2560; gcol = 512 + head * 64;
  } else {
    Qp = Pb + head * 64; ldq = 3072; Kp = Pb + 1024 + head * 64; ldk = 3072;
    Vt = (const bf16_t*)(p.ws + OFF_VT) + (size_t)(b * 16 + head) * 64 * NKEY;
    Zp = Pb + 2048 + head * 64; ldz = 3072; gcol = head * 64;
  }
  const int qtok0 = is_ctx ? T_LAT + b * 256 : b * 8192 + qt * QPB;

  int lat_lo = 0, nlat = 0;
  if (!is_ctx) {
    if (MODE == 0) {
      int lo = 4 * qt - 2; if (lo < 0) lo = 0;
      int hi = 4 * qt + 5; if (hi > 127) hi = 127;
      lat_lo = lo; nlat = hi - lo + 1;
    } else if (MODE == 1) { lat_lo = 0; nlat = 128; }
    else {
      int lo = 4 * qt - 4; lo = lo < 0 ? 0 : (lo > 120 ? 120 : lo);
      int hi = 4 * qt + 3 - 4; hi = hi < 0 ? 0 : (hi > 120 ? 120 : hi); hi += 7;
      lat_lo = lo; nlat = hi - lo + 1;
    }
  }
  const int ntiles = nlat + 4;

  const bool nat2 = (MODE == 2) && !is_ctx;
  auto tokmap = [&](int row) { return nat2 ? qtok0 + ((w >> 2) * 2 + (row >> 4)) * 64 + (w & 3) * 16 + (row & 15) : qtok0 + w * 32 + row; };
  const int qtok = tokmap(l31);
  bf16x8 qf[NKS];
#pragma unroll
  for (int ks = 0; ks < NKS; ++ks) qf[ks] = *(const bf16x8*)(Qp + (size_t)qtok * ldq + ks * 16 + hh * 8);
  if (MODE == 2 && !is_ctx) {
    for (int i = tid; i < 465; i += NT) rpbs[i] = p.c_rpb[(size_t)(i2 * 16 + head) * 465 + i] * LOG2E;
  }
  float m_ = (MODE == 0) ? p.a_sink[i2 * 8 + head] * LOG2E : MASKV;
  float l_ = (MODE == 0 && hh == 0) ? 1.f : 0.f;
  f32x16 O[2];
#pragma unroll
  for (int dh = 0; dh < 2; ++dh)
#pragma unroll
    for (int r = 0; r < 16; ++r) O[dh][r] = 0.f;

  const int k0row = tid / NKC, k0cc = tid % NKC;
  const int k1row = (tid + NT) / NKC, k1cc = (tid + NT) % NKC;
  const bool k1 = (KCH > NT) && (tid + NT < KCH);
  struct Stg { u32x4 k0, k1, v; };
  Stg R0, R1;
  R0.k1 = (u32x4){0u, 0u, 0u, 0u}; R1.k1 = R0.k1;
  auto tile_kt = [&](int i) { return i < nlat ? lat_lo + i : 128 + (i - nlat); };
  auto kload = [&](int krow0, int row, int cc) -> u32x4 {
    if (MODE == 1 && cc >= 8) return *(const u32x4*)(Krp + (size_t)(krow0 + row) * 2560 + (cc - 8) * 8);
    return *(const u32x4*)(Kp + (size_t)(krow0 + row) * ldk + cc * 8);
  };
  auto gload = [&](int i, Stg& r) {
    const int kt = tile_kt(i < ntiles ? i : ntiles - 1);
    const int krow0 = kt < 128 ? b * 8192 + kt * 64 : T_LAT + b * 256 + (kt - 128) * 64;
    r.k0 = kload(krow0, k0row, k0cc);
    if (k1) r.k1 = kload(krow0, k1row, k1cc);
    r.v = *(const u32x4*)(Vt + (size_t)(tid >> 3) * NKEY + kt * 64 + (tid & 7) * 8);
  };
  auto lstore = [&](int st, const Stg& r) {
    char* kb = lds + st * STAGE;
    *(u32x4*)(kb + k0row * KSTR + k0cc * 16) = r.k0;
    if (k1) *(u32x4*)(kb + k1row * KSTR + k1cc * 16) = r.k1;
    *(u32x4*)(kb + KBYTES + (tid >> 3) * VSTR + (tid & 7) * 16) = r.v;
  };

  const int pr = (l31 & ~12) | ((l31 & 4) << 1) | ((l31 & 8) >> 1);
  int qr = 0, qc = 0, rs0 = 0, cs = 0, csw = 0, wlo = 0, whi = 0;
  if (MODE == 2) {
    qr = qt * 4 + (w >> 2) * 2 + (l31 >> 4); qc = (w & 3) * 16 + (l31 & 15);
    rs0 = qr - 4; rs0 = rs0 < 0 ? 0 : (rs0 > 120 ? 120 : rs0);
    cs = qc - 8; cs = cs < 0 ? 0 : (cs > 48 ? 48 : cs);
    csw = (w & 3) * 16 - 8; csw = csw < 0 ? 0 : (csw > 32 ? 32 : csw);
    const int r_lo = qt * 4 + (w >> 2) * 2;
    wlo = r_lo - 4; wlo = wlo < 0 ? 0 : (wlo > 120 ? 120 : wlo);
    whi = r_lo + 1 - 4; whi = whi < 0 ? 0 : (whi > 120 ? 120 : whi); whi += 7;
  }
  const int s0w = qt * QPB + w * 32;
  const int nsup = (ntiles + 1) >> 1;
  __syncthreads();
  gload(0, R0); gload(1, R1);
  lstore(0, R0); lstore(1, R1);
  gload(2, R0); gload(3, R1);
  __syncthreads();
  auto body = [&](int it, const char* kb) {
    const char* vb = kb + KBYTES;
    const int kt = tile_kt(it);
    const bool lat_tile = it < nlat;
    bool skip = (it >= ntiles);
    if (MODE == 2 && lat_tile) skip = (kt < wlo) || (kt > whi);
    if (MODE == 0 && lat_tile) skip = (kt * 64 + 63 < s0w - 128) || (kt * 64 > s0w + 31 + 128);
    const int nsub = (MODE == 2 && lat_tile) ? 1 : 2;
    const int krb = (MODE == 2 && lat_tile) ? csw : 0;
    if (!skip) {
      f32x16 S[2];
#pragma unroll
      for (int t = 0; t < 2; ++t)
#pragma unroll
        for (int r = 0; r < 16; ++r) S[t][r] = 0.f;
#pragma unroll
      for (int ks = 0; ks < NKS; ++ks) {
        const bf16x8 a0 = *(const bf16x8*)(kb + (krb + pr) * KSTR + ks * 32 + hh * 16);
        S[0] = MFMA32(a0, qf[ks], S[0]);
        if (nsub == 2) {
          const bf16x8 a1 = *(const bf16x8*)(kb + (32 + pr) * KSTR + ks * 32 + hh * 16);
          S[1] = MFMA32(a1, qf[ks], S[1]);
        }
      }
      if (MODE == 0 && lat_tile) {
        const int s = qt * QPB + w * 32 + l31;
#pragma unroll
        for (int t = 0; t < 2; ++t)
#pragma unroll
          for (int r = 0; r < 16; ++r) {
            const int kk = kt * 64 + t * 32 + 16 * (r >> 3) + 8 * hh + (r & 7);
            const int d = kk - s;
            if (d > 128 || d < -128) S[t][r] = MASKV;
          }
      }
      if (MODE == 2 && lat_tile) {
        int ri = kt - qr + 7; ri = ri < 0 ? 0 : (ri > 14 ? 14 : ri);
        const float* brow = rpbs + ri * 31;
        const bool rok = (kt >= rs0) && (kt <= rs0 + 7);
        float bv[16];
#pragma unroll
        for (int r = 0; r < 16; ++r) {
          const int kc = csw + 16 * (r >> 3) + 8 * hh + (r & 7);
          int bi = kc - qc + 15; bi = bi < 0 ? 0 : (bi > 30 ? 30 : bi);
          bv[r] = brow[bi];
        }
#pragma unroll
        for (int r = 0; r < 16; ++r) asm volatile("" : "+v"(bv[r]));
#pragma unroll
        for (int r = 0; r < 16; ++r) {
          const int kc = csw + 16 * (r >> 3) + 8 * hh + (r & 7);
          const bool ok = rok && (kc >= cs) && (kc < cs + 16);
          S[0][r] = ok ? S[0][r] + bv[r] : MASKV;
        }
      }
      float mx = S[0][0];
#pragma unroll
      for (int r = 0; r < 16; ++r) mx = fmaxf(mx, S[0][r]);
      if (nsub == 2) {
#pragma unroll
        for (int r = 0; r < 16; ++r) mx = fmaxf(mx, S[1][r]);
      }
      mx = fmaxf(mx, __shfl_xor(mx, 32));
      if (__any(mx > m_ + 8.f)) {
        const float mnew = fmaxf(m_, mx);
        const float alpha = fexp2(m_ - mnew);
        m_ = mnew;
        l_ *= alpha;
#pragma unroll
        for (int dh = 0; dh < 2; ++dh)
#pragma unroll
          for (int r = 0; r < 16; ++r) O[dh][r] *= alpha;
      }
      float rsum = 0.f;
#pragma unroll
      for (int t = 0; t < 2; ++t)
        if (t < nsub) {
#pragma unroll
          for (int r = 0; r < 16; ++r) { const float e = fexp2(S[t][r] - m_); S[t][r] = e; rsum += e; }
        }
      l_ += rsum;
#pragma unroll
      for (int t = 0; t < 2; ++t)
       if (t < nsub)
#pragma unroll
        for (int s = 0; s < 2; ++s) {
          u32x4 u;
          u.x = pack_bf16(S[t][8 * s + 0], S[t][8 * s + 1]); u.y = pack_bf16(S[t][8 * s + 2], S[t][8 * s + 3]);
          u.z = pack_bf16(S[t][8 * s + 4], S[t][8 * s + 5]); u.w = pack_bf16(S[t][8 * s + 6], S[t][8 * s + 7]);
          const bf16x8 pf = __builtin_bit_cast(bf16x8, u);
#pragma unroll
          for (int dh = 0; dh < 2; ++dh) {
            const bf16x8 v = *(const bf16x8*)(vb + (dh * 32 + l31) * VSTR + (krb + t * 32 + s * 16 + hh * 8) * 2);
            O[dh] = MFMA32(v, pf, O[dh]);
          }
        }
    }
  };
  for (int j = 0; j < nsup; ++j) {
    const char* sb = lds + (j & 1) * 2 * STAGE;
    body(2 * j, sb);
    body(2 * j + 1, sb + STAGE);
    __builtin_amdgcn_sched_barrier(0);
    {
      const int so = ((j + 1) & 1) * 2;
      lstore(so, R0); lstore(so + 1, R1);
      gload(2 * j + 4, R0); gload(2 * j + 5, R1);
    }
    __syncthreads();
  }

  {
    const float lt = l_ + __shfl_xor(l_, 32);
    const float inv = 1.f / lt;
    char* orow = ostage + (w * 32) * OSTR;
#pragma unroll
    for (int dh = 0; dh < 2; ++dh)
#pragma unroll
      for (int g = 0; g < 4; ++g) {
        f32x4 v; v[0] = O[dh][4 * g] * inv; v[1] = O[dh][4 * g + 1] * inv; v[2] = O[dh][4 * g + 2] * inv; v[3] = O[dh][4 * g + 3] * inv;
        *(f32x4*)(orow + l31 * OSTR + (dh * 32 + 8 * g + 4 * hh) * 4) = v;
      }
    __builtin_amdgcn_s_waitcnt(0xc07f);
#pragma unroll
    for (int it = 0; it < 4; ++it) {
      const int cidx = lane + 64 * it, row = cidx >> 3, ch = cidx & 7;
      const f32x4 o0 = *(const f32x4*)(orow + row * OSTR + ch * 32), o1 = *(const f32x4*)(orow + row * OSTR + ch * 32 + 16);
      const int tok = tokmap(row);
      const u32x4 z = *(const u32x4*)(Zp + (size_t)tok * ldz + ch * 8);
      u32x4 wv;
      wv.x = pack_bf16(o0[0] * silu(bf_lo(z.x)), o0[1] * silu(bf_hi(z.x)));
      wv.y = pack_bf16(o0[2] * silu(bf_lo(z.y)), o0[3] * silu(bf_hi(z.y)));
      wv.z = pack_bf16(o1[0] * silu(bf_lo(z.z)), o1[1] * silu(bf_hi(z.z)));
      wv.w = pack_bf16(o1[2] * silu(bf_lo(z.w)), o1[3] * silu(bf_hi(z.w)));
      *(u32x4*)(UG + ablk(tok, gcol + ch * 8)) = wv;
    }
  }
}

DI void mla_item2(const Params& p, int layer, int b, int qt, int head, char* lds) {
  constexpr int DK = 96, NKS = 6, KSTR = DK * 2 + 16, VSTR = 144, KBYTES = 64 * KSTR, STAGE = KBYTES + 64 * VSTR;
  constexpr int NKC = 12, KCH = 64 * NKC, OSTR = 272, QG = 2, NTILES = 132;
  constexpr float MASKV = -1e30f;
  char* ostage = lds;
  const int tid = otid(), lane = tid & 63, w = tid >> 6, l31 = lane & 31, hh = lane >> 5;
  const bf16_t* Pb = (const bf16_t*)(p.ws + OFF_P);
  bf16_t* UG = (bf16_t*)(p.ws + OFF_UG);
  const bf16_t* Qp = (const bf16_t*)(p.ws + OFF_QB) + head * 96;
  const bf16_t* Kp = (const bf16_t*)(p.ws + OFF_KB) + head * 64;
  const bf16_t* Krp = Pb + 1920;
  const bf16_t* Vt = (const bf16_t*)(p.ws + OFF_VTB) + (size_t)(b * 8 + head) * 64 * NKEY;
  const bf16_t* Zp = Pb + 1952 + head * 64;
  const int gcol = 512 + head * 64;
  const int qtok0 = b * 8192 + qt * 512;
  bf16x8 qf[QG][NKS];
#pragma unroll
  for (int qg = 0; qg < QG; ++qg)
#pragma unroll
    for (int ks = 0; ks < NKS; ++ks) qf[qg][ks] = *(const bf16x8*)(Qp + (size_t)(qtok0 + qg * 256 + w * 32 + l31) * 768 + ks * 16 + hh * 8);
  float m_[QG], l_[QG];
  f32x16 O[QG][2];
#pragma unroll
  for (int qg = 0; qg < QG; ++qg) {
    m_[qg] = MASKV; l_[qg] = 0.f;
#pragma unroll
    for (int dh = 0; dh < 2; ++dh)
#pragma unroll
      for (int r = 0; r < 16; ++r) O[qg][dh][r] = 0.f;
  }
  const int k0row = tid / NKC, k0cc = tid % NKC;
  const int k1row = (tid + NT) / NKC, k1cc = (tid + NT) % NKC;
  const bool k1 = (tid + NT < KCH);
  struct Stg { u32x4 k0, k1, v; };
  Stg R0;
  R0.k1 = (u32x4){0u, 0u, 0u, 0u};
  auto kload = [&](int krow0, int row, int cc) -> u32x4 {
    if (cc >= 8) return *(const u32x4*)(Krp + (size_t)(krow0 + row) * 2560 + (cc - 8) * 8);
    return *(const u32x4*)(Kp + (size_t)(krow0 + row) * 512 + cc * 8);
  };
  auto gload = [&](int i, Stg& r) {
    const int kt = i < NTILES ? i : NTILES - 1;
    const int krow0 = kt < 128 ? b * 8192 + kt * 64 : T_LAT + b * 256 + (kt - 128) * 64;
    r.k0 = kload(krow0, k0row, k0cc);
    if (k1) r.k1 = kload(krow0, k1row, k1cc);
    r.v = *(const u32x4*)(Vt + (size_t)(tid >> 3) * NKEY + kt * 64 + (tid & 7) * 8);
  };
  auto lstore = [&](int st, const Stg& r) {
    char* kb = lds + st * STAGE;
    *(u32x4*)(kb + k0row * KSTR + k0cc * 16) = r.k0;
    if (k1) *(u32x4*)(kb + k1row * KSTR + k1cc * 16) = r.k1;
    *(u32x4*)(kb + KBYTES + (tid >> 3) * VSTR + (tid & 7) * 16) = r.v;
  };
  const int pr = (l31 & ~12) | ((l31 & 4) << 1) | ((l31 & 8) >> 1);
  __syncthreads();
  gload(0, R0); lstore(0, R0);
  gload(1, R0);
  __syncthreads();
  auto body = [&](const char* kb) {
    const char* vb = kb + KBYTES;
    f32x16 S[QG][2];
#pragma unroll
    for (int qg = 0; qg < QG; ++qg)
#pragma unroll
      for (int t = 0; t < 2; ++t)
#pragma unroll
        for (int r = 0; r < 16; ++r) S[qg][t][r] = 0.f;
#pragma unroll
    for (int ks = 0; ks < NKS; ++ks) {
      const bf16x8 a0 = *(const bf16x8*)(kb + pr * KSTR + ks * 32 + hh * 16);
      const bf16x8 a1 = *(const bf16x8*)(kb + (32 + pr) * KSTR + ks * 32 + hh * 16);
#pragma unroll
      for (int qg = 0; qg < QG; ++qg) { S[qg][0] = MFMA32(a0, qf[qg][ks], S[qg][0]); S[qg][1] = MFMA32(a1, qf[qg][ks], S[qg][1]); }
    }
#pragma unroll
    for (int qg = 0; qg < QG; ++qg) {
      float mx = S[qg][0][0];
#pragma unroll
      for (int t = 0; t < 2; ++t)
#pragma unroll
        for (int r = 0; r < 16; ++r) mx = fmaxf(mx, S[qg][t][r]);
      mx = fmaxf(mx, __shfl_xor(mx, 32));
      if (__any(mx > m_[qg] + 8.f)) {
        const float mnew = fmaxf(m_[qg], mx);
        const float alpha = fexp2(m_[qg] - mnew);
        m_[qg] = mnew;
        l_[qg] *= alpha;
#pragma unroll
        for (int dh = 0; dh < 2; ++dh)
#pragma unroll
          for (int r = 0; r < 16; ++r) O[qg][dh][r] *= alpha;
      }
      float rsum = 0.f;
#pragma unroll
      for (int t = 0; t < 2; ++t)
#pragma unroll
        for (int r = 0; r < 16; ++r) { const float e = fexp2(S[qg][t][r] - m_[qg]); S[qg][t][r] = e; rsum += e; }
      l_[qg] += rsum;
    }
#pragma unroll
    for (int t = 0; t < 2; ++t)
#pragma unroll
      for (int s = 0; s < 2; ++s) {
        bf16x8 pf[QG];
#pragma unroll
        for (int qg = 0; qg < QG; ++qg) {
          u32x4 u;
          u.x = pack_bf16(S[qg][t][8 * s + 0], S[qg][t][8 * s + 1]); u.y = pack_bf16(S[qg][t][8 * s + 2], S[qg][t][8 * s + 3]);
          u.z = pack_bf16(S[qg][t][8 * s + 4], S[qg][t][8 * s + 5]); u.w = pack_bf16(S[qg][t][8 * s + 6], S[qg][t][8 * s + 7]);
          pf[qg] = __builtin_bit_cast(bf16x8, u);
        }
#pragma unroll
        for (int dh = 0; dh < 2; ++dh) {
          const bf16x8 v = *(const bf16x8*)(vb + (dh * 32 + l31) * VSTR + (t * 32 + s * 16 + hh * 8) * 2);
#pragma unroll
          for (int qg = 0; qg < QG; ++qg) O[qg][dh] = MFMA32(v, pf[qg], O[qg][dh]);
        }
      }
  };
  for (int j = 0; j < NTILES; ++j) {
    body(lds + (j & 1) * STAGE);
    __builtin_amdgcn_sched_barrier(0);
    lstore((j + 1) & 1, R0);
    gload(j + 2, R0);
    __syncthreads();
  }
#pragma unroll
  for (int qg = 0; qg < QG; ++qg) {
    const float lt = l_[qg] + __shfl_xor(l_[qg], 32);
    const float inv = 1.f / lt;
    char* orow = ostage + (w * 32) * OSTR;
#pragma unroll
    for (int dh = 0; dh < 2; ++dh)
#pragma unroll
      for (int g = 0; g < 4; ++g) {
        f32x4 v; v[0] = O[qg][dh][4 * g] * inv; v[1] = O[qg][dh][4 * g + 1] * inv; v[2] = O[qg][dh][4 * g + 2] * inv; v[3] = O[qg][dh][4 * g + 3] * inv;
        *(f32x4*)(orow + l31 * OSTR + (dh * 32 + 8 * g + 4 * hh) * 4) = v;
      }
    __builtin_amdgcn_s_waitcnt(0xc07f);
#pragma unroll
    for (int it = 0; it < 4; ++it) {
      const int cidx = lane + 64 * it, row = cidx >> 3, ch = cidx & 7;
      const f32x4 o0 = *(const f32x4*)(orow + row * OSTR + ch * 32), o1 = *(const f32x4*)(orow + row * OSTR + ch * 32 + 16);
      const int tok = qtok0 + qg * 256 + w * 32 + row;
      const u32x4 z = *(const u32x4*)(Zp + (size_t)tok * 2560 + ch * 8);
      u32x4 wv;
      wv.x = pack_bf16(o0[0] * silu(bf_lo(z.x)), o0[1] * silu(bf_hi(z.x)));
      wv.y = pack_bf16(o0[2] * silu(bf_lo(z.y)), o0[3] * silu(bf_hi(z.y)));
      wv.z = pack_bf16(o1[0] * silu(bf_lo(z.z)), o1[1] * silu(bf_hi(z.z)));
      wv.w = pack_bf16(o1[2] * silu(bf_lo(z.w)), o1[3] * silu(bf_hi(z.w)));
      *(u32x4*)(UG + ablk(tok, gcol + ch * 8)) = wv;
    }
    __builtin_amdgcn_s_waitcnt(0xc07f);
  }
}

DI void attn_phase_ab(const Params& p, int layer, char* lds) {
  const int G = ogrid();
  for (int v = obid(); v < 512; v += G) {
    const int xcd = v & 7, s = v >> 3;
    const int grp = (s >> 4) * 8 + xcd, qt = s & 15;
    mla_item2(p, layer, grp >> 3, qt, grp & 7, lds);
  }
  for (int v = obid(); v < 32; v += G) attn_item<1>(p, layer, v >> 3, 0, v & 7, true, lds);
  for (int v = obid(); v < 1024 + 32; v += G) {
    if (v < 1024) attn_item<0>(p, layer, v >> 8, v & 31, (v >> 5) & 7, false, lds);
    else { const int c = v - 1024; attn_item<0>(p, layer, c >> 3, 0, c & 7, true, lds); }
  }
}

DI void attn_phase_c(const Params& p, int layer, char* lds) {
  const int G = ogrid();
  const int nctx = (layer == 3) ? 0 : 64;
  for (int v = obid(); v < 2048 + nctx; v += G) {
    if (v < 2048) attn_item<2>(p, layer, v >> 9, v & 31, (v >> 5) & 15, false, lds);
    else { const int c = v - 2048; attn_item<2>(p, layer, c >> 4, 0, c & 15, true, lds); }
  }
}

__global__ void __launch_bounds__(512, 2) fwd_megakernel(Params p) {
  __shared__ __attribute__((aligned(16))) char lds[LDS_BYTES];
  __shared__ uint4 xb_words;
  if (threadIdx.x == 0) xb_words = make_uint4(0u, 0u, 0u, 0u);
  __syncthreads();
  if (obid() == 0) { unsigned* bw = (unsigned*)(p.ws + OFF_BAR); for (int i = otid(); i < 4096; i += NT) bw[i] = 0u; }
  XcdBarrier xb; xb.bar = (unsigned*)(p.ws + OFF_BAR); xb.x = 0; xb.st = (volatile LAS unsigned*)&xb_words;
  bool first = true, posted = false;
  for (int ph = p.ph_begin; ph < p.ph_end; ++ph) {
    const int layer = (ph - 1) / 5, s = (ph - 1) % 5;
    const bool even = (layer & 1) == 0;
    const int i2 = layer >> 1;
    if (ph >= 1 && ph <= 20 && s == 2 && !even) continue;
    if (!first) {
      if (!posted) { cg::this_grid().sync(); xb = xcd_barrier_post((unsigned*)(p.ws + OFF_BAR), (volatile LAS unsigned*)&xb_words); posted = true; }
      else xcd_barrier(xb);
    }
    first = false;
    if (ph == 0) prologue_phase(p, lds);
    else if (ph == 21) final_phase(p);
    else if (s == 0) norm_phase(p, layer);
    else if (s == 1) {
      const bf16_t* U = (const bf16_t*)(p.ws + OFF_UG);
      for (int rep = 0; rep < REP_GEMM; ++rep) {
        if (even) gemm_phase<EPI_AB_IN>(p, layer, U, 0, (const bf16_t*)(p.ws + OFF_W_IN) + (size_t)i2 * 2560 * 1024, 1024, 128, 10, true, false, lds);
        else gemm_phase<EPI_C_IN>(p, layer, U, 0, (const bf16_t*)(p.ws + OFF_W_CIN) + (size_t)i2 * 4096 * 1024, 1024, 128, 16, true, false, lds);
        if (rep + 1 < REP_GEMM) xcd_barrier(xb);
      }
    } else if (s == 2) {
      const bf16_t* Pb = (const bf16_t*)(p.ws + OFF_P);
      gemm_phase<EPI_QB>(p, layer, Pb + 1280, 2560, (const bf16_t*)(p.ws + OFF_W_UQ) + (size_t)i2 * 768 * 384, 384, 128, 3, true, false, lds);
      gemm_phase<EPI_KVB>(p, layer, Pb + 1664, 2560, (const bf16_t*)(p.ws + OFF_W_UKV) + (size_t)i2 * 1024 * 256, 256, 128, 4, true, true, lds);
      vta_phase(p, lds);
    } else if (s == 3) {
      for (int rep = 0; rep < REP_ATTN; ++rep) {
        if (even) attn_phase_ab(p, layer, lds); else attn_phase_c(p, layer, lds);
        if (rep + 1 < REP_ATTN) xcd_barrier(xb);
      }
    } else {
      const bf16_t* Gm = (const bf16_t*)(p.ws + OFF_UG);
      const bf16_t* W = even ? (const bf16_t*)(p.ws + OFF_W_OUT) + (size_t)i2 * 1024 * 1024 : (const bf16_t*)(p.ws + OFF_W_COUT) + (size_t)i2 * 1024 * 1024;
      gemm_phase<EPI_OUT>(p, layer, Gm, 0, W, 1024, 128, 4, layer != 3, false, lds);
    }
  }
}

extern "C" void kernel_launch(void* const* d_in, const int* in_sizes, int n_in, void* d_out, int out_size, void* d_ws, size_t ws_size,
                              hipStream_t stream) {
  static int grid_blocks = 0;
  if (!grid_blocks) {
    int dev = 0, cus = 0, per_cu = 0;
    hipGetDevice(&dev);
    hipDeviceGetAttribute(&cus, hipDeviceAttributeMultiprocessorCount, dev);
    hipOccupancyMaxActiveBlocksPerMultiprocessor(&per_cu, fwd_megakernel, NT, 0);
    per_cu = 1;
    grid_blocks = cus * per_cu;
    if (ws_size < OFF_END) fprintf(stderr, "kernel_launch: workspace too small: %zu < %zu\n", ws_size, (size_t)OFF_END);
  }
  Params p{};
  const float** f = (const float**)&p;
  for (int i = 0; i < 18; ++i) f[i] = (const float*)d_in[i];
  p.out = (float*)d_out;
  p.ws = (char*)d_ws;
#if MK_MULTI_LAUNCH
  for (int ph = 0; ph < 22; ++ph) {
    if (ph >= 1 && ph <= 20 && ((ph - 1) % 5) == 2 && (((ph - 1) / 5) & 1)) continue;
    p.ph_begin = ph; p.ph_end = ph + 1;
    hipLaunchKernelGGL(fwd_megakernel, dim3(grid_blocks), dim3(NT), 0, stream, p);
  }
#else
  p.ph_begin = 0; p.ph_end = 22;
  void* args[] = {&p};
  hipError_t e = hipLaunchCooperativeKernel((void*)fwd_megakernel, dim3(grid_blocks), dim3(NT), args, 0, stream);
  if (e != hipSuccess) fprintf(stderr, "cooperative launch failed: %s (grid %d)\n", hipGetErrorString(e), grid_blocks);
#endif
}
```

```cpp
#include <hip/hip_runtime.h>
#include <hip/hip_cooperative_groups.h>
#include <stdint.h>
#include <stdio.h>
namespace cg = cooperative_groups;

#ifndef REP_ATTN
#define REP_ATTN 1
#endif
#ifndef REP_GEMM
#define REP_GEMM 1
#endif
#ifndef MK_MULTI_LAUNCH
#define MK_MULTI_LAUNCH 0
#endif

typedef unsigned short bf16_t;
typedef short bf16x8 __attribute__((ext_vector_type(8)));
typedef float f32x16 __attribute__((ext_vector_type(16)));
typedef float f32x4 __attribute__((ext_vector_type(4)));
typedef float f32x2 __attribute__((ext_vector_type(2)));
typedef unsigned u32x4 __attribute__((ext_vector_type(4)));
typedef unsigned u32x2 __attribute__((ext_vector_type(2)));

#define DI __device__ __forceinline__
#define MFMA32(a, b, c) __builtin_amdgcn_mfma_f32_32x32x16_bf16((a), (b), (c), 0, 0, 0)

constexpr int T_LAT = 32768, T_ALL = 33792, NKEY = 8448, NT = 512;
constexpr float LOG2E = 1.4426950408889634f;
constexpr float QSCALE_A = 0.125f * LOG2E;
constexpr float QSCALE_B = 0.10206207261596575f * LOG2E;

constexpr size_t OFF_HC   = 0;
constexpr size_t OFF_UG   = OFF_HC + 1024ull * 1024 * 4;
constexpr size_t OFF_P    = OFF_UG + (size_t)T_ALL * 1024 * 2;
constexpr size_t OFF_QB   = OFF_P + (size_t)T_ALL * 2560 * 2;
constexpr size_t OFF_KB   = OFF_QB + (size_t)T_ALL * 768 * 2;
constexpr size_t OFF_VT   = OFF_KB + (size_t)T_ALL * 512 * 2;
constexpr size_t OFF_VTB  = OFF_VT + 4ull * 2 * 64 * NKEY * 2;
constexpr size_t OFF_W    = OFF_VT + 4ull * 16 * 64 * NKEY * 2;
constexpr size_t OFF_W_IN   = OFF_W;
constexpr size_t OFF_W_OUT  = OFF_W_IN + 2ull * 2560 * 1024 * 2;
constexpr size_t OFF_W_UQ   = OFF_W_OUT + 2ull * 1024 * 1024 * 2;
constexpr size_t OFF_W_UKV  = OFF_W_UQ + 2ull * 768 * 384 * 2;
constexpr size_t OFF_W_CIN  = OFF_W_UKV + 2ull * 1024 * 256 * 2;
constexpr size_t OFF_W_COUT = OFF_W_CIN + 2ull * 4096 * 1024 * 2;
constexpr size_t OFF_MOD    = OFF_W_COUT + 2ull * 1024 * 1024 * 2;
constexpr size_t OFF_ROPE   = OFF_MOD + 4ull * 5 * 3072 * 4;
constexpr size_t OFF_BAR    = OFF_ROPE + 2ull * 8192 * 32 * 4 + 2ull * 8192 * 16 * 4;
constexpr size_t OFF_END    = OFF_BAR + 16384;

struct Params {
  const float *x, *c, *ctx, *c_ctx, *ada_w, *ada_b, *norm_g, *ab_in_w, *ab_out_w, *a_sink, *b_qn_g, *b_w_uq, *b_kvn_g, *b_w_ukv,
      *c_in_w, *c_out_w, *c_rpb, *final_g;
  float* out;
  char* ws;
  int ph_begin, ph_end;
};

DI int otid() { int t = threadIdx.x; asm volatile("" : "+v"(t)); return t; }
DI int obid() { int t = blockIdx.x; asm volatile("" : "+s"(t)); return t; }
DI int ogrid() { int t = gridDim.x; asm volatile("" : "+s"(t)); return t; }
DI unsigned pack_bf16(float lo, float hi) { unsigned r; asm("v_cvt_pk_bf16_f32 %0, %1, %2" : "=v"(r) : "v"(lo), "v"(hi)); return r; }
DI float bf_lo(unsigned u) { return __uint_as_float(u << 16); }
DI float bf_hi(unsigned u) { return __uint_as_float(u & 0xffff0000u); }
DI float fexp2(float x) { return __builtin_amdgcn_exp2f(x); }
DI float silu(float z) { return z * __builtin_amdgcn_rcpf(1.f + __expf(-z)); }

DI size_t ablk(int tok, int k) { return ((size_t)((tok >> 8) * 16 + (k >> 6)) << 14) + ((tok & 255) << 6) + (k & 63); }
DI void tok_bk(int tok, int& b, int& key) {
  if (tok < T_LAT) { b = tok >> 13; key = tok & 8191; } else { int r = tok - T_LAT; b = r >> 8; key = 8192 + (r & 255); }
}
DI const float* h_src(const Params& p, int layer, int tok) {
  if (layer == 0) return tok < T_LAT ? p.x + (size_t)tok * 1024 : p.ctx + (size_t)(tok - T_LAT) * 1024;
  return tok < T_LAT ? p.out + (size_t)tok * 1024 : (const float*)(p.ws + OFF_HC) + (size_t)(tok - T_LAT) * 1024;
}
DI float* h_dst(const Params& p, int tok) {
  return tok < T_LAT ? p.out + (size_t)tok * 1024 : (float*)(p.ws + OFF_HC) + (size_t)(tok - T_LAT) * 1024;
}

#define XB_TMO      128
#define XB_XCNT(j)  (256  + 64 * (j))
#define XB_XSUB(j)  (1280 + 64 * (j))
#define XB_XGEN(j)  (2304 + 64 * (j))
#define XB_TOP      3328
#define XB_TOPGEN   3392
#define XCD_BAR_WORDS 3456
#define XB_SPIN_CAP (1u << 22)
#define LAS __attribute__((address_space(3)))
DI unsigned xb_ld(unsigned* p) { return __hip_atomic_load(p, __ATOMIC_RELAXED, __HIP_MEMORY_SCOPE_AGENT); }
DI unsigned xb_add(unsigned* p, unsigned v) { return __hip_atomic_fetch_add(p, v, __ATOMIC_RELAXED, __HIP_MEMORY_SCOPE_AGENT); }
DI unsigned xb_xcc_id() { return (unsigned)__builtin_amdgcn_s_getreg((3 << 11) | 20) & 0xFu; }
#define XB_SPIN(cond, bar) do { unsigned _sp = 0; while (cond) { __builtin_amdgcn_s_sleep(1); \
    if ((++_sp & 255u) == 0u) { if (xb_ld(&(bar)[XB_TMO])) break; if (_sp > XB_SPIN_CAP) { atomicAdd(&(bar)[XB_TMO], 1u); break; } } } } while (0)
struct XcdBarrier { unsigned* bar; unsigned x; volatile LAS unsigned* st; };
DI XcdBarrier xcd_barrier_post(unsigned* bar, volatile LAS unsigned* st) {
  XcdBarrier b; b.bar = bar; b.x = xb_xcc_id(); b.st = st;
  if (threadIdx.x == 0) (void)xb_add(&bar[XB_XCNT(b.x)], 1u);
  return b;
}
DI void xcd_barrier_complete(unsigned* bar, unsigned x, unsigned& nloc, unsigned& nx) {
  const unsigned G = gridDim.x * gridDim.y * gridDim.z;
  unsigned sum, cnt, mine, sp = 0u;
  for (;;) {
    sum = 0u; cnt = 0u; mine = 0u;
#pragma unroll
    for (unsigned j = 0; j < 16; ++j) { const unsigned c = xb_ld(&bar[XB_XCNT(j)]); sum += c; cnt += (c > 0u) ? 1u : 0u; mine = (j == x) ? c : mine; }
    if (sum == G) break;
    __builtin_amdgcn_s_sleep(1);
    if ((++sp & 255u) == 0u) { if (xb_ld(&bar[XB_TMO])) break; if (sp > XB_SPIN_CAP) { atomicAdd(&bar[XB_TMO], 1u); break; } }
  }
  nloc = mine > 0u ? mine : 1u; nx = cnt > 0u ? cnt : 1u;
}
DI void xcd_barrier(const XcdBarrier& b) {
  asm volatile("s_waitcnt vmcnt(0)" ::: "memory");
  __syncthreads();
  if (threadIdx.x == 0) {
    unsigned* bar = b.bar;
    __builtin_amdgcn_s_waitcnt(0);
    unsigned nloc = b.st[0], nx = b.st[1];
    if (nloc == 0u) { xcd_barrier_complete(bar, b.x, nloc, nx); b.st[0] = nloc; b.st[1] = nx; }
    const unsigned old = xb_add(&bar[XB_XSUB(b.x)], 1u);
    const unsigned gen = old / nloc;
    if (old + 1u == (gen + 1u) * nloc) {
      __builtin_amdgcn_fence(__ATOMIC_RELEASE, "agent");
      asm volatile("s_waitcnt vmcnt(0)" ::: "memory");
      const unsigned og = xb_add(&bar[XB_TOP], 1u);
      const unsigned tg = og / nx;
      if (og + 1u == (tg + 1u) * nx) xb_add(&bar[XB_TOPGEN], 1u);
      else XB_SPIN(xb_ld(&bar[XB_TOPGEN]) == tg, bar);
      __builtin_amdgcn_fence(__ATOMIC_ACQUIRE, "agent");
      xb_add(&bar[XB_XGEN(b.x)], 1u);
      asm volatile("s_waitcnt vmcnt(0)" ::: "memory");
    } else {
      XB_SPIN(xb_ld(&bar[XB_XGEN(b.x)]) == gen, bar);
      __builtin_amdgcn_fence(__ATOMIC_ACQUIRE, "agent");
      asm volatile("s_waitcnt vmcnt(0)" ::: "memory");
    }
  }
  __syncthreads();
}

struct TJob { const float* src; const float* rs; bf16_t* dst; int K, N, tk, tn, perm; };
DI TJob tr_job(const Params& p, int t) {
  TJob j; j.rs = nullptr; j.perm = 0;
  const int i2 = t / 2312; t -= i2 * 2312;
  if (t < 640) { j.src = p.ab_in_w + (size_t)i2 * 1024 * 2464; j.K = 1024; j.N = 2464; j.dst = (bf16_t*)(p.ws + OFF_W_IN) + (size_t)i2 * 2560 * 1024; j.tk = t / 40; j.tn = t % 40; }
  else if ((t -= 640) < 256) { j.src = p.ab_out_w + (size_t)i2 * 1024 * 1024; j.K = 1024; j.N = 1024; j.dst = (bf16_t*)(p.ws + OFF_W_OUT) + (size_t)i2 * 1024 * 1024; j.tk = t / 16; j.tn = t % 16; }
  else if ((t -= 256) < 72) { j.src = p.b_w_uq + (size_t)i2 * 384 * 768; j.K = 384; j.N = 768; j.dst = (bf16_t*)(p.ws + OFF_W_UQ) + (size_t)i2 * 768 * 384; j.rs = p.b_qn_g + i2 * 384; j.tk = t / 12; j.tn = t % 12; }
  else if ((t -= 72) < 64) { j.src = p.b_w_ukv + (size_t)i2 * 256 * 1024; j.K = 256; j.N = 1024; j.dst = (bf16_t*)(p.ws + OFF_W_UKV) + (size_t)i2 * 1024 * 256; j.rs = p.b_kvn_g + i2 * 256; j.tk = t / 16; j.tn = t % 16; j.perm = 1; }
  else if ((t -= 64) < 1024) { j.src = p.c_in_w + (size_t)i2 * 1024 * 4096; j.K = 1024; j.N = 4096; j.dst = (bf16_t*)(p.ws + OFF_W_CIN) + (size_t)i2 * 4096 * 1024; j.tk = t / 64; j.tn = t % 64; }
  else { t -= 1024; j.src = p.c_out_w + (size_t)i2 * 1024 * 1024; j.K = 1024; j.N = 1024; j.dst = (bf16_t*)(p.ws + OFF_W_COUT) + (size_t)i2 * 1024 * 1024; j.tk = t / 16; j.tn = t % 16; }
  return j;
}
DI void tr_load(const TJob& j, int tid, float (&v)[8]) {
#pragma unroll
  for (int i = 0; i < 8; ++i) {
    const int kk = (tid >> 6) + 8 * i, n = j.tn * 64 + (tid & 63);
    float x = (n < j.N) ? j.src[(size_t)(j.tk * 64 + kk) * j.N + n] : 0.f;
    if (j.rs) x *= j.rs[j.tk * 64 + kk];
    v[i] = x;
  }
}

DI void prologue_phase(const Params& p, char* lds) {
  const int tid = otid();
  constexpr int N_MOD = 192, N_TR = 4624, N_ROPE = 768;
  for (int u = obid(); u < N_MOD + N_TR + N_ROPE; u += ogrid()) {
    if (u < N_MOD) {
      const int layer = u / 48, cb = u % 48;
      float* sl = (float*)lds;
      for (int i = tid; i < 5120; i += NT) {
        const int bb = i >> 10, k = i & 1023;
        const float cv = bb < 4 ? p.c[bb * 1024 + k] : p.c_ctx[k];
        sl[i] = silu(cv);
      }
      __syncthreads();
      const int col = cb * 64 + (tid & 63), kg = tid >> 6;
      float a0 = 0, a1 = 0, a2 = 0, a3 = 0, a4 = 0;
      const float* wp = p.ada_w + (size_t)layer * 1024 * 3072 + col;
#pragma unroll 8
      for (int k = kg * 128; k < kg * 128 + 128; ++k) {
        const float wv = wp[(size_t)k * 3072];
        a0 += sl[k] * wv; a1 += sl[1024 + k] * wv; a2 += sl[2048 + k] * wv; a3 += sl[3072 + k] * wv; a4 += sl[4096 + k] * wv;
      }
      float* red = (float*)(lds + 20480);
      red[(kg * 5 + 0) * 64 + (tid & 63)] = a0; red[(kg * 5 + 1) * 64 + (tid & 63)] = a1; red[(kg * 5 + 2) * 64 + (tid & 63)] = a2;
      red[(kg * 5 + 3) * 64 + (tid & 63)] = a3; red[(kg * 5 + 4) * 64 + (tid & 63)] = a4;
      __syncthreads();
      if (tid < 64) {
        float* mod = (float*)(p.ws + OFF_MOD);
        const float bias = p.ada_b[layer * 3072 + col];
#pragma unroll
        for (int bb = 0; bb < 5; ++bb) {
          float s = bias;
#pragma unroll
          for (int g = 0; g < 8; ++g) s += red[(g * 5 + bb) * 64 + tid];
          mod[(size_t)(layer * 5 + bb) * 3072 + col] = s;
        }
      }
      __syncthreads();
    } else if (u < N_MOD + N_TR) {
    } else {
      const int idx = (u - N_MOD - N_TR) * NT + tid;
      float* ropeA = (float*)(p.ws + OFF_ROPE);
      float* ropeB = ropeA + 2 * 8192 * 32;
      if (idx < 8192 * 32) {
        const int pos = idx >> 5, pr = idx & 31;
        const float pv = pr < 16 ? (float)(pos >> 6) : (float)(pos & 63);
        const float inv = exp2f(-(float)(pr & 15) * (13.287712379549449f / 16.f));
        const float ang = pv * inv;
        ropeA[idx] = cosf(ang); ropeA[8192 * 32 + idx] = sinf(ang);
      } else {
        const int j = idx - 8192 * 32;
        const int pos = j >> 4, pr = j & 15;
        const float pv = pr < 8 ? (float)(pos >> 6) : (float)(pos & 63);
        const float inv = exp2f(-(float)(pr & 7) * (13.287712379549449f / 8.f));
        const float ang = pv * inv;
        ropeB[j] = cosf(ang); ropeB[8192 * 16 + j] = sinf(ang);
      }
    }
  }
  {
    const int G = ogrid();
    int t = obid();
    float v[8], nv[8];
    TJob cur, nxt;
    if (t < N_TR) { cur = tr_job(p, t); tr_load(cur, tid, v); }
    int buf = 0;
    for (; t < N_TR; t += G) {
      const bool more = t + G < N_TR;
      if (more) { nxt = tr_job(p, t + G); tr_load(nxt, tid, nv); }
      float* tile = (float*)(lds + buf * 16640);
#pragma unroll
      for (int i = 0; i < 8; ++i) tile[((tid >> 6) + 8 * i) * 65 + (tid & 63)] = v[i];
      __syncthreads();
      {
        const int nn = tid & 63, k8 = (tid >> 6) * 8;
        int n = cur.tn * 64 + nn;
        if (cur.perm) n = ((n & 64) ? 512 : 0) + (n >> 7) * 64 + (n & 63);
        u32x4 w;
        w.x = pack_bf16(tile[(k8 + 0) * 65 + nn], tile[(k8 + 1) * 65 + nn]); w.y = pack_bf16(tile[(k8 + 2) * 65 + nn], tile[(k8 + 3) * 65 + nn]);
        w.z = pack_bf16(tile[(k8 + 4) * 65 + nn], tile[(k8 + 5) * 65 + nn]); w.w = pack_bf16(tile[(k8 + 6) * 65 + nn], tile[(k8 + 7) * 65 + nn]);
        *(u32x4*)(cur.dst + ((size_t)((n >> 8) * (cur.K >> 6) + cur.tk) << 14) + ((n & 255) << 6) + k8) = w;
      }
      buf ^= 1;
      if (more) {
        cur = nxt;
#pragma unroll
        for (int i = 0; i < 8; ++i) v[i] = nv[i];
      }
    }
    __syncthreads();
  }
}

DI float wave_sum(float v) {
#pragma unroll
  for (int o = 32; o >= 1; o >>= 1) v += __shfl_xor(v, o);
  return v;
}

DI void norm_phase(const Params& p, int layer) {
  const int lane = otid() & 63;
  const int wave = obid() * 8 + (otid() >> 6), nw = ogrid() * 8;
  const float* g = p.norm_g + layer * 1024;
  const float* mod = (const float*)(p.ws + OFF_MOD) + (size_t)layer * 5 * 3072;
  bf16_t* U = (bf16_t*)(p.ws + OFF_UG);
  f32x4 gv[4];
#pragma unroll
  for (int i = 0; i < 4; ++i) gv[i] = *(const f32x4*)(g + lane * 4 + 256 * i);
  for (int row = wave; row < T_ALL; row += nw) {
    const int bb = row < T_LAT ? (row >> 13) : 4;
    const float* src = h_src(p, layer, row);
    f32x4 v[4];
    float ss = 0.f;
#pragma unroll
    for (int i = 0; i < 4; ++i) {
      v[i] = *(const f32x4*)(src + lane * 4 + 256 * i);
      ss += v[i][0] * v[i][0] + v[i][1] * v[i][1] + v[i][2] * v[i][2] + v[i][3] * v[i][3];
    }
    ss = wave_sum(ss);
    const float rstd = rsqrtf(ss * (1.f / 1024.f) + 1e-6f);
    const float* mrow = mod + bb * 3072;
#pragma unroll
    for (int i = 0; i < 4; ++i) {
      const int cidx = lane * 4 + 256 * i;
      const f32x4 sh = *(const f32x4*)(mrow + cidx), sc = *(const f32x4*)(mrow + 1024 + cidx);
      f32x4 o = (v[i] * rstd) * gv[i] * (sc + 1.f) + sh;
      u32x2 w; w.x = pack_bf16(o[0], o[1]); w.y = pack_bf16(o[2], o[3]);
      *(u32x2*)(U + ablk(row, cidx)) = w;
    }
  }
}

DI void final_phase(const Params& p) {
  const int lane = otid() & 63;
  const int wave = obid() * 8 + (otid() >> 6), nw = ogrid() * 8;
  f32x4 gv[4];
#pragma unroll
  for (int i = 0; i < 4; ++i) gv[i] = *(const f32x4*)(p.final_g + lane * 4 + 256 * i);
  for (int row = wave; row < T_LAT; row += nw) {
    float* src = p.out + (size_t)row * 1024;
    f32x4 v[4];
    float ss = 0.f;
#pragma unroll
    for (int i = 0; i < 4; ++i) {
      v[i] = *(const f32x4*)(src + lane * 4 + 256 * i);
      ss += v[i][0] * v[i][0] + v[i][1] * v[i][1] + v[i][2] * v[i][2] + v[i][3] * v[i][3];
    }
    ss = wave_sum(ss);
    const float rstd = rsqrtf(ss * (1.f / 1024.f) + 1e-6f);
#pragma unroll
    for (int i = 0; i < 4; ++i) *(f32x4*)(src + lane * 4 + 256 * i) = (v[i] * rstd) * gv[i];
  }
}

enum { EPI_AB_IN = 0, EPI_QB = 1, EPI_KVB = 2, EPI_C_IN = 3, EPI_OUT = 4 };
constexpr int G_STR = 144;
constexpr int G_OPER = 256 * G_STR;
constexpr int G_STAGE = 2 * G_OPER;
constexpr int OFF_RSTD = 2 * G_STAGE;
constexpr int LDS_BYTES = OFF_RSTD + 1024;

DI void rope2(float& v0, float& v1, float& v2, float& v3, const float* cs, const float* sn) {
  const f32x2 c = *(const f32x2*)cs, s = *(const f32x2*)sn;
  const float a0 = v0 * c.x - v1 * s.x, a1 = v0 * s.x + v1 * c.x, a2 = v2 * c.y - v3 * s.y, a3 = v2 * s.y + v3 * c.y;
  v0 = a0; v1 = a1; v2 = a2; v3 = a3;
}

template <int EPI>
DI void epi_math(const Params& p, int tok, int f0, float& v0, float& v1, float& v2, float& v3, float rs) {
  const float* ropeA = (const float*)(p.ws + OFF_ROPE);
  const float* ropeB = ropeA + 2 * 8192 * 32;
  const bool lat = tok < T_LAT;
  const int pos = tok & 8191;
  if (EPI == EPI_AB_IN) {
    if (f0 < 640) {
      if (lat) { const int p0 = (f0 & 63) >> 1; rope2(v0, v1, v2, v3, ropeA + pos * 32 + p0, ropeA + 8192 * 32 + pos * 32 + p0); }
      if (f0 < 512) { v0 *= QSCALE_A; v1 *= QSCALE_A; v2 *= QSCALE_A; v3 *= QSCALE_A; }
    } else if (f0 >= 1920 && f0 < 1952) {
      if (lat) { const int p0 = (f0 - 1920) >> 1; rope2(v0, v1, v2, v3, ropeB + pos * 16 + p0, ropeB + 8192 * 16 + pos * 16 + p0); }
    }
  } else if (EPI == EPI_QB) {
    const float s = rs * QSCALE_B;
    v0 *= s; v1 *= s; v2 *= s; v3 *= s;
    const int fh = f0 % 96;
    if (fh >= 64 && lat) { const int p0 = (fh - 64) >> 1; rope2(v0, v1, v2, v3, ropeB + pos * 16 + p0, ropeB + 8192 * 16 + pos * 16 + p0); }
  } else if (EPI == EPI_KVB) {
    v0 *= rs; v1 *= rs; v2 *= rs; v3 *= rs;
  } else if (EPI == EPI_C_IN) {
    if (f0 < 1024) { v0 *= QSCALE_A; v1 *= QSCALE_A; v2 *= QSCALE_A; v3 *= QSCALE_A; }
  }
}

template <int EPI>
DI bf16_t* dst_tr(const Params& p, int tok, int col) {
  if (EPI == EPI_AB_IN) return col < 2464 ? (bf16_t*)(p.ws + OFF_P) + (size_t)tok * 2560 + col : nullptr;
  if (EPI == EPI_QB) return (bf16_t*)(p.ws + OFF_QB) + (size_t)tok * 768 + col;
  if (EPI == EPI_KVB) return (bf16_t*)(p.ws + OFF_KB) + (size_t)tok * 512 + col;
  return (bf16_t*)(p.ws + OFF_P) + (size_t)tok * 3072 + (col >= 3072 ? col - 1024 : col);
}
template <int EPI>
DI bf16_t* dst_v(const Params& p, int t0, int col) {
  int b, key; tok_bk(t0, b, key);
  if (EPI == EPI_KVB) return (bf16_t*)(p.ws + OFF_VTB) + ((size_t)(b * 8 + ((col - 512) >> 6)) * 64 + (col & 63)) * NKEY + key;
  return (bf16_t*)(p.ws + OFF_VT) + ((size_t)(b * 16 + ((col - 2048) >> 6)) * 64 + (col & 63)) * NKEY + key;
}

struct TilePf { bool pre; bool has_next; int nm0, nnt; };
template <int EPI, int TM>
DI void gemm_tile(const Params& p, int layer, const bf16_t* __restrict__ A, int lda, const bf16_t* __restrict__ Bt, int K, int m0, int nt, char* lds,
                  u32x4 (&ra)[TM / 64], u32x4 (&rb)[4], const TilePf pf) {
  constexpr int NJ = TM == 256 ? 4 : 2, NI = TM == 256 ? 2 : 1, NA = TM / 64;
  const int tid = otid(), lane = tid & 63, w = tid >> 6;
  const int wm = TM == 256 ? (w >> 2) : 0, wn = TM == 256 ? (w & 3) : w;
  const int fb = TM == 256 ? wn * 64 : wn * 32, tb = TM == 256 ? wm * 128 : 0;
  const int l31 = lane & 31, hh = lane >> 5;
  const int n0 = nt * 256;
  float* rstd = (float*)(lds + OFF_RSTD);
  const int srow = tid >> 3, scc = tid & 7;
  const bool ablocked = (lda == 0);
  const int nkb = K >> 6;
  const bf16_t* ag = ablocked ? A + ((size_t)((m0 >> 8) * 16) << 14) + (m0 & 255) * 64 + tid * 8 : A + (size_t)(m0 + srow) * lda + scc * 8;
  const size_t a_i = ablocked ? 4096 : (size_t)64 * lda, a_k = ablocked ? 16384 : 64;
  const bf16_t* bg = Bt + ((size_t)(nt * nkb) << 14) + tid * 8;

  if (EPI == EPI_QB || EPI == EPI_KVB) {
    __syncthreads();
    if (tid < 2 * TM) {
      const int r = tid >> 1, half = tid & 1;
      const bf16_t* ap = A + (size_t)(m0 + r) * lda + half * (K / 2);
      float ss = 0.f;
      for (int cidx = 0; cidx < K / 2; cidx += 8) {
        const u32x4 v = *(const u32x4*)(ap + cidx);
#pragma unroll
        for (int e = 0; e < 4; ++e) { const float a = bf_lo(v[e]), b2 = bf_hi(v[e]); ss += a * a + b2 * b2; }
      }
      ss += __shfl_xor(ss, 1);
      if (half == 0) rstd[r] = rsqrtf(ss / (float)K + 1e-6f);
    }
  }

  f32x16 acc[NI][NJ];
#pragma unroll
  for (int i = 0; i < NI; ++i)
#pragma unroll
    for (int j = 0; j < NJ; ++j)
#pragma unroll
      for (int r = 0; r < 16; ++r) acc[i][j][r] = 0.f;

  const int nk = K >> 6;
  if (!pf.pre) {
#pragma unroll
    for (int i = 0; i < NA; ++i) ra[i] = *(const u32x4*)(ag + i * a_i);
#pragma unroll
    for (int i = 0; i < 4; ++i) rb[i] = *(const u32x4*)(bg + i * 4096);
  }
#pragma unroll
  for (int i = 0; i < NA; ++i) *(u32x4*)(lds + (srow + 64 * i) * G_STR + scc * 16) = ra[i];
#pragma unroll
  for (int i = 0; i < 4; ++i) *(u32x4*)(lds + G_OPER + (srow + 64 * i) * G_STR + scc * 16) = rb[i];
#pragma unroll
  for (int i = 0; i < NA; ++i) ra[i] = *(const u32x4*)(ag + i * a_i + a_k);
#pragma unroll
  for (int i = 0; i < 4; ++i) rb[i] = *(const u32x4*)(bg + i * 4096 + 16384);
  __syncthreads();
  for (int kt = 0; kt < nk; ++kt) {
    {
      char* st = lds + ((kt + 1) & 1) * G_STAGE;
#pragma unroll
      for (int i = 0; i < NA; ++i) *(u32x4*)(st + (srow + 64 * i) * G_STR + scc * 16) = ra[i];
#pragma unroll
      for (int i = 0; i < 4; ++i) *(u32x4*)(st + G_OPER + (srow + 64 * i) * G_STR + scc * 16) = rb[i];
    }
    if (kt + 2 < nk) {
#pragma unroll
      for (int i = 0; i < NA; ++i) ra[i] = *(const u32x4*)(ag + i * a_i + (size_t)(kt + 2) * a_k);
#pragma unroll
      for (int i = 0; i < 4; ++i) rb[i] = *(const u32x4*)(bg + i * 4096 + ((size_t)(kt + 2) << 14));
    }
    __builtin_amdgcn_sched_barrier(0);
    const char* as = lds + (kt & 1) * G_STAGE;
    const char* fp = as + G_OPER + (fb + l31) * G_STR + hh * 16;
    const char* sp = as + (tb + l31) * G_STR + hh * 16;
#pragma unroll
    for (int ks = 0; ks < 4; ++ks) {
      bf16x8 f[NI], s[NJ];
#pragma unroll
      for (int i = 0; i < NI; ++i) f[i] = *(const bf16x8*)(fp + i * 32 * G_STR + ks * 32);
#pragma unroll
      for (int j = 0; j < NJ; ++j) s[j] = *(const bf16x8*)(sp + j * 32 * G_STR + ks * 32);
#pragma unroll
      for (int j = 0; j < NJ; ++j)
#pragma unroll
        for (int i = 0; i < NI; ++i) acc[i][j] = MFMA32(f[i], s[j], acc[i][j]);
    }
    __syncthreads();
  }

  auto prefetch_next = [&]() {
    if (TM == 256 && pf.has_next) {
      const bf16_t* nag = ablocked ? A + ((size_t)((pf.nm0 >> 8) * 16) << 14) + (pf.nm0 & 255) * 64 + tid * 8 : A + (size_t)(pf.nm0 + srow) * lda + scc * 8;
      const bf16_t* nbg = Bt + ((size_t)(pf.nnt * nkb) << 14) + tid * 8;
#pragma unroll
      for (int i = 0; i < NA; ++i) ra[i] = *(const u32x4*)(nag + i * a_i);
#pragma unroll
      for (int i = 0; i < 4; ++i) rb[i] = *(const u32x4*)(nbg + i * 4096);
      __builtin_amdgcn_sched_barrier(0);
    }
  };
  constexpr int SB = 528;
  constexpr int SV = TM * 2 + 16;
  constexpr int NIT = TM * 32 / NT;
  if (EPI == EPI_OUT) {
    const int bb = m0 < T_LAT ? (m0 >> 13) : 4;
#pragma unroll
    for (int h = 0; h < 2; ++h) {
      if ((TM == 256 ? (wn >> 1) : (wn >> 2)) == h) {
#pragma unroll
        for (int j = 0; j < NJ; ++j)
#pragma unroll
          for (int i = 0; i < NI; ++i)
#pragma unroll
            for (int g = 0; g < 4; ++g) {
              f32x4 v; v[0] = acc[i][j][4 * g]; v[1] = acc[i][j][4 * g + 1]; v[2] = acc[i][j][4 * g + 2]; v[3] = acc[i][j][4 * g + 3];
              *(f32x4*)(lds + (tb + j * 32 + l31) * SB + ((fb & 127) + i * 32 + 8 * g + 4 * hh) * 4) = v;
            }
      }
      if (h == 1) prefetch_next();
      __syncthreads();
      const float* gate = (const float*)(p.ws + OFF_MOD) + (size_t)(layer * 5 + bb) * 3072 + 2048 + n0 + h * 128;
#pragma unroll 4
      for (int it = 0; it < NIT; ++it) {
        const int cidx = tid + NT * it, row = cidx >> 5, ch = cidx & 31;
        const f32x4 y = *(const f32x4*)(lds + row * SB + ch * 16);
        const f32x4 gt = *(const f32x4*)(gate + ch * 4);
        const f32x4 old = *(const f32x4*)(h_src(p, layer, m0 + row) + n0 + h * 128 + ch * 4);
        *(f32x4*)(h_dst(p, m0 + row) + n0 + h * 128 + ch * 4) = old + gt * y;
      }
      __syncthreads();
    }
  } else {
    const bool vt = (EPI == EPI_KVB && nt >= 2) || (EPI == EPI_C_IN && nt >= 8 && nt < 12);
#pragma unroll
    for (int j = 0; j < NJ; ++j) {
      const int rl = tb + j * 32 + l31;
      float rs = 1.f;
      if (EPI == EPI_QB || EPI == EPI_KVB) rs = rstd[rl];
#pragma unroll
      for (int i = 0; i < NI; ++i)
#pragma unroll
        for (int g = 0; g < 4; ++g) {
          const int fl = fb + i * 32 + 8 * g + 4 * hh;
          float v0 = acc[i][j][4 * g], v1 = acc[i][j][4 * g + 1], v2 = acc[i][j][4 * g + 2], v3 = acc[i][j][4 * g + 3];
          epi_math<EPI>(p, m0 + rl, n0 + fl, v0, v1, v2, v3, rs);
          const unsigned w01 = pack_bf16(v0, v1), w23 = pack_bf16(v2, v3);
          if (!vt) {
            u32x2 wv; wv.x = w01; wv.y = w23;
            *(u32x2*)(lds + rl * SB + fl * 2) = wv;
          } else {
            *(bf16_t*)(lds + (fl + 0) * SV + rl * 2) = (bf16_t)(w01 & 0xffffu);
            *(bf16_t*)(lds + (fl + 1) * SV + rl * 2) = (bf16_t)(w01 >> 16);
            *(bf16_t*)(lds + (fl + 2) * SV + rl * 2) = (bf16_t)(w23 & 0xffffu);
            *(bf16_t*)(lds + (fl + 3) * SV + rl * 2) = (bf16_t)(w23 >> 16);
          }
        }
    }
    prefetch_next();
    __syncthreads();
#pragma unroll 4
    for (int it = 0; it < NIT; ++it) {
      const int cidx = tid + NT * it;
      if (vt) {
        const int row = cidx / (TM / 8), ch = cidx % (TM / 8);
        *(u32x4*)dst_v<EPI>(p, m0 + ch * 8, n0 + row) = *(const u32x4*)(lds + row * SV + ch * 16);
      } else {
        const int row = cidx >> 5, ch = cidx & 31;
        bf16_t* d = dst_tr<EPI>(p, m0 + row, n0 + ch * 8);
        if (d) *(u32x4*)d = *(const u32x4*)(lds + row * SB + ch * 16);
      }
    }
    __syncthreads();
  }
}

template <int EPI>
DI void gemm_phase(const Params& p, int layer, const bf16_t* A, int lda, const bf16_t* Bt, int K, int mtiles, int ntiles, bool ctx, bool reverse, char* lds) {
  const int G = ogrid();
  const int bid = reverse ? (G - 1 - obid()) : obid();
  u32x4 ra[4], rb[4];
  const bool simple = (G & 7) != 0;
  const int xcd = bid & 7, local = simple ? bid : (bid >> 3), nlocal = simple ? G : (G >> 3);
  const int mlo = simple ? 0 : ((xcd * mtiles) >> 3), cnt = simple ? mtiles : ((((xcd + 1) * mtiles) >> 3) - mlo);
  const int total = cnt * ntiles, gsize = 4 * ntiles;
  auto tile_of = [&](int j, int& m0, int& nt) {
    const int g = j / gsize, r = j - g * gsize;
    int gm = cnt - g * 4; gm = gm > 4 ? 4 : gm;
    m0 = (mlo + g * 4 + (r % gm)) * 256; nt = r / gm;
  };
  bool pre = false;
  for (int j = local; j < total; j += nlocal) {
    int m0, nt; tile_of(j, m0, nt);
    TilePf pf; pf.pre = pre; pf.has_next = (j + nlocal < total); pf.nm0 = 0; pf.nnt = 0;
    if (pf.has_next) tile_of(j + nlocal, pf.nm0, pf.nnt);
    gemm_tile<EPI, 256>(p, layer, A, lda, Bt, K, m0, nt, lds, ra, rb, pf);
    pre = pf.has_next;
  }
  if (ctx) {
    const int b2 = G - 1 - bid;
    u32x4 ra1[1];
    TilePf pf; pf.pre = false; pf.has_next = false; pf.nm0 = 0; pf.nnt = 0;
    for (int u = b2; u < 16 * ntiles; u += G) gemm_tile<EPI, 64>(p, layer, A, lda, Bt, K, T_LAT + (u & 15) * 64, u >> 4, lds, ra1, rb, pf);
  }
}

DI void vta_phase(const Params& p, char* lds) {
  const int tid = otid();
  const bf16_t* Pb = (const bf16_t*)(p.ws + OFF_P);
  for (int u = ogrid() - 1 - obid(); u < T_ALL / 64; u += ogrid()) {
    const int t0 = u * 64;
#pragma unroll
    for (int it = 0; it < 2; ++it) {
      const int cidx = tid + NT * it, row = cidx >> 4, ch = cidx & 15;
      *(u32x4*)(lds + row * 272 + ch * 16) = *(const u32x4*)(Pb + (size_t)(t0 + row) * 2560 + 640 + ch * 8);
    }
    __syncthreads();
    int b, key; tok_bk(t0, b, key);
#pragma unroll
    for (int it = 0; it < 2; ++it) {
      const int cidx = tid + NT * it, f = cidx & 127, tc = cidx >> 7;
      unsigned short e[8];
#pragma unroll
      for (int k = 0; k < 8; ++k) e[k] = *(const bf16_t*)(lds + (tc * 8 + k) * 272 + f * 2);
      u32x4 v; v.x = e[0] | ((unsigned)e[1] << 16); v.y = e[2] | ((unsigned)e[3] << 16); v.z = e[4] | ((unsigned)e[5] << 16); v.w = e[6] | ((unsigned)e[7] << 16);
      *(u32x4*)((bf16_t*)(p.ws + OFF_VT) + ((size_t)(b * 2 + (f >> 6)) * 64 + (f & 63)) * NKEY + key + tc * 8) = v;
    }
    __syncthreads();
  }
}

template <int MODE>
DI void attn_item(const Params& p, int layer, int b, int qt, int head, bool is_ctx, char* lds) {
  constexpr int DK = (MODE == 1) ? 96 : 64;
  constexpr int NKS = DK / 16;
  constexpr int KSTR = DK * 2 + 16;
  constexpr int VSTR = 144;
  constexpr int KBYTES = 64 * KSTR;
  constexpr int STAGE = KBYTES + 64 * VSTR;
  constexpr int QPB = 256;
  constexpr int NKC = DK / 8;
  constexpr int KCH = 64 * NKC;
  constexpr int OSTR = 272;
  constexpr float MASKV = -1e30f;
  float* rpbs = (float*)(lds + 4 * STAGE);
  char* ostage = lds;

  const int tid = otid(), lane = tid & 63, w = tid >> 6, l31 = lane & 31, hh = lane >> 5;
  const int i2 = layer >> 1;
  const bf16_t* Pb = (const bf16_t*)(p.ws + OFF_P);
  bf16_t* UG = (bf16_t*)(p.ws + OFF_UG);
  const bf16_t *Qp, *Kp, *Krp = nullptr, *Zp, *Vt;
  int ldq, ldk, ldz, gcol;
  if (MODE == 0) {
    Qp = Pb + head * 64; ldq = 2560; Kp = Pb + 512 + (head >> 2) * 64; ldk = 2560;
    Vt = (const bf16_t*)(p.ws + OFF_VT) + (size_t)(b * 2 + (head >> 2)) * 64 * NKEY;
    Zp = Pb + 768 + head * 64; ldz = 2560; gcol = head * 64;
  } else if (MODE == 1) {
    Qp = (const bf16_t*)(p.ws + OFF_QB) + head * 96; ldq = 768; Kp = (const bf16_t*)(p.ws + OFF_KB) + head * 64; ldk = 512; Krp = Pb + 1920;
    Vt = (const bf16_t*)(p.ws + OFF_VTB) + (size_t)(b * 8 + head) * 64 * NKEY;
    Zp = Pb + 1952 + head * 64; ldz = 2560; gcol = 512 + head * 64;
  } else {
    Qp = Pb + head * 64; ldq = 3072; Kp = Pb + 1024 + head * 64; ldk = 3072;
    Vt = (const bf16_t*)(p.ws + OFF_VT) + (size_t)(b * 16 + head) * 64 * NKEY;
    Zp = Pb + 2048 + head * 64; ldz = 3072; gcol = head * 64;
  }
  const int qtok0 = is_ctx ? T_LAT + b * 256 : b * 8192 + qt * QPB;

  int lat_lo = 0, nlat = 0;
  if (!is_ctx) {
    if (MODE == 0) {
      int lo = 4 * qt - 2; if (lo < 0) lo = 0;
      int hi = 4 * qt + 5; if (hi > 127) hi = 127;
      lat_lo = lo; nlat = hi - lo + 1;
    } else if (MODE == 1) { lat_lo = 0; nlat = 128; }
    else {
      int lo = 4 * qt - 4; lo = lo < 0 ? 0 : (lo > 120 ? 120 : lo);
      int hi = 4 * qt + 3 - 4; hi = hi < 0 ? 0 : (hi > 120 ? 120 : hi); hi += 7;
      lat_lo = lo; nlat = hi - lo + 1;
    }
  }
  const int ntiles = nlat + 4;

  const bool nat2 = (MODE == 2) && !is_ctx;
  auto tokmap = [&](int row) { return nat2 ? qtok0 + ((w >> 2) * 2 + (row >> 4)) * 64 + (w & 3) * 16 + (row & 15) : qtok0 + w * 32 + row; };
  const int qtok = tokmap(l31);
  bf16x8 qf[NKS];
#pragma unroll
  for (int ks = 0; ks < NKS; ++ks) qf[ks] = *(const bf16x8*)(Qp + (size_t)qtok * ldq + ks * 16 + hh * 8);
  if (MODE == 2 && !is_ctx) {
    for (int i = tid; i < 465; i += NT) rpbs[i] = p.c_rpb[(size_t)(i2 * 16 + head) * 465 + i] * LOG2E;
  }
  float m_ = (MODE == 0) ? p.a_sink[i2 * 8 + head] * LOG2E : MASKV;
  float l_ = (MODE == 0 && hh == 0) ? 1.f : 0.f;
  f32x16 O[2];
#pragma unroll
  for (int dh = 0; dh < 2; ++dh)
#pragma unroll
    for (int r = 0; r < 16; ++r) O[dh][r] = 0.f;

  const int k0row = tid / NKC, k0cc = tid % NKC;
  const int k1row = (tid + NT) / NKC, k1cc = (tid + NT) % NKC;
  const bool k1 = (KCH > NT) && (tid + NT < KCH);
  struct Stg { u32x4 k0, k1, v; };
  Stg R0, R1;
  R0.k1 = (u32x4){0u, 0u, 0u, 0u}; R1.k1 = R0.k1;
  auto tile_kt = [&](int i) { return i < nlat ? lat_lo + i : 128 + (i - nlat); };
  auto kload = [&](int krow0, int row, int cc) -> u32x4 {
    if (MODE == 1 && cc >= 8) return *(const u32x4*)(Krp + (size_t)(krow0 + row) * 2560 + (cc - 8) * 8);
    return *(const u32x4*)(Kp + (size_t)(krow0 + row) * ldk + cc * 8);
  };
  auto gload = [&](int i, Stg& r) {
    const int kt = tile_kt(i < ntiles ? i : ntiles - 1);
    const int krow0 = kt < 128 ? b * 8192 + kt * 64 : T_LAT + b * 256 + (kt - 128) * 64;
    r.k0 = kload(krow0, k0row, k0cc);
    if (k1) r.k1 = kload(krow0, k1row, k1cc);
    r.v = *(const u32x4*)(Vt + (size_t)(tid >> 3) * NKEY + kt * 64 + (tid & 7) * 8);
  };
  auto lstore = [&](int st, const Stg& r) {
    char* kb = lds + st * STAGE;
    *(u32x4*)(kb + k0row * KSTR + k0cc * 16) = r.k0;
    if (k1) *(u32x4*)(kb + k1row * KSTR + k1cc * 16) = r.k1;
    *(u32x4*)(kb + KBYTES + (tid >> 3) * VSTR + (tid & 7) * 16) = r.v;
  };

  const int pr = (l31 & ~12) | ((l31 & 4) << 1) | ((l31 & 8) >> 1);
  int qr = 0, qc = 0, rs0 = 0, cs = 0, csw = 0, wlo = 0, whi = 0;
  if (MODE == 2) {
    qr = qt * 4 + (w >> 2) * 2 + (l31 >> 4); qc = (w & 3) * 16 + (l31 & 15);
    rs0 = qr - 4; rs0 = rs0 < 0 ? 0 : (rs0 > 120 ? 120 : rs0);
    cs = qc - 8; cs = cs < 0 ? 0 : (cs > 48 ? 48 : cs);
    csw = (w & 3) * 16 - 8; csw = csw < 0 ? 0 : (csw > 32 ? 32 : csw);
    const int r_lo = qt * 4 + (w >> 2) * 2;
    wlo = r_lo - 4; wlo = wlo < 0 ? 0 : (wlo > 120 ? 120 : wlo);
    whi = r_lo + 1 - 4; whi = whi < 0 ? 0 : (whi > 120 ? 120 : whi); whi += 7;
  }
  const int s0w = qt * QPB + w * 32;
  const int nsup = (ntiles + 1) >> 1;
  __syncthreads();
  gload(0, R0); gload(1, R1);
  lstore(0, R0); lstore(1, R1);
  gload(2, R0); gload(3, R1);
  __syncthreads();
  auto body = [&](int it, const char* kb) {
    const char* vb = kb + KBYTES;
    const int kt = tile_kt(it);
    const bool lat_tile = it < nlat;
    bool skip = (it >= ntiles);
    if (MODE == 2 && lat_tile) skip = (kt < wlo) || (kt > whi);
    if (MODE == 0 && lat_tile) skip = (kt * 64 + 63 < s0w - 128) || (kt * 64 > s0w + 31 + 128);
    const int nsub = (MODE == 2 && lat_tile) ? 1 : 2;
    const int krb = (MODE == 2 && lat_tile) ? csw : 0;
    if (!skip) {
      f32x16 S[2];
#pragma unroll
      for (int t = 0; t < 2; ++t)
#pragma unroll
        for (int r = 0; r < 16; ++r) S[t][r] = 0.f;
#pragma unroll
      for (int ks = 0; ks < NKS; ++ks) {
        const bf16x8 a0 = *(const bf16x8*)(kb + (krb + pr) * KSTR + ks * 32 + hh * 16);
        S[0] = MFMA32(a0, qf[ks], S[0]);
        if (nsub == 2) {
          const bf16x8 a1 = *(const bf16x8*)(kb + (32 + pr) * KSTR + ks * 32 + hh * 16);
          S[1] = MFMA32(a1, qf[ks], S[1]);
        }
      }
      if (MODE == 0 && lat_tile) {
        const int s = qt * QPB + w * 32 + l31;
#pragma unroll
        for (int t = 0; t < 2; ++t)
#pragma unroll
          for (int r = 0; r < 16; ++r) {
            const int kk = kt * 64 + t * 32 + 16 * (r >> 3) + 8 * hh + (r & 7);
            const int d = kk - s;
            if (d > 128 || d < -128) S[t][r] = MASKV;
          }
      }
      if (MODE == 2 && lat_tile) {
        int ri = kt - qr + 7; ri = ri < 0 ? 0 : (ri > 14 ? 14 : ri);
        const float* brow = rpbs + ri * 31;
        const bool rok = (kt >= rs0) && (kt <= rs0 + 7);
        float bv[16];
#pragma unroll
        for (int r = 0; r < 16; ++r) {
          const int kc = csw + 16 * (r >> 3) + 8 * hh + (r & 7);
          int bi = kc - qc + 15; bi = bi < 0 ? 0 : (bi > 30 ? 30 : bi);
          bv[r] = brow[bi];
        }
#pragma unroll
        for (int r = 0; r < 16; ++r) asm volatile("" : "+v"(bv[r]));
#pragma unroll
        for (int r = 0; r < 16; ++r) {
          const int kc = csw + 16 * (r >> 3) + 8 * hh + (r & 7);
          const bool ok = rok && (kc >= cs) && (kc < cs + 16);
          S[0][r] = ok ? S[0][r] + bv[r] : MASKV;
        }
      }
      float mx = S[0][0];
#pragma unroll
      for (int r = 0; r < 16; ++r) mx = fmaxf(mx, S[0][r]);
      if (nsub == 2) {
#pragma unroll
        for (int r = 0; r < 16; ++r) mx = fmaxf(mx, S[1][r]);
      }
      mx = fmaxf(mx, __shfl_xor(mx, 32));
      if (__any(mx > m_ + 8.f)) {
        const float mnew = fmaxf(m_, mx);
        const float alpha = fexp2(m_ - mnew);
        m_ = mnew;
        l_ *= alpha;
#pragma unroll
        for (int dh = 0; dh < 2; ++dh)
#pragma unroll
          for (int r = 0; r < 16; ++r) O[dh][r] *= alpha;
      }
      float rsum = 0.f;
#pragma unroll
      for (int t = 0; t < 2; ++t)
        if (t < nsub) {
#pragma unroll
          for (int r = 0; r < 16; ++r) { const float e = fexp2(S[t][r] - m_); S[t][r] = e; rsum += e; }
        }
      l_ += rsum;
#pragma unroll
      for (int t = 0; t < 2; ++t)
       if (t < nsub)
#pragma unroll
        for (int s = 0; s < 2; ++s) {
          u32x4 u;
          u.x = pack_bf16(S[t][8 * s + 0], S[t][8 * s + 1]); u.y = pack_bf16(S[t][8 * s + 2], S[t][8 * s + 3]);
          u.z = pack_bf16(S[t][8 * s + 4], S[t][8 * s + 5]); u.w = pack_bf16(S[t][8 * s + 6], S[t][8 * s + 7]);
          const bf16x8 pf = __builtin_bit_cast(bf16x8, u);
#pragma unroll
          for (int dh = 0; dh < 2; ++dh) {
            const bf16x8 v = *(const bf16x8*)(vb + (dh * 32 + l31) * VSTR + (krb + t * 32 + s * 16 + hh * 8) * 2);
            O[dh] = MFMA32(v, pf, O[dh]);
          }
        }
    }
  };
  for (int j = 0; j < nsup; ++j) {
    const char* sb = lds + (j & 1) * 2 * STAGE;
    body(2 * j, sb);
    body(2 * j + 1, sb + STAGE);
    __builtin_amdgcn_sched_barrier(0);
    {
      const int so = ((j + 1) & 1) * 2;
      lstore(so, R0); lstore(so + 1, R1);
      gload(2 * j + 4, R0); gload(2 * j + 5, R1);
    }
    __syncthreads();
  }

  {
    const float lt = l_ + __shfl_xor(l_, 32);
    const float inv = 1.f / lt;
    char* orow = ostage + (w * 32) * OSTR;
#pragma unroll
    for (int dh = 0; dh < 2; ++dh)
#pragma unroll
      for (int g = 0; g < 4; ++g) {
        f32x4 v; v[0] = O[dh][4 * g] * inv; v[1] = O[dh][4 * g + 1] * inv; v[2] = O[dh][4 * g + 2] * inv; v[3] = O[dh][4 * g + 3] * inv;
        *(f32x4*)(orow + l31 * OSTR + (dh * 32 + 8 * g + 4 * hh) * 4) = v;
      }
    __builtin_amdgcn_s_waitcnt(0xc07f);
#pragma unroll
    for (int it = 0; it < 4; ++it) {
      const int cidx = lane + 64 * it, row = cidx >> 3, ch = cidx & 7;
      const f32x4 o0 = *(const f32x4*)(orow + row * OSTR + ch * 32), o1 = *(const f32x4*)(orow + row * OSTR + ch * 32 + 16);
      const int tok = tokmap(row);
      const u32x4 z = *(const u32x4*)(Zp + (size_t)tok * ldz + ch * 8);
      u32x4 wv;
      wv.x = pack_bf16(o0[0] * silu(bf_lo(z.x)), o0[1] * silu(bf_hi(z.x)));
      wv.y = pack_bf16(o0[2] * silu(bf_lo(z.y)), o0[3] * silu(bf_hi(z.y)));
      wv.z = pack_bf16(o1[0] * silu(bf_lo(z.z)), o1[1] * silu(bf_hi(z.z)));
      wv.w = pack_bf16(o1[2] * silu(bf_lo(z.w)), o1[3] * silu(bf_hi(z.w)));
      *(u32x4*)(UG + ablk(tok, gcol + ch * 8)) = wv;
    }
  }
}

DI void mla_item2(const Params& p, int layer, int b, int qt, int head, char* lds) {
  constexpr int DK = 96, NKS = 6, KSTR = DK * 2 + 16, VSTR = 144, KBYTES = 64 * KSTR, STAGE = KBYTES + 64 * VSTR;
  constexpr int NKC = 12, KCH = 64 * NKC, OSTR = 272, QG = 2, NTILES = 132;
  constexpr float MASKV = -1e30f;
  char* ostage = lds;
  const int tid = otid(), lane = tid & 63, w = tid >> 6, l31 = lane & 31, hh = lane >> 5;
  const bf16_t* Pb = (const bf16_t*)(p.ws + OFF_P);
  bf16_t* UG = (bf16_t*)(p.ws + OFF_UG);
  const bf16_t* Qp = (const bf16_t*)(p.ws + OFF_QB) + head * 96;
  const bf16_t* Kp = (const bf16_t*)(p.ws + OFF_KB) + head * 64;
  const bf16_t* Krp = Pb + 1920;
  const bf16_t* Vt = (const bf16_t*)(p.ws + OFF_VTB) + (size_t)(b * 8 + head) * 64 * NKEY;
  const bf16_t* Zp = Pb + 1952 + head * 64;
  const int gcol = 512 + head * 64;
  const int qtok0 = b * 8192 + qt * 512;
  bf16x8 qf[QG][NKS];
#pragma unroll
  for (int qg = 0; qg < QG; ++qg)
#pragma unroll
    for (int ks = 0; ks < NKS; ++ks) qf[qg][ks] = *(const bf16x8*)(Qp + (size_t)(qtok0 + qg * 256 + w * 32 + l31) * 768 + ks * 16 + hh * 8);
  float m_[QG], l_[QG];
  f32x16 O[QG][2];
#pragma unroll
  for (int qg = 0; qg < QG; ++qg) {
    m_[qg] = MASKV; l_[qg] = 0.f;
#pragma unroll
    for (int dh = 0; dh < 2; ++dh)
#pragma unroll
      for (int r = 0; r < 16; ++r) O[qg][dh][r] = 0.f;
  }
  const int k0row = tid / NKC, k0cc = tid % NKC;
  const int k1row = (tid + NT) / NKC, k1cc = (tid + NT) % NKC;
  const bool k1 = (tid + NT < KCH);
  struct Stg { u32x4 k0, k1, v; };
  Stg R0;
  R0.k1 = (u32x4){0u, 0u, 0u, 0u};
  auto kload = [&](int krow0, int row, int cc) -> u32x4 {
    if (cc >= 8) return *(const u32x4*)(Krp + (size_t)(krow0 + row) * 2560 + (cc - 8) * 8);
    return *(const u32x4*)(Kp + (size_t)(krow0 + row) * 512 + cc * 8);
  };
  auto gload = [&](int i, Stg& r) {
    const int kt = i < NTILES ? i : NTILES - 1;
    const int krow0 = kt < 128 ? b * 8192 + kt * 64 : T_LAT + b * 256 + (kt - 128) * 64;
    r.k0 = kload(krow0, k0row, k0cc);
    if (k1) r.k1 = kload(krow0, k1row, k1cc);
    r.v = *(const u32x4*)(Vt + (size_t)(tid >> 3) * NKEY + kt * 64 + (tid & 7) * 8);
  };
  auto lstore = [&](int st, const Stg& r) {
    char* kb = lds + st * STAGE;
    *(u32x4*)(kb + k0row * KSTR + k0cc * 16) = r.k0;
    if (k1) *(u32x4*)(kb + k1row * KSTR + k1cc * 16) = r.k1;
    *(u32x4*)(kb + KBYTES + (tid >> 3) * VSTR + (tid & 7) * 16) = r.v;
  };
  const int pr = (l31 & ~12) | ((l31 & 4) << 1) | ((l31 & 8) >> 1);
  __syncthreads();
  gload(0, R0); lstore(0, R0);
  gload(1, R0);
  __syncthreads();
  auto body = [&](const char* kb) {
    const char* vb = kb + KBYTES;
    f32x16 S[QG][2];
#pragma unroll
    for (int qg = 0; qg < QG; ++qg)
#pragma unroll
      for (int t = 0; t < 2; ++t)
#pragma unroll
        for (int r = 0; r < 16; ++r) S[qg][t][r] = 0.f;
#pragma unroll
    for (int ks = 0; ks < NKS; ++ks) {
      const bf16x8 a0 = *(const bf16x8*)(kb + pr * KSTR + ks * 32 + hh * 16);
      const bf16x8 a1 = *(const bf16x8*)(kb + (32 + pr) * KSTR + ks * 32 + hh * 16);
#pragma unroll
      for (int qg = 0; qg < QG; ++qg) { S[qg][0] = MFMA32(a0, qf[qg][ks], S[qg][0]); S[qg][1] = MFMA32(a1, qf[qg][ks], S[qg][1]); }
    }
#pragma unroll
    for (int qg = 0; qg < QG; ++qg) {
      float mx = S[qg][0][0];
#pragma unroll
      for (int t = 0; t < 2; ++t)
#pragma unroll
        for (int r = 0; r < 16; ++r) mx = fmaxf(mx, S[qg][t][r]);
      mx = fmaxf(mx, __shfl_xor(mx, 32));
      if (__any(mx > m_[qg] + 8.f)) {
        const float mnew = fmaxf(m_[qg], mx);
        const float alpha = fexp2(m_[qg] - mnew);
        m_[qg] = mnew;
        l_[qg] *= alpha;
#pragma unroll
        for (int dh = 0; dh < 2; ++dh)
#pragma unroll
          for (int r = 0; r < 16; ++r) O[qg][dh][r] *= alpha;
      }
      float rsum = 0.f;
#pragma unroll
      for (int t = 0; t < 2; ++t)
#pragma unroll
        for (int r = 0; r < 16; ++r) { const float e = fexp2(S[qg][t][r] - m_[qg]); S[qg][t][r] = e; rsum += e; }
      l_[qg] += rsum;
    }
#pragma unroll
    for (int t = 0; t < 2; ++t)
#pragma unroll
      for (int s = 0; s < 2; ++s) {
        bf16x8 pf[QG];
#pragma unroll
        for (int qg = 0; qg < QG; ++qg) {
          u32x4 u;
          u.x = pack_bf16(S[qg][t][8 * s + 0], S[qg][t][8 * s + 1]); u.y = pack_bf16(S[qg][t][8 * s + 2], S[qg][t][8 * s + 3]);
          u.z = pack_bf16(S[qg][t][8 * s + 4], S[qg][t][8 * s + 5]); u.w = pack_bf16(S[qg][t][8 * s + 6], S[qg][t][8 * s + 7]);
          pf[qg] = __builtin_bit_cast(bf16x8, u);
        }
#pragma unroll
        for (int dh = 0; dh < 2; ++dh) {
          const bf16x8 v = *(const bf16x8*)(vb + (dh * 32 + l31) * VSTR + (t * 32 + s * 16 + hh * 8) * 2);
#pragma unroll
          for (int qg = 0; qg < QG; ++qg) O[qg][dh] = MFMA32(v, pf[qg], O[qg][dh]);
        }
      }
  };
  if (w >= 4) __builtin_amdgcn_s_setprio(2);
  for (int j = 0; j < NTILES; ++j) {
    body(lds + (j & 1) * STAGE);
    __builtin_amdgcn_sched_barrier(0);
    lstore((j + 1) & 1, R0);
    gload(j + 2, R0);
    __syncthreads();
  }
  __builtin_amdgcn_s_setprio(0);
#pragma unroll
  for (int qg = 0; qg < QG; ++qg) {
    const float lt = l_[qg] + __shfl_xor(l_[qg], 32);
    const float inv = 1.f / lt;
    char* orow = ostage + (w * 32) * OSTR;
#pragma unroll
    for (int dh = 0; dh < 2; ++dh)
#pragma unroll
      for (int g = 0; g < 4; ++g) {
        f32x4 v; v[0] = O[qg][dh][4 * g] * inv; v[1] = O[qg][dh][4 * g + 1] * inv; v[2] = O[qg][dh][4 * g + 2] * inv; v[3] = O[qg][dh][4 * g + 3] * inv;
        *(f32x4*)(orow + l31 * OSTR + (dh * 32 + 8 * g + 4 * hh) * 4) = v;
      }
    __builtin_amdgcn_s_waitcnt(0xc07f);
#pragma unroll
    for (int it = 0; it < 4; ++it) {
      const int cidx = lane + 64 * it, row = cidx >> 3, ch = cidx & 7;
      const f32x4 o0 = *(const f32x4*)(orow + row * OSTR + ch * 32), o1 = *(const f32x4*)(orow + row * OSTR + ch * 32 + 16);
      const int tok = qtok0 + qg * 256 + w * 32 + row;
      const u32x4 z = *(const u32x4*)(Zp + (size_t)tok * 2560 + ch * 8);
      u32x4 wv;
      wv.x = pack_bf16(o0[0] * silu(bf_lo(z.x)), o0[1] * silu(bf_hi(z.x)));
      wv.y = pack_bf16(o0[2] * silu(bf_lo(z.y)), o0[3] * silu(bf_hi(z.y)));
      wv.z = pack_bf16(o1[0] * silu(bf_lo(z.z)), o1[1] * silu(bf_hi(z.z)));
      wv.w = pack_bf16(o1[2] * silu(bf_lo(z.w)), o1[3] * silu(bf_hi(z.w)));
      *(u32x4*)(UG + ablk(tok, gcol + ch * 8)) = wv;
    }
    __builtin_amdgcn_s_waitcnt(0xc07f);
  }
}

DI void attn_phase_ab(const Params& p, int layer, char* lds) {
  const int G = ogrid();
  for (int v = obid(); v < 512; v += G) {
    const int xcd = v & 7, s = v >> 3;
    const int grp = (s >> 4) * 8 + xcd, qt = s & 15;
    mla_item2(p, layer, grp >> 3, qt, grp & 7, lds);
  }
  for (int v = obid(); v < 32; v += G) attn_item<1>(p, layer, v >> 3, 0, v & 7, true, lds);
  for (int v = obid(); v < 1024 + 32; v += G) {
    if (v < 1024) attn_item<0>(p, layer, v >> 8, v & 31, (v >> 5) & 7, false, lds);
    else { const int c = v - 1024; attn_item<0>(p, layer, c >> 3, 0, c & 7, true, lds); }
  }
}

DI void attn_phase_c(const Params& p, int layer, char* lds) {
  const int G = ogrid();
  const int nctx = (layer == 3) ? 0 : 64;
  for (int v = obid(); v < 2048 + nctx; v += G) {
    if (v < 2048) attn_item<2>(p, layer, v >> 9, v & 31, (v >> 5) & 15, false, lds);
    else { const int c = v - 2048; attn_item<2>(p, layer, c >> 4, 0, c & 15, true, lds); }
  }
}

__global__ void __launch_bounds__(512, 2) fwd_megakernel(Params p) {
  __shared__ __attribute__((aligned(16))) char lds[LDS_BYTES];
  __shared__ uint4 xb_words;
  if (threadIdx.x == 0) xb_words = make_uint4(0u, 0u, 0u, 0u);
  __syncthreads();
  if (obid() == 0) { unsigned* bw = (unsigned*)(p.ws + OFF_BAR); for (int i = otid(); i < 4096; i += NT) bw[i] = 0u; }
  XcdBarrier xb; xb.bar = (unsigned*)(p.ws + OFF_BAR); xb.x = 0; xb.st = (volatile LAS unsigned*)&xb_words;
  bool first = true, posted = false;
  for (int ph = p.ph_begin; ph < p.ph_end; ++ph) {
    const int layer = (ph - 1) / 5, s = (ph - 1) % 5;
    const bool even = (layer & 1) == 0;
    const int i2 = layer >> 1;
    if (ph >= 1 && ph <= 20 && s == 2 && !even) continue;
    if (!first) {
      if (!posted) { cg::this_grid().sync(); xb = xcd_barrier_post((unsigned*)(p.ws + OFF_BAR), (volatile LAS unsigned*)&xb_words); posted = true; }
      else xcd_barrier(xb);
    }
    first = false;
    if (ph == 0) prologue_phase(p, lds);
    else if (ph == 21) final_phase(p);
    else if (s == 0) norm_phase(p, layer);
    else if (s == 1) {
      const bf16_t* U = (const bf16_t*)(p.ws + OFF_UG);
      for (int rep = 0; rep < REP_GEMM; ++rep) {
        if (even) gemm_phase<EPI_AB_IN>(p, layer, U, 0, (const bf16_t*)(p.ws + OFF_W_IN) + (size_t)i2 * 2560 * 1024, 1024, 128, 10, true, false, lds);
        else gemm_phase<EPI_C_IN>(p, layer, U, 0, (const bf16_t*)(p.ws + OFF_W_CIN) + (size_t)i2 * 4096 * 1024, 1024, 128, 16, true, false, lds);
        if (rep + 1 < REP_GEMM) xcd_barrier(xb);
      }
    } else if (s == 2) {
      const bf16_t* Pb = (const bf16_t*)(p.ws + OFF_P);
      gemm_phase<EPI_QB>(p, layer, Pb + 1280, 2560, (const bf16_t*)(p.ws + OFF_W_UQ) + (size_t)i2 * 768 * 384, 384, 128, 3, true, false, lds);
      gemm_phase<EPI_KVB>(p, layer, Pb + 1664, 2560, (const bf16_t*)(p.ws + OFF_W_UKV) + (size_t)i2 * 1024 * 256, 256, 128, 4, true, true, lds);
      vta_phase(p, lds);
    } else if (s == 3) {
      for (int rep = 0; rep < REP_ATTN; ++rep) {
        if (even) attn_phase_ab(p, layer, lds); else attn_phase_c(p, layer, lds);
        if (rep + 1 < REP_ATTN) xcd_barrier(xb);
      }
    } else {
      const bf16_t* Gm = (const bf16_t*)(p.ws + OFF_UG);
      const bf16_t* W = even ? (const bf16_t*)(p.ws + OFF_W_OUT) + (size_t)i2 * 1024 * 1024 : (const bf16_t*)(p.ws + OFF_W_COUT) + (size_t)i2 * 1024 * 1024;
      gemm_phase<EPI_OUT>(p, layer, Gm, 0, W, 1024, 128, 4, layer != 3, false, lds);
    }
  }
}

extern "C" void kernel_launch(void* const* d_in, const int* in_sizes, int n_in, void* d_out, int out_size, void* d_ws, size_t ws_size,
                              hipStream_t stream) {
  static int grid_blocks = 0;
  if (!grid_blocks) {
    int dev = 0, cus = 0, per_cu = 0;
    hipGetDevice(&dev);
    hipDeviceGetAttribute(&cus, hipDeviceAttributeMultiprocessorCount, dev);
    hipOccupancyMaxActiveBlocksPerMultiprocessor(&per_cu, fwd_megakernel, NT, 0);
    per_cu = 1;
    grid_blocks = cus * per_cu;
    if (ws_size < OFF_END) fprintf(stderr, "kernel_launch: workspace too small: %zu < %zu\n", ws_size, (size_t)OFF_END);
  }
  Params p{};
  const float** f = (const float**)&p;
  for (int i = 0; i < 18; ++i) f[i] = (const float*)d_in[i];
  p.out = (float*)d_out;
  p.ws = (char*)d_ws;
#if MK_MULTI_LAUNCH
  for (int ph = 0; ph < 22; ++ph) {
    if (ph >= 1 && ph <= 20 && ((ph - 1) % 5) == 2 && (((ph - 1) / 5) & 1)) continue;
    p.ph_begin = ph; p.ph_end = ph + 1;
    hipLaunchKernelGGL(fwd_megakernel, dim3(grid_blocks), dim3(NT), 0, stream, p);
  }
#else
  p.ph_begin = 0; p.ph_end = 22;
  void* args[] = {&p};
  hipError_t e = hipLaunchCooperativeKernel((void*)fwd_megakernel, dim3(grid_blocks), dim3(NT), args, 0, stream);
  if (e != hipSuccess) fprintf(stderr, "cooperative launch failed: %s (grid %d)\n", hipGetErrorString(e), grid_blocks);
#endif
}
```

```cpp
#include <hip/hip_runtime.h>
#include <hip/hip_cooperative_groups.h>
#include <stdint.h>
#include <stdio.h>
namespace cg = cooperative_groups;

#ifndef MK_MULTI_LAUNCH
#define MK_MULTI_LAUNCH 0
#endif

typedef unsigned short bf16_t;
typedef short bf16x8 __attribute__((ext_vector_type(8)));
typedef float f32x16 __attribute__((ext_vector_type(16)));
typedef float f32x4 __attribute__((ext_vector_type(4)));
typedef float f32x2 __attribute__((ext_vector_type(2)));
typedef unsigned u32x4 __attribute__((ext_vector_type(4)));
typedef unsigned u32x2 __attribute__((ext_vector_type(2)));

#define DI __device__ __forceinline__
#define MFMA32(a, b, c) __builtin_amdgcn_mfma_f32_32x32x16_bf16((a), (b), (c), 0, 0, 0)

constexpr int T_LAT = 32768, T_ALL = 33792, NKEY = 8448, NT = 512;
constexpr float LOG2E = 1.4426950408889634f;
constexpr float QSCALE_A = 0.125f * LOG2E;
constexpr float QSCALE_B = 0.10206207261596575f * LOG2E;

constexpr size_t OFF_HC   = 0;
constexpr size_t OFF_UG   = OFF_HC + 1024ull * 1024 * 4;
constexpr size_t OFF_P    = OFF_UG + (size_t)T_ALL * 1024 * 2;
constexpr size_t OFF_QB   = OFF_P + (size_t)T_ALL * 2560 * 2;
constexpr size_t OFF_KB   = OFF_QB + (size_t)T_ALL * 768 * 2;
constexpr size_t OFF_VT   = OFF_KB + (size_t)T_ALL * 512 * 2;
constexpr size_t OFF_VTB  = OFF_VT + 4ull * 2 * 64 * NKEY * 2;
constexpr size_t OFF_W    = OFF_VT + 4ull * 16 * 64 * NKEY * 2;
constexpr size_t OFF_W_IN   = OFF_W;
constexpr size_t OFF_W_OUT  = OFF_W_IN + 2ull * 2560 * 1024 * 2;
constexpr size_t OFF_W_UQ   = OFF_W_OUT + 2ull * 1024 * 1024 * 2;
constexpr size_t OFF_W_UKV  = OFF_W_UQ + 2ull * 768 * 384 * 2;
constexpr size_t OFF_W_CIN  = OFF_W_UKV + 2ull * 1024 * 256 * 2;
constexpr size_t OFF_W_COUT = OFF_W_CIN + 2ull * 4096 * 1024 * 2;
constexpr size_t OFF_MOD    = OFF_W_COUT + 2ull * 1024 * 1024 * 2;
constexpr size_t OFF_ROPE   = OFF_MOD + 4ull * 5 * 3072 * 4;
constexpr size_t OFF_BAR    = OFF_ROPE + 2ull * 8192 * 32 * 4 + 2ull * 8192 * 16 * 4;
constexpr size_t OFF_END    = OFF_BAR + 16384;

struct Params {
  const float *x, *c, *ctx, *c_ctx, *ada_w, *ada_b, *norm_g, *ab_in_w, *ab_out_w, *a_sink, *b_qn_g, *b_w_uq, *b_kvn_g, *b_w_ukv,
      *c_in_w, *c_out_w, *c_rpb, *final_g;
  float* out;
  char* ws;
  int ph_begin, ph_end;
};

DI int otid() { int t = threadIdx.x; asm volatile("" : "+v"(t)); return t; }
DI int obid() { int t = blockIdx.x; asm volatile("" : "+s"(t)); return t; }
DI int ogrid() { int t = gridDim.x; asm volatile("" : "+s"(t)); return t; }
DI unsigned pack_bf16(float lo, float hi) { unsigned r; asm("v_cvt_pk_bf16_f32 %0, %1, %2" : "=v"(r) : "v"(lo), "v"(hi)); return r; }
DI float bf_lo(unsigned u) { return __uint_as_float(u << 16); }
DI float bf_hi(unsigned u) { return __uint_as_float(u & 0xffff0000u); }
DI float fexp2(float x) { return __builtin_amdgcn_exp2f(x); }
DI float silu(float z) { return z * __builtin_amdgcn_rcpf(1.f + __expf(-z)); }

DI size_t ablk(int tok, int k) { return ((size_t)((tok >> 8) * 16 + (k >> 6)) << 14) + ((tok & 255) << 6) + (k & 63); }
DI void tok_bk(int tok, int& b, int& key) {
  if (tok < T_LAT) { b = tok >> 13; key = tok & 8191; } else { int r = tok - T_LAT; b = r >> 8; key = 8192 + (r & 255); }
}
DI const float* h_src(const Params& p, int layer, int tok) {
  if (layer == 0) return tok < T_LAT ? p.x + (size_t)tok * 1024 : p.ctx + (size_t)(tok - T_LAT) * 1024;
  return tok < T_LAT ? p.out + (size_t)tok * 1024 : (const float*)(p.ws + OFF_HC) + (size_t)(tok - T_LAT) * 1024;
}
DI float* h_dst(const Params& p, int tok) {
  return tok < T_LAT ? p.out + (size_t)tok * 1024 : (float*)(p.ws + OFF_HC) + (size_t)(tok - T_LAT) * 1024;
}

#define XB_TMO      128
#define XB_XCNT(j)  (256  + 64 * (j))
#define XB_XSUB(j)  (1280 + 64 * (j))
#define XB_XGEN(j)  (2304 + 64 * (j))
#define XB_TOP      3328
#define XB_TOPGEN   3392
#define XCD_BAR_WORDS 3456
#define XB_SPIN_CAP (1u << 22)
#define LAS __attribute__((address_space(3)))
DI unsigned xb_ld(unsigned* p) { return __hip_atomic_load(p, __ATOMIC_RELAXED, __HIP_MEMORY_SCOPE_AGENT); }
DI unsigned xb_add(unsigned* p, unsigned v) { return __hip_atomic_fetch_add(p, v, __ATOMIC_RELAXED, __HIP_MEMORY_SCOPE_AGENT); }
DI unsigned xb_xcc_id() { return (unsigned)__builtin_amdgcn_s_getreg((3 << 11) | 20) & 0xFu; }
#define XB_SPIN(cond, bar) do { unsigned _sp = 0; while (cond) { __builtin_amdgcn_s_sleep(1); \
    if ((++_sp & 255u) == 0u) { if (xb_ld(&(bar)[XB_TMO])) break; if (_sp > XB_SPIN_CAP) { atomicAdd(&(bar)[XB_TMO], 1u); break; } } } } while (0)
struct XcdBarrier { unsigned* bar; unsigned x; volatile LAS unsigned* st; };
DI XcdBarrier xcd_barrier_post(unsigned* bar, volatile LAS unsigned* st) {
  XcdBarrier b; b.bar = bar; b.x = xb_xcc_id(); b.st = st;
  if (threadIdx.x == 0) (void)xb_add(&bar[XB_XCNT(b.x)], 1u);
  return b;
}
DI void xcd_barrier_complete(unsigned* bar, unsigned x, unsigned& nloc, unsigned& nx) {
  const unsigned G = gridDim.x * gridDim.y * gridDim.z;
  unsigned sum, cnt, mine, sp = 0u;
  for (;;) {
    sum = 0u; cnt = 0u; mine = 0u;
#pragma unroll
    for (unsigned j = 0; j < 16; ++j) { const unsigned c = xb_ld(&bar[XB_XCNT(j)]); sum += c; cnt += (c > 0u) ? 1u : 0u; mine = (j == x) ? c : mine; }
    if (sum == G) break;
    __builtin_amdgcn_s_sleep(1);
    if ((++sp & 255u) == 0u) { if (xb_ld(&bar[XB_TMO])) break; if (sp > XB_SPIN_CAP) { atomicAdd(&bar[XB_TMO], 1u); break; } }
  }
  nloc = mine > 0u ? mine : 1u; nx = cnt > 0u ? cnt : 1u;
}
DI void xcd_barrier(const XcdBarrier& b) {
  asm volatile("s_waitcnt vmcnt(0)" ::: "memory");
  __syncthreads();
  if (threadIdx.x == 0) {
    unsigned* bar = b.bar;
    __builtin_amdgcn_s_waitcnt(0);
    unsigned nloc = b.st[0], nx = b.st[1];
    if (nloc == 0u) { xcd_barrier_complete(bar, b.x, nloc, nx); b.st[0] = nloc; b.st[1] = nx; }
    const unsigned old = xb_add(&bar[XB_XSUB(b.x)], 1u);
    const unsigned gen = old / nloc;
    if (old + 1u == (gen + 1u) * nloc) {
      __builtin_amdgcn_fence(__ATOMIC_RELEASE, "agent");
      asm volatile("s_waitcnt vmcnt(0)" ::: "memory");
      const unsigned og = xb_add(&bar[XB_TOP], 1u);
      const unsigned tg = og / nx;
      if (og + 1u == (tg + 1u) * nx) xb_add(&bar[XB_TOPGEN], 1u);
      else XB_SPIN(xb_ld(&bar[XB_TOPGEN]) == tg, bar);
      __builtin_amdgcn_fence(__ATOMIC_ACQUIRE, "agent");
      xb_add(&bar[XB_XGEN(b.x)], 1u);
      asm volatile("s_waitcnt vmcnt(0)" ::: "memory");
    } else {
      XB_SPIN(xb_ld(&bar[XB_XGEN(b.x)]) == gen, bar);
      __builtin_amdgcn_fence(__ATOMIC_ACQUIRE, "agent");
      asm volatile("s_waitcnt vmcnt(0)" ::: "memory");
    }
  }
  __syncthreads();
}

struct TJob { const float* src; const float* rs; bf16_t* dst; int K, N, tk, tn, perm; };
DI TJob tr_job(const Params& p, int t) {
  TJob j; j.rs = nullptr; j.perm = 0;
  const int i2 = t / 2312; t -= i2 * 2312;
  if (t < 640) { j.src = p.ab_in_w + (size_t)i2 * 1024 * 2464; j.K = 1024; j.N = 2464; j.dst = (bf16_t*)(p.ws + OFF_W_IN) + (size_t)i2 * 2560 * 1024; j.tk = t / 40; j.tn = t % 40; }
  else if ((t -= 640) < 256) { j.src = p.ab_out_w + (size_t)i2 * 1024 * 1024; j.K = 1024; j.N = 1024; j.dst = (bf16_t*)(p.ws + OFF_W_OUT) + (size_t)i2 * 1024 * 1024; j.tk = t / 16; j.tn = t % 16; }
  else if ((t -= 256) < 72) { j.src = p.b_w_uq + (size_t)i2 * 384 * 768; j.K = 384; j.N = 768; j.dst = (bf16_t*)(p.ws + OFF_W_UQ) + (size_t)i2 * 768 * 384; j.rs = p.b_qn_g + i2 * 384; j.tk = t / 12; j.tn = t % 12; }
  else if ((t -= 72) < 64) { j.src = p.b_w_ukv + (size_t)i2 * 256 * 1024; j.K = 256; j.N = 1024; j.dst = (bf16_t*)(p.ws + OFF_W_UKV) + (size_t)i2 * 1024 * 256; j.rs = p.b_kvn_g + i2 * 256; j.tk = t / 16; j.tn = t % 16; j.perm = 1; }
  else if ((t -= 64) < 1024) { j.src = p.c_in_w + (size_t)i2 * 1024 * 4096; j.K = 1024; j.N = 4096; j.dst = (bf16_t*)(p.ws + OFF_W_CIN) + (size_t)i2 * 4096 * 1024; j.tk = t / 64; j.tn = t % 64; }
  else { t -= 1024; j.src = p.c_out_w + (size_t)i2 * 1024 * 1024; j.K = 1024; j.N = 1024; j.dst = (bf16_t*)(p.ws + OFF_W_COUT) + (size_t)i2 * 1024 * 1024; j.tk = t / 16; j.tn = t % 16; }
  return j;
}
DI void tr_load(const TJob& j, int tid, float (&v)[8]) {
#pragma unroll
  for (int i = 0; i < 8; ++i) {
    const int kk = (tid >> 6) + 8 * i, n = j.tn * 64 + (tid & 63);
    float x = (n < j.N) ? j.src[(size_t)(j.tk * 64 + kk) * j.N + n] : 0.f;
    if (j.rs) x *= j.rs[j.tk * 64 + kk];
    v[i] = x;
  }
}

DI void prologue_phase(const Params& p, char* lds) {
  const int tid = otid();
  constexpr int N_MOD = 192, N_TR = 4624, N_ROPE = 768;
  for (int u = obid(); u < N_MOD + N_TR + N_ROPE; u += ogrid()) {
    if (u < N_MOD) {
      const int layer = u / 48, cb = u % 48;
      float* sl = (float*)lds;
      for (int i = tid; i < 5120; i += NT) {
        const int bb = i >> 10, k = i & 1023;
        const float cv = bb < 4 ? p.c[bb * 1024 + k] : p.c_ctx[k];
        sl[i] = silu(cv);
      }
      __syncthreads();
      const int col = cb * 64 + (tid & 63), kg = tid >> 6;
      float a0 = 0, a1 = 0, a2 = 0, a3 = 0, a4 = 0;
      const float* wp = p.ada_w + (size_t)layer * 1024 * 3072 + col;
#pragma unroll 8
      for (int k = kg * 128; k < kg * 128 + 128; ++k) {
        const float wv = wp[(size_t)k * 3072];
        a0 += sl[k] * wv; a1 += sl[1024 + k] * wv; a2 += sl[2048 + k] * wv; a3 += sl[3072 + k] * wv; a4 += sl[4096 + k] * wv;
      }
      float* red = (float*)(lds + 20480);
      red[(kg * 5 + 0) * 64 + (tid & 63)] = a0; red[(kg * 5 + 1) * 64 + (tid & 63)] = a1; red[(kg * 5 + 2) * 64 + (tid & 63)] = a2;
      red[(kg * 5 + 3) * 64 + (tid & 63)] = a3; red[(kg * 5 + 4) * 64 + (tid & 63)] = a4;
      __syncthreads();
      if (tid < 64) {
        float* mod = (float*)(p.ws + OFF_MOD);
        const float bias = p.ada_b[layer * 3072 + col];
#pragma unroll
        for (int bb = 0; bb < 5; ++bb) {
          float s = bias;
#pragma unroll
          for (int g = 0; g < 8; ++g) s += red[(g * 5 + bb) * 64 + tid];
          mod[(size_t)(layer * 5 + bb) * 3072 + col] = s;
        }
      }
      __syncthreads();
    } else if (u < N_MOD + N_TR) {
    } else {
      const int idx = (u - N_MOD - N_TR) * NT + tid;
      float* ropeA = (float*)(p.ws + OFF_ROPE);
      float* ropeB = ropeA + 2 * 8192 * 32;
      if (idx < 8192 * 32) {
        const int pos = idx >> 5, pr = idx & 31;
        const float pv = pr < 16 ? (float)(pos >> 6) : (float)(pos & 63);
        const float inv = exp2f(-(float)(pr & 15) * (13.287712379549449f / 16.f));
        const float ang = pv * inv;
        ropeA[idx] = cosf(ang); ropeA[8192 * 32 + idx] = sinf(ang);
      } else {
        const int j = idx - 8192 * 32;
        const int pos = j >> 4, pr = j & 15;
        const float pv = pr < 8 ? (float)(pos >> 6) : (float)(pos & 63);
        const float inv = exp2f(-(float)(pr & 7) * (13.287712379549449f / 8.f));
        const float ang = pv * inv;
        ropeB[j] = cosf(ang); ropeB[8192 * 16 + j] = sinf(ang);
      }
    }
  }
  {
    const int G = ogrid();
    int t = obid();
    float v[8], nv[8];
    TJob cur, nxt;
    if (t < N_TR) { cur = tr_job(p, t); tr_load(cur, tid, v); }
    int buf = 0;
    for (; t < N_TR; t += G) {
      const bool more = t + G < N_TR;
      if (more) { nxt = tr_job(p, t + G); tr_load(nxt, tid, nv); }
      float* tile = (float*)(lds + buf * 16640);
#pragma unroll
      for (int i = 0; i < 8; ++i) tile[((tid >> 6) + 8 * i) * 65 + (tid & 63)] = v[i];
      __syncthreads();
      {
        const int nn = tid & 63, k8 = (tid >> 6) * 8;
        int n = cur.tn * 64 + nn;
        if (cur.perm) n = ((n & 64) ? 512 : 0) + (n >> 7) * 64 + (n & 63);
        u32x4 w;
        w.x = pack_bf16(tile[(k8 + 0) * 65 + nn], tile[(k8 + 1) * 65 + nn]); w.y = pack_bf16(tile[(k8 + 2) * 65 + nn], tile[(k8 + 3) * 65 + nn]);
        w.z = pack_bf16(tile[(k8 + 4) * 65 + nn], tile[(k8 + 5) * 65 + nn]); w.w = pack_bf16(tile[(k8 + 6) * 65 + nn], tile[(k8 + 7) * 65 + nn]);
        *(u32x4*)(cur.dst + ((size_t)((n >> 8) * (cur.K >> 6) + cur.tk) << 14) + ((n & 255) << 6) + k8) = w;
      }
      buf ^= 1;
      if (more) {
        cur = nxt;
#pragma unroll
        for (int i = 0; i < 8; ++i) v[i] = nv[i];
      }
    }
    __syncthreads();
  }
}

DI float wave_sum(float v) {
#pragma unroll
  for (int o = 32; o >= 1; o >>= 1) v += __shfl_xor(v, o);
  return v;
}

DI void norm_phase(const Params& p, int layer) {
  const int lane = otid() & 63;
  const int wave = obid() * 8 + (otid() >> 6), nw = ogrid() * 8;
  const float* g = p.norm_g + layer * 1024;
  const float* mod = (const float*)(p.ws + OFF_MOD) + (size_t)layer * 5 * 3072;
  bf16_t* U = (bf16_t*)(p.ws + OFF_UG);
  f32x4 gv[4];
#pragma unroll
  for (int i = 0; i < 4; ++i) gv[i] = *(const f32x4*)(g + lane * 4 + 256 * i);
  for (int row = wave; row < T_ALL; row += nw) {
    const int bb = row < T_LAT ? (row >> 13) : 4;
    const float* src = h_src(p, layer, row);
    f32x4 v[4];
    float ss = 0.f;
#pragma unroll
    for (int i = 0; i < 4; ++i) {
      v[i] = *(const f32x4*)(src + lane * 4 + 256 * i);
      ss += v[i][0] * v[i][0] + v[i][1] * v[i][1] + v[i][2] * v[i][2] + v[i][3] * v[i][3];
    }
    ss = wave_sum(ss);
    const float rstd = rsqrtf(ss * (1.f / 1024.f) + 1e-6f);
    const float* mrow = mod + bb * 3072;
#pragma unroll
    for (int i = 0; i < 4; ++i) {
      const int cidx = lane * 4 + 256 * i;
      const f32x4 sh = *(const f32x4*)(mrow + cidx), sc = *(const f32x4*)(mrow + 1024 + cidx);
      f32x4 o = (v[i] * rstd) * gv[i] * (sc + 1.f) + sh;
      u32x2 w; w.x = pack_bf16(o[0], o[1]); w.y = pack_bf16(o[2], o[3]);
      *(u32x2*)(U + ablk(row, cidx)) = w;
    }
  }
}

DI void final_phase(const Params& p) {
  const int lane = otid() & 63;
  const int wave = obid() * 8 + (otid() >> 6), nw = ogrid() * 8;
  f32x4 gv[4];
#pragma unroll
  for (int i = 0; i < 4; ++i) gv[i] = *(const f32x4*)(p.final_g + lane * 4 + 256 * i);
  for (int row = wave; row < T_LAT; row += nw) {
    float* src = p.out + (size_t)row * 1024;
    f32x4 v[4];
    float ss = 0.f;
#pragma unroll
    for (int i = 0; i < 4; ++i) {
      v[i] = *(const f32x4*)(src + lane * 4 + 256 * i);
      ss += v[i][0] * v[i][0] + v[i][1] * v[i][1] + v[i][2] * v[i][2] + v[i][3] * v[i][3];
    }
    ss = wave_sum(ss);
    const float rstd = rsqrtf(ss * (1.f / 1024.f) + 1e-6f);
#pragma unroll
    for (int i = 0; i < 4; ++i) *(f32x4*)(src + lane * 4 + 256 * i) = (v[i] * rstd) * gv[i];
  }
}

enum { EPI_AB_IN = 0, EPI_QB = 1, EPI_KVB = 2, EPI_C_IN = 3, EPI_OUT = 4 };
constexpr int G_STR = 144;
constexpr int G_OPER = 256 * G_STR;
constexpr int G_STAGE = 2 * G_OPER;
constexpr int OFF_RSTD = 2 * G_STAGE;
constexpr int LDS_BYTES = OFF_RSTD + 1024;

DI void rope2(float& v0, float& v1, float& v2, float& v3, const float* cs, const float* sn) {
  const f32x2 c = *(const f32x2*)cs, s = *(const f32x2*)sn;
  const float a0 = v0 * c.x - v1 * s.x, a1 = v0 * s.x + v1 * c.x, a2 = v2 * c.y - v3 * s.y, a3 = v2 * s.y + v3 * c.y;
  v0 = a0; v1 = a1; v2 = a2; v3 = a3;
}

template <int EPI>
DI void epi_math(const Params& p, int tok, int f0, float& v0, float& v1, float& v2, float& v3, float rs) {
  const float* ropeA = (const float*)(p.ws + OFF_ROPE);
  const float* ropeB = ropeA + 2 * 8192 * 32;
  const bool lat = tok < T_LAT;
  const int pos = tok & 8191;
  if (EPI == EPI_AB_IN) {
    if (f0 < 640) {
      if (lat) { const int p0 = (f0 & 63) >> 1; rope2(v0, v1, v2, v3, ropeA + pos * 32 + p0, ropeA + 8192 * 32 + pos * 32 + p0); }
      if (f0 < 512) { v0 *= QSCALE_A; v1 *= QSCALE_A; v2 *= QSCALE_A; v3 *= QSCALE_A; }
    } else if (f0 >= 1920 && f0 < 1952) {
      if (lat) { const int p0 = (f0 - 1920) >> 1; rope2(v0, v1, v2, v3, ropeB + pos * 16 + p0, ropeB + 8192 * 16 + pos * 16 + p0); }
    }
  } else if (EPI == EPI_QB) {
    const float s = rs * QSCALE_B;
    v0 *= s; v1 *= s; v2 *= s; v3 *= s;
    const int fh = f0 % 96;
    if (fh >= 64 && lat) { const int p0 = (fh - 64) >> 1; rope2(v0, v1, v2, v3, ropeB + pos * 16 + p0, ropeB + 8192 * 16 + pos * 16 + p0); }
  } else if (EPI == EPI_KVB) {
    v0 *= rs; v1 *= rs; v2 *= rs; v3 *= rs;
  } else if (EPI == EPI_C_IN) {
    if (f0 < 1024) { v0 *= QSCALE_A; v1 *= QSCALE_A; v2 *= QSCALE_A; v3 *= QSCALE_A; }
  }
}

template <int EPI>
DI bf16_t* dst_tr(const Params& p, int tok, int col) {
  if (EPI == EPI_AB_IN) return col < 2464 ? (bf16_t*)(p.ws + OFF_P) + (size_t)tok * 2560 + col : nullptr;
  if (EPI == EPI_QB) return (bf16_t*)(p.ws + OFF_QB) + (size_t)tok * 768 + col;
  if (EPI == EPI_KVB) return (bf16_t*)(p.ws + OFF_KB) + (size_t)tok * 512 + col;
  return (bf16_t*)(p.ws + OFF_P) + (size_t)tok * 3072 + (col >= 3072 ? col - 1024 : col);
}
template <int EPI>
DI bf16_t* dst_v(const Params& p, int t0, int col) {
  int b, key; tok_bk(t0, b, key);
  if (EPI == EPI_KVB) return (bf16_t*)(p.ws + OFF_VTB) + ((size_t)(b * 8 + ((col - 512) >> 6)) * 64 + (col & 63)) * NKEY + key;
  return (bf16_t*)(p.ws + OFF_VT) + ((size_t)(b * 16 + ((col - 2048) >> 6)) * 64 + (col & 63)) * NKEY + key;
}

struct TilePf { bool pre; bool has_next; int nm0, nnt; };
template <int EPI, int TM>
DI void gemm_tile(const Params& p, int layer, const bf16_t* __restrict__ A, int lda, const bf16_t* __restrict__ Bt, int K, int m0, int nt, char* lds,
                  u32x4 (&ra)[TM / 64], u32x4 (&rb)[4], const TilePf pf) {
  constexpr int NJ = TM == 256 ? 4 : 2, NI = TM == 256 ? 2 : 1, NA = TM / 64;
  const int tid = otid(), lane = tid & 63, w = tid >> 6;
  const int wm = TM == 256 ? (w >> 2) : 0, wn = TM == 256 ? (w & 3) : w;
  const int fb = TM == 256 ? wn * 64 : wn * 32, tb = TM == 256 ? wm * 128 : 0;
  const int l31 = lane & 31, hh = lane >> 5;
  const int n0 = nt * 256;
  float* rstd = (float*)(lds + OFF_RSTD);
  const int srow = tid >> 3, scc = tid & 7;
  const bool ablocked = (lda == 0);
  const int nkb = K >> 6;
  const bf16_t* ag = ablocked ? A + ((size_t)((m0 >> 8) * 16) << 14) + (m0 & 255) * 64 + tid * 8 : A + (size_t)(m0 + srow) * lda + scc * 8;
  const size_t a_i = ablocked ? 4096 : (size_t)64 * lda, a_k = ablocked ? 16384 : 64;
  const bf16_t* bg = Bt + ((size_t)(nt * nkb) << 14) + tid * 8;

  if (EPI == EPI_QB || EPI == EPI_KVB) {
    __syncthreads();
    if (tid < 2 * TM) {
      const int r = tid >> 1, half = tid & 1;
      const bf16_t* ap = A + (size_t)(m0 + r) * lda + half * (K / 2);
      float ss = 0.f;
      for (int cidx = 0; cidx < K / 2; cidx += 8) {
        const u32x4 v = *(const u32x4*)(ap + cidx);
#pragma unroll
        for (int e = 0; e < 4; ++e) { const float a = bf_lo(v[e]), b2 = bf_hi(v[e]); ss += a * a + b2 * b2; }
      }
      ss += __shfl_xor(ss, 1);
      if (half == 0) rstd[r] = rsqrtf(ss / (float)K + 1e-6f);
    }
  }

  f32x16 acc[NI][NJ];
#pragma unroll
  for (int i = 0; i < NI; ++i)
#pragma unroll
    for (int j = 0; j < NJ; ++j)
#pragma unroll
      for (int r = 0; r < 16; ++r) acc[i][j][r] = 0.f;

  const int nk = K >> 6;
  if (!pf.pre) {
#pragma unroll
    for (int i = 0; i < NA; ++i) ra[i] = *(const u32x4*)(ag + i * a_i);
#pragma unroll
    for (int i = 0; i < 4; ++i) rb[i] = *(const u32x4*)(bg + i * 4096);
  }
#pragma unroll
  for (int i = 0; i < NA; ++i) *(u32x4*)(lds + (srow + 64 * i) * G_STR + scc * 16) = ra[i];
#pragma unroll
  for (int i = 0; i < 4; ++i) *(u32x4*)(lds + G_OPER + (srow + 64 * i) * G_STR + scc * 16) = rb[i];
#pragma unroll
  for (int i = 0; i < NA; ++i) ra[i] = *(const u32x4*)(ag + i * a_i + a_k);
#pragma unroll
  for (int i = 0; i < 4; ++i) rb[i] = *(const u32x4*)(bg + i * 4096 + 16384);
  __syncthreads();
  for (int kt = 0; kt < nk; ++kt) {
    {
      char* st = lds + ((kt + 1) & 1) * G_STAGE;
#pragma unroll
      for (int i = 0; i < NA; ++i) *(u32x4*)(st + (srow + 64 * i) * G_STR + scc * 16) = ra[i];
#pragma unroll
      for (int i = 0; i < 4; ++i) *(u32x4*)(st + G_OPER + (srow + 64 * i) * G_STR + scc * 16) = rb[i];
    }
    if (kt + 2 < nk) {
#pragma unroll
      for (int i = 0; i < NA; ++i) ra[i] = *(const u32x4*)(ag + i * a_i + (size_t)(kt + 2) * a_k);
#pragma unroll
      for (int i = 0; i < 4; ++i) rb[i] = *(const u32x4*)(bg + i * 4096 + ((size_t)(kt + 2) << 14));
    }
    __builtin_amdgcn_sched_barrier(0);
    const char* as = lds + (kt & 1) * G_STAGE;
    const char* fp = as + G_OPER + (fb + l31) * G_STR + hh * 16;
    const char* sp = as + (tb + l31) * G_STR + hh * 16;
#pragma unroll
    for (int ks = 0; ks < 4; ++ks) {
      bf16x8 f[NI], s[NJ];
#pragma unroll
      for (int i = 0; i < NI; ++i) f[i] = *(const bf16x8*)(fp + i * 32 * G_STR + ks * 32);
#pragma unroll
      for (int j = 0; j < NJ; ++j) s[j] = *(const bf16x8*)(sp + j * 32 * G_STR + ks * 32);
#pragma unroll
      for (int j = 0; j < NJ; ++j)
#pragma unroll
        for (int i = 0; i < NI; ++i) acc[i][j] = MFMA32(f[i], s[j], acc[i][j]);
    }
    __syncthreads();
  }

  auto prefetch_next = [&]() {
    if (TM == 256 && pf.has_next) {
      const bf16_t* nag = ablocked ? A + ((size_t)((pf.nm0 >> 8) * 16) << 14) + (pf.nm0 & 255) * 64 + tid * 8 : A + (size_t)(pf.nm0 + srow) * lda + scc * 8;
      const bf16_t* nbg = Bt + ((size_t)(pf.nnt * nkb) << 14) + tid * 8;
#pragma unroll
      for (int i = 0; i < NA; ++i) ra[i] = *(const u32x4*)(nag + i * a_i);
#pragma unroll
      for (int i = 0; i < 4; ++i) rb[i] = *(const u32x4*)(nbg + i * 4096);
      __builtin_amdgcn_sched_barrier(0);
    }
  };
  constexpr int SB = 528;
  constexpr int SV = TM * 2 + 16;
  constexpr int NIT = TM * 32 / NT;
  if (EPI == EPI_OUT) {
    const int bb = m0 < T_LAT ? (m0 >> 13) : 4;
#pragma unroll
    for (int h = 0; h < 2; ++h) {
      if ((TM == 256 ? (wn >> 1) : (wn >> 2)) == h) {
#pragma unroll
        for (int j = 0; j < NJ; ++j)
#pragma unroll
          for (int i = 0; i < NI; ++i)
#pragma unroll
            for (int g = 0; g < 4; ++g) {
              f32x4 v; v[0] = acc[i][j][4 * g]; v[1] = acc[i][j][4 * g + 1]; v[2] = acc[i][j][4 * g + 2]; v[3] = acc[i][j][4 * g + 3];
              *(f32x4*)(lds + (tb + j * 32 + l31) * SB + ((fb & 127) + i * 32 + 8 * g + 4 * hh) * 4) = v;
            }
      }
      if (h == 1) prefetch_next();
      __syncthreads();
      const float* gate = (const float*)(p.ws + OFF_MOD) + (size_t)(layer * 5 + bb) * 3072 + 2048 + n0 + h * 128;
#pragma unroll 4
      for (int it = 0; it < NIT; ++it) {
        const int cidx = tid + NT * it, row = cidx >> 5, ch = cidx & 31;
        const f32x4 y = *(const f32x4*)(lds + row * SB + ch * 16);
        const f32x4 gt = *(const f32x4*)(gate + ch * 4);
        const f32x4 old = *(const f32x4*)(h_src(p, layer, m0 + row) + n0 + h * 128 + ch * 4);
        *(f32x4*)(h_dst(p, m0 + row) + n0 + h * 128 + ch * 4) = old + gt * y;
      }
      __syncthreads();
    }
  } else {
    const bool vt = (EPI == EPI_KVB && nt >= 2) || (EPI == EPI_C_IN && nt >= 8 && nt < 12);
#pragma unroll
    for (int j = 0; j < NJ; ++j) {
      const int rl = tb + j * 32 + l31;
      float rs = 1.f;
      if (EPI == EPI_QB || EPI == EPI_KVB) rs = rstd[rl];
#pragma unroll
      for (int i = 0; i < NI; ++i)
#pragma unroll
        for (int g = 0; g < 4; ++g) {
          const int fl = fb + i * 32 + 8 * g + 4 * hh;
          float v0 = acc[i][j][4 * g], v1 = acc[i][j][4 * g + 1], v2 = acc[i][j][4 * g + 2], v3 = acc[i][j][4 * g + 3];
          epi_math<EPI>(p, m0 + rl, n0 + fl, v0, v1, v2, v3, rs);
          const unsigned w01 = pack_bf16(v0, v1), w23 = pack_bf16(v2, v3);
          if (!vt) {
            u32x2 wv; wv.x = w01; wv.y = w23;
            *(u32x2*)(lds + rl * SB + fl * 2) = wv;
          } else {
            *(bf16_t*)(lds + (fl + 0) * SV + rl * 2) = (bf16_t)(w01 & 0xffffu);
            *(bf16_t*)(lds + (fl + 1) * SV + rl * 2) = (bf16_t)(w01 >> 16);
            *(bf16_t*)(lds + (fl + 2) * SV + rl * 2) = (bf16_t)(w23 & 0xffffu);
            *(bf16_t*)(lds + (fl + 3) * SV + rl * 2) = (bf16_t)(w23 >> 16);
          }
        }
    }
    prefetch_next();
    __syncthreads();
#pragma unroll 4
    for (int it = 0; it < NIT; ++it) {
      const int cidx = tid + NT * it;
      if (vt) {
        const int row = cidx / (TM / 8), ch = cidx % (TM / 8);
        *(u32x4*)dst_v<EPI>(p, m0 + ch * 8, n0 + row) = *(const u32x4*)(lds + row * SV + ch * 16);
      } else {
        const int row = cidx >> 5, ch = cidx & 31;
        bf16_t* d = dst_tr<EPI>(p, m0 + row, n0 + ch * 8);
        if (d) *(u32x4*)d = *(const u32x4*)(lds + row * SB + ch * 16);
      }
    }
    __syncthreads();
  }
}

template <int EPI>
DI void gemm_phase(const Params& p, int layer, const bf16_t* A, int lda, const bf16_t* Bt, int K, int mtiles, int ntiles, bool ctx, bool reverse, char* lds) {
  const int G = ogrid();
  const int bid = reverse ? (G - 1 - obid()) : obid();
  u32x4 ra[4], rb[4];
  const bool simple = (G & 7) != 0;
  const int xcd = bid & 7, local = simple ? bid : (bid >> 3), nlocal = simple ? G : (G >> 3);
  const int mlo = simple ? 0 : ((xcd * mtiles) >> 3), cnt = simple ? mtiles : ((((xcd + 1) * mtiles) >> 3) - mlo);
  const int total = cnt * ntiles, gsize = 4 * ntiles;
  auto tile_of = [&](int j, int& m0, int& nt) {
    const int g = j / gsize, r = j - g * gsize;
    int gm = cnt - g * 4; gm = gm > 4 ? 4 : gm;
    m0 = (mlo + g * 4 + (r % gm)) * 256; nt = r / gm;
  };
  bool pre = false;
  for (int j = local; j < total; j += nlocal) {
    int m0, nt; tile_of(j, m0, nt);
    TilePf pf; pf.pre = pre; pf.has_next = (j + nlocal < total); pf.nm0 = 0; pf.nnt = 0;
    if (pf.has_next) tile_of(j + nlocal, pf.nm0, pf.nnt);
    gemm_tile<EPI, 256>(p, layer, A, lda, Bt, K, m0, nt, lds, ra, rb, pf);
    pre = pf.has_next;
  }
  if (ctx) {
    const int b2 = G - 1 - bid;
    u32x4 ra1[1];
    TilePf pf; pf.pre = false; pf.has_next = false; pf.nm0 = 0; pf.nnt = 0;
    for (int u = b2; u < 16 * ntiles; u += G) gemm_tile<EPI, 64>(p, layer, A, lda, Bt, K, T_LAT + (u & 15) * 64, u >> 4, lds, ra1, rb, pf);
  }
}

DI void vta_phase(const Params& p, char* lds) {
  const int tid = otid();
  const bf16_t* Pb = (const bf16_t*)(p.ws + OFF_P);
  for (int u = ogrid() - 1 - obid(); u < T_ALL / 64; u += ogrid()) {
    const int t0 = u * 64;
#pragma unroll
    for (int it = 0; it < 2; ++it) {
      const int cidx = tid + NT * it, row = cidx >> 4, ch = cidx & 15;
      *(u32x4*)(lds + row * 272 + ch * 16) = *(const u32x4*)(Pb + (size_t)(t0 + row) * 2560 + 640 + ch * 8);
    }
    __syncthreads();
    int b, key; tok_bk(t0, b, key);
#pragma unroll
    for (int it = 0; it < 2; ++it) {
      const int cidx = tid + NT * it, f = cidx & 127, tc = cidx >> 7;
      unsigned short e[8];
#pragma unroll
      for (int k = 0; k < 8; ++k) e[k] = *(const bf16_t*)(lds + (tc * 8 + k) * 272 + f * 2);
      u32x4 v; v.x = e[0] | ((unsigned)e[1] << 16); v.y = e[2] | ((unsigned)e[3] << 16); v.z = e[4] | ((unsigned)e[5] << 16); v.w = e[6] | ((unsigned)e[7] << 16);
      *(u32x4*)((bf16_t*)(p.ws + OFF_VT) + ((size_t)(b * 2 + (f >> 6)) * 64 + (f & 63)) * NKEY + key + tc * 8) = v;
    }
    __syncthreads();
  }
}

template <int MODE>
DI void attn_item(const Params& p, int layer, int b, int qt, int head, bool is_ctx, char* lds) {
  constexpr int DK = (MODE == 1) ? 96 : 64;
  constexpr int NKS = DK / 16;
  constexpr int KSTR = DK * 2 + 16;
  constexpr int VSTR = 144;
  constexpr int KBYTES = 64 * KSTR;
  constexpr int STAGE = KBYTES + 64 * VSTR;
  constexpr int QPB = 256;
  constexpr int NKC = DK / 8;
  constexpr int KCH = 64 * NKC;
  constexpr int OSTR = 272;
  constexpr float MASKV = -1e30f;
  float* rpbs = (float*)(lds + 4 * STAGE);
  char* ostage = lds;

  const int tid = otid(), lane = tid & 63, w = tid >> 6, l31 = lane & 31, hh = lane >> 5;
  const int i2 = layer >> 1;
  const bf16_t* Pb = (const bf16_t*)(p.ws + OFF_P);
  bf16_t* UG = (bf16_t*)(p.ws + OFF_UG);
  const bf16_t *Qp, *Kp, *Krp = nullptr, *Zp, *Vt;
  int ldq, ldk, ldz, gcol;
  if (MODE == 0) {
    Qp = Pb + head * 64; ldq = 2560; Kp = Pb + 512 + (head >> 2) * 64; ldk = 2560;
    Vt = (const bf16_t*)(p.ws + OFF_VT) + (size_t)(b * 2 + (head >> 2)) * 64 * NKEY;
    Zp = Pb + 768 + head * 64; ldz = 2560; gcol = head * 64;
  } else if (MODE == 1) {
    Qp = (const bf16_t*)(p.ws + OFF_QB) + head * 96; ldq = 768; Kp = (const bf16_t*)(p.ws + OFF_KB) + head * 64; ldk = 512; Krp = Pb + 1920;
    Vt = (const bf16_t*)(p.ws + OFF_VTB) + (size_t)(b * 8 + head) * 64 * NKEY;
    Zp = Pb + 1952 + head * 64; ldz = 2560; gcol = 512 + head * 64;
  } else {
    Qp = Pb + head * 64; ldq = 3072; Kp = Pb + 1024 + head * 64; ldk = 3072;
    Vt = (const bf16_t*)(p.ws + OFF_VT) + (size_t)(b * 16 + head) * 64 * NKEY;
    Zp = Pb + 2048 + head * 64; ldz = 3072; gcol = head * 64;
  }
  const int qtok0 = is_ctx ? T_LAT + b * 256 : b * 8192 + qt * QPB;

  int lat_lo = 0, nlat = 0;
  if (!is_ctx) {
    if (MODE == 0) {
      int lo = 4 * qt - 2; if (lo < 0) lo = 0;
      int hi = 4 * qt + 5; if (hi > 127) hi = 127;
      lat_lo = lo; nlat = hi - lo + 1;
    } else if (MODE == 1) { lat_lo = 0; nlat = 128; }
    else {
      int lo = 4 * qt - 4; lo = lo < 0 ? 0 : (lo > 120 ? 120 : lo);
      int hi = 4 * qt + 3 - 4; hi = hi < 0 ? 0 : (hi > 120 ? 120 : hi); hi += 7;
      lat_lo = lo; nlat = hi - lo + 1;
    }
  }
  const int ntiles = nlat + 4;

  const bool nat2 = (MODE == 2) && !is_ctx;
  auto tokmap = [&](int row) { return nat2 ? qtok0 + ((w >> 2) * 2 + (row >> 4)) * 64 + (w & 3) * 16 + (row & 15) : qtok0 + w * 32 + row; };
  const int qtok = tokmap(l31);
  bf16x8 qf[NKS];
#pragma unroll
  for (int ks = 0; ks < NKS; ++ks) qf[ks] = *(const bf16x8*)(Qp + (size_t)qtok * ldq + ks * 16 + hh * 8);
  if (MODE == 2 && !is_ctx) {
    for (int i = tid; i < 465; i += NT) rpbs[i] = p.c_rpb[(size_t)(i2 * 16 + head) * 465 + i] * LOG2E;
  }
  float m_ = (MODE == 0) ? p.a_sink[i2 * 8 + head] * LOG2E : MASKV;
  float l_ = (MODE == 0 && hh == 0) ? 1.f : 0.f;
  f32x16 O[2];
#pragma unroll
  for (int dh = 0; dh < 2; ++dh)
#pragma unroll
    for (int r = 0; r < 16; ++r) O[dh][r] = 0.f;

  const int k0row = tid / NKC, k0cc = tid % NKC;
  const int k1row = (tid + NT) / NKC, k1cc = (tid + NT) % NKC;
  const bool k1 = (KCH > NT) && (tid + NT < KCH);
  struct Stg { u32x4 k0, k1, v; };
  Stg R0, R1;
  R0.k1 = (u32x4){0u, 0u, 0u, 0u}; R1.k1 = R0.k1;
  auto tile_kt = [&](int i) { return i < nlat ? lat_lo + i : 128 + (i - nlat); };
  auto kload = [&](int krow0, int row, int cc) -> u32x4 {
    if (MODE == 1 && cc >= 8) return *(const u32x4*)(Krp + (size_t)(krow0 + row) * 2560 + (cc - 8) * 8);
    return *(const u32x4*)(Kp + (size_t)(krow0 + row) * ldk + cc * 8);
  };
  auto gload = [&](int i, Stg& r) {
    const int kt = tile_kt(i < ntiles ? i : ntiles - 1);
    const int krow0 = kt < 128 ? b * 8192 + kt * 64 : T_LAT + b * 256 + (kt - 128) * 64;
    r.k0 = kload(krow0, k0row, k0cc);
    if (k1) r.k1 = kload(krow0, k1row, k1cc);
    r.v = *(const u32x4*)(Vt + (size_t)(tid >> 3) * NKEY + kt * 64 + (tid & 7) * 8);
  };
  auto lstore = [&](int st, const Stg& r) {
    char* kb = lds + st * STAGE;
    *(u32x4*)(kb + k0row * KSTR + k0cc * 16) = r.k0;
    if (k1) *(u32x4*)(kb + k1row * KSTR + k1cc * 16) = r.k1;
    *(u32x4*)(kb + KBYTES + (tid >> 3) * VSTR + (tid & 7) * 16) = r.v;
  };

  const int pr = (l31 & ~12) | ((l31 & 4) << 1) | ((l31 & 8) >> 1);
  int qr = 0, qc = 0, rs0 = 0, cs = 0, csw = 0, wlo = 0, whi = 0;
  if (MODE == 2) {
    qr = qt * 4 + (w >> 2) * 2 + (l31 >> 4); qc = (w & 3) * 16 + (l31 & 15);
    rs0 = qr - 4; rs0 = rs0 < 0 ? 0 : (rs0 > 120 ? 120 : rs0);
    cs = qc - 8; cs = cs < 0 ? 0 : (cs > 48 ? 48 : cs);
    csw = (w & 3) * 16 - 8; csw = csw < 0 ? 0 : (csw > 32 ? 32 : csw);
    const int r_lo = qt * 4 + (w >> 2) * 2;
    wlo = r_lo - 4; wlo = wlo < 0 ? 0 : (wlo > 120 ? 120 : wlo);
    whi = r_lo + 1 - 4; whi = whi < 0 ? 0 : (whi > 120 ? 120 : whi); whi += 7;
  }
  const int s0w = qt * QPB + w * 32;
  const int nsup = (ntiles + 1) >> 1;
  __syncthreads();
  gload(0, R0); gload(1, R1);
  lstore(0, R0); lstore(1, R1);
  gload(2, R0); gload(3, R1);
  __syncthreads();
  auto body = [&](int it, const char* kb) {
    const char* vb = kb + KBYTES;
    const int kt = tile_kt(it);
    const bool lat_tile = it < nlat;
    bool skip = (it >= ntiles);
    if (MODE == 2 && lat_tile) skip = (kt < wlo) || (kt > whi);
    if (MODE == 0 && lat_tile) skip = (kt * 64 + 63 < s0w - 128) || (kt * 64 > s0w + 31 + 128);
    const int nsub = (MODE == 2 && lat_tile) ? 1 : 2;
    const int krb = (MODE == 2 && lat_tile) ? csw : 0;
    if (!skip) {
      f32x16 S[2];
#pragma unroll
      for (int t = 0; t < 2; ++t)
#pragma unroll
        for (int r = 0; r < 16; ++r) S[t][r] = 0.f;
#pragma unroll
      for (int ks = 0; ks < NKS; ++ks) {
        const bf16x8 a0 = *(const bf16x8*)(kb + (krb + pr) * KSTR + ks * 32 + hh * 16);
        S[0] = MFMA32(a0, qf[ks], S[0]);
        if (nsub == 2) {
          const bf16x8 a1 = *(const bf16x8*)(kb + (32 + pr) * KSTR + ks * 32 + hh * 16);
          S[1] = MFMA32(a1, qf[ks], S[1]);
        }
      }
      if (MODE == 0 && lat_tile) {
        const int s = qt * QPB + w * 32 + l31;
#pragma unroll
        for (int t = 0; t < 2; ++t)
#pragma unroll
          for (int r = 0; r < 16; ++r) {
            const int kk = kt * 64 + t * 32 + 16 * (r >> 3) + 8 * hh + (r & 7);
            const int d = kk - s;
            if (d > 128 || d < -128) S[t][r] = MASKV;
          }
      }
      if (MODE == 2 && lat_tile) {
        int ri = kt - qr + 7; ri = ri < 0 ? 0 : (ri > 14 ? 14 : ri);
        const float* brow = rpbs + ri * 31;
        const bool rok = (kt >= rs0) && (kt <= rs0 + 7);
        float bv[16];
#pragma unroll
        for (int r = 0; r < 16; ++r) {
          const int kc = csw + 16 * (r >> 3) + 8 * hh + (r & 7);
          int bi = kc - qc + 15; bi = bi < 0 ? 0 : (bi > 30 ? 30 : bi);
          bv[r] = brow[bi];
        }
#pragma unroll
        for (int r = 0; r < 16; ++r) asm volatile("" : "+v"(bv[r]));
#pragma unroll
        for (int r = 0; r < 16; ++r) {
          const int kc = csw + 16 * (r >> 3) + 8 * hh + (r & 7);
          const bool ok = rok && (kc >= cs) && (kc < cs + 16);
          S[0][r] = ok ? S[0][r] + bv[r] : MASKV;
        }
      }
      float mx = S[0][0];
#pragma unroll
      for (int r = 0; r < 16; ++r) mx = fmaxf(mx, S[0][r]);
      if (nsub == 2) {
#pragma unroll
        for (int r = 0; r < 16; ++r) mx = fmaxf(mx, S[1][r]);
      }
      mx = fmaxf(mx, __shfl_xor(mx, 32));
      if (__any(mx > m_ + 8.f)) {
        const float mnew = fmaxf(m_, mx);
        const float alpha = fexp2(m_ - mnew);
        m_ = mnew;
        l_ *= alpha;
#pragma unroll
        for (int dh = 0; dh < 2; ++dh)
#pragma unroll
          for (int r = 0; r < 16; ++r) O[dh][r] *= alpha;
      }
      float rsum = 0.f;
#pragma unroll
      for (int t = 0; t < 2; ++t)
        if (t < nsub) {
#pragma unroll
          for (int r = 0; r < 16; ++r) { const float e = fexp2(S[t][r] - m_); S[t][r] = e; rsum += e; }
        }
      l_ += rsum;
#pragma unroll
      for (int t = 0; t < 2; ++t)
       if (t < nsub)
#pragma unroll
        for (int s = 0; s < 2; ++s) {
          u32x4 u;
          u.x = pack_bf16(S[t][8 * s + 0], S[t][8 * s + 1]); u.y = pack_bf16(S[t][8 * s + 2], S[t][8 * s + 3]);
          u.z = pack_bf16(S[t][8 * s + 4], S[t][8 * s + 5]); u.w = pack_bf16(S[t][8 * s + 6], S[t][8 * s + 7]);
          const bf16x8 pf = __builtin_bit_cast(bf16x8, u);
#pragma unroll
          for (int dh = 0; dh < 2; ++dh) {
            const bf16x8 v = *(const bf16x8*)(vb + (dh * 32 + l31) * VSTR + (krb + t * 32 + s * 16 + hh * 8) * 2);
            O[dh] = MFMA32(v, pf, O[dh]);
          }
        }
    }
  };
  for (int j = 0; j < nsup; ++j) {
    const char* sb = lds + (j & 1) * 2 * STAGE;
    body(2 * j, sb);
    body(2 * j + 1, sb + STAGE);
    __builtin_amdgcn_sched_barrier(0);
    {
      const int so = ((j + 1) & 1) * 2;
      lstore(so, R0); lstore(so + 1, R1);
      gload(2 * j + 4, R0); gload(2 * j + 5, R1);
    }
    __syncthreads();
  }

  {
    const float lt = l_ + __shfl_xor(l_, 32);
    const float inv = 1.f / lt;
    char* orow = ostage + (w * 32) * OSTR;
#pragma unroll
    for (int dh = 0; dh < 2; ++dh)
#pragma unroll
      for (int g = 0; g < 4; ++g) {
        f32x4 v; v[0] = O[dh][4 * g] * inv; v[1] = O[dh][4 * g + 1] * inv; v[2] = O[dh][4 * g + 2] * inv; v[3] = O[dh][4 * g + 3] * inv;
        *(f32x4*)(orow + l31 * OSTR + (dh * 32 + 8 * g + 4 * hh) * 4) = v;
      }
    __builtin_amdgcn_s_waitcnt(0xc07f);
#pragma unroll
    for (int it = 0; it < 4; ++it) {
      const int cidx = lane + 64 * it, row = cidx >> 3, ch = cidx & 7;
      const f32x4 o0 = *(const f32x4*)(orow + row * OSTR + ch * 32), o1 = *(const f32x4*)(orow + row * OSTR + ch * 32 + 16);
      const int tok = tokmap(row);
      const u32x4 z = *(const u32x4*)(Zp + (size_t)tok * ldz + ch * 8);
      u32x4 wv;
      wv.x = pack_bf16(o0[0] * silu(bf_lo(z.x)), o0[1] * silu(bf_hi(z.x)));
      wv.y = pack_bf16(o0[2] * silu(bf_lo(z.y)), o0[3] * silu(bf_hi(z.y)));
      wv.z = pack_bf16(o1[0] * silu(bf_lo(z.z)), o1[1] * silu(bf_hi(z.z)));
      wv.w = pack_bf16(o1[2] * silu(bf_lo(z.w)), o1[3] * silu(bf_hi(z.w)));
      *(u32x4*)(UG + ablk(tok, gcol + ch * 8)) = wv;
    }
  }
}

DI void mla_item2(const Params& p, int layer, int b, int qt, int head, char* lds) {
  constexpr int DK = 96, NKS = 6, KSTR = DK * 2 + 16, VSTR = 144, KBYTES = 64 * KSTR, STAGE = KBYTES + 64 * VSTR;
  constexpr int NKC = 12, KCH = 64 * NKC, OSTR = 272, QG = 2, NTILES = 132;
  constexpr float MASKV = -1e30f;
  char* ostage = lds;
  const int tid = otid(), lane = tid & 63, w = tid >> 6, l31 = lane & 31, hh = lane >> 5;
  const bf16_t* Pb = (const bf16_t*)(p.ws + OFF_P);
  bf16_t* UG = (bf16_t*)(p.ws + OFF_UG);
  const bf16_t* Qp = (const bf16_t*)(p.ws + OFF_QB) + head * 96;
  const bf16_t* Kp = (const bf16_t*)(p.ws + OFF_KB) + head * 64;
  const bf16_t* Krp = Pb + 1920;
  const bf16_t* Vt = (const bf16_t*)(p.ws + OFF_VTB) + (size_t)(b * 8 + head) * 64 * NKEY;
  const bf16_t* Zp = Pb + 1952 + head * 64;
  const int gcol = 512 + head * 64;
  const int qtok0 = b * 8192 + qt * 512;
  bf16x8 qf[QG][NKS];
#pragma unroll
  for (int qg = 0; qg < QG; ++qg)
#pragma unroll
    for (int ks = 0; ks < NKS; ++ks) qf[qg][ks] = *(const bf16x8*)(Qp + (size_t)(qtok0 + qg * 256 + w * 32 + l31) * 768 + ks * 16 + hh * 8);
  float m_[QG], l_[QG];
  f32x16 O[QG][2];
#pragma unroll
  for (int qg = 0; qg < QG; ++qg) {
    m_[qg] = MASKV; l_[qg] = 0.f;
#pragma unroll
    for (int dh = 0; dh < 2; ++dh)
#pragma unroll
      for (int r = 0; r < 16; ++r) O[qg][dh][r] = 0.f;
  }
  const int k0row = tid / NKC, k0cc = tid % NKC;
  const int k1row = (tid + NT) / NKC, k1cc = (tid + NT) % NKC;
  const bool k1 = (tid + NT < KCH);
  struct Stg { u32x4 k0, k1, v; };
  Stg R0;
  R0.k1 = (u32x4){0u, 0u, 0u, 0u};
  auto kload = [&](int krow0, int row, int cc) -> u32x4 {
    if (cc >= 8) return *(const u32x4*)(Krp + (size_t)(krow0 + row) * 2560 + (cc - 8) * 8);
    return *(const u32x4*)(Kp + (size_t)(krow0 + row) * 512 + cc * 8);
  };
  auto gload = [&](int i, Stg& r) {
    const int kt = i < NTILES ? i : NTILES - 1;
    const int krow0 = kt < 128 ? b * 8192 + kt * 64 : T_LAT + b * 256 + (kt - 128) * 64;
    r.k0 = kload(krow0, k0row, k0cc);
    if (k1) r.k1 = kload(krow0, k1row, k1cc);
    r.v = *(const u32x4*)(Vt + (size_t)(tid >> 3) * NKEY + kt * 64 + (tid & 7) * 8);
  };
  auto lstore = [&](int st, const Stg& r) {
    char* kb = lds + st * STAGE;
    *(u32x4*)(kb + k0row * KSTR + k0cc * 16) = r.k0;
    if (k1) *(u32x4*)(kb + k1row * KSTR + k1cc * 16) = r.k1;
    *(u32x4*)(kb + KBYTES + (tid >> 3) * VSTR + (tid & 7) * 16) = r.v;
  };
  const int pr = (l31 & ~12) | ((l31 & 4) << 1) | ((l31 & 8) >> 1);
  __syncthreads();
  gload(0, R0); lstore(0, R0);
  gload(1, R0);
  __syncthreads();
  auto body = [&](const char* kb) {
    const char* vb = kb + KBYTES;
    f32x16 S[QG][2];
#pragma unroll
    for (int qg = 0; qg < QG; ++qg)
#pragma unroll
      for (int t = 0; t < 2; ++t)
#pragma unroll
        for (int r = 0; r < 16; ++r) S[qg][t][r] = 0.f;
#pragma unroll
    for (int ks = 0; ks < NKS; ++ks) {
      const bf16x8 a0 = *(const bf16x8*)(kb + pr * KSTR + ks * 32 + hh * 16);
      const bf16x8 a1 = *(const bf16x8*)(kb + (32 + pr) * KSTR + ks * 32 + hh * 16);
#pragma unroll
      for (int qg = 0; qg < QG; ++qg) { S[qg][0] = MFMA32(a0, qf[qg][ks], S[qg][0]); S[qg][1] = MFMA32(a1, qf[qg][ks], S[qg][1]); }
    }
#pragma unroll
    for (int qg = 0; qg < QG; ++qg) {
      float mx = S[qg][0][0];
#pragma unroll
      for (int t = 0; t < 2; ++t)
#pragma unroll
        for (int r = 0; r < 16; ++r) mx = fmaxf(mx, S[qg][t][r]);
      mx = fmaxf(mx, __shfl_xor(mx, 32));
      if (__any(mx > m_[qg] + 8.f)) {
        const float mnew = fmaxf(m_[qg], mx);
        const float alpha = fexp2(m_[qg] - mnew);
        m_[qg] = mnew;
        l_[qg] *= alpha;
#pragma unroll
        for (int dh = 0; dh < 2; ++dh)
#pragma unroll
          for (int r = 0; r < 16; ++r) O[qg][dh][r] *= alpha;
      }
      float rsum = 0.f;
#pragma unroll
      for (int t = 0; t < 2; ++t)
#pragma unroll
        for (int r = 0; r < 16; ++r) { const float e = fexp2(S[qg][t][r] - m_[qg]); S[qg][t][r] = e; rsum += e; }
      l_[qg] += rsum;
    }
#pragma unroll
    for (int t = 0; t < 2; ++t)
#pragma unroll
      for (int s = 0; s < 2; ++s) {
        bf16x8 pf[QG];
#pragma unroll
        for (int qg = 0; qg < QG; ++qg) {
          u32x4 u;
          u.x = pack_bf16(S[qg][t][8 * s + 0], S[qg][t][8 * s + 1]); u.y = pack_bf16(S[qg][t][8 * s + 2], S[qg][t][8 * s + 3]);
          u.z = pack_bf16(S[qg][t][8 * s + 4], S[qg][t][8 * s + 5]); u.w = pack_bf16(S[qg][t][8 * s + 6], S[qg][t][8 * s + 7]);
          pf[qg] = __builtin_bit_cast(bf16x8, u);
        }
#pragma unroll
        for (int dh = 0; dh < 2; ++dh) {
          const bf16x8 v = *(const bf16x8*)(vb + (dh * 32 + l31) * VSTR + (t * 32 + s * 16 + hh * 8) * 2);
#pragma unroll
          for (int qg = 0; qg < QG; ++qg) O[qg][dh] = MFMA32(v, pf[qg], O[qg][dh]);
        }
      }
  };
  if (w >= 4) __builtin_amdgcn_s_setprio(2);
  for (int j = 0; j < NTILES; ++j) {
    body(lds + (j & 1) * STAGE);
    __builtin_amdgcn_sched_barrier(0);
    lstore((j + 1) & 1, R0);
    gload(j + 2, R0);
    __syncthreads();
  }
  __builtin_amdgcn_s_setprio(0);
#pragma unroll
  for (int qg = 0; qg < QG; ++qg) {
    const float lt = l_[qg] + __shfl_xor(l_[qg], 32);
    const float inv = 1.f / lt;
    char* orow = ostage + (w * 32) * OSTR;
#pragma unroll
    for (int dh = 0; dh < 2; ++dh)
#pragma unroll
      for (int g = 0; g < 4; ++g) {
        f32x4 v; v[0] = O[qg][dh][4 * g] * inv; v[1] = O[qg][dh][4 * g + 1] * inv; v[2] = O[qg][dh][4 * g + 2] * inv; v[3] = O[qg][dh][4 * g + 3] * inv;
        *(f32x4*)(orow + l31 * OSTR + (dh * 32 + 8 * g + 4 * hh) * 4) = v;
      }
    __builtin_amdgcn_s_waitcnt(0xc07f);
#pragma unroll
    for (int it = 0; it < 4; ++it) {
      const int cidx = lane + 64 * it, row = cidx >> 3, ch = cidx & 7;
      const f32x4 o0 = *(const f32x4*)(orow + row * OSTR + ch * 32), o1 = *(const f32x4*)(orow + row * OSTR + ch * 32 + 16);
      const int tok = qtok0 + qg * 256 + w * 32 + row;
      const u32x4 z = *(const u32x4*)(Zp + (size_t)tok * 2560 + ch * 8);
      u32x4 wv;
      wv.x = pack_bf16(o0[0] * silu(bf_lo(z.x)), o0[1] * silu(bf_hi(z.x)));
      wv.y = pack_bf16(o0[2] * silu(bf_lo(z.y)), o0[3] * silu(bf_hi(z.y)));
      wv.z = pack_bf16(o1[0] * silu(bf_lo(z.z)), o1[1] * silu(bf_hi(z.z)));
      wv.w = pack_bf16(o1[2] * silu(bf_lo(z.w)), o1[3] * silu(bf_hi(z.w)));
      *(u32x4*)(UG + ablk(tok, gcol + ch * 8)) = wv;
    }
    __builtin_amdgcn_s_waitcnt(0xc07f);
  }
}

DI void attn_phase_ab(const Params& p, int layer, char* lds) {
  const int G = ogrid();
  for (int v = obid(); v < 512; v += G) {
    const int xcd = v & 7, s = v >> 3;
    const int grp = (s >> 4) * 8 + xcd, qt = s & 15;
    mla_item2(p, layer, grp >> 3, qt, grp & 7, lds);
  }
  for (int v = obid(); v < 32; v += G) attn_item<1>(p, layer, v >> 3, 0, v & 7, true, lds);
  for (int v = obid(); v < 1024 + 32; v += G) {
    if (v < 1024) attn_item<0>(p, layer, v >> 8, v & 31, (v >> 5) & 7, false, lds);
    else { const int c = v - 1024; attn_item<0>(p, layer, c >> 3, 0, c & 7, true, lds); }
  }
}

DI void attn_phase_c(const Params& p, int layer, char* lds) {
  const int G = ogrid();
  const int nctx = (layer == 3) ? 0 : 64;
  for (int v = obid(); v < 2048 + nctx; v += G) {
    if (v < 2048) attn_item<2>(p, layer, v >> 9, v & 31, (v >> 5) & 15, false, lds);
    else { const int c = v - 2048; attn_item<2>(p, layer, c >> 4, 0, c & 15, true, lds); }
  }
}

__global__ void __launch_bounds__(512, 2) fwd_megakernel(Params p) {
  __shared__ __attribute__((aligned(16))) char lds[LDS_BYTES];
  __shared__ uint4 xb_words;
  if (threadIdx.x == 0) xb_words = make_uint4(0u, 0u, 0u, 0u);
  __syncthreads();
  if (obid() == 0) { unsigned* bw = (unsigned*)(p.ws + OFF_BAR); for (int i = otid(); i < 4096; i += NT) bw[i] = 0u; }
  XcdBarrier xb; xb.bar = (unsigned*)(p.ws + OFF_BAR); xb.x = 0; xb.st = (volatile LAS unsigned*)&xb_words;
  bool first = true, posted = false;
  for (int ph = p.ph_begin; ph < p.ph_end; ++ph) {
    const int layer = (ph - 1) / 5, s = (ph - 1) % 5;
    const bool even = (layer & 1) == 0;
    const int i2 = layer >> 1;
    if (ph >= 1 && ph <= 20 && s == 2 && !even) continue;
    if (!first) {
      if (!posted) { cg::this_grid().sync(); xb = xcd_barrier_post((unsigned*)(p.ws + OFF_BAR), (volatile LAS unsigned*)&xb_words); posted = true; }
      else xcd_barrier(xb);
    }
    first = false;
    if (ph == 0) prologue_phase(p, lds);
    else if (ph == 21) final_phase(p);
    else if (s == 0) norm_phase(p, layer);
    else if (s == 1) {
      const bf16_t* U = (const bf16_t*)(p.ws + OFF_UG);
      if (even) gemm_phase<EPI_AB_IN>(p, layer, U, 0, (const bf16_t*)(p.ws + OFF_W_IN) + (size_t)i2 * 2560 * 1024, 1024, 128, 10, true, false, lds);
      else gemm_phase<EPI_C_IN>(p, layer, U, 0, (const bf16_t*)(p.ws + OFF_W_CIN) + (size_t)i2 * 4096 * 1024, 1024, 128, 16, true, false, lds);
    } else if (s == 2) {
      const bf16_t* Pb = (const bf16_t*)(p.ws + OFF_P);
      gemm_phase<EPI_QB>(p, layer, Pb + 1280, 2560, (const bf16_t*)(p.ws + OFF_W_UQ) + (size_t)i2 * 768 * 384, 384, 128, 3, true, false, lds);
      gemm_phase<EPI_KVB>(p, layer, Pb + 1664, 2560, (const bf16_t*)(p.ws + OFF_W_UKV) + (size_t)i2 * 1024 * 256, 256, 128, 4, true, true, lds);
      vta_phase(p, lds);
    } else if (s == 3) {
      if (even) attn_phase_ab(p, layer, lds); else attn_phase_c(p, layer, lds);
    } else {
      const bf16_t* Gm = (const bf16_t*)(p.ws + OFF_UG);
      const bf16_t* W = even ? (const bf16_t*)(p.ws + OFF_W_OUT) + (size_t)i2 * 1024 * 1024 : (const bf16_t*)(p.ws + OFF_W_COUT) + (size_t)i2 * 1024 * 1024;
      gemm_phase<EPI_OUT>(p, layer, Gm, 0, W, 1024, 128, 4, layer != 3, false, lds);
    }
  }
}

extern "C" void kernel_launch(void* const* d_in, const int* in_sizes, int n_in, void* d_out, int out_size, void* d_ws, size_t ws_size,
                              hipStream_t stream) {
  static int grid_blocks = 0;
  if (!grid_blocks) {
    int dev = 0, cus = 0, per_cu = 0;
    hipGetDevice(&dev);
    hipDeviceGetAttribute(&cus, hipDeviceAttributeMultiprocessorCount, dev);
    hipOccupancyMaxActiveBlocksPerMultiprocessor(&per_cu, fwd_megakernel, NT, 0);
    per_cu = 1;
    grid_blocks = cus * per_cu;
    if (ws_size < OFF_END) fprintf(stderr, "kernel_launch: workspace too small: %zu < %zu\n", ws_size, (size_t)OFF_END);
  }
  Params p{};
  const float** f = (const float**)&p;
  for (int i = 0; i < 18; ++i) f[i] = (const float*)d_in[i];
  p.out = (float*)d_out;
  p.ws = (char*)d_ws;
#if MK_MULTI_LAUNCH
  for (int ph = 0; ph < 22; ++ph) {
    if (ph >= 1 && ph <= 20 && ((ph - 1) % 5) == 2 && (((ph - 1) / 5) & 1)) continue;
    p.ph_begin = ph; p.ph_end = ph + 1;
    hipLaunchKernelGGL(fwd_megakernel, dim3(grid_blocks), dim3(NT), 0, stream, p);
  }
#else
  p.ph_begin = 0; p.ph_end = 22;
  void* args[] = {&p};
  hipError_t e = hipLaunchCooperativeKernel((void*)fwd_megakernel, dim3(grid_blocks), dim3(NT), args, 0, stream);
  if (e != hipSuccess) fprintf(stderr, "cooperative launch failed: %s (grid %d)\n", hipGetErrorString(e), grid_blocks);
#endif
}
```

```cpp
#include <hip/hip_runtime.h>
#include <hip/hip_cooperative_groups.h>
#include <stdint.h>
#include <stdio.h>
namespace cg = cooperative_groups;

#ifndef MK_MULTI_LAUNCH
#define MK_MULTI_LAUNCH 0
#endif

typedef unsigned short bf16_t;
typedef short bf16x8 __attribute__((ext_vector_type(8)));
typedef float f32x16 __attribute__((ext_vector_type(16)));
typedef float f32x4 __attribute__((ext_vector_type(4)));
typedef float f32x2 __attribute__((ext_vector_type(2)));
typedef unsigned u32x4 __attribute__((ext_vector_type(4)));
typedef unsigned u32x2 __attribute__((ext_vector_type(2)));

#define DI __device__ __forceinline__
#define MFMA32(a, b, c) __builtin_amdgcn_mfma_f32_32x32x16_bf16((a), (b), (c), 0, 0, 0)

constexpr int T_LAT = 32768, T_ALL = 33792, NKEY = 8448, NT = 512;
constexpr float LOG2E = 1.4426950408889634f;
constexpr float QSCALE_A = 0.125f * LOG2E;
constexpr float QSCALE_B = 0.10206207261596575f * LOG2E;

constexpr size_t OFF_HC   = 0;
constexpr size_t OFF_UG   = OFF_HC + 1024ull * 1024 * 4;
constexpr size_t OFF_P    = OFF_UG + (size_t)T_ALL * 1024 * 2;
constexpr size_t OFF_QB   = OFF_P + (size_t)T_ALL * 2560 * 2;
constexpr size_t OFF_KB   = OFF_QB + (size_t)T_ALL * 768 * 2;
constexpr size_t OFF_VT   = OFF_KB + (size_t)T_ALL * 512 * 2;
constexpr size_t OFF_VTB  = OFF_VT + 4ull * 2 * 64 * NKEY * 2;
constexpr size_t OFF_W    = OFF_VT + 4ull * 16 * 64 * NKEY * 2;
constexpr size_t OFF_W_IN   = OFF_W;
constexpr size_t OFF_W_OUT  = OFF_W_IN + 2ull * 2560 * 1024 * 2;
constexpr size_t OFF_W_UQ   = OFF_W_OUT + 2ull * 1024 * 1024 * 2;
constexpr size_t OFF_W_UKV  = OFF_W_UQ + 2ull * 768 * 384 * 2;
constexpr size_t OFF_W_CIN  = OFF_W_UKV + 2ull * 1024 * 256 * 2;
constexpr size_t OFF_W_COUT = OFF_W_CIN + 2ull * 4096 * 1024 * 2;
constexpr size_t OFF_MOD    = OFF_W_COUT + 2ull * 1024 * 1024 * 2;
constexpr size_t OFF_ROPE   = OFF_MOD + 4ull * 5 * 3072 * 4;
constexpr size_t OFF_BAR    = OFF_ROPE + 2ull * 8192 * 32 * 4 + 2ull * 8192 * 16 * 4;
constexpr size_t OFF_END    = OFF_BAR + 16384;

struct Params {
  const float *x, *c, *ctx, *c_ctx, *ada_w, *ada_b, *norm_g, *ab_in_w, *ab_out_w, *a_sink, *b_qn_g, *b_w_uq, *b_kvn_g, *b_w_ukv,
      *c_in_w, *c_out_w, *c_rpb, *final_g;
  float* out;
  char* ws;
  int ph_begin, ph_end;
};

DI int otid() { int t = threadIdx.x; asm volatile("" : "+v"(t)); return t; }
DI int obid() { int t = blockIdx.x; asm volatile("" : "+s"(t)); return t; }
DI int ogrid() { int t = gridDim.x; asm volatile("" : "+s"(t)); return t; }
DI unsigned pack_bf16(float lo, float hi) { unsigned r; asm("v_cvt_pk_bf16_f32 %0, %1, %2" : "=v"(r) : "v"(lo), "v"(hi)); return r; }
DI float bf_lo(unsigned u) { return __uint_as_float(u << 16); }
DI float bf_hi(unsigned u) { return __uint_as_float(u & 0xffff0000u); }
DI float fexp2(float x) { return __builtin_amdgcn_exp2f(x); }
DI float silu(float z) { return z * __builtin_amdgcn_rcpf(1.f + __expf(-z)); }

DI size_t ablk(int tok, int k) { return ((size_t)((tok >> 8) * 16 + (k >> 6)) << 14) + ((tok & 255) << 6) + (k & 63); }
DI void tok_bk(int tok, int& b, int& key) {
  if (tok < T_LAT) { b = tok >> 13; key = tok & 8191; } else { int r = tok - T_LAT; b = r >> 8; key = 8192 + (r & 255); }
}
DI const float* h_src(const Params& p, int layer, int tok) {
  if (layer == 0) return tok < T_LAT ? p.x + (size_t)tok * 1024 : p.ctx + (size_t)(tok - T_LAT) * 1024;
  return tok < T_LAT ? p.out + (size_t)tok * 1024 : (const float*)(p.ws + OFF_HC) + (size_t)(tok - T_LAT) * 1024;
}
DI float* h_dst(const Params& p, int tok) {
  return tok < T_LAT ? p.out + (size_t)tok * 1024 : (float*)(p.ws + OFF_HC) + (size_t)(tok - T_LAT) * 1024;
}

#define XB_TMO      128
#define XB_XCNT(j)  (256  + 64 * (j))
#define XB_XSUB(j)  (1280 + 64 * (j))
#define XB_XGEN(j)  (2304 + 64 * (j))
#define XB_TOP      3328
#define XB_TOPGEN   3392
#define XCD_BAR_WORDS 3456
#define XB_SPIN_CAP (1u << 22)
#define LAS __attribute__((address_space(3)))
DI unsigned xb_ld(unsigned* p) { return __hip_atomic_load(p, __ATOMIC_RELAXED, __HIP_MEMORY_SCOPE_AGENT); }
DI unsigned xb_add(unsigned* p, unsigned v) { return __hip_atomic_fetch_add(p, v, __ATOMIC_RELAXED, __HIP_MEMORY_SCOPE_AGENT); }
DI unsigned xb_xcc_id() { return (unsigned)__builtin_amdgcn_s_getreg((3 << 11) | 20) & 0xFu; }
#define XB_SPIN(cond, bar) do { unsigned _sp = 0; while (cond) { __builtin_amdgcn_s_sleep(1); \
    if ((++_sp & 255u) == 0u) { if (xb_ld(&(bar)[XB_TMO])) break; if (_sp > XB_SPIN_CAP) { atomicAdd(&(bar)[XB_TMO], 1u); break; } } } } while (0)
struct XcdBarrier { unsigned* bar; unsigned x; volatile LAS unsigned* st; };
DI XcdBarrier xcd_barrier_post(unsigned* bar, volatile LAS unsigned* st) {
  XcdBarrier b; b.bar = bar; b.x = xb_xcc_id(); b.st = st;
  if (threadIdx.x == 0) (void)xb_add(&bar[XB_XCNT(b.x)], 1u);
  return b;
}
DI void xcd_barrier_complete(unsigned* bar, unsigned x, unsigned& nloc, unsigned& nx) {
  const unsigned G = gridDim.x * gridDim.y * gridDim.z;
  unsigned sum, cnt, mine, sp = 0u;
  for (;;) {
    sum = 0u; cnt = 0u; mine = 0u;
#pragma unroll
    for (unsigned j = 0; j < 16; ++j) { const unsigned c = xb_ld(&bar[XB_XCNT(j)]); sum += c; cnt += (c > 0u) ? 1u : 0u; mine = (j == x) ? c : mine; }
    if (sum == G) break;
    __builtin_amdgcn_s_sleep(1);
    if ((++sp & 255u) == 0u) { if (xb_ld(&bar[XB_TMO])) break; if (sp > XB_SPIN_CAP) { atomicAdd(&bar[XB_TMO], 1u); break; } }
  }
  nloc = mine > 0u ? mine : 1u; nx = cnt > 0u ? cnt : 1u;
}
DI void xcd_barrier(const XcdBarrier& b) {
  asm volatile("s_waitcnt vmcnt(0)" ::: "memory");
  __syncthreads();
  if (threadIdx.x == 0) {
    unsigned* bar = b.bar;
    __builtin_amdgcn_s_waitcnt(0);
    unsigned nloc = b.st[0], nx = b.st[1];
    if (nloc == 0u) { xcd_barrier_complete(bar, b.x, nloc, nx); b.st[0] = nloc; b.st[1] = nx; }
    const unsigned old = xb_add(&bar[XB_XSUB(b.x)], 1u);
    const unsigned gen = old / nloc;
    if (old + 1u == (gen + 1u) * nloc) {
      __builtin_amdgcn_fence(__ATOMIC_RELEASE, "agent");
      asm volatile("s_waitcnt vmcnt(0)" ::: "memory");
      const unsigned og = xb_add(&bar[XB_TOP], 1u);
      const unsigned tg = og / nx;
      if (og + 1u == (tg + 1u) * nx) xb_add(&bar[XB_TOPGEN], 1u);
      else XB_SPIN(xb_ld(&bar[XB_TOPGEN]) == tg, bar);
      __builtin_amdgcn_fence(__ATOMIC_ACQUIRE, "agent");
      xb_add(&bar[XB_XGEN(b.x)], 1u);
      asm volatile("s_waitcnt vmcnt(0)" ::: "memory");
    } else {
      XB_SPIN(xb_ld(&bar[XB_XGEN(b.x)]) == gen, bar);
      __builtin_amdgcn_fence(__ATOMIC_ACQUIRE, "agent");
      asm volatile("s_waitcnt vmcnt(0)" ::: "memory");
    }
  }
  __syncthreads();
}

struct TJob { const float* src; const float* rs; bf16_t* dst; int K, N, tk, tn, perm; };
DI TJob tr_job(const Params& p, int t) {
  TJob j; j.rs = nullptr; j.perm = 0;
  const int i2 = t / 2312; t -= i2 * 2312;
  if (t < 640) { j.src = p.ab_in_w + (size_t)i2 * 1024 * 2464; j.K = 1024; j.N = 2464; j.dst = (bf16_t*)(p.ws + OFF_W_IN) + (size_t)i2 * 2560 * 1024; j.tk = t / 40; j.tn = t % 40; }
  else if ((t -= 640) < 256) { j.src = p.ab_out_w + (size_t)i2 * 1024 * 1024; j.K = 1024; j.N = 1024; j.dst = (bf16_t*)(p.ws + OFF_W_OUT) + (size_t)i2 * 1024 * 1024; j.tk = t / 16; j.tn = t % 16; }
  else if ((t -= 256) < 72) { j.src = p.b_w_uq + (size_t)i2 * 384 * 768; j.K = 384; j.N = 768; j.dst = (bf16_t*)(p.ws + OFF_W_UQ) + (size_t)i2 * 768 * 384; j.rs = p.b_qn_g + i2 * 384; j.tk = t / 12; j.tn = t % 12; }
  else if ((t -= 72) < 64) { j.src = p.b_w_ukv + (size_t)i2 * 256 * 1024; j.K = 256; j.N = 1024; j.dst = (bf16_t*)(p.ws + OFF_W_UKV) + (size_t)i2 * 1024 * 256; j.rs = p.b_kvn_g + i2 * 256; j.tk = t / 16; j.tn = t % 16; j.perm = 1; }
  else if ((t -= 64) < 1024) { j.src = p.c_in_w + (size_t)i2 * 1024 * 4096; j.K = 1024; j.N = 4096; j.dst = (bf16_t*)(p.ws + OFF_W_CIN) + (size_t)i2 * 4096 * 1024; j.tk = t / 64; j.tn = t % 64; }
  else { t -= 1024; j.src = p.c_out_w + (size_t)i2 * 1024 * 1024; j.K = 1024; j.N = 1024; j.dst = (bf16_t*)(p.ws + OFF_W_COUT) + (size_t)i2 * 1024 * 1024; j.tk = t / 16; j.tn = t % 16; }
  return j;
}
DI void tr_load(const TJob& j, int tid, float (&v)[8]) {
#pragma unroll
  for (int i = 0; i < 8; ++i) {
    const int kk = (tid >> 6) + 8 * i, n = j.tn * 64 + (tid & 63);
    float x = (n < j.N) ? j.src[(size_t)(j.tk * 64 + kk) * j.N + n] : 0.f;
    if (j.rs) x *= j.rs[j.tk * 64 + kk];
    v[i] = x;
  }
}

DI void prologue_phase(const Params& p, char* lds) {
  const int tid = otid();
  constexpr int N_MOD = 192, N_TR = 4624, N_ROPE = 768;
  for (int u = obid(); u < N_MOD + N_TR + N_ROPE; u += ogrid()) {
    if (u < N_MOD) {
      const int layer = u / 48, cb = u % 48;
      float* sl = (float*)lds;
      for (int i = tid; i < 5120; i += NT) {
        const int bb = i >> 10, k = i & 1023;
        const float cv = bb < 4 ? p.c[bb * 1024 + k] : p.c_ctx[k];
        sl[i] = silu(cv);
      }
      __syncthreads();
      const int col = cb * 64 + (tid & 63), kg = tid >> 6;
      float a0 = 0, a1 = 0, a2 = 0, a3 = 0, a4 = 0;
      const float* wp = p.ada_w + (size_t)layer * 1024 * 3072 + col;
#pragma unroll 8
      for (int k = kg * 128; k < kg * 128 + 128; ++k) {
        const float wv = wp[(size_t)k * 3072];
        a0 += sl[k] * wv; a1 += sl[1024 + k] * wv; a2 += sl[2048 + k] * wv; a3 += sl[3072 + k] * wv; a4 += sl[4096 + k] * wv;
      }
      float* red = (float*)(lds + 20480);
      red[(kg * 5 + 0) * 64 + (tid & 63)] = a0; red[(kg * 5 + 1) * 64 + (tid & 63)] = a1; red[(kg * 5 + 2) * 64 + (tid & 63)] = a2;
      red[(kg * 5 + 3) * 64 + (tid & 63)] = a3; red[(kg * 5 + 4) * 64 + (tid & 63)] = a4;
      __syncthreads();
      if (tid < 64) {
        float* mod = (float*)(p.ws + OFF_MOD);
        const float bias = p.ada_b[layer * 3072 + col];
#pragma unroll
        for (int bb = 0; bb < 5; ++bb) {
          float s = bias;
#pragma unroll
          for (int g = 0; g < 8; ++g) s += red[(g * 5 + bb) * 64 + tid];
          mod[(size_t)(layer * 5 + bb) * 3072 + col] = s;
        }
      }
      __syncthreads();
    } else if (u < N_MOD + N_TR) {
    } else {
      const int idx = (u - N_MOD - N_TR) * NT + tid;
      float* ropeA = (float*)(p.ws + OFF_ROPE);
      float* ropeB = ropeA + 2 * 8192 * 32;
      if (idx < 8192 * 32) {
        const int pos = idx >> 5, pr = idx & 31;
        const float pv = pr < 16 ? (float)(pos >> 6) : (float)(pos & 63);
        const float inv = exp2f(-(float)(pr & 15) * (13.287712379549449f / 16.f));
        const float ang = pv * inv;
        ropeA[idx] = cosf(ang); ropeA[8192 * 32 + idx] = sinf(ang);
      } else {
        const int j = idx - 8192 * 32;
        const int pos = j >> 4, pr = j & 15;
        const float pv = pr < 8 ? (float)(pos >> 6) : (float)(pos & 63);
        const float inv = exp2f(-(float)(pr & 7) * (13.287712379549449f / 8.f));
        const float ang = pv * inv;
        ropeB[j] = cosf(ang); ropeB[8192 * 16 + j] = sinf(ang);
      }
    }
  }
  {
    const int G = ogrid();
    int t = obid();
    float v[8], nv[8];
    TJob cur, nxt;
    if (t < N_TR) { cur = tr_job(p, t); tr_load(cur, tid, v); }
    int buf = 0;
    for (; t < N_TR; t += G) {
      const bool more = t + G < N_TR;
      if (more) { nxt = tr_job(p, t + G); tr_load(nxt, tid, nv); }
      float* tile = (float*)(lds + buf * 16640);
#pragma unroll
      for (int i = 0; i < 8; ++i) tile[((tid >> 6) + 8 * i) * 65 + (tid & 63)] = v[i];
      __syncthreads();
      {
        const int nn = tid & 63, k8 = (tid >> 6) * 8;
        int n = cur.tn * 64 + nn;
        if (cur.perm) n = ((n & 64) ? 512 : 0) + (n >> 7) * 64 + (n & 63);
        u32x4 w;
        w.x = pack_bf16(tile[(k8 + 0) * 65 + nn], tile[(k8 + 1) * 65 + nn]); w.y = pack_bf16(tile[(k8 + 2) * 65 + nn], tile[(k8 + 3) * 65 + nn]);
        w.z = pack_bf16(tile[(k8 + 4) * 65 + nn], tile[(k8 + 5) * 65 + nn]); w.w = pack_bf16(tile[(k8 + 6) * 65 + nn], tile[(k8 + 7) * 65 + nn]);
        *(u32x4*)(cur.dst + ((size_t)((n >> 8) * (cur.K >> 6) + cur.tk) << 14) + ((n & 255) << 6) + k8) = w;
      }
      buf ^= 1;
      if (more) {
        cur = nxt;
#pragma unroll
        for (int i = 0; i < 8; ++i) v[i] = nv[i];
      }
    }
    __syncthreads();
  }
}

DI float wave_sum(float v) {
#pragma unroll
  for (int o = 32; o >= 1; o >>= 1) v += __shfl_xor(v, o);
  return v;
}

DI void norm_phase(const Params& p, int layer) {
  const int lane = otid() & 63;
  const int wave = obid() * 8 + (otid() >> 6), nw = ogrid() * 8;
  const float* g = p.norm_g + layer * 1024;
  const float* mod = (const float*)(p.ws + OFF_MOD) + (size_t)layer * 5 * 3072;
  bf16_t* U = (bf16_t*)(p.ws + OFF_UG);
  f32x4 gv[4];
#pragma unroll
  for (int i = 0; i < 4; ++i) gv[i] = *(const f32x4*)(g + lane * 4 + 256 * i);
  f32x4 nv[4];
  if (wave < T_ALL) {
    const float* s0 = h_src(p, layer, wave);
#pragma unroll
    for (int i = 0; i < 4; ++i) nv[i] = *(const f32x4*)(s0 + lane * 4 + 256 * i);
  }
  for (int row = wave; row < T_ALL; row += nw) {
    const int bb = row < T_LAT ? (row >> 13) : 4;
    f32x4 v[4];
#pragma unroll
    for (int i = 0; i < 4; ++i) v[i] = nv[i];
    if (row + nw < T_ALL) {
      const float* s1 = h_src(p, layer, row + nw);
#pragma unroll
      for (int i = 0; i < 4; ++i) nv[i] = *(const f32x4*)(s1 + lane * 4 + 256 * i);
    }
    float ss = 0.f;
#pragma unroll
    for (int i = 0; i < 4; ++i) ss += v[i][0] * v[i][0] + v[i][1] * v[i][1] + v[i][2] * v[i][2] + v[i][3] * v[i][3];
    ss = wave_sum(ss);
    const float rstd = rsqrtf(ss * (1.f / 1024.f) + 1e-6f);
    const float* mrow = mod + bb * 3072;
#pragma unroll
    for (int i = 0; i < 4; ++i) {
      const int cidx = lane * 4 + 256 * i;
      const f32x4 sh = *(const f32x4*)(mrow + cidx), sc = *(const f32x4*)(mrow + 1024 + cidx);
      f32x4 o = (v[i] * rstd) * gv[i] * (sc + 1.f) + sh;
      u32x2 w; w.x = pack_bf16(o[0], o[1]); w.y = pack_bf16(o[2], o[3]);
      *(u32x2*)(U + ablk(row, cidx)) = w;
    }
  }
}

DI void final_phase(const Params& p) {
  const int lane = otid() & 63;
  const int wave = obid() * 8 + (otid() >> 6), nw = ogrid() * 8;
  f32x4 gv[4];
#pragma unroll
  for (int i = 0; i < 4; ++i) gv[i] = *(const f32x4*)(p.final_g + lane * 4 + 256 * i);
  f32x4 nv[4];
  if (wave < T_LAT) {
#pragma unroll
    for (int i = 0; i < 4; ++i) nv[i] = *(const f32x4*)(p.out + (size_t)wave * 1024 + lane * 4 + 256 * i);
  }
  for (int row = wave; row < T_LAT; row += nw) {
    float* src = p.out + (size_t)row * 1024;
    f32x4 v[4];
#pragma unroll
    for (int i = 0; i < 4; ++i) v[i] = nv[i];
    if (row + nw < T_LAT) {
#pragma unroll
      for (int i = 0; i < 4; ++i) nv[i] = *(const f32x4*)(p.out + (size_t)(row + nw) * 1024 + lane * 4 + 256 * i);
    }
    float ss = 0.f;
#pragma unroll
    for (int i = 0; i < 4; ++i) ss += v[i][0] * v[i][0] + v[i][1] * v[i][1] + v[i][2] * v[i][2] + v[i][3] * v[i][3];
    ss = wave_sum(ss);
    const float rstd = rsqrtf(ss * (1.f / 1024.f) + 1e-6f);
#pragma unroll
    for (int i = 0; i < 4; ++i) *(f32x4*)(src + lane * 4 + 256 * i) = (v[i] * rstd) * gv[i];
  }
}

enum { EPI_AB_IN = 0, EPI_QB = 1, EPI_KVB = 2, EPI_C_IN = 3, EPI_OUT = 4 };
constexpr int G_STR = 144;
constexpr int G_OPER = 256 * G_STR;
constexpr int G_STAGE = 2 * G_OPER;
constexpr int OFF_RSTD = 2 * G_STAGE;
constexpr int LDS_BYTES = OFF_RSTD + 1024;

DI void rope2(float& v0, float& v1, float& v2, float& v3, const float* cs, const float* sn) {
  const f32x2 c = *(const f32x2*)cs, s = *(const f32x2*)sn;
  const float a0 = v0 * c.x - v1 * s.x, a1 = v0 * s.x + v1 * c.x, a2 = v2 * c.y - v3 * s.y, a3 = v2 * s.y + v3 * c.y;
  v0 = a0; v1 = a1; v2 = a2; v3 = a3;
}

template <int EPI>
DI void epi_math(const Params& p, int tok, int f0, float& v0, float& v1, float& v2, float& v3, float rs) {
  const float* ropeA = (const float*)(p.ws + OFF_ROPE);
  const float* ropeB = ropeA + 2 * 8192 * 32;
  const bool lat = tok < T_LAT;
  const int pos = tok & 8191;
  if (EPI == EPI_AB_IN) {
    if (f0 < 640) {
      if (lat) { const int p0 = (f0 & 63) >> 1; rope2(v0, v1, v2, v3, ropeA + pos * 32 + p0, ropeA + 8192 * 32 + pos * 32 + p0); }
      if (f0 < 512) { v0 *= QSCALE_A; v1 *= QSCALE_A; v2 *= QSCALE_A; v3 *= QSCALE_A; }
    } else if (f0 >= 1920 && f0 < 1952) {
      if (lat) { const int p0 = (f0 - 1920) >> 1; rope2(v0, v1, v2, v3, ropeB + pos * 16 + p0, ropeB + 8192 * 16 + pos * 16 + p0); }
    }
  } else if (EPI == EPI_QB) {
    const float s = rs * QSCALE_B;
    v0 *= s; v1 *= s; v2 *= s; v3 *= s;
    const int fh = f0 % 96;
    if (fh >= 64 && lat) { const int p0 = (fh - 64) >> 1; rope2(v0, v1, v2, v3, ropeB + pos * 16 + p0, ropeB + 8192 * 16 + pos * 16 + p0); }
  } else if (EPI == EPI_KVB) {
    v0 *= rs; v1 *= rs; v2 *= rs; v3 *= rs;
  } else if (EPI == EPI_C_IN) {
    if (f0 < 1024) { v0 *= QSCALE_A; v1 *= QSCALE_A; v2 *= QSCALE_A; v3 *= QSCALE_A; }
  }
}

template <int EPI>
DI bf16_t* dst_tr(const Params& p, int tok, int col) {
  if (EPI == EPI_AB_IN) return col < 2464 ? (bf16_t*)(p.ws + OFF_P) + (size_t)tok * 2560 + col : nullptr;
  if (EPI == EPI_QB) return (bf16_t*)(p.ws + OFF_QB) + (size_t)tok * 768 + col;
  if (EPI == EPI_KVB) return (bf16_t*)(p.ws + OFF_KB) + (size_t)tok * 512 + col;
  return (bf16_t*)(p.ws + OFF_P) + (size_t)tok * 3072 + (col >= 3072 ? col - 1024 : col);
}
template <int EPI>
DI bf16_t* dst_v(const Params& p, int t0, int col) {
  int b, key; tok_bk(t0, b, key);
  if (EPI == EPI_KVB) return (bf16_t*)(p.ws + OFF_VTB) + ((size_t)(b * 8 + ((col - 512) >> 6)) * 64 + (col & 63)) * NKEY + key;
  return (bf16_t*)(p.ws + OFF_VT) + ((size_t)(b * 16 + ((col - 2048) >> 6)) * 64 + (col & 63)) * NKEY + key;
}

struct TilePf { bool pre; bool has_next; int nm0, nnt; };
template <int EPI, int TM>
DI void gemm_tile(const Params& p, int layer, const bf16_t* __restrict__ A, int lda, const bf16_t* __restrict__ Bt, int K, int m0, int nt, char* lds,
                  u32x4 (&ra)[TM / 64], u32x4 (&rb)[4], const TilePf pf) {
  constexpr int NJ = TM == 256 ? 4 : 2, NI = TM == 256 ? 2 : 1, NA = TM / 64;
  const int tid = otid(), lane = tid & 63, w = tid >> 6;
  const int wm = TM == 256 ? (w >> 2) : 0, wn = TM == 256 ? (w & 3) : w;
  const int fb = TM == 256 ? wn * 64 : wn * 32, tb = TM == 256 ? wm * 128 : 0;
  const int l31 = lane & 31, hh = lane >> 5;
  const int n0 = nt * 256;
  float* rstd = (float*)(lds + OFF_RSTD);
  const int srow = tid >> 3, scc = tid & 7;
  const bool ablocked = (lda == 0);
  const int nkb = K >> 6;
  const bf16_t* ag = ablocked ? A + ((size_t)((m0 >> 8) * 16) << 14) + (m0 & 255) * 64 + tid * 8 : A + (size_t)(m0 + srow) * lda + scc * 8;
  const size_t a_i = ablocked ? 4096 : (size_t)64 * lda, a_k = ablocked ? 16384 : 64;
  const bf16_t* bg = Bt + ((size_t)(nt * nkb) << 14) + tid * 8;

  if (EPI == EPI_QB || EPI == EPI_KVB) {
    __syncthreads();
    if (tid < 2 * TM) {
      const int r = tid >> 1, half = tid & 1;
      const bf16_t* ap = A + (size_t)(m0 + r) * lda + half * (K / 2);
      float ss = 0.f;
      for (int cidx = 0; cidx < K / 2; cidx += 8) {
        const u32x4 v = *(const u32x4*)(ap + cidx);
#pragma unroll
        for (int e = 0; e < 4; ++e) { const float a = bf_lo(v[e]), b2 = bf_hi(v[e]); ss += a * a + b2 * b2; }
      }
      ss += __shfl_xor(ss, 1);
      if (half == 0) rstd[r] = rsqrtf(ss / (float)K + 1e-6f);
    }
  }

  f32x16 acc[NI][NJ];
#pragma unroll
  for (int i = 0; i < NI; ++i)
#pragma unroll
    for (int j = 0; j < NJ; ++j)
#pragma unroll
      for (int r = 0; r < 16; ++r) acc[i][j][r] = 0.f;

  const int nk = K >> 6;
  if (!pf.pre) {
#pragma unroll
    for (int i = 0; i < NA; ++i) ra[i] = *(const u32x4*)(ag + i * a_i);
#pragma unroll
    for (int i = 0; i < 4; ++i) rb[i] = *(const u32x4*)(bg + i * 4096);
  }
#pragma unroll
  for (int i = 0; i < NA; ++i) *(u32x4*)(lds + (srow + 64 * i) * G_STR + scc * 16) = ra[i];
#pragma unroll
  for (int i = 0; i < 4; ++i) *(u32x4*)(lds + G_OPER + (srow + 64 * i) * G_STR + scc * 16) = rb[i];
#pragma unroll
  for (int i = 0; i < NA; ++i) ra[i] = *(const u32x4*)(ag + i * a_i + a_k);
#pragma unroll
  for (int i = 0; i < 4; ++i) rb[i] = *(const u32x4*)(bg + i * 4096 + 16384);
  __syncthreads();
  for (int kt = 0; kt < nk; ++kt) {
    {
      char* st = lds + ((kt + 1) & 1) * G_STAGE;
#pragma unroll
      for (int i = 0; i < NA; ++i) *(u32x4*)(st + (srow + 64 * i) * G_STR + scc * 16) = ra[i];
#pragma unroll
      for (int i = 0; i < 4; ++i) *(u32x4*)(st + G_OPER + (srow + 64 * i) * G_STR + scc * 16) = rb[i];
    }
    if (kt + 2 < nk) {
#pragma unroll
      for (int i = 0; i < NA; ++i) ra[i] = *(const u32x4*)(ag + i * a_i + (size_t)(kt + 2) * a_k);
#pragma unroll
      for (int i = 0; i < 4; ++i) rb[i] = *(const u32x4*)(bg + i * 4096 + ((size_t)(kt + 2) << 14));
    }
    __builtin_amdgcn_sched_barrier(0);
    const char* as = lds + (kt & 1) * G_STAGE;
    const char* fp = as + G_OPER + (fb + l31) * G_STR + hh * 16;
    const char* sp = as + (tb + l31) * G_STR + hh * 16;
#pragma unroll
    for (int ks = 0; ks < 4; ++ks) {
      bf16x8 f[NI], s[NJ];
#pragma unroll
      for (int i = 0; i < NI; ++i) f[i] = *(const bf16x8*)(fp + i * 32 * G_STR + ks * 32);
#pragma unroll
      for (int j = 0; j < NJ; ++j) s[j] = *(const bf16x8*)(sp + j * 32 * G_STR + ks * 32);
#pragma unroll
      for (int j = 0; j < NJ; ++j)
#pragma unroll
        for (int i = 0; i < NI; ++i) acc[i][j] = MFMA32(f[i], s[j], acc[i][j]);
    }
    __syncthreads();
  }

  auto prefetch_next = [&]() {
    if (TM == 256 && pf.has_next) {
      const bf16_t* nag = ablocked ? A + ((size_t)((pf.nm0 >> 8) * 16) << 14) + (pf.nm0 & 255) * 64 + tid * 8 : A + (size_t)(pf.nm0 + srow) * lda + scc * 8;
      const bf16_t* nbg = Bt + ((size_t)(pf.nnt * nkb) << 14) + tid * 8;
#pragma unroll
      for (int i = 0; i < NA; ++i) ra[i] = *(const u32x4*)(nag + i * a_i);
#pragma unroll
      for (int i = 0; i < 4; ++i) rb[i] = *(const u32x4*)(nbg + i * 4096);
      __builtin_amdgcn_sched_barrier(0);
    }
  };
  constexpr int SB = 528;
  constexpr int SV = TM * 2 + 16;
  constexpr int NIT = TM * 32 / NT;
  if (EPI == EPI_OUT) {
    const int bb = m0 < T_LAT ? (m0 >> 13) : 4;
#pragma unroll
    for (int h = 0; h < 2; ++h) {
      if ((TM == 256 ? (wn >> 1) : (wn >> 2)) == h) {
#pragma unroll
        for (int j = 0; j < NJ; ++j)
#pragma unroll
          for (int i = 0; i < NI; ++i)
#pragma unroll
            for (int g = 0; g < 4; ++g) {
              f32x4 v; v[0] = acc[i][j][4 * g]; v[1] = acc[i][j][4 * g + 1]; v[2] = acc[i][j][4 * g + 2]; v[3] = acc[i][j][4 * g + 3];
              *(f32x4*)(lds + (tb + j * 32 + l31) * SB + ((fb & 127) + i * 32 + 8 * g + 4 * hh) * 4) = v;
            }
      }
      if (h == 1) prefetch_next();
      __syncthreads();
      const float* gate = (const float*)(p.ws + OFF_MOD) + (size_t)(layer * 5 + bb) * 3072 + 2048 + n0 + h * 128;
#pragma unroll 4
      for (int it = 0; it < NIT; ++it) {
        const int cidx = tid + NT * it, row = cidx >> 5, ch = cidx & 31;
        const f32x4 y = *(const f32x4*)(lds + row * SB + ch * 16);
        const f32x4 gt = *(const f32x4*)(gate + ch * 4);
        const f32x4 old = *(const f32x4*)(h_src(p, layer, m0 + row) + n0 + h * 128 + ch * 4);
        *(f32x4*)(h_dst(p, m0 + row) + n0 + h * 128 + ch * 4) = old + gt * y;
      }
      __syncthreads();
    }
  } else {
    const bool vt = (EPI == EPI_KVB && nt >= 2) || (EPI == EPI_C_IN && nt >= 8 && nt < 12);
#pragma unroll
    for (int j = 0; j < NJ; ++j) {
      const int rl = tb + j * 32 + l31;
      float rs = 1.f;
      if (EPI == EPI_QB || EPI == EPI_KVB) rs = rstd[rl];
#pragma unroll
      for (int i = 0; i < NI; ++i)
#pragma unroll
        for (int g = 0; g < 4; ++g) {
          const int fl = fb + i * 32 + 8 * g + 4 * hh;
          float v0 = acc[i][j][4 * g], v1 = acc[i][j][4 * g + 1], v2 = acc[i][j][4 * g + 2], v3 = acc[i][j][4 * g + 3];
          epi_math<EPI>(p, m0 + rl, n0 + fl, v0, v1, v2, v3, rs);
          const unsigned w01 = pack_bf16(v0, v1), w23 = pack_bf16(v2, v3);
          if (!vt) {
            u32x2 wv; wv.x = w01; wv.y = w23;
            *(u32x2*)(lds + rl * SB + fl * 2) = wv;
          } else {
            *(bf16_t*)(lds + (fl + 0) * SV + rl * 2) = (bf16_t)(w01 & 0xffffu);
            *(bf16_t*)(lds + (fl + 1) * SV + rl * 2) = (bf16_t)(w01 >> 16);
            *(bf16_t*)(lds + (fl + 2) * SV + rl * 2) = (bf16_t)(w23 & 0xffffu);
            *(bf16_t*)(lds + (fl + 3) * SV + rl * 2) = (bf16_t)(w23 >> 16);
          }
        }
    }
    prefetch_next();
    __syncthreads();
#pragma unroll 4
    for (int it = 0; it < NIT; ++it) {
      const int cidx = tid + NT * it;
      if (vt) {
        const int row = cidx / (TM / 8), ch = cidx % (TM / 8);
        *(u32x4*)dst_v<EPI>(p, m0 + ch * 8, n0 + row) = *(const u32x4*)(lds + row * SV + ch * 16);
      } else {
        const int row = cidx >> 5, ch = cidx & 31;
        bf16_t* d = dst_tr<EPI>(p, m0 + row, n0 + ch * 8);
        if (d) *(u32x4*)d = *(const u32x4*)(lds + row * SB + ch * 16);
      }
    }
    __syncthreads();
  }
}

template <int EPI>
DI void gemm_phase(const Params& p, int layer, const bf16_t* A, int lda, const bf16_t* Bt, int K, int mtiles, int ntiles, bool ctx, bool reverse, char* lds) {
  const int G = ogrid();
  const int bid = reverse ? (G - 1 - obid()) : obid();
  u32x4 ra[4], rb[4];
  const bool simple = (G & 7) != 0;
  const int xcd = bid & 7, local = simple ? bid : (bid >> 3), nlocal = simple ? G : (G >> 3);
  const int mlo = simple ? 0 : ((xcd * mtiles) >> 3), cnt = simple ? mtiles : ((((xcd + 1) * mtiles) >> 3) - mlo);
  const int total = cnt * ntiles, gsize = 4 * ntiles;
  auto tile_of = [&](int j, int& m0, int& nt) {
    const int g = j / gsize, r = j - g * gsize;
    int gm = cnt - g * 4; gm = gm > 4 ? 4 : gm;
    m0 = (mlo + g * 4 + (r % gm)) * 256; nt = r / gm;
  };
  bool pre = false;
  for (int j = local; j < total; j += nlocal) {
    int m0, nt; tile_of(j, m0, nt);
    TilePf pf; pf.pre = pre; pf.has_next = (j + nlocal < total); pf.nm0 = 0; pf.nnt = 0;
    if (pf.has_next) tile_of(j + nlocal, pf.nm0, pf.nnt);
    gemm_tile<EPI, 256>(p, layer, A, lda, Bt, K, m0, nt, lds, ra, rb, pf);
    pre = pf.has_next;
  }
  if (ctx) {
    const int b2 = G - 1 - bid;
    u32x4 ra1[1];
    TilePf pf; pf.pre = false; pf.has_next = false; pf.nm0 = 0; pf.nnt = 0;
    for (int u = b2; u < 16 * ntiles; u += G) gemm_tile<EPI, 64>(p, layer, A, lda, Bt, K, T_LAT + (u & 15) * 64, u >> 4, lds, ra1, rb, pf);
  }
}

DI void vta_phase(const Params& p, char* lds) {
  const int tid = otid();
  const bf16_t* Pb = (const bf16_t*)(p.ws + OFF_P);
  for (int u = ogrid() - 1 - obid(); u < T_ALL / 64; u += ogrid()) {
    const int t0 = u * 64;
#pragma unroll
    for (int it = 0; it < 2; ++it) {
      const int cidx = tid + NT * it, row = cidx >> 4, ch = cidx & 15;
      *(u32x4*)(lds + row * 272 + ch * 16) = *(const u32x4*)(Pb + (size_t)(t0 + row) * 2560 + 640 + ch * 8);
    }
    __syncthreads();
    int b, key; tok_bk(t0, b, key);
#pragma unroll
    for (int it = 0; it < 2; ++it) {
      const int cidx = tid + NT * it, f = cidx & 127, tc = cidx >> 7;
      unsigned short e[8];
#pragma unroll
      for (int k = 0; k < 8; ++k) e[k] = *(const bf16_t*)(lds + (tc * 8 + k) * 272 + f * 2);
      u32x4 v; v.x = e[0] | ((unsigned)e[1] << 16); v.y = e[2] | ((unsigned)e[3] << 16); v.z = e[4] | ((unsigned)e[5] << 16); v.w = e[6] | ((unsigned)e[7] << 16);
      *(u32x4*)((bf16_t*)(p.ws + OFF_VT) + ((size_t)(b * 2 + (f >> 6)) * 64 + (f & 63)) * NKEY + key + tc * 8) = v;
    }
    __syncthreads();
  }
}

template <int MODE>
DI void attn_item(const Params& p, int layer, int b, int qt, int head, bool is_ctx, char* lds) {
  constexpr int DK = (MODE == 1) ? 96 : 64;
  constexpr int NKS = DK / 16;
  constexpr int KSTR = DK * 2 + 16;
  constexpr int VSTR = 144;
  constexpr int KBYTES = 64 * KSTR;
  constexpr int STAGE = KBYTES + 64 * VSTR;
  constexpr int QPB = 256;
  constexpr int NKC = DK / 8;
  constexpr int KCH = 64 * NKC;
  constexpr int OSTR = 272;
  constexpr float MASKV = -1e30f;
  float* rpbs = (float*)(lds + 4 * STAGE);
  char* ostage = lds;

  const int tid = otid(), lane = tid & 63, w = tid >> 6, l31 = lane & 31, hh = lane >> 5;
  const int i2 = layer >> 1;
  const bf16_t* Pb = (const bf16_t*)(p.ws + OFF_P);
  bf16_t* UG = (bf16_t*)(p.ws + OFF_UG);
  const bf16_t *Qp, *Kp, *Krp = nullptr, *Zp, *Vt;
  int ldq, ldk, ldz, gcol;
  if (MODE == 0) {
    Qp = Pb + head * 64; ldq = 2560; Kp = Pb + 512 + (head >> 2) * 64; ldk = 2560;
    Vt = (const bf16_t*)(p.ws + OFF_VT) + (size_t)(b * 2 + (head >> 2)) * 64 * NKEY;
    Zp = Pb + 768 + head * 64; ldz = 2560; gcol = head * 64;
  } else if (MODE == 1) {
    Qp = (const bf16_t*)(p.ws + OFF_QB) + head * 96; ldq = 768; Kp = (const bf16_t*)(p.ws + OFF_KB) + head * 64; ldk = 512; Krp = Pb + 1920;
    Vt = (const bf16_t*)(p.ws + OFF_VTB) + (size_t)(b * 8 + head) * 64 * NKEY;
    Zp = Pb + 1952 + head * 64; ldz = 2560; gcol = 512 + head * 64;
  } else {
    Qp = Pb + head * 64; ldq = 3072; Kp = Pb + 1024 + head * 64; ldk = 3072;
    Vt = (const bf16_t*)(p.ws + OFF_VT) + (size_t)(b * 16 + head) * 64 * NKEY;
    Zp = Pb + 2048 + head * 64; ldz = 3072; gcol = head * 64;
  }
  const int qtok0 = is_ctx ? T_LAT + b * 256 : b * 8192 + qt * QPB;

  int lat_lo = 0, nlat = 0;
  if (!is_ctx) {
    if (MODE == 0) {
      int lo = 4 * qt - 2; if (lo < 0) lo = 0;
      int hi = 4 * qt + 5; if (hi > 127) hi = 127;
      lat_lo = lo; nlat = hi - lo + 1;
    } else if (MODE == 1) { lat_lo = 0; nlat = 128; }
    else {
      int lo = 4 * qt - 4; lo = lo < 0 ? 0 : (lo > 120 ? 120 : lo);
      int hi = 4 * qt + 3 - 4; hi = hi < 0 ? 0 : (hi > 120 ? 120 : hi); hi += 7;
      lat_lo = lo; nlat = hi - lo + 1;
    }
  }
  const int ntiles = nlat + 4;

  const bool nat2 = (MODE == 2) && !is_ctx;
  auto tokmap = [&](int row) { return nat2 ? qtok0 + ((w >> 2) * 2 + (row >> 4)) * 64 + (w & 3) * 16 + (row & 15) : qtok0 + w * 32 + row; };
  const int qtok = tokmap(l31);
  bf16x8 qf[NKS];
#pragma unroll
  for (int ks = 0; ks < NKS; ++ks) qf[ks] = *(const bf16x8*)(Qp + (size_t)qtok * ldq + ks * 16 + hh * 8);
  if (MODE == 2 && !is_ctx) {
    for (int i = tid; i < 465; i += NT) rpbs[i] = p.c_rpb[(size_t)(i2 * 16 + head) * 465 + i] * LOG2E;
  }
  float m_ = (MODE == 0) ? p.a_sink[i2 * 8 + head] * LOG2E : MASKV;
  float l_ = (MODE == 0 && hh == 0) ? 1.f : 0.f;
  f32x16 O[2];
#pragma unroll
  for (int dh = 0; dh < 2; ++dh)
#pragma unroll
    for (int r = 0; r < 16; ++r) O[dh][r] = 0.f;

  const int k0row = tid / NKC, k0cc = tid % NKC;
  const int k1row = (tid + NT) / NKC, k1cc = (tid + NT) % NKC;
  const bool k1 = (KCH > NT) && (tid + NT < KCH);
  struct Stg { u32x4 k0, k1, v; };
  Stg R0, R1;
  R0.k1 = (u32x4){0u, 0u, 0u, 0u}; R1.k1 = R0.k1;
  auto tile_kt = [&](int i) { return i < nlat ? lat_lo + i : 128 + (i - nlat); };
  auto kload = [&](int krow0, int row, int cc) -> u32x4 {
    if (MODE == 1 && cc >= 8) return *(const u32x4*)(Krp + (size_t)(krow0 + row) * 2560 + (cc - 8) * 8);
    return *(const u32x4*)(Kp + (size_t)(krow0 + row) * ldk + cc * 8);
  };
  auto gload = [&](int i, Stg& r) {
    const int kt = tile_kt(i < ntiles ? i : ntiles - 1);
    const int krow0 = kt < 128 ? b * 8192 + kt * 64 : T_LAT + b * 256 + (kt - 128) * 64;
    r.k0 = kload(krow0, k0row, k0cc);
    if (k1) r.k1 = kload(krow0, k1row, k1cc);
    r.v = *(const u32x4*)(Vt + (size_t)(tid >> 3) * NKEY + kt * 64 + (tid & 7) * 8);
  };
  auto lstore = [&](int st, const Stg& r) {
    char* kb = lds + st * STAGE;
    *(u32x4*)(kb + k0row * KSTR + k0cc * 16) = r.k0;
    if (k1) *(u32x4*)(kb + k1row * KSTR + k1cc * 16) = r.k1;
    *(u32x4*)(kb + KBYTES + (tid >> 3) * VSTR + (tid & 7) * 16) = r.v;
  };

  const int pr = (l31 & ~12) | ((l31 & 4) << 1) | ((l31 & 8) >> 1);
  int qr = 0, qc = 0, rs0 = 0, cs = 0, csw = 0, wlo = 0, whi = 0;
  if (MODE == 2) {
    qr = qt * 4 + (w >> 2) * 2 + (l31 >> 4); qc = (w & 3) * 16 + (l31 & 15);
    rs0 = qr - 4; rs0 = rs0 < 0 ? 0 : (rs0 > 120 ? 120 : rs0);
    cs = qc - 8; cs = cs < 0 ? 0 : (cs > 48 ? 48 : cs);
    csw = (w & 3) * 16 - 8; csw = csw < 0 ? 0 : (csw > 32 ? 32 : csw);
    const int r_lo = qt * 4 + (w >> 2) * 2;
    wlo = r_lo - 4; wlo = wlo < 0 ? 0 : (wlo > 120 ? 120 : wlo);
    whi = r_lo + 1 - 4; whi = whi < 0 ? 0 : (whi > 120 ? 120 : whi); whi += 7;
  }
  const int s0w = qt * QPB + w * 32;
  const int nsup = (ntiles + 1) >> 1;
  __syncthreads();
  gload(0, R0); gload(1, R1);
  lstore(0, R0); lstore(1, R1);
  gload(2, R0); gload(3, R1);
  __syncthreads();
  auto body = [&](int it, const char* kb) {
    const char* vb = kb + KBYTES;
    const int kt = tile_kt(it);
    const bool lat_tile = it < nlat;
    bool skip = (it >= ntiles);
    if (MODE == 2 && lat_tile) skip = (kt < wlo) || (kt > whi);
    if (MODE == 0 && lat_tile) skip = (kt * 64 + 63 < s0w - 128) || (kt * 64 > s0w + 31 + 128);
    const int nsub = (MODE == 2 && lat_tile) ? 1 : 2;
    const int krb = (MODE == 2 && lat_tile) ? csw : 0;
    if (!skip) {
      f32x16 S[2];
#pragma unroll
      for (int t = 0; t < 2; ++t)
#pragma unroll
        for (int r = 0; r < 16; ++r) S[t][r] = 0.f;
#pragma unroll
      for (int ks = 0; ks < NKS; ++ks) {
        const bf16x8 a0 = *(const bf16x8*)(kb + (krb + pr) * KSTR + ks * 32 + hh * 16);
        S[0] = MFMA32(a0, qf[ks], S[0]);
        if (nsub == 2) {
          const bf16x8 a1 = *(const bf16x8*)(kb + (32 + pr) * KSTR + ks * 32 + hh * 16);
          S[1] = MFMA32(a1, qf[ks], S[1]);
        }
      }
      if (MODE == 0 && lat_tile) {
        const int s = qt * QPB + w * 32 + l31;
#pragma unroll
        for (int t = 0; t < 2; ++t)
#pragma unroll
          for (int r = 0; r < 16; ++r) {
            const int kk = kt * 64 + t * 32 + 16 * (r >> 3) + 8 * hh + (r & 7);
            const int d = kk - s;
            if (d > 128 || d < -128) S[t][r] = MASKV;
          }
      }
      if (MODE == 2 && lat_tile) {
        int ri = kt - qr + 7; ri = ri < 0 ? 0 : (ri > 14 ? 14 : ri);
        const float* brow = rpbs + ri * 31;
        const bool rok = (kt >= rs0) && (kt <= rs0 + 7);
        float bv[16];
#pragma unroll
        for (int r = 0; r < 16; ++r) {
          const int kc = csw + 16 * (r >> 3) + 8 * hh + (r & 7);
          int bi = kc - qc + 15; bi = bi < 0 ? 0 : (bi > 30 ? 30 : bi);
          bv[r] = brow[bi];
        }
#pragma unroll
        for (int r = 0; r < 16; ++r) asm volatile("" : "+v"(bv[r]));
#pragma unroll
        for (int r = 0; r < 16; ++r) {
          const int kc = csw + 16 * (r >> 3) + 8 * hh + (r & 7);
          const bool ok = rok && (kc >= cs) && (kc < cs + 16);
          S[0][r] = ok ? S[0][r] + bv[r] : MASKV;
        }
      }
      float mx = S[0][0];
#pragma unroll
      for (int r = 0; r < 16; ++r) mx = fmaxf(mx, S[0][r]);
      if (nsub == 2) {
#pragma unroll
        for (int r = 0; r < 16; ++r) mx = fmaxf(mx, S[1][r]);
      }
      mx = fmaxf(mx, __shfl_xor(mx, 32));
      if (__any(mx > m_ + 8.f)) {
        const float mnew = fmaxf(m_, mx);
        const float alpha = fexp2(m_ - mnew);
        m_ = mnew;
        l_ *= alpha;
#pragma unroll
        for (int dh = 0; dh < 2; ++dh)
#pragma unroll
          for (int r = 0; r < 16; ++r) O[dh][r] *= alpha;
      }
      float rsum = 0.f;
#pragma unroll
      for (int t = 0; t < 2; ++t)
        if (t < nsub) {
#pragma unroll
          for (int r = 0; r < 16; ++r) { const float e = fexp2(S[t][r] - m_); S[t][r] = e; rsum += e; }
        }
      l_ += rsum;
#pragma unroll
      for (int t = 0; t < 2; ++t)
       if (t < nsub)
#pragma unroll
        for (int s = 0; s < 2; ++s) {
          u32x4 u;
          u.x = pack_bf16(S[t][8 * s + 0], S[t][8 * s + 1]); u.y = pack_bf16(S[t][8 * s + 2], S[t][8 * s + 3]);
          u.z = pack_bf16(S[t][8 * s + 4], S[t][8 * s + 5]); u.w = pack_bf16(S[t][8 * s + 6], S[t][8 * s + 7]);
          const bf16x8 pf = __builtin_bit_cast(bf16x8, u);
#pragma unroll
          for (int dh = 0; dh < 2; ++dh) {
            const bf16x8 v = *(const bf16x8*)(vb + (dh * 32 + l31) * VSTR + (krb + t * 32 + s * 16 + hh * 8) * 2);
            O[dh] = MFMA32(v, pf, O[dh]);
          }
        }
    }
  };
  for (int j = 0; j < nsup; ++j) {
    const char* sb = lds + (j & 1) * 2 * STAGE;
    body(2 * j, sb);
    body(2 * j + 1, sb + STAGE);
    __builtin_amdgcn_sched_barrier(0);
    {
      const int so = ((j + 1) & 1) * 2;
      lstore(so, R0); lstore(so + 1, R1);
      gload(2 * j + 4, R0); gload(2 * j + 5, R1);
    }
    __syncthreads();
  }

  {
    const float lt = l_ + __shfl_xor(l_, 32);
    const float inv = 1.f / lt;
    char* orow = ostage + (w * 32) * OSTR;
#pragma unroll
    for (int dh = 0; dh < 2; ++dh)
#pragma unroll
      for (int g = 0; g < 4; ++g) {
        f32x4 v; v[0] = O[dh][4 * g] * inv; v[1] = O[dh][4 * g + 1] * inv; v[2] = O[dh][4 * g + 2] * inv; v[3] = O[dh][4 * g + 3] * inv;
        *(f32x4*)(orow + l31 * OSTR + (dh * 32 + 8 * g + 4 * hh) * 4) = v;
      }
    __builtin_amdgcn_s_waitcnt(0xc07f);
#pragma unroll
    for (int it = 0; it < 4; ++it) {
      const int cidx = lane + 64 * it, row = cidx >> 3, ch = cidx & 7;
      const f32x4 o0 = *(const f32x4*)(orow + row * OSTR + ch * 32), o1 = *(const f32x4*)(orow + row * OSTR + ch * 32 + 16);
      const int tok = tokmap(row);
      const u32x4 z = *(const u32x4*)(Zp + (size_t)tok * ldz + ch * 8);
      u32x4 wv;
      wv.x = pack_bf16(o0[0] * silu(bf_lo(z.x)), o0[1] * silu(bf_hi(z.x)));
      wv.y = pack_bf16(o0[2] * silu(bf_lo(z.y)), o0[3] * silu(bf_hi(z.y)));
      wv.z = pack_bf16(o1[0] * silu(bf_lo(z.z)), o1[1] * silu(bf_hi(z.z)));
      wv.w = pack_bf16(o1[2] * silu(bf_lo(z.w)), o1[3] * silu(bf_hi(z.w)));
      *(u32x4*)(UG + ablk(tok, gcol + ch * 8)) = wv;
    }
  }
}

DI void mla_item2(const Params& p, int layer, int b, int qt, int head, char* lds) {
  constexpr int DK = 96, NKS = 6, KSTR = DK * 2 + 16, VSTR = 144, KBYTES = 64 * KSTR, STAGE = KBYTES + 64 * VSTR;
  constexpr int NKC = 12, KCH = 64 * NKC, OSTR = 272, QG = 2, NTILES = 132;
  constexpr float MASKV = -1e30f;
  char* ostage = lds;
  const int tid = otid(), lane = tid & 63, w = tid >> 6, l31 = lane & 31, hh = lane >> 5;
  const bf16_t* Pb = (const bf16_t*)(p.ws + OFF_P);
  bf16_t* UG = (bf16_t*)(p.ws + OFF_UG);
  const bf16_t* Qp = (const bf16_t*)(p.ws + OFF_QB) + head * 96;
  const bf16_t* Kp = (const bf16_t*)(p.ws + OFF_KB) + head * 64;
  const bf16_t* Krp = Pb + 1920;
  const bf16_t* Vt = (const bf16_t*)(p.ws + OFF_VTB) + (size_t)(b * 8 + head) * 64 * NKEY;
  const bf16_t* Zp = Pb + 1952 + head * 64;
  const int gcol = 512 + head * 64;
  const int qtok0 = b * 8192 + qt * 512;
  bf16x8 qf[QG][NKS];
#pragma unroll
  for (int qg = 0; qg < QG; ++qg)
#pragma unroll
    for (int ks = 0; ks < NKS; ++ks) qf[qg][ks] = *(const bf16x8*)(Qp + (size_t)(qtok0 + qg * 256 + w * 32 + l31) * 768 + ks * 16 + hh * 8);
  float m_[QG], l_[QG];
  f32x16 O[QG][2];
#pragma unroll
  for (int qg = 0; qg < QG; ++qg) {
    m_[qg] = MASKV; l_[qg] = 0.f;
#pragma unroll
    for (int dh = 0; dh < 2; ++dh)
#pragma unroll
      for (int r = 0; r < 16; ++r) O[qg][dh][r] = 0.f;
  }
  const int k0row = tid / NKC, k0cc = tid % NKC;
  const int k1row = (tid + NT) / NKC, k1cc = (tid + NT) % NKC;
  const bool k1 = (tid + NT < KCH);
  struct Stg { u32x4 k0, k1, v; };
  Stg R0;
  R0.k1 = (u32x4){0u, 0u, 0u, 0u};
  auto kload = [&](int krow0, int row, int cc) -> u32x4 {
    if (cc >= 8) return *(const u32x4*)(Krp + (size_t)(krow0 + row) * 2560 + (cc - 8) * 8);
    return *(const u32x4*)(Kp + (size_t)(krow0 + row) * 512 + cc * 8);
  };
  auto gload = [&](int i, Stg& r) {
    const int kt = i < NTILES ? i : NTILES - 1;
    const int krow0 = kt < 128 ? b * 8192 + kt * 64 : T_LAT + b * 256 + (kt - 128) * 64;
    r.k0 = kload(krow0, k0row, k0cc);
    if (k1) r.k1 = kload(krow0, k1row, k1cc);
    r.v = *(const u32x4*)(Vt + (size_t)(tid >> 3) * NKEY + kt * 64 + (tid & 7) * 8);
  };
  auto lstore = [&](int st, const Stg& r) {
    char* kb = lds + st * STAGE;
    *(u32x4*)(kb + k0row * KSTR + k0cc * 16) = r.k0;
    if (k1) *(u32x4*)(kb + k1row * KSTR + k1cc * 16) = r.k1;
    *(u32x4*)(kb + KBYTES + (tid >> 3) * VSTR + (tid & 7) * 16) = r.v;
  };
  const int pr = (l31 & ~12) | ((l31 & 4) << 1) | ((l31 & 8) >> 1);
  __syncthreads();
  gload(0, R0); lstore(0, R0);
  gload(1, R0);
  __syncthreads();
  auto body = [&](const char* kb) {
    const char* vb = kb + KBYTES;
    f32x16 S[QG][2];
#pragma unroll
    for (int qg = 0; qg < QG; ++qg)
#pragma unroll
      for (int t = 0; t < 2; ++t)
#pragma unroll
        for (int r = 0; r < 16; ++r) S[qg][t][r] = 0.f;
#pragma unroll
    for (int ks = 0; ks < NKS; ++ks) {
      const bf16x8 a0 = *(const bf16x8*)(kb + pr * KSTR + ks * 32 + hh * 16);
      const bf16x8 a1 = *(const bf16x8*)(kb + (32 + pr) * KSTR + ks * 32 + hh * 16);
#pragma unroll
      for (int qg = 0; qg < QG; ++qg) { S[qg][0] = MFMA32(a0, qf[qg][ks], S[qg][0]); S[qg][1] = MFMA32(a1, qf[qg][ks], S[qg][1]); }
    }
#pragma unroll
    for (int qg = 0; qg < QG; ++qg) {
      float mx = S[qg][0][0];
#pragma unroll
      for (int t = 0; t < 2; ++t)
#pragma unroll
        for (int r = 0; r < 16; ++r) mx = fmaxf(mx, S[qg][t][r]);
      mx = fmaxf(mx, __shfl_xor(mx, 32));
      if (__any(mx > m_[qg] + 8.f)) {
        const float mnew = fmaxf(m_[qg], mx);
        const float alpha = fexp2(m_[qg] - mnew);
        m_[qg] = mnew;
        l_[qg] *= alpha;
#pragma unroll
        for (int dh = 0; dh < 2; ++dh)
#pragma unroll
          for (int r = 0; r < 16; ++r) O[qg][dh][r] *= alpha;
      }
      float rsum = 0.f;
#pragma unroll
      for (int t = 0; t < 2; ++t)
#pragma unroll
        for (int r = 0; r < 16; ++r) { const float e = fexp2(S[qg][t][r] - m_[qg]); S[qg][t][r] = e; rsum += e; }
      l_[qg] += rsum;
    }
#pragma unroll
    for (int t = 0; t < 2; ++t)
#pragma unroll
      for (int s = 0; s < 2; ++s) {
        bf16x8 pf[QG];
#pragma unroll
        for (int qg = 0; qg < QG; ++qg) {
          u32x4 u;
          u.x = pack_bf16(S[qg][t][8 * s + 0], S[qg][t][8 * s + 1]); u.y = pack_bf16(S[qg][t][8 * s + 2], S[qg][t][8 * s + 3]);
          u.z = pack_bf16(S[qg][t][8 * s + 4], S[qg][t][8 * s + 5]); u.w = pack_bf16(S[qg][t][8 * s + 6], S[qg][t][8 * s + 7]);
          pf[qg] = __builtin_bit_cast(bf16x8, u);
        }
#pragma unroll
        for (int dh = 0; dh < 2; ++dh) {
          const bf16x8 v = *(const bf16x8*)(vb + (dh * 32 + l31) * VSTR + (t * 32 + s * 16 + hh * 8) * 2);
#pragma unroll
          for (int qg = 0; qg < QG; ++qg) O[qg][dh] = MFMA32(v, pf[qg], O[qg][dh]);
        }
      }
  };
  if (w >= 4) __builtin_amdgcn_s_setprio(2);
  for (int j = 0; j < NTILES; ++j) {
    body(lds + (j & 1) * STAGE);
    __builtin_amdgcn_sched_barrier(0);
    lstore((j + 1) & 1, R0);
    gload(j + 2, R0);
    __syncthreads();
  }
  __builtin_amdgcn_s_setprio(0);
#pragma unroll
  for (int qg = 0; qg < QG; ++qg) {
    const float lt = l_[qg] + __shfl_xor(l_[qg], 32);
    const float inv = 1.f / lt;
    char* orow = ostage + (w * 32) * OSTR;
#pragma unroll
    for (int dh = 0; dh < 2; ++dh)
#pragma unroll
      for (int g = 0; g < 4; ++g) {
        f32x4 v; v[0] = O[qg][dh][4 * g] * inv; v[1] = O[qg][dh][4 * g + 1] * inv; v[2] = O[qg][dh][4 * g + 2] * inv; v[3] = O[qg][dh][4 * g + 3] * inv;
        *(f32x4*)(orow + l31 * OSTR + (dh * 32 + 8 * g + 4 * hh) * 4) = v;
      }
    __builtin_amdgcn_s_waitcnt(0xc07f);
#pragma unroll
    for (int it = 0; it < 4; ++it) {
      const int cidx = lane + 64 * it, row = cidx >> 3, ch = cidx & 7;
      const f32x4 o0 = *(const f32x4*)(orow + row * OSTR + ch * 32), o1 = *(const f32x4*)(orow + row * OSTR + ch * 32 + 16);
      const int tok = qtok0 + qg * 256 + w * 32 + row;
      const u32x4 z = *(const u32x4*)(Zp + (size_t)tok * 2560 + ch * 8);
      u32x4 wv;
      wv.x = pack_bf16(o0[0] * silu(bf_lo(z.x)), o0[1] * silu(bf_hi(z.x)));
      wv.y = pack_bf16(o0[2] * silu(bf_lo(z.y)), o0[3] * silu(bf_hi(z.y)));
      wv.z = pack_bf16(o1[0] * silu(bf_lo(z.z)), o1[1] * silu(bf_hi(z.z)));
      wv.w = pack_bf16(o1[2] * silu(bf_lo(z.w)), o1[3] * silu(bf_hi(z.w)));
      *(u32x4*)(UG + ablk(tok, gcol + ch * 8)) = wv;
    }
    __builtin_amdgcn_s_waitcnt(0xc07f);
  }
}

DI void attn_phase_ab(const Params& p, int layer, char* lds) {
  const int G = ogrid();
  for (int v = obid(); v < 512; v += G) {
    const int xcd = v & 7, s = v >> 3;
    const int grp = (s >> 4) * 8 + xcd, qt = s & 15;
    mla_item2(p, layer, grp >> 3, qt, grp & 7, lds);
  }
  for (int v = obid(); v < 32; v += G) attn_item<1>(p, layer, v >> 3, 0, v & 7, true, lds);
  for (int v = obid(); v < 1024 + 32; v += G) {
    if (v < 1024) attn_item<0>(p, layer, v >> 8, v & 31, (v >> 5) & 7, false, lds);
    else { const int c = v - 1024; attn_item<0>(p, layer, c >> 3, 0, c & 7, true, lds); }
  }
}

DI void attn_phase_c(const Params& p, int layer, char* lds) {
  const int G = ogrid();
  const int nctx = (layer == 3) ? 0 : 64;
  for (int v = obid(); v < 2048 + nctx; v += G) {
    if (v < 2048) attn_item<2>(p, layer, v >> 9, v & 31, (v >> 5) & 15, false, lds);
    else { const int c = v - 2048; attn_item<2>(p, layer, c >> 4, 0, c & 15, true, lds); }
  }
}

__global__ void __launch_bounds__(512, 2) fwd_megakernel(Params p) {
  __shared__ __attribute__((aligned(16))) char lds[LDS_BYTES];
  __shared__ uint4 xb_words;
  if (threadIdx.x == 0) xb_words = make_uint4(0u, 0u, 0u, 0u);
  __syncthreads();
  if (obid() == 0) { unsigned* bw = (unsigned*)(p.ws + OFF_BAR); for (int i = otid(); i < 4096; i += NT) bw[i] = 0u; }
  XcdBarrier xb; xb.bar = (unsigned*)(p.ws + OFF_BAR); xb.x = 0; xb.st = (volatile LAS unsigned*)&xb_words;
  bool first = true, posted = false;
  for (int ph = p.ph_begin; ph < p.ph_end; ++ph) {
    const int layer = (ph - 1) / 5, s = (ph - 1) % 5;
    const bool even = (layer & 1) == 0;
    const int i2 = layer >> 1;
    if (ph >= 1 && ph <= 20 && s == 2 && !even) continue;
    if (!first) {
      if (!posted) { cg::this_grid().sync(); xb = xcd_barrier_post((unsigned*)(p.ws + OFF_BAR), (volatile LAS unsigned*)&xb_words); posted = true; }
      else xcd_barrier(xb);
    }
    first = false;
    if (ph == 0) prologue_phase(p, lds);
    else if (ph == 21) final_phase(p);
    else if (s == 0) norm_phase(p, layer);
    else if (s == 1) {
      const bf16_t* U = (const bf16_t*)(p.ws + OFF_UG);
      if (even) gemm_phase<EPI_AB_IN>(p, layer, U, 0, (const bf16_t*)(p.ws + OFF_W_IN) + (size_t)i2 * 2560 * 1024, 1024, 128, 10, true, false, lds);
      else gemm_phase<EPI_C_IN>(p, layer, U, 0, (const bf16_t*)(p.ws + OFF_W_CIN) + (size_t)i2 * 4096 * 1024, 1024, 128, 16, true, false, lds);
    } else if (s == 2) {
      const bf16_t* Pb = (const bf16_t*)(p.ws + OFF_P);
      gemm_phase<EPI_QB>(p, layer, Pb + 1280, 2560, (const bf16_t*)(p.ws + OFF_W_UQ) + (size_t)i2 * 768 * 384, 384, 128, 3, true, false, lds);
      gemm_phase<EPI_KVB>(p, layer, Pb + 1664, 2560, (const bf16_t*)(p.ws + OFF_W_UKV) + (size_t)i2 * 1024 * 256, 256, 128, 4, true, true, lds);
      vta_phase(p, lds);
    } else if (s == 3) {
      if (even) attn_phase_ab(p, layer, lds); else attn_phase_c(p, layer, lds);
    } else {
      const bf16_t* Gm = (const bf16_t*)(p.ws + OFF_UG);
      const bf16_t* W = even ? (const bf16_t*)(p.ws + OFF_W_OUT) + (size_t)i2 * 1024 * 1024 : (const bf16_t*)(p.ws + OFF_W_COUT) + (size_t)i2 * 1024 * 1024;
      gemm_phase<EPI_OUT>(p, layer, Gm, 0, W, 1024, 128, 4, layer != 3, false, lds);
    }
  }
}

extern "C" void kernel_launch(void* const* d_in, const int* in_sizes, int n_in, void* d_out, int out_size, void* d_ws, size_t ws_size,
                              hipStream_t stream) {
  static int grid_blocks = 0;
  if (!grid_blocks) {
    int dev = 0, cus = 0, per_cu = 0;
    hipGetDevice(&dev);
    hipDeviceGetAttribute(&cus, hipDeviceAttributeMultiprocessorCount, dev);
    hipOccupancyMaxActiveBlocksPerMultiprocessor(&per_cu, fwd_megakernel, NT, 0);
    per_cu = 1;
    grid_blocks = cus * per_cu;
    if (ws_size < OFF_END) fprintf(stderr, "kernel_launch: workspace too small: %zu < %zu\n", ws_size, (size_t)OFF_END);
  }
  Params p{};
  const float** f = (const float**)&p;
  for (int i = 0; i < 18; ++i) f[i] = (const float*)d_in[i];
  p.out = (float*)d_out;
  p.ws = (char*)d_ws;
#if MK_MULTI_LAUNCH
  for (int ph = 0; ph < 22; ++ph) {
    if (ph >= 1 && ph <= 20 && ((ph - 1) % 5) == 2 && (((ph - 1) / 5) & 1)) continue;
    p.ph_begin = ph; p.ph_end = ph + 1;
    hipLaunchKernelGGL(fwd_megakernel, dim3(grid_blocks), dim3(NT), 0, stream, p);
  }
#else
  p.ph_begin = 0; p.ph_end = 22;
  void* args[] = {&p};
  hipError_t e = hipLaunchCooperativeKernel((void*)fwd_megakernel, dim3(grid_blocks), dim3(NT), args, 0, stream);
  if (e != hipSuccess) fprintf(stderr, "cooperative launch failed: %s (grid %d)\n", hipGetErrorString(e), grid_blocks);
#endif
}
```

```cpp
#include <hip/hip_runtime.h>
#include <hip/hip_cooperative_groups.h>
#include <stdint.h>
#include <stdio.h>
namespace cg = cooperative_groups;

#ifndef MK_MULTI_LAUNCH
#define MK_MULTI_LAUNCH 0
#endif

typedef unsigned short bf16_t;
typedef short bf16x8 __attribute__((ext_vector_type(8)));
typedef float f32x16 __attribute__((ext_vector_type(16)));
typedef float f32x4 __attribute__((ext_vector_type(4)));
typedef float f32x2 __attribute__((ext_vector_type(2)));
typedef unsigned u32x4 __attribute__((ext_vector_type(4)));
typedef unsigned u32x2 __attribute__((ext_vector_type(2)));

#define DI __device__ __forceinline__
#define MFMA32(a, b, c) __builtin_amdgcn_mfma_f32_32x32x16_bf16((a), (b), (c), 0, 0, 0)

constexpr int T_LAT = 32768, T_ALL = 33792, NKEY = 8448, NT = 512;
constexpr float LOG2E = 1.4426950408889634f;
constexpr float QSCALE_A = 0.125f * LOG2E;
constexpr float QSCALE_B = 0.10206207261596575f * LOG2E;

constexpr size_t OFF_HC   = 0;
constexpr size_t OFF_UG   = OFF_HC + 1024ull * 1024 * 4;
constexpr size_t OFF_P    = OFF_UG + (size_t)T_ALL * 1024 * 2;
constexpr size_t OFF_QB   = OFF_P + (size_t)T_ALL * 2560 * 2;
constexpr size_t OFF_KB   = OFF_QB + (size_t)T_ALL * 768 * 2;
constexpr size_t OFF_VT   = OFF_KB + (size_t)T_ALL * 512 * 2;
constexpr size_t OFF_VTB  = OFF_VT + 4ull * 2 * 64 * NKEY * 2;
constexpr size_t OFF_W    = OFF_VT + 4ull * 16 * 64 * NKEY * 2;
constexpr size_t OFF_W_IN   = OFF_W;
constexpr size_t OFF_W_OUT  = OFF_W_IN + 2ull * 2560 * 1024 * 2;
constexpr size_t OFF_W_UQ   = OFF_W_OUT + 2ull * 1024 * 1024 * 2;
constexpr size_t OFF_W_UKV  = OFF_W_UQ + 2ull * 768 * 384 * 2;
constexpr size_t OFF_W_CIN  = OFF_W_UKV + 2ull * 1024 * 256 * 2;
constexpr size_t OFF_W_COUT = OFF_W_CIN + 2ull * 4096 * 1024 * 2;
constexpr size_t OFF_MOD    = OFF_W_COUT + 2ull * 1024 * 1024 * 2;
constexpr size_t OFF_ROPE   = OFF_MOD + 4ull * 5 * 3072 * 4;
constexpr size_t OFF_BAR    = OFF_ROPE + 2ull * 8192 * 32 * 4 + 2ull * 8192 * 16 * 4;
constexpr size_t OFF_END    = OFF_BAR + 16384;

struct Params {
  const float *x, *c, *ctx, *c_ctx, *ada_w, *ada_b, *norm_g, *ab_in_w, *ab_out_w, *a_sink, *b_qn_g, *b_w_uq, *b_kvn_g, *b_w_ukv,
      *c_in_w, *c_out_w, *c_rpb, *final_g;
  float* out;
  char* ws;
  int ph_begin, ph_end;
};

DI int otid() { int t = threadIdx.x; asm volatile("" : "+v"(t)); return t; }
DI int obid() { int t = blockIdx.x; asm volatile("" : "+s"(t)); return t; }
DI int ogrid() { int t = gridDim.x; asm volatile("" : "+s"(t)); return t; }
DI unsigned pack_bf16(float lo, float hi) { unsigned r; asm("v_cvt_pk_bf16_f32 %0, %1, %2" : "=v"(r) : "v"(lo), "v"(hi)); return r; }
DI float bf_lo(unsigned u) { return __uint_as_float(u << 16); }
DI float bf_hi(unsigned u) { return __uint_as_float(u & 0xffff0000u); }
DI float fexp2(float x) { return __builtin_amdgcn_exp2f(x); }
DI float silu(float z) { return z * __builtin_amdgcn_rcpf(1.f + __expf(-z)); }

DI size_t ablk(int tok, int k) { return ((size_t)((tok >> 8) * 16 + (k >> 6)) << 14) + ((tok & 255) << 6) + (k & 63); }
DI void tok_bk(int tok, int& b, int& key) {
  if (tok < T_LAT) { b = tok >> 13; key = tok & 8191; } else { int r = tok - T_LAT; b = r >> 8; key = 8192 + (r & 255); }
}
DI const float* h_src(const Params& p, int layer, int tok) {
  if (layer == 0) return tok < T_LAT ? p.x + (size_t)tok * 1024 : p.ctx + (size_t)(tok - T_LAT) * 1024;
  return tok < T_LAT ? p.out + (size_t)tok * 1024 : (const float*)(p.ws + OFF_HC) + (size_t)(tok - T_LAT) * 1024;
}
DI float* h_dst(const Params& p, int tok) {
  return tok < T_LAT ? p.out + (size_t)tok * 1024 : (float*)(p.ws + OFF_HC) + (size_t)(tok - T_LAT) * 1024;
}

#define XB_TMO      128
#define XB_XCNT(j)  (256  + 64 * (j))
#define XB_XSUB(j)  (1280 + 64 * (j))
#define XB_XGEN(j)  (2304 + 64 * (j))
#define XB_TOP      3328
#define XB_TOPGEN   3392
#define XCD_BAR_WORDS 3456
#define XB_SPIN_CAP (1u << 22)
#define LAS __attribute__((address_space(3)))
DI unsigned xb_ld(unsigned* p) { return __hip_atomic_load(p, __ATOMIC_RELAXED, __HIP_MEMORY_SCOPE_AGENT); }
DI unsigned xb_add(unsigned* p, unsigned v) { return __hip_atomic_fetch_add(p, v, __ATOMIC_RELAXED, __HIP_MEMORY_SCOPE_AGENT); }
DI unsigned xb_xcc_id() { return (unsigned)__builtin_amdgcn_s_getreg((3 << 11) | 20) & 0xFu; }
#define XB_SPIN(cond, bar) do { unsigned _sp = 0; while (cond) { __builtin_amdgcn_s_sleep(1); \
    if ((++_sp & 255u) == 0u) { if (xb_ld(&(bar)[XB_TMO])) break; if (_sp > XB_SPIN_CAP) { atomicAdd(&(bar)[XB_TMO], 1u); break; } } } } while (0)
struct XcdBarrier { unsigned* bar; unsigned x; volatile LAS unsigned* st; };
DI XcdBarrier xcd_barrier_post(unsigned* bar, volatile LAS unsigned* st) {
  XcdBarrier b; b.bar = bar; b.x = xb_xcc_id(); b.st = st;
  if (threadIdx.x == 0) (void)xb_add(&bar[XB_XCNT(b.x)], 1u);
  return b;
}
DI void xcd_barrier_complete(unsigned* bar, unsigned x, unsigned& nloc, unsigned& nx) {
  const unsigned G = gridDim.x * gridDim.y * gridDim.z;
  unsigned sum, cnt, mine, sp = 0u;
  for (;;) {
    sum = 0u; cnt = 0u; mine = 0u;
#pragma unroll
    for (unsigned j = 0; j < 16; ++j) { const unsigned c = xb_ld(&bar[XB_XCNT(j)]); sum += c; cnt += (c > 0u) ? 1u : 0u; mine = (j == x) ? c : mine; }
    if (sum == G) break;
    __builtin_amdgcn_s_sleep(1);
    if ((++sp & 255u) == 0u) { if (xb_ld(&bar[XB_TMO])) break; if (sp > XB_SPIN_CAP) { atomicAdd(&bar[XB_TMO], 1u); break; } }
  }
  nloc = mine > 0u ? mine : 1u; nx = cnt > 0u ? cnt : 1u;
}
DI void xcd_barrier(const XcdBarrier& b) {
  asm volatile("s_waitcnt vmcnt(0)" ::: "memory");
  __syncthreads();
  if (threadIdx.x == 0) {
    unsigned* bar = b.bar;
    __builtin_amdgcn_s_waitcnt(0);
    unsigned nloc = b.st[0], nx = b.st[1];
    if (nloc == 0u) { xcd_barrier_complete(bar, b.x, nloc, nx); b.st[0] = nloc; b.st[1] = nx; }
    const unsigned old = xb_add(&bar[XB_XSUB(b.x)], 1u);
    const unsigned gen = old / nloc;
    if (old + 1u == (gen + 1u) * nloc) {
      __builtin_amdgcn_fence(__ATOMIC_RELEASE, "agent");
      asm volatile("s_waitcnt vmcnt(0)" ::: "memory");
      const unsigned og = xb_add(&bar[XB_TOP], 1u);
      const unsigned tg = og / nx;
      if (og + 1u == (tg + 1u) * nx) xb_add(&bar[XB_TOPGEN], 1u);
      else XB_SPIN(xb_ld(&bar[XB_TOPGEN]) == tg, bar);
      __builtin_amdgcn_fence(__ATOMIC_ACQUIRE, "agent");
      xb_add(&bar[XB_XGEN(b.x)], 1u);
      asm volatile("s_waitcnt vmcnt(0)" ::: "memory");
    } else {
      XB_SPIN(xb_ld(&bar[XB_XGEN(b.x)]) == gen, bar);
      __builtin_amdgcn_fence(__ATOMIC_ACQUIRE, "agent");
      asm volatile("s_waitcnt vmcnt(0)" ::: "memory");
    }
  }
  __syncthreads();
}

struct TJob { const float* src; const float* rs; bf16_t* dst; int K, N, tk, tn, perm; };
DI TJob tr_job(const Params& p, int t) {
  TJob j; j.rs = nullptr; j.perm = 0;
  const int i2 = t / 2312; t -= i2 * 2312;
  if (t < 640) { j.src = p.ab_in_w + (size_t)i2 * 1024 * 2464; j.K = 1024; j.N = 2464; j.dst = (bf16_t*)(p.ws + OFF_W_IN) + (size_t)i2 * 2560 * 1024; j.tk = t / 40; j.tn = t % 40; }
  else if ((t -= 640) < 256) { j.src = p.ab_out_w + (size_t)i2 * 1024 * 1024; j.K = 1024; j.N = 1024; j.dst = (bf16_t*)(p.ws + OFF_W_OUT) + (size_t)i2 * 1024 * 1024; j.tk = t / 16; j.tn = t % 16; }
  else if ((t -= 256) < 72) { j.src = p.b_w_uq + (size_t)i2 * 384 * 768; j.K = 384; j.N = 768; j.dst = (bf16_t*)(p.ws + OFF_W_UQ) + (size_t)i2 * 768 * 384; j.rs = p.b_qn_g + i2 * 384; j.tk = t / 12; j.tn = t % 12; }
  else if ((t -= 72) < 64) { j.src = p.b_w_ukv + (size_t)i2 * 256 * 1024; j.K = 256; j.N = 1024; j.dst = (bf16_t*)(p.ws + OFF_W_UKV) + (size_t)i2 * 1024 * 256; j.rs = p.b_kvn_g + i2 * 256; j.tk = t / 16; j.tn = t % 16; j.perm = 1; }
  else if ((t -= 64) < 1024) { j.src = p.c_in_w + (size_t)i2 * 1024 * 4096; j.K = 1024; j.N = 4096; j.dst = (bf16_t*)(p.ws + OFF_W_CIN) + (size_t)i2 * 4096 * 1024; j.tk = t / 64; j.tn = t % 64; }
  else { t -= 1024; j.src = p.c_out_w + (size_t)i2 * 1024 * 1024; j.K = 1024; j.N = 1024; j.dst = (bf16_t*)(p.ws + OFF_W_COUT) + (size_t)i2 * 1024 * 1024; j.tk = t / 16; j.tn = t % 16; }
  return j;
}
DI void tr_load(const TJob& j, int tid, float (&v)[8]) {
#pragma unroll
  for (int i = 0; i < 8; ++i) {
    const int kk = (tid >> 6) + 8 * i, n = j.tn * 64 + (tid & 63);
    float x = (n < j.N) ? j.src[(size_t)(j.tk * 64 + kk) * j.N + n] : 0.f;
    if (j.rs) x *= j.rs[j.tk * 64 + kk];
    v[i] = x;
  }
}

DI void prologue_phase(const Params& p, char* lds) {
  const int tid = otid();
  constexpr int N_MOD = 192, N_TR = 4624, N_ROPE = 768;
  for (int u = obid(); u < N_MOD + N_TR + N_ROPE; u += ogrid()) {
    if (u < N_MOD) {
      const int layer = u / 48, cb = u % 48;
      float* sl = (float*)lds;
      for (int i = tid; i < 5120; i += NT) {
        const int bb = i >> 10, k = i & 1023;
        const float cv = bb < 4 ? p.c[bb * 1024 + k] : p.c_ctx[k];
        sl[i] = silu(cv);
      }
      __syncthreads();
      const int col = cb * 64 + (tid & 63), kg = tid >> 6;
      float a0 = 0, a1 = 0, a2 = 0, a3 = 0, a4 = 0;
      const float* wp = p.ada_w + (size_t)layer * 1024 * 3072 + col;
#pragma unroll 32
      for (int k = kg * 128; k < kg * 128 + 128; ++k) {
        const float wv = wp[(size_t)k * 3072];
        a0 += sl[k] * wv; a1 += sl[1024 + k] * wv; a2 += sl[2048 + k] * wv; a3 += sl[3072 + k] * wv; a4 += sl[4096 + k] * wv;
      }
      float* red = (float*)(lds + 20480);
      red[(kg * 5 + 0) * 64 + (tid & 63)] = a0; red[(kg * 5 + 1) * 64 + (tid & 63)] = a1; red[(kg * 5 + 2) * 64 + (tid & 63)] = a2;
      red[(kg * 5 + 3) * 64 + (tid & 63)] = a3; red[(kg * 5 + 4) * 64 + (tid & 63)] = a4;
      __syncthreads();
      if (tid < 64) {
        float* mod = (float*)(p.ws + OFF_MOD);
        const float bias = p.ada_b[layer * 3072 + col];
#pragma unroll
        for (int bb = 0; bb < 5; ++bb) {
          float s = bias;
#pragma unroll
          for (int g = 0; g < 8; ++g) s += red[(g * 5 + bb) * 64 + tid];
          mod[(size_t)(layer * 5 + bb) * 3072 + col] = s;
        }
      }
      __syncthreads();
    } else if (u < N_MOD + N_TR) {
    } else {
      const int idx = (u - N_MOD - N_TR) * NT + tid;
      float* ropeA = (float*)(p.ws + OFF_ROPE);
      float* ropeB = ropeA + 2 * 8192 * 32;
      if (idx < 8192 * 32) {
        const int pos = idx >> 5, pr = idx & 31;
        const float pv = pr < 16 ? (float)(pos >> 6) : (float)(pos & 63);
        const float inv = exp2f(-(float)(pr & 15) * (13.287712379549449f / 16.f));
        const float ang = pv * inv;
        ropeA[idx] = cosf(ang); ropeA[8192 * 32 + idx] = sinf(ang);
      } else {
        const int j = idx - 8192 * 32;
        const int pos = j >> 4, pr = j & 15;
        const float pv = pr < 8 ? (float)(pos >> 6) : (float)(pos & 63);
        const float inv = exp2f(-(float)(pr & 7) * (13.287712379549449f / 8.f));
        const float ang = pv * inv;
        ropeB[j] = cosf(ang); ropeB[8192 * 16 + j] = sinf(ang);
      }
    }
  }
  {
    const int G = ogrid();
    int t = obid();
    float v[8], nv[8];
    TJob cur, nxt;
    if (t < N_TR) { cur = tr_job(p, t); tr_load(cur, tid, v); }
    int buf = 0;
    for (; t < N_TR; t += G) {
      const bool more = t + G < N_TR;
      if (more) { nxt = tr_job(p, t + G); tr_load(nxt, tid, nv); }
      float* tile = (float*)(lds + buf * 16640);
#pragma unroll
      for (int i = 0; i < 8; ++i) tile[((tid >> 6) + 8 * i) * 65 + (tid & 63)] = v[i];
      __syncthreads();
      {
        const int nn = tid & 63, k8 = (tid >> 6) * 8;
        int n = cur.tn * 64 + nn;
        if (cur.perm) n = ((n & 64) ? 512 : 0) + (n >> 7) * 64 + (n & 63);
        u32x4 w;
        w.x = pack_bf16(tile[(k8 + 0) * 65 + nn], tile[(k8 + 1) * 65 + nn]); w.y = pack_bf16(tile[(k8 + 2) * 65 + nn], tile[(k8 + 3) * 65 + nn]);
        w.z = pack_bf16(tile[(k8 + 4) * 65 + nn], tile[(k8 + 5) * 65 + nn]); w.w = pack_bf16(tile[(k8 + 6) * 65 + nn], tile[(k8 + 7) * 65 + nn]);
        *(u32x4*)(cur.dst + ((size_t)((n >> 8) * (cur.K >> 6) + cur.tk) << 14) + ((n & 255) << 6) + k8) = w;
      }
      buf ^= 1;
      if (more) {
        cur = nxt;
#pragma unroll
        for (int i = 0; i < 8; ++i) v[i] = nv[i];
      }
    }
    __syncthreads();
  }
}

DI float wave_sum(float v) {
#pragma unroll
  for (int o = 32; o >= 1; o >>= 1) v += __shfl_xor(v, o);
  return v;
}

DI void norm_phase(const Params& p, int layer) {
  const int lane = otid() & 63;
  const int wave = obid() * 8 + (otid() >> 6), nw = ogrid() * 8;
  const float* g = p.norm_g + layer * 1024;
  const float* mod = (const float*)(p.ws + OFF_MOD) + (size_t)layer * 5 * 3072;
  bf16_t* U = (bf16_t*)(p.ws + OFF_UG);
  f32x4 gv[4];
#pragma unroll
  for (int i = 0; i < 4; ++i) gv[i] = *(const f32x4*)(g + lane * 4 + 256 * i);
  f32x4 nv[4];
  if (wave < T_ALL) {
    const float* s0 = h_src(p, layer, wave);
#pragma unroll
    for (int i = 0; i < 4; ++i) nv[i] = *(const f32x4*)(s0 + lane * 4 + 256 * i);
  }
  for (int row = wave; row < T_ALL; row += nw) {
    const int bb = row < T_LAT ? (row >> 13) : 4;
    f32x4 v[4];
#pragma unroll
    for (int i = 0; i < 4; ++i) v[i] = nv[i];
    if (row + nw < T_ALL) {
      const float* s1 = h_src(p, layer, row + nw);
#pragma unroll
      for (int i = 0; i < 4; ++i) nv[i] = *(const f32x4*)(s1 + lane * 4 + 256 * i);
    }
    float ss = 0.f;
#pragma unroll
    for (int i = 0; i < 4; ++i) ss += v[i][0] * v[i][0] + v[i][1] * v[i][1] + v[i][2] * v[i][2] + v[i][3] * v[i][3];
    ss = wave_sum(ss);
    const float rstd = rsqrtf(ss * (1.f / 1024.f) + 1e-6f);
    const float* mrow = mod + bb * 3072;
#pragma unroll
    for (int i = 0; i < 4; ++i) {
      const int cidx = lane * 4 + 256 * i;
      const f32x4 sh = *(const f32x4*)(mrow + cidx), sc = *(const f32x4*)(mrow + 1024 + cidx);
      f32x4 o = (v[i] * rstd) * gv[i] * (sc + 1.f) + sh;
      u32x2 w; w.x = pack_bf16(o[0], o[1]); w.y = pack_bf16(o[2], o[3]);
      *(u32x2*)(U + ablk(row, cidx)) = w;
    }
  }
}

DI void final_phase(const Params& p) {
  const int lane = otid() & 63;
  const int wave = obid() * 8 + (otid() >> 6), nw = ogrid() * 8;
  f32x4 gv[4];
#pragma unroll
  for (int i = 0; i < 4; ++i) gv[i] = *(const f32x4*)(p.final_g + lane * 4 + 256 * i);
  f32x4 nv[4];
  if (wave < T_LAT) {
#pragma unroll
    for (int i = 0; i < 4; ++i) nv[i] = *(const f32x4*)(p.out + (size_t)wave * 1024 + lane * 4 + 256 * i);
  }
  for (int row = wave; row < T_LAT; row += nw) {
    float* src = p.out + (size_t)row * 1024;
    f32x4 v[4];
#pragma unroll
    for (int i = 0; i < 4; ++i) v[i] = nv[i];
    if (row + nw < T_LAT) {
#pragma unroll
      for (int i = 0; i < 4; ++i) nv[i] = *(const f32x4*)(p.out + (size_t)(row + nw) * 1024 + lane * 4 + 256 * i);
    }
    float ss = 0.f;
#pragma unroll
    for (int i = 0; i < 4; ++i) ss += v[i][0] * v[i][0] + v[i][1] * v[i][1] + v[i][2] * v[i][2] + v[i][3] * v[i][3];
    ss = wave_sum(ss);
    const float rstd = rsqrtf(ss * (1.f / 1024.f) + 1e-6f);
#pragma unroll
    for (int i = 0; i < 4; ++i) *(f32x4*)(src + lane * 4 + 256 * i) = (v[i] * rstd) * gv[i];
  }
}

enum { EPI_AB_IN = 0, EPI_QB = 1, EPI_KVB = 2, EPI_C_IN = 3, EPI_OUT = 4 };
constexpr int G_STR = 144;
constexpr int G_OPER = 256 * G_STR;
constexpr int G_STAGE = 2 * G_OPER;
constexpr int OFF_RSTD = 2 * G_STAGE;
constexpr int LDS_BYTES = OFF_RSTD + 1024;

DI void rope2(float& v0, float& v1, float& v2, float& v3, const float* cs, const float* sn) {
  const f32x2 c = *(const f32x2*)cs, s = *(const f32x2*)sn;
  const float a0 = v0 * c.x - v1 * s.x, a1 = v0 * s.x + v1 * c.x, a2 = v2 * c.y - v3 * s.y, a3 = v2 * s.y + v3 * c.y;
  v0 = a0; v1 = a1; v2 = a2; v3 = a3;
}

template <int EPI>
DI void epi_math(const Params& p, int tok, int f0, float& v0, float& v1, float& v2, float& v3, float rs) {
  const float* ropeA = (const float*)(p.ws + OFF_ROPE);
  const float* ropeB = ropeA + 2 * 8192 * 32;
  const bool lat = tok < T_LAT;
  const int pos = tok & 8191;
  if (EPI == EPI_AB_IN) {
    if (f0 < 640) {
      if (lat) { const int p0 = (f0 & 63) >> 1; rope2(v0, v1, v2, v3, ropeA + pos * 32 + p0, ropeA + 8192 * 32 + pos * 32 + p0); }
      if (f0 < 512) { v0 *= QSCALE_A; v1 *= QSCALE_A; v2 *= QSCALE_A; v3 *= QSCALE_A; }
    } else if (f0 >= 1920 && f0 < 1952) {
      if (lat) { const int p0 = (f0 - 1920) >> 1; rope2(v0, v1, v2, v3, ropeB + pos * 16 + p0, ropeB + 8192 * 16 + pos * 16 + p0); }
    }
  } else if (EPI == EPI_QB) {
    const float s = rs * QSCALE_B;
    v0 *= s; v1 *= s; v2 *= s; v3 *= s;
    const int fh = f0 % 96;
    if (fh >= 64 && lat) { const int p0 = (fh - 64) >> 1; rope2(v0, v1, v2, v3, ropeB + pos * 16 + p0, ropeB + 8192 * 16 + pos * 16 + p0); }
  } else if (EPI == EPI_KVB) {
    v0 *= rs; v1 *= rs; v2 *= rs; v3 *= rs;
  } else if (EPI == EPI_C_IN) {
    if (f0 < 1024) { v0 *= QSCALE_A; v1 *= QSCALE_A; v2 *= QSCALE_A; v3 *= QSCALE_A; }
  }
}

template <int EPI>
DI bf16_t* dst_tr(const Params& p, int tok, int col) {
  if (EPI == EPI_AB_IN) return col < 2464 ? (bf16_t*)(p.ws + OFF_P) + (size_t)tok * 2560 + col : nullptr;
  if (EPI == EPI_QB) return (bf16_t*)(p.ws + OFF_QB) + (size_t)tok * 768 + col;
  if (EPI == EPI_KVB) return (bf16_t*)(p.ws + OFF_KB) + (size_t)tok * 512 + col;
  return (bf16_t*)(p.ws + OFF_P) + (size_t)tok * 3072 + (col >= 3072 ? col - 1024 : col);
}
template <int EPI>
DI bf16_t* dst_v(const Params& p, int t0, int col) {
  int b, key; tok_bk(t0, b, key);
  if (EPI == EPI_KVB) return (bf16_t*)(p.ws + OFF_VTB) + ((size_t)(b * 8 + ((col - 512) >> 6)) * 64 + (col & 63)) * NKEY + key;
  return (bf16_t*)(p.ws + OFF_VT) + ((size_t)(b * 16 + ((col - 2048) >> 6)) * 64 + (col & 63)) * NKEY + key;
}

struct TilePf { bool pre; bool has_next; int nm0, nnt; };
template <int EPI, int TM>
DI void gemm_tile(const Params& p, int layer, const bf16_t* __restrict__ A, int lda, const bf16_t* __restrict__ Bt, int K, int m0, int nt, char* lds,
                  u32x4 (&ra)[TM / 64], u32x4 (&rb)[4], const TilePf pf) {
  constexpr int NJ = TM == 256 ? 4 : 2, NI = TM == 256 ? 2 : 1, NA = TM / 64;
  const int tid = otid(), lane = tid & 63, w = tid >> 6;
  const int wm = TM == 256 ? (w >> 2) : 0, wn = TM == 256 ? (w & 3) : w;
  const int fb = TM == 256 ? wn * 64 : wn * 32, tb = TM == 256 ? wm * 128 : 0;
  const int l31 = lane & 31, hh = lane >> 5;
  const int n0 = nt * 256;
  float* rstd = (float*)(lds + OFF_RSTD);
  const int srow = tid >> 3, scc = tid & 7;
  const bool ablocked = (lda == 0);
  const int nkb = K >> 6;
  const bf16_t* ag = ablocked ? A + ((size_t)((m0 >> 8) * 16) << 14) + (m0 & 255) * 64 + tid * 8 : A + (size_t)(m0 + srow) * lda + scc * 8;
  const size_t a_i = ablocked ? 4096 : (size_t)64 * lda, a_k = ablocked ? 16384 : 64;
  const bf16_t* bg = Bt + ((size_t)(nt * nkb) << 14) + tid * 8;

  if (EPI == EPI_QB || EPI == EPI_KVB) {
    __syncthreads();
    if (tid < 2 * TM) {
      const int r = tid >> 1, half = tid & 1;
      const bf16_t* ap = A + (size_t)(m0 + r) * lda + half * (K / 2);
      float ss = 0.f;
#pragma unroll 8
      for (int cidx = 0; cidx < K / 2; cidx += 8) {
        const u32x4 v = *(const u32x4*)(ap + cidx);
#pragma unroll
        for (int e = 0; e < 4; ++e) { const float a = bf_lo(v[e]), b2 = bf_hi(v[e]); ss += a * a + b2 * b2; }
      }
      ss += __shfl_xor(ss, 1);
      if (half == 0) rstd[r] = rsqrtf(ss / (float)K + 1e-6f);
    }
  }

  f32x16 acc[NI][NJ];
#pragma unroll
  for (int i = 0; i < NI; ++i)
#pragma unroll
    for (int j = 0; j < NJ; ++j)
#pragma unroll
      for (int r = 0; r < 16; ++r) acc[i][j][r] = 0.f;

  const int nk = K >> 6;
  if (!pf.pre) {
#pragma unroll
    for (int i = 0; i < NA; ++i) ra[i] = *(const u32x4*)(ag + i * a_i);
#pragma unroll
    for (int i = 0; i < 4; ++i) rb[i] = *(const u32x4*)(bg + i * 4096);
  }
#pragma unroll
  for (int i = 0; i < NA; ++i) *(u32x4*)(lds + (srow + 64 * i) * G_STR + scc * 16) = ra[i];
#pragma unroll
  for (int i = 0; i < 4; ++i) *(u32x4*)(lds + G_OPER + (srow + 64 * i) * G_STR + scc * 16) = rb[i];
#pragma unroll
  for (int i = 0; i < NA; ++i) ra[i] = *(const u32x4*)(ag + i * a_i + a_k);
#pragma unroll
  for (int i = 0; i < 4; ++i) rb[i] = *(const u32x4*)(bg + i * 4096 + 16384);
  __syncthreads();
  for (int kt = 0; kt < nk; ++kt) {
    {
      char* st = lds + ((kt + 1) & 1) * G_STAGE;
#pragma unroll
      for (int i = 0; i < NA; ++i) *(u32x4*)(st + (srow + 64 * i) * G_STR + scc * 16) = ra[i];
#pragma unroll
      for (int i = 0; i < 4; ++i) *(u32x4*)(st + G_OPER + (srow + 64 * i) * G_STR + scc * 16) = rb[i];
    }
    if (kt + 2 < nk) {
#pragma unroll
      for (int i = 0; i < NA; ++i) ra[i] = *(const u32x4*)(ag + i * a_i + (size_t)(kt + 2) * a_k);
#pragma unroll
      for (int i = 0; i < 4; ++i) rb[i] = *(const u32x4*)(bg + i * 4096 + ((size_t)(kt + 2) << 14));
    }
    __builtin_amdgcn_sched_barrier(0);
    const char* as = lds + (kt & 1) * G_STAGE;
    const char* fp = as + G_OPER + (fb + l31) * G_STR + hh * 16;
    const char* sp = as + (tb + l31) * G_STR + hh * 16;
#pragma unroll
    for (int ks = 0; ks < 4; ++ks) {
      bf16x8 f[NI], s[NJ];
#pragma unroll
      for (int i = 0; i < NI; ++i) f[i] = *(const bf16x8*)(fp + i * 32 * G_STR + ks * 32);
#pragma unroll
      for (int j = 0; j < NJ; ++j) s[j] = *(const bf16x8*)(sp + j * 32 * G_STR + ks * 32);
#pragma unroll
      for (int j = 0; j < NJ; ++j)
#pragma unroll
        for (int i = 0; i < NI; ++i) acc[i][j] = MFMA32(f[i], s[j], acc[i][j]);
    }
    __syncthreads();
  }

  auto prefetch_next = [&]() {
    if (TM == 256 && pf.has_next) {
      const bf16_t* nag = ablocked ? A + ((size_t)((pf.nm0 >> 8) * 16) << 14) + (pf.nm0 & 255) * 64 + tid * 8 : A + (size_t)(pf.nm0 + srow) * lda + scc * 8;
      const bf16_t* nbg = Bt + ((size_t)(pf.nnt * nkb) << 14) + tid * 8;
#pragma unroll
      for (int i = 0; i < NA; ++i) ra[i] = *(const u32x4*)(nag + i * a_i);
#pragma unroll
      for (int i = 0; i < 4; ++i) rb[i] = *(const u32x4*)(nbg + i * 4096);
      __builtin_amdgcn_sched_barrier(0);
    }
  };
  constexpr int SB = 528;
  constexpr int SV = TM * 2 + 16;
  constexpr int NIT = TM * 32 / NT;
  if (EPI == EPI_OUT) {
    const int bb = m0 < T_LAT ? (m0 >> 13) : 4;
#pragma unroll
    for (int h = 0; h < 2; ++h) {
      if ((TM == 256 ? (wn >> 1) : (wn >> 2)) == h) {
#pragma unroll
        for (int j = 0; j < NJ; ++j)
#pragma unroll
          for (int i = 0; i < NI; ++i)
#pragma unroll
            for (int g = 0; g < 4; ++g) {
              f32x4 v; v[0] = acc[i][j][4 * g]; v[1] = acc[i][j][4 * g + 1]; v[2] = acc[i][j][4 * g + 2]; v[3] = acc[i][j][4 * g + 3];
              *(f32x4*)(lds + (tb + j * 32 + l31) * SB + ((fb & 127) + i * 32 + 8 * g + 4 * hh) * 4) = v;
            }
      }
      if (h == 1) prefetch_next();
      __syncthreads();
      const float* gate = (const float*)(p.ws + OFF_MOD) + (size_t)(layer * 5 + bb) * 3072 + 2048 + n0 + h * 128;
#pragma unroll 4
      for (int it = 0; it < NIT; ++it) {
        const int cidx = tid + NT * it, row = cidx >> 5, ch = cidx & 31;
        const f32x4 y = *(const f32x4*)(lds + row * SB + ch * 16);
        const f32x4 gt = *(const f32x4*)(gate + ch * 4);
        const f32x4 old = *(const f32x4*)(h_src(p, layer, m0 + row) + n0 + h * 128 + ch * 4);
        *(f32x4*)(h_dst(p, m0 + row) + n0 + h * 128 + ch * 4) = old + gt * y;
      }
      __syncthreads();
    }
  } else {
    const bool vt = (EPI == EPI_KVB && nt >= 2) || (EPI == EPI_C_IN && nt >= 8 && nt < 12);
#pragma unroll
    for (int j = 0; j < NJ; ++j) {
      const int rl = tb + j * 32 + l31;
      float rs = 1.f;
      if (EPI == EPI_QB || EPI == EPI_KVB) rs = rstd[rl];
#pragma unroll
      for (int i = 0; i < NI; ++i)
#pragma unroll
        for (int g = 0; g < 4; ++g) {
          const int fl = fb + i * 32 + 8 * g + 4 * hh;
          float v0 = acc[i][j][4 * g], v1 = acc[i][j][4 * g + 1], v2 = acc[i][j][4 * g + 2], v3 = acc[i][j][4 * g + 3];
          epi_math<EPI>(p, m0 + rl, n0 + fl, v0, v1, v2, v3, rs);
          const unsigned w01 = pack_bf16(v0, v1), w23 = pack_bf16(v2, v3);
          if (!vt) {
            u32x2 wv; wv.x = w01; wv.y = w23;
            *(u32x2*)(lds + rl * SB + fl * 2) = wv;
          } else {
            *(bf16_t*)(lds + (fl + 0) * SV + rl * 2) = (bf16_t)(w01 & 0xffffu);
            *(bf16_t*)(lds + (fl + 1) * SV + rl * 2) = (bf16_t)(w01 >> 16);
            *(bf16_t*)(lds + (fl + 2) * SV + rl * 2) = (bf16_t)(w23 & 0xffffu);
            *(bf16_t*)(lds + (fl + 3) * SV + rl * 2) = (bf16_t)(w23 >> 16);
          }
        }
    }
    prefetch_next();
    __syncthreads();
#pragma unroll 4
    for (int it = 0; it < NIT; ++it) {
      const int cidx = tid + NT * it;
      if (vt) {
        const int row = cidx / (TM / 8), ch = cidx % (TM / 8);
        *(u32x4*)dst_v<EPI>(p, m0 + ch * 8, n0 + row) = *(const u32x4*)(lds + row * SV + ch * 16);
      } else {
        const int row = cidx >> 5, ch = cidx & 31;
        bf16_t* d = dst_tr<EPI>(p, m0 + row, n0 + ch * 8);
        if (d) *(u32x4*)d = *(const u32x4*)(lds + row * SB + ch * 16);
      }
    }
    __syncthreads();
  }
}

template <int EPI>
DI void gemm_phase(const Params& p, int layer, const bf16_t* A, int lda, const bf16_t* Bt, int K, int mtiles, int ntiles, bool ctx, bool reverse, char* lds) {
  const int G = ogrid();
  const int bid = reverse ? (G - 1 - obid()) : obid();
  u32x4 ra[4], rb[4];
  const bool simple = (G & 7) != 0;
  const int xcd = bid & 7, local = simple ? bid : (bid >> 3), nlocal = simple ? G : (G >> 3);
  const int mlo = simple ? 0 : ((xcd * mtiles) >> 3), cnt = simple ? mtiles : ((((xcd + 1) * mtiles) >> 3) - mlo);
  const int total = cnt * ntiles, gsize = 4 * ntiles;
  auto tile_of = [&](int j, int& m0, int& nt) {
    const int g = j / gsize, r = j - g * gsize;
    int gm = cnt - g * 4; gm = gm > 4 ? 4 : gm;
    m0 = (mlo + g * 4 + (r % gm)) * 256; nt = r / gm;
  };
  bool pre = false;
  for (int j = local; j < total; j += nlocal) {
    int m0, nt; tile_of(j, m0, nt);
    TilePf pf; pf.pre = pre; pf.has_next = (j + nlocal < total); pf.nm0 = 0; pf.nnt = 0;
    if (pf.has_next) tile_of(j + nlocal, pf.nm0, pf.nnt);
    gemm_tile<EPI, 256>(p, layer, A, lda, Bt, K, m0, nt, lds, ra, rb, pf);
    pre = pf.has_next;
  }
  if (ctx) {
    const int b2 = G - 1 - bid;
    u32x4 ra1[1];
    TilePf pf; pf.pre = false; pf.has_next = false; pf.nm0 = 0; pf.nnt = 0;
    for (int u = b2; u < 16 * ntiles; u += G) gemm_tile<EPI, 64>(p, layer, A, lda, Bt, K, T_LAT + (u & 15) * 64, u >> 4, lds, ra1, rb, pf);
  }
}

DI void vta_phase(const Params& p, char* lds) {
  const int tid = otid();
  const bf16_t* Pb = (const bf16_t*)(p.ws + OFF_P);
  for (int u = ogrid() - 1 - obid(); u < T_ALL / 64; u += ogrid()) {
    const int t0 = u * 64;
#pragma unroll
    for (int it = 0; it < 2; ++it) {
      const int cidx = tid + NT * it, row = cidx >> 4, ch = cidx & 15;
      *(u32x4*)(lds + row * 272 + ch * 16) = *(const u32x4*)(Pb + (size_t)(t0 + row) * 2560 + 640 + ch * 8);
    }
    __syncthreads();
    int b, key; tok_bk(t0, b, key);
#pragma unroll
    for (int it = 0; it < 2; ++it) {
      const int cidx = tid + NT * it, f = cidx & 127, tc = cidx >> 7;
      unsigned short e[8];
#pragma unroll
      for (int k = 0; k < 8; ++k) e[k] = *(const bf16_t*)(lds + (tc * 8 + k) * 272 + f * 2);
      u32x4 v; v.x = e[0] | ((unsigned)e[1] << 16); v.y = e[2] | ((unsigned)e[3] << 16); v.z = e[4] | ((unsigned)e[5] << 16); v.w = e[6] | ((unsigned)e[7] << 16);
      *(u32x4*)((bf16_t*)(p.ws + OFF_VT) + ((size_t)(b * 2 + (f >> 6)) * 64 + (f & 63)) * NKEY + key + tc * 8) = v;
    }
    __syncthreads();
  }
}

template <int MODE>
DI void attn_item(const Params& p, int layer, int b, int qt, int head, bool is_ctx, char* lds) {
  constexpr int DK = (MODE == 1) ? 96 : 64;
  constexpr int NKS = DK / 16;
  constexpr int KSTR = DK * 2 + 16;
  constexpr int VSTR = 144;
  constexpr int KBYTES = 64 * KSTR;
  constexpr int STAGE = KBYTES + 64 * VSTR;
  constexpr int QPB = 256;
  constexpr int NKC = DK / 8;
  constexpr int KCH = 64 * NKC;
  constexpr int OSTR = 272;
  constexpr float MASKV = -1e30f;
  float* rpbs = (float*)(lds + 4 * STAGE);
  char* ostage = lds;

  const int tid = otid(), lane = tid & 63, w = tid >> 6, l31 = lane & 31, hh = lane >> 5;
  const int i2 = layer >> 1;
  const bf16_t* Pb = (const bf16_t*)(p.ws + OFF_P);
  bf16_t* UG = (bf16_t*)(p.ws + OFF_UG);
  const bf16_t *Qp, *Kp, *Krp = nullptr, *Zp, *Vt;
  int ldq, ldk, ldz, gcol;
  if (MODE == 0) {
    Qp = Pb + head * 64; ldq = 2560; Kp = Pb + 512 + (head >> 2) * 64; ldk = 2560;
    Vt = (const bf16_t*)(p.ws + OFF_VT) + (size_t)(b * 2 + (head >> 2)) * 64 * NKEY;
    Zp = Pb + 768 + head * 64; ldz = 2560; gcol = head * 64;
  } else if (MODE == 1) {
    Qp = (const bf16_t*)(p.ws + OFF_QB) + head * 96; ldq = 768; Kp = (const bf16_t*)(p.ws + OFF_KB) + head * 64; ldk = 512; Krp = Pb + 1920;
    Vt = (const bf16_t*)(p.ws + OFF_VTB) + (size_t)(b * 8 + head) * 64 * NKEY;
    Zp = Pb + 1952 + head * 64; ldz = 2560; gcol = 512 + head * 64;
  } else {
    Qp = Pb + head * 64; ldq = 3072; Kp = Pb + 1024 + head * 64; ldk = 3072;
    Vt = (const bf16_t*)(p.ws + OFF_VT) + (size_t)(b * 16 + head) * 64 * NKEY;
    Zp = Pb + 2048 + head * 64; ldz = 3072; gcol = head * 64;
  }
  const int qtok0 = is_ctx ? T_LAT + b * 256 : b * 8192 + qt * QPB;

  int lat_lo = 0, nlat = 0;
  if (!is_ctx) {
    if (MODE == 0) {
      int lo = 4 * qt - 2; if (lo < 0) lo = 0;
      int hi = 4 * qt + 5; if (hi > 127) hi = 127;
      lat_lo = lo; nlat = hi - lo + 1;
    } else if (MODE == 1) { lat_lo = 0; nlat = 128; }
    else {
      int lo = 4 * qt - 4; lo = lo < 0 ? 0 : (lo > 120 ? 120 : lo);
      int hi = 4 * qt + 3 - 4; hi = hi < 0 ? 0 : (hi > 120 ? 120 : hi); hi += 7;
      lat_lo = lo; nlat = hi - lo + 1;
    }
  }
  const int ntiles = nlat + 4;

  const bool nat2 = (MODE == 2) && !is_ctx;
  auto tokmap = [&](int row) { return nat2 ? qtok0 + ((w >> 2) * 2 + (row >> 4)) * 64 + (w & 3) * 16 + (row & 15) : qtok0 + w * 32 + row; };
  const int qtok = tokmap(l31);
  bf16x8 qf[NKS];
#pragma unroll
  for (int ks = 0; ks < NKS; ++ks) qf[ks] = *(const bf16x8*)(Qp + (size_t)qtok * ldq + ks * 16 + hh * 8);
  if (MODE == 2 && !is_ctx) {
    for (int i = tid; i < 465; i += NT) rpbs[i] = p.c_rpb[(size_t)(i2 * 16 + head) * 465 + i] * LOG2E;
  }
  float m_ = (MODE == 0) ? p.a_sink[i2 * 8 + head] * LOG2E : MASKV;
  float l_ = (MODE == 0 && hh == 0) ? 1.f : 0.f;
  f32x16 O[2];
#pragma unroll
  for (int dh = 0; dh < 2; ++dh)
#pragma unroll
    for (int r = 0; r < 16; ++r) O[dh][r] = 0.f;

  const int k0row = tid / NKC, k0cc = tid % NKC;
  const int k1row = (tid + NT) / NKC, k1cc = (tid + NT) % NKC;
  const bool k1 = (KCH > NT) && (tid + NT < KCH);
  struct Stg { u32x4 k0, k1, v; };
  Stg R0, R1;
  R0.k1 = (u32x4){0u, 0u, 0u, 0u}; R1.k1 = R0.k1;
  auto tile_kt = [&](int i) { return i < nlat ? lat_lo + i : 128 + (i - nlat); };
  auto kload = [&](int krow0, int row, int cc) -> u32x4 {
    if (MODE == 1 && cc >= 8) return *(const u32x4*)(Krp + (size_t)(krow0 + row) * 2560 + (cc - 8) * 8);
    return *(const u32x4*)(Kp + (size_t)(krow0 + row) * ldk + cc * 8);
  };
  auto gload = [&](int i, Stg& r) {
    const int kt = tile_kt(i < ntiles ? i : ntiles - 1);
    const int krow0 = kt < 128 ? b * 8192 + kt * 64 : T_LAT + b * 256 + (kt - 128) * 64;
    r.k0 = kload(krow0, k0row, k0cc);
    if (k1) r.k1 = kload(krow0, k1row, k1cc);
    r.v = *(const u32x4*)(Vt + (size_t)(tid >> 3) * NKEY + kt * 64 + (tid & 7) * 8);
  };
  auto lstore = [&](int st, const Stg& r) {
    char* kb = lds + st * STAGE;
    *(u32x4*)(kb + k0row * KSTR + k0cc * 16) = r.k0;
    if (k1) *(u32x4*)(kb + k1row * KSTR + k1cc * 16) = r.k1;
    *(u32x4*)(kb + KBYTES + (tid >> 3) * VSTR + (tid & 7) * 16) = r.v;
  };

  const int pr = (l31 & ~12) | ((l31 & 4) << 1) | ((l31 & 8) >> 1);
  int qr = 0, qc = 0, rs0 = 0, cs = 0, csw = 0, wlo = 0, whi = 0;
  if (MODE == 2) {
    qr = qt * 4 + (w >> 2) * 2 + (l31 >> 4); qc = (w & 3) * 16 + (l31 & 15);
    rs0 = qr - 4; rs0 = rs0 < 0 ? 0 : (rs0 > 120 ? 120 : rs0);
    cs = qc - 8; cs = cs < 0 ? 0 : (cs > 48 ? 48 : cs);
    csw = (w & 3) * 16 - 8; csw = csw < 0 ? 0 : (csw > 32 ? 32 : csw);
    const int r_lo = qt * 4 + (w >> 2) * 2;
    wlo = r_lo - 4; wlo = wlo < 0 ? 0 : (wlo > 120 ? 120 : wlo);
    whi = r_lo + 1 - 4; whi = whi < 0 ? 0 : (whi > 120 ? 120 : whi); whi += 7;
  }
  const int s0w = qt * QPB + w * 32;
  const int nsup = (ntiles + 1) >> 1;
  __syncthreads();
  gload(0, R0); gload(1, R1);
  lstore(0, R0); lstore(1, R1);
  gload(2, R0); gload(3, R1);
  __syncthreads();
  auto body = [&](int it, const char* kb) {
    const char* vb = kb + KBYTES;
    const int kt = tile_kt(it);
    const bool lat_tile = it < nlat;
    bool skip = (it >= ntiles);
    if (MODE == 2 && lat_tile) skip = (kt < wlo) || (kt > whi);
    if (MODE == 0 && lat_tile) skip = (kt * 64 + 63 < s0w - 128) || (kt * 64 > s0w + 31 + 128);
    const int nsub = (MODE == 2 && lat_tile) ? 1 : 2;
    const int krb = (MODE == 2 && lat_tile) ? csw : 0;
    if (!skip) {
      f32x16 S[2];
#pragma unroll
      for (int t = 0; t < 2; ++t)
#pragma unroll
        for (int r = 0; r < 16; ++r) S[t][r] = 0.f;
#pragma unroll
      for (int ks = 0; ks < NKS; ++ks) {
        const bf16x8 a0 = *(const bf16x8*)(kb + (krb + pr) * KSTR + ks * 32 + hh * 16);
        S[0] = MFMA32(a0, qf[ks], S[0]);
        if (nsub == 2) {
          const bf16x8 a1 = *(const bf16x8*)(kb + (32 + pr) * KSTR + ks * 32 + hh * 16);
          S[1] = MFMA32(a1, qf[ks], S[1]);
        }
      }
      if (MODE == 0 && lat_tile) {
        const int s = qt * QPB + w * 32 + l31;
#pragma unroll
        for (int t = 0; t < 2; ++t)
#pragma unroll
          for (int r = 0; r < 16; ++r) {
            const int kk = kt * 64 + t * 32 + 16 * (r >> 3) + 8 * hh + (r & 7);
            const int d = kk - s;
            if (d > 128 || d < -128) S[t][r] = MASKV;
          }
      }
      if (MODE == 2 && lat_tile) {
        int ri = kt - qr + 7; ri = ri < 0 ? 0 : (ri > 14 ? 14 : ri);
        const float* brow = rpbs + ri * 31;
        const bool rok = (kt >= rs0) && (kt <= rs0 + 7);
        float bv[16];
#pragma unroll
        for (int r = 0; r < 16; ++r) {
          const int kc = csw + 16 * (r >> 3) + 8 * hh + (r & 7);
          int bi = kc - qc + 15; bi = bi < 0 ? 0 : (bi > 30 ? 30 : bi);
          bv[r] = brow[bi];
        }
#pragma unroll
        for (int r = 0; r < 16; ++r) asm volatile("" : "+v"(bv[r]));
#pragma unroll
        for (int r = 0; r < 16; ++r) {
          const int kc = csw + 16 * (r >> 3) + 8 * hh + (r & 7);
          const bool ok = rok && (kc >= cs) && (kc < cs + 16);
          S[0][r] = ok ? S[0][r] + bv[r] : MASKV;
        }
      }
      float mx = S[0][0];
#pragma unroll
      for (int r = 0; r < 16; ++r) mx = fmaxf(mx, S[0][r]);
      if (nsub == 2) {
#pragma unroll
        for (int r = 0; r < 16; ++r) mx = fmaxf(mx, S[1][r]);
      }
      mx = fmaxf(mx, __shfl_xor(mx, 32));
      if (__any(mx > m_ + 8.f)) {
        const float mnew = fmaxf(m_, mx);
        const float alpha = fexp2(m_ - mnew);
        m_ = mnew;
        l_ *= alpha;
#pragma unroll
        for (int dh = 0; dh < 2; ++dh)
#pragma unroll
          for (int r = 0; r < 16; ++r) O[dh][r] *= alpha;
      }
      float rsum = 0.f;
#pragma unroll
      for (int t = 0; t < 2; ++t)
        if (t < nsub) {
#pragma unroll
          for (int r = 0; r < 16; ++r) { const float e = fexp2(S[t][r] - m_); S[t][r] = e; rsum += e; }
        }
      l_ += rsum;
#pragma unroll
      for (int t = 0; t < 2; ++t)
       if (t < nsub)
#pragma unroll
        for (int s = 0; s < 2; ++s) {
          u32x4 u;
          u.x = pack_bf16(S[t][8 * s + 0], S[t][8 * s + 1]); u.y = pack_bf16(S[t][8 * s + 2], S[t][8 * s + 3]);
          u.z = pack_bf16(S[t][8 * s + 4], S[t][8 * s + 5]); u.w = pack_bf16(S[t][8 * s + 6], S[t][8 * s + 7]);
          const bf16x8 pf = __builtin_bit_cast(bf16x8, u);
#pragma unroll
          for (int dh = 0; dh < 2; ++dh) {
            const bf16x8 v = *(const bf16x8*)(vb + (dh * 32 + l31) * VSTR + (krb + t * 32 + s * 16 + hh * 8) * 2);
            O[dh] = MFMA32(v, pf, O[dh]);
          }
        }
    }
  };
  for (int j = 0; j < nsup; ++j) {
    const char* sb = lds + (j & 1) * 2 * STAGE;
    body(2 * j, sb);
    body(2 * j + 1, sb + STAGE);
    __builtin_amdgcn_sched_barrier(0);
    {
      const int so = ((j + 1) & 1) * 2;
      lstore(so, R0); lstore(so + 1, R1);
      gload(2 * j + 4, R0); gload(2 * j + 5, R1);
    }
    __syncthreads();
  }

  {
    const float lt = l_ + __shfl_xor(l_, 32);
    const float inv = 1.f / lt;
    char* orow = ostage + (w * 32) * OSTR;
#pragma unroll
    for (int dh = 0; dh < 2; ++dh)
#pragma unroll
      for (int g = 0; g < 4; ++g) {
        f32x4 v; v[0] = O[dh][4 * g] * inv; v[1] = O[dh][4 * g + 1] * inv; v[2] = O[dh][4 * g + 2] * inv; v[3] = O[dh][4 * g + 3] * inv;
        *(f32x4*)(orow + l31 * OSTR + (dh * 32 + 8 * g + 4 * hh) * 4) = v;
      }
    __builtin_amdgcn_s_waitcnt(0xc07f);
#pragma unroll
    for (int it = 0; it < 4; ++it) {
      const int cidx = lane + 64 * it, row = cidx >> 3, ch = cidx & 7;
      const f32x4 o0 = *(const f32x4*)(orow + row * OSTR + ch * 32), o1 = *(const f32x4*)(orow + row * OSTR + ch * 32 + 16);
      const int tok = tokmap(row);
      const u32x4 z = *(const u32x4*)(Zp + (size_t)tok * ldz + ch * 8);
      u32x4 wv;
      wv.x = pack_bf16(o0[0] * silu(bf_lo(z.x)), o0[1] * silu(bf_hi(z.x)));
      wv.y = pack_bf16(o0[2] * silu(bf_lo(z.y)), o0[3] * silu(bf_hi(z.y)));
      wv.z = pack_bf16(o1[0] * silu(bf_lo(z.z)), o1[1] * silu(bf_hi(z.z)));
      wv.w = pack_bf16(o1[2] * silu(bf_lo(z.w)), o1[3] * silu(bf_hi(z.w)));
      *(u32x4*)(UG + ablk(tok, gcol + ch * 8)) = wv;
    }
  }
}

DI void mla_item2(const Params& p, int layer, int b, int qt, int head, char* lds) {
  constexpr int DK = 96, NKS = 6, KSTR = DK * 2 + 16, VSTR = 144, KBYTES = 64 * KSTR, STAGE = KBYTES + 64 * VSTR;
  constexpr int NKC = 12, KCH = 64 * NKC, OSTR = 272, QG = 2, NTILES = 132;
  constexpr float MASKV = -1e30f;
  char* ostage = lds;
  const int tid = otid(), lane = tid & 63, w = tid >> 6, l31 = lane & 31, hh = lane >> 5;
  const bf16_t* Pb = (const bf16_t*)(p.ws + OFF_P);
  bf16_t* UG = (bf16_t*)(p.ws + OFF_UG);
  const bf16_t* Qp = (const bf16_t*)(p.ws + OFF_QB) + head * 96;
  const bf16_t* Kp = (const bf16_t*)(p.ws + OFF_KB) + head * 64;
  const bf16_t* Krp = Pb + 1920;
  const bf16_t* Vt = (const bf16_t*)(p.ws + OFF_VTB) + (size_t)(b * 8 + head) * 64 * NKEY;
  const bf16_t* Zp = Pb + 1952 + head * 64;
  const int gcol = 512 + head * 64;
  const int qtok0 = b * 8192 + qt * 512;
  bf16x8 qf[QG][NKS];
#pragma unroll
  for (int qg = 0; qg < QG; ++qg)
#pragma unroll
    for (int ks = 0; ks < NKS; ++ks) qf[qg][ks] = *(const bf16x8*)(Qp + (size_t)(qtok0 + qg * 256 + w * 32 + l31) * 768 + ks * 16 + hh * 8);
  float m_[QG], l_[QG];
  f32x16 O[QG][2];
#pragma unroll
  for (int qg = 0; qg < QG; ++qg) {
    m_[qg] = MASKV; l_[qg] = 0.f;
#pragma unroll
    for (int dh = 0; dh < 2; ++dh)
#pragma unroll
      for (int r = 0; r < 16; ++r) O[qg][dh][r] = 0.f;
  }
  const int k0row = tid / NKC, k0cc = tid % NKC;
  const int k1row = (tid + NT) / NKC, k1cc = (tid + NT) % NKC;
  const bool k1 = (tid + NT < KCH);
  struct Stg { u32x4 k0, k1, v; };
  Stg R0;
  R0.k1 = (u32x4){0u, 0u, 0u, 0u};
  auto kload = [&](int krow0, int row, int cc) -> u32x4 {
    if (cc >= 8) return *(const u32x4*)(Krp + (size_t)(krow0 + row) * 2560 + (cc - 8) * 8);
    return *(const u32x4*)(Kp + (size_t)(krow0 + row) * 512 + cc * 8);
  };
  auto gload = [&](int i, Stg& r) {
    const int kt = i < NTILES ? i : NTILES - 1;
    const int krow0 = kt < 128 ? b * 8192 + kt * 64 : T_LAT + b * 256 + (kt - 128) * 64;
    r.k0 = kload(krow0, k0row, k0cc);
    if (k1) r.k1 = kload(krow0, k1row, k1cc);
    r.v = *(const u32x4*)(Vt + (size_t)(tid >> 3) * NKEY + kt * 64 + (tid & 7) * 8);
  };
  auto lstore = [&](int st, const Stg& r) {
    char* kb = lds + st * STAGE;
    *(u32x4*)(kb + k0row * KSTR + k0cc * 16) = r.k0;
    if (k1) *(u32x4*)(kb + k1row * KSTR + k1cc * 16) = r.k1;
    *(u32x4*)(kb + KBYTES + (tid >> 3) * VSTR + (tid & 7) * 16) = r.v;
  };
  const int pr = (l31 & ~12) | ((l31 & 4) << 1) | ((l31 & 8) >> 1);
  __syncthreads();
  gload(0, R0); lstore(0, R0);
  gload(1, R0);
  __syncthreads();
  auto body = [&](const char* kb) {
    const char* vb = kb + KBYTES;
    f32x16 S[QG][2];
#pragma unroll
    for (int qg = 0; qg < QG; ++qg)
#pragma unroll
      for (int t = 0; t < 2; ++t)
#pragma unroll
        for (int r = 0; r < 16; ++r) S[qg][t][r] = 0.f;
#pragma unroll
    for (int ks = 0; ks < NKS; ++ks) {
      const bf16x8 a0 = *(const bf16x8*)(kb + pr * KSTR + ks * 32 + hh * 16);
      const bf16x8 a1 = *(const bf16x8*)(kb + (32 + pr) * KSTR + ks * 32 + hh * 16);
#pragma unroll
      for (int qg = 0; qg < QG; ++qg) { S[qg][0] = MFMA32(a0, qf[qg][ks], S[qg][0]); S[qg][1] = MFMA32(a1, qf[qg][ks], S[qg][1]); }
    }
#pragma unroll
    for (int qg = 0; qg < QG; ++qg) {
      float mx = S[qg][0][0];
#pragma unroll
      for (int t = 0; t < 2; ++t)
#pragma unroll
        for (int r = 0; r < 16; ++r) mx = fmaxf(mx, S[qg][t][r]);
      mx = fmaxf(mx, __shfl_xor(mx, 32));
      if (__any(mx > m_[qg] + 8.f)) {
        const float mnew = fmaxf(m_[qg], mx);
        const float alpha = fexp2(m_[qg] - mnew);
        m_[qg] = mnew;
        l_[qg] *= alpha;
#pragma unroll
        for (int dh = 0; dh < 2; ++dh)
#pragma unroll
          for (int r = 0; r < 16; ++r) O[qg][dh][r] *= alpha;
      }
      float rsum = 0.f;
#pragma unroll
      for (int t = 0; t < 2; ++t)
#pragma unroll
        for (int r = 0; r < 16; ++r) { const float e = fexp2(S[qg][t][r] - m_[qg]); S[qg][t][r] = e; rsum += e; }
      l_[qg] += rsum;
    }
#pragma unroll
    for (int t = 0; t < 2; ++t)
#pragma unroll
      for (int s = 0; s < 2; ++s) {
        bf16x8 pf[QG];
#pragma unroll
        for (int qg = 0; qg < QG; ++qg) {
          u32x4 u;
          u.x = pack_bf16(S[qg][t][8 * s + 0], S[qg][t][8 * s + 1]); u.y = pack_bf16(S[qg][t][8 * s + 2], S[qg][t][8 * s + 3]);
          u.z = pack_bf16(S[qg][t][8 * s + 4], S[qg][t][8 * s + 5]); u.w = pack_bf16(S[qg][t][8 * s + 6], S[qg][t][8 * s + 7]);
          pf[qg] = __builtin_bit_cast(bf16x8, u);
        }
#pragma unroll
        for (int dh = 0; dh < 2; ++dh) {
          const bf16x8 v = *(const bf16x8*)(vb + (dh * 32 + l31) * VSTR + (t * 32 + s * 16 + hh * 8) * 2);
#pragma unroll
          for (int qg = 0; qg < QG; ++qg) O[qg][dh] = MFMA32(v, pf[qg], O[qg][dh]);
        }
      }
  };
  if (w >= 4) __builtin_amdgcn_s_setprio(2);
  for (int j = 0; j < NTILES; ++j) {
    body(lds + (j & 1) * STAGE);
    __builtin_amdgcn_sched_barrier(0);
    lstore((j + 1) & 1, R0);
    gload(j + 2, R0);
    __syncthreads();
  }
  __builtin_amdgcn_s_setprio(0);
#pragma unroll
  for (int qg = 0; qg < QG; ++qg) {
    const float lt = l_[qg] + __shfl_xor(l_[qg], 32);
    const float inv = 1.f / lt;
    char* orow = ostage + (w * 32) * OSTR;
#pragma unroll
    for (int dh = 0; dh < 2; ++dh)
#pragma unroll
      for (int g = 0; g < 4; ++g) {
        f32x4 v; v[0] = O[qg][dh][4 * g] * inv; v[1] = O[qg][dh][4 * g + 1] * inv; v[2] = O[qg][dh][4 * g + 2] * inv; v[3] = O[qg][dh][4 * g + 3] * inv;
        *(f32x4*)(orow + l31 * OSTR + (dh * 32 + 8 * g + 4 * hh) * 4) = v;
      }
    __builtin_amdgcn_s_waitcnt(0xc07f);
#pragma unroll
    for (int it = 0; it < 4; ++it) {
      const int cidx = lane + 64 * it, row = cidx >> 3, ch = cidx & 7;
      const f32x4 o0 = *(const f32x4*)(orow + row * OSTR + ch * 32), o1 = *(const f32x4*)(orow + row * OSTR + ch * 32 + 16);
      const int tok = qtok0 + qg * 256 + w * 32 + row;
      const u32x4 z = *(const u32x4*)(Zp + (size_t)tok * 2560 + ch * 8);
      u32x4 wv;
      wv.x = pack_bf16(o0[0] * silu(bf_lo(z.x)), o0[1] * silu(bf_hi(z.x)));
      wv.y = pack_bf16(o0[2] * silu(bf_lo(z.y)), o0[3] * silu(bf_hi(z.y)));
      wv.z = pack_bf16(o1[0] * silu(bf_lo(z.z)), o1[1] * silu(bf_hi(z.z)));
      wv.w = pack_bf16(o1[2] * silu(bf_lo(z.w)), o1[3] * silu(bf_hi(z.w)));
      *(u32x4*)(UG + ablk(tok, gcol + ch * 8)) = wv;
    }
    __builtin_amdgcn_s_waitcnt(0xc07f);
  }
}

DI void attn_phase_ab(const Params& p, int layer, char* lds) {
  const int G = ogrid();
  for (int v = obid(); v < 512; v += G) {
    const int xcd = v & 7, s = v >> 3;
    const int grp = (s >> 4) * 8 + xcd, qt = s & 15;
    mla_item2(p, layer, grp >> 3, qt, grp & 7, lds);
  }
  for (int v = obid(); v < 32; v += G) attn_item<1>(p, layer, v >> 3, 0, v & 7, true, lds);
  for (int v = obid(); v < 1024 + 32; v += G) {
    if (v < 1024) attn_item<0>(p, layer, v >> 8, v & 31, (v >> 5) & 7, false, lds);
    else { const int c = v - 1024; attn_item<0>(p, layer, c >> 3, 0, c & 7, true, lds); }
  }
}

DI void attn_phase_c(const Params& p, int layer, char* lds) {
  const int G = ogrid();
  const int nctx = (layer == 3) ? 0 : 64;
  for (int v = obid(); v < 2048 + nctx; v += G) {
    if (v < 2048) attn_item<2>(p, layer, v >> 9, v & 31, (v >> 5) & 15, false, lds);
    else { const int c = v - 2048; attn_item<2>(p, layer, c >> 4, 0, c & 15, true, lds); }
  }
}

__global__ void __launch_bounds__(512, 2) fwd_megakernel(Params p) {
  __shared__ __attribute__((aligned(16))) char lds[LDS_BYTES];
  __shared__ uint4 xb_words;
  if (threadIdx.x == 0) xb_words = make_uint4(0u, 0u, 0u, 0u);
  __syncthreads();
  if (obid() == 0) { unsigned* bw = (unsigned*)(p.ws + OFF_BAR); for (int i = otid(); i < 4096; i += NT) bw[i] = 0u; }
  XcdBarrier xb; xb.bar = (unsigned*)(p.ws + OFF_BAR); xb.x = 0; xb.st = (volatile LAS unsigned*)&xb_words;
  bool first = true, posted = false;
  for (int ph = p.ph_begin; ph < p.ph_end; ++ph) {
    const int layer = (ph - 1) / 5, s = (ph - 1) % 5;
    const bool even = (layer & 1) == 0;
    const int i2 = layer >> 1;
    if (ph >= 1 && ph <= 20 && s == 2 && !even) continue;
    if (!first) {
      if (!posted) { cg::this_grid().sync(); xb = xcd_barrier_post((unsigned*)(p.ws + OFF_BAR), (volatile LAS unsigned*)&xb_words); posted = true; }
      else xcd_barrier(xb);
    }
    first = false;
    if (ph == 0) prologue_phase(p, lds);
    else if (ph == 21) final_phase(p);
    else if (s == 0) norm_phase(p, layer);
    else if (s == 1) {
      const bf16_t* U = (const bf16_t*)(p.ws + OFF_UG);
      if (even) gemm_phase<EPI_AB_IN>(p, layer, U, 0, (const bf16_t*)(p.ws + OFF_W_IN) + (size_t)i2 * 2560 * 1024, 1024, 128, 10, true, false, lds);
      else gemm_phase<EPI_C_IN>(p, layer, U, 0, (const bf16_t*)(p.ws + OFF_W_CIN) + (size_t)i2 * 4096 * 1024, 1024, 128, 16, true, false, lds);
    } else if (s == 2) {
      const bf16_t* Pb = (const bf16_t*)(p.ws + OFF_P);
      gemm_phase<EPI_QB>(p, layer, Pb + 1280, 2560, (const bf16_t*)(p.ws + OFF_W_UQ) + (size_t)i2 * 768 * 384, 384, 128, 3, true, false, lds);
      gemm_phase<EPI_KVB>(p, layer, Pb + 1664, 2560, (const bf16_t*)(p.ws + OFF_W_UKV) + (size_t)i2 * 1024 * 256, 256, 128, 4, true, true, lds);
      vta_phase(p, lds);
    } else if (s == 3) {
      if (even) attn_phase_ab(p, layer, lds); else attn_phase_c(p, layer, lds);
    } else {
      const bf16_t* Gm = (const bf16_t*)(p.ws + OFF_UG);
      const bf16_t* W = even ? (const bf16_t*)(p.ws + OFF_W_OUT) + (size_t)i2 * 1024 * 1024 : (const bf16_t*)(p.ws + OFF_W_COUT) + (size_t)i2 * 1024 * 1024;
      gemm_phase<EPI_OUT>(p, layer, Gm, 0, W, 1024, 128, 4, layer != 3, false, lds);
    }
  }
}

extern "C" void kernel_launch(void* const* d_in, const int* in_sizes, int n_in, void* d_out, int out_size, void* d_ws, size_t ws_size,
                              hipStream_t stream) {
  static int grid_blocks = 0;
  if (!grid_blocks) {
    int dev = 0, cus = 0, per_cu = 0;
    hipGetDevice(&dev);
    hipDeviceGetAttribute(&cus, hipDeviceAttributeMultiprocessorCount, dev);
    hipOccupancyMaxActiveBlocksPerMultiprocessor(&per_cu, fwd_megakernel, NT, 0);
    per_cu = 1;
    grid_blocks = cus * per_cu;
    if (ws_size < OFF_END) fprintf(stderr, "kernel_launch: workspace too small: %zu < %zu\n", ws_size, (size_t)OFF_END);
  }
  Params p{};
  const float** f = (const float**)&p;
  for (int i = 0; i < 18; ++i) f[i] = (const float*)d_in[i];
  p.out = (float*)d_out;
  p.ws = (char*)d_ws;
#if MK_MULTI_LAUNCH
  for (int ph = 0; ph < 22; ++ph) {
    if (ph >= 1 && ph <= 20 && ((ph - 1) % 5) == 2 && (((ph - 1) / 5) & 1)) continue;
    p.ph_begin = ph; p.ph_end = ph + 1;
    hipLaunchKernelGGL(fwd_megakernel, dim3(grid_blocks), dim3(NT), 0, stream, p);
  }
#else
  p.ph_begin = 0; p.ph_end = 22;
  void* args[] = {&p};
  hipError_t e = hipLaunchCooperativeKernel((void*)fwd_megakernel, dim3(grid_blocks), dim3(NT), args, 0, stream);
  if (e != hipSuccess) fprintf(stderr, "cooperative launch failed: %s (grid %d)\n", hipGetErrorString(e), grid_blocks);
#endif
}
```

```cpp
#include <hip/hip_runtime.h>
#include <hip/hip_cooperative_groups.h>
#include <stdint.h>
#include <stdio.h>
namespace cg = cooperative_groups;

#ifndef MK_MULTI_LAUNCH
#define MK_MULTI_LAUNCH 0
#endif

typedef unsigned short bf16_t;
typedef short bf16x8 __attribute__((ext_vector_type(8)));
typedef float f32x16 __attribute__((ext_vector_type(16)));
typedef float f32x4 __attribute__((ext_vector_type(4)));
typedef float f32x2 __attribute__((ext_vector_type(2)));
typedef unsigned u32x4 __attribute__((ext_vector_type(4)));
typedef unsigned u32x2 __attribute__((ext_vector_type(2)));

#define DI __device__ __forceinline__
#define MFMA32(a, b, c) __builtin_amdgcn_mfma_f32_32x32x16_bf16((a), (b), (c), 0, 0, 0)

constexpr int T_LAT = 32768, T_ALL = 33792, NKEY = 8448, NT = 512;
constexpr float LOG2E = 1.4426950408889634f;
constexpr float QSCALE_A = 0.125f * LOG2E;
constexpr float QSCALE_B = 0.10206207261596575f * LOG2E;

constexpr size_t OFF_HC   = 0;
constexpr size_t OFF_UG   = OFF_HC + 1024ull * 1024 * 4;
constexpr size_t OFF_P    = OFF_UG + (size_t)T_ALL * 1024 * 2;
constexpr size_t OFF_QB   = OFF_P + (size_t)T_ALL * 2560 * 2;
constexpr size_t OFF_KB   = OFF_QB + (size_t)T_ALL * 768 * 2;
constexpr size_t OFF_VT   = OFF_KB + (size_t)T_ALL * 512 * 2;
constexpr size_t OFF_VTB  = OFF_VT + 4ull * 2 * 64 * NKEY * 2;
constexpr size_t OFF_W    = OFF_VT + 4ull * 16 * 64 * NKEY * 2;
constexpr size_t OFF_W_IN   = OFF_W;
constexpr size_t OFF_W_OUT  = OFF_W_IN + 2ull * 2560 * 1024 * 2;
constexpr size_t OFF_W_UQ   = OFF_W_OUT + 2ull * 1024 * 1024 * 2;
constexpr size_t OFF_W_UKV  = OFF_W_UQ + 2ull * 768 * 384 * 2;
constexpr size_t OFF_W_CIN  = OFF_W_UKV + 2ull * 1024 * 256 * 2;
constexpr size_t OFF_W_COUT = OFF_W_CIN + 2ull * 4096 * 1024 * 2;
constexpr size_t OFF_MOD    = OFF_W_COUT + 2ull * 1024 * 1024 * 2;
constexpr size_t OFF_ROPE   = OFF_MOD + 4ull * 5 * 3072 * 4;
constexpr size_t OFF_BAR    = OFF_ROPE + 2ull * 8192 * 32 * 4 + 2ull * 8192 * 16 * 4;
constexpr size_t OFF_END    = OFF_BAR + 16384;

struct Params {
  const float *x, *c, *ctx, *c_ctx, *ada_w, *ada_b, *norm_g, *ab_in_w, *ab_out_w, *a_sink, *b_qn_g, *b_w_uq, *b_kvn_g, *b_w_ukv,
      *c_in_w, *c_out_w, *c_rpb, *final_g;
  float* out;
  char* ws;
  int ph_begin, ph_end;
};

DI int otid() { int t = threadIdx.x; asm volatile("" : "+v"(t)); return t; }
DI int obid() { int t = blockIdx.x; asm volatile("" : "+s"(t)); return t; }
DI int ogrid() { int t = gridDim.x; asm volatile("" : "+s"(t)); return t; }
DI unsigned pack_bf16(float lo, float hi) { unsigned r; asm("v_cvt_pk_bf16_f32 %0, %1, %2" : "=v"(r) : "v"(lo), "v"(hi)); return r; }
DI float bf_lo(unsigned u) { return __uint_as_float(u << 16); }
DI float bf_hi(unsigned u) { return __uint_as_float(u & 0xffff0000u); }
DI float fexp2(float x) { return __builtin_amdgcn_exp2f(x); }
DI float silu(float z) { return z * __builtin_amdgcn_rcpf(1.f + __expf(-z)); }

DI size_t ablk(int tok, int k) { return ((size_t)((tok >> 8) * 16 + (k >> 6)) << 14) + ((tok & 255) << 6) + (k & 63); }
DI void tok_bk(int tok, int& b, int& key) {
  if (tok < T_LAT) { b = tok >> 13; key = tok & 8191; } else { int r = tok - T_LAT; b = r >> 8; key = 8192 + (r & 255); }
}
DI const float* h_src(const Params& p, int layer, int tok) {
  if (layer == 0) return tok < T_LAT ? p.x + (size_t)tok * 1024 : p.ctx + (size_t)(tok - T_LAT) * 1024;
  return tok < T_LAT ? p.out + (size_t)tok * 1024 : (const float*)(p.ws + OFF_HC) + (size_t)(tok - T_LAT) * 1024;
}
DI float* h_dst(const Params& p, int tok) {
  return tok < T_LAT ? p.out + (size_t)tok * 1024 : (float*)(p.ws + OFF_HC) + (size_t)(tok - T_LAT) * 1024;
}

#define XB_TMO      128
#define XB_XCNT(j)  (256  + 64 * (j))
#define XB_XSUB(j)  (1280 + 64 * (j))
#define XB_XGEN(j)  (2304 + 64 * (j))
#define XB_TOP      3328
#define XB_TOPGEN   3392
#define XCD_BAR_WORDS 3456
#define XB_SPIN_CAP (1u << 22)
#define LAS __attribute__((address_space(3)))
DI unsigned xb_ld(unsigned* p) { return __hip_atomic_load(p, __ATOMIC_RELAXED, __HIP_MEMORY_SCOPE_AGENT); }
DI unsigned xb_add(unsigned* p, unsigned v) { return __hip_atomic_fetch_add(p, v, __ATOMIC_RELAXED, __HIP_MEMORY_SCOPE_AGENT); }
DI unsigned xb_xcc_id() { return (unsigned)__builtin_amdgcn_s_getreg((3 << 11) | 20) & 0xFu; }
#define XB_SPIN(cond, bar) do { unsigned _sp = 0; while (cond) { __builtin_amdgcn_s_sleep(1); \
    if ((++_sp & 255u) == 0u) { if (xb_ld(&(bar)[XB_TMO])) break; if (_sp > XB_SPIN_CAP) { atomicAdd(&(bar)[XB_TMO], 1u); break; } } } } while (0)
struct XcdBarrier { unsigned* bar; unsigned x; volatile LAS unsigned* st; };
DI XcdBarrier xcd_barrier_post(unsigned* bar, volatile LAS unsigned* st) {
  XcdBarrier b; b.bar = bar; b.x = xb_xcc_id(); b.st = st;
  if (threadIdx.x == 0) (void)xb_add(&bar[XB_XCNT(b.x)], 1u);
  return b;
}
DI void xcd_barrier_complete(unsigned* bar, unsigned x, unsigned& nloc, unsigned& nx) {
  const unsigned G = gridDim.x * gridDim.y * gridDim.z;
  unsigned sum, cnt, mine, sp = 0u;
  for (;;) {
    sum = 0u; cnt = 0u; mine = 0u;
#pragma unroll
    for (unsigned j = 0; j < 16; ++j) { const unsigned c = xb_ld(&bar[XB_XCNT(j)]); sum += c; cnt += (c > 0u) ? 1u : 0u; mine = (j == x) ? c : mine; }
    if (sum == G) break;
    __builtin_amdgcn_s_sleep(1);
    if ((++sp & 255u) == 0u) { if (xb_ld(&bar[XB_TMO])) break; if (sp > XB_SPIN_CAP) { atomicAdd(&bar[XB_TMO], 1u); break; } }
  }
  nloc = mine > 0u ? mine : 1u; nx = cnt > 0u ? cnt : 1u;
}
DI void xcd_barrier(const XcdBarrier& b) {
  asm volatile("s_waitcnt vmcnt(0)" ::: "memory");
  __syncthreads();
  if (threadIdx.x == 0) {
    unsigned* bar = b.bar;
    __builtin_amdgcn_s_waitcnt(0);
    unsigned nloc = b.st[0], nx = b.st[1];
    if (nloc == 0u) { xcd_barrier_complete(bar, b.x, nloc, nx); b.st[0] = nloc; b.st[1] = nx; }
    const unsigned old = xb_add(&bar[XB_XSUB(b.x)], 1u);
    const unsigned gen = old / nloc;
    if (old + 1u == (gen + 1u) * nloc) {
      __builtin_amdgcn_fence(__ATOMIC_RELEASE, "agent");
      asm volatile("s_waitcnt vmcnt(0)" ::: "memory");
      const unsigned og = xb_add(&bar[XB_TOP], 1u);
      const unsigned tg = og / nx;
      if (og + 1u == (tg + 1u) * nx) xb_add(&bar[XB_TOPGEN], 1u);
      else XB_SPIN(xb_ld(&bar[XB_TOPGEN]) == tg, bar);
      __builtin_amdgcn_fence(__ATOMIC_ACQUIRE, "agent");
      xb_add(&bar[XB_XGEN(b.x)], 1u);
      asm volatile("s_waitcnt vmcnt(0)" ::: "memory");
    } else {
      XB_SPIN(xb_ld(&bar[XB_XGEN(b.x)]) == gen, bar);
      __builtin_amdgcn_fence(__ATOMIC_ACQUIRE, "agent");
      asm volatile("s_waitcnt vmcnt(0)" ::: "memory");
    }
  }
  __syncthreads();
}

struct TJob { const float* src; const float* rs; bf16_t* dst; int K, N, tk, tn, perm; };
DI TJob tr_job(const Params& p, int t) {
  TJob j; j.rs = nullptr; j.perm = 0;
  const int i2 = t / 2312; t -= i2 * 2312;
  if (t < 640) { j.src = p.ab_in_w + (size_t)i2 * 1024 * 2464; j.K = 1024; j.N = 2464; j.dst = (bf16_t*)(p.ws + OFF_W_IN) + (size_t)i2 * 2560 * 1024; j.tk = t / 40; j.tn = t % 40; }
  else if ((t -= 640) < 256) { j.src = p.ab_out_w + (size_t)i2 * 1024 * 1024; j.K = 1024; j.N = 1024; j.dst = (bf16_t*)(p.ws + OFF_W_OUT) + (size_t)i2 * 1024 * 1024; j.tk = t / 16; j.tn = t % 16; }
  else if ((t -= 256) < 72) { j.src = p.b_w_uq + (size_t)i2 * 384 * 768; j.K = 384; j.N = 768; j.dst = (bf16_t*)(p.ws + OFF_W_UQ) + (size_t)i2 * 768 * 384; j.rs = p.b_qn_g + i2 * 384; j.tk = t / 12; j.tn = t % 12; }
  else if ((t -= 72) < 64) { j.src = p.b_w_ukv + (size_t)i2 * 256 * 1024; j.K = 256; j.N = 1024; j.dst = (bf16_t*)(p.ws + OFF_W_UKV) + (size_t)i2 * 1024 * 256; j.rs = p.b_kvn_g + i2 * 256; j.tk = t / 16; j.tn = t % 16; j.perm = 1; }
  else if ((t -= 64) < 1024) { j.src = p.c_in_w + (size_t)i2 * 1024 * 4096; j.K = 1024; j.N = 4096; j.dst = (bf16_t*)(p.ws + OFF_W_CIN) + (size_t)i2 * 4096 * 1024; j.tk = t / 64; j.tn = t % 64; }
  else { t -= 1024; j.src = p.c_out_w + (size_t)i2 * 1024 * 1024; j.K = 1024; j.N = 1024; j.dst = (bf16_t*)(p.ws + OFF_W_COUT) + (size_t)i2 * 1024 * 1024; j.tk = t / 16; j.tn = t % 16; }
  return j;
}
DI void tr_load(const TJob& j, int tid, float (&v)[8]) {
#pragma unroll
  for (int i = 0; i < 8; ++i) {
    const int kk = (tid >> 6) + 8 * i, n = j.tn * 64 + (tid & 63);
    float x = (n < j.N) ? j.src[(size_t)(j.tk * 64 + kk) * j.N + n] : 0.f;
    if (j.rs) x *= j.rs[j.tk * 64 + kk];
    v[i] = x;
  }
}

DI void prologue_phase(const Params& p, char* lds) {
  const int tid = otid();
  constexpr int N_MOD = 192, N_TR = 4624, N_ROPE = 768;
  for (int u = obid(); u < N_MOD + N_TR + N_ROPE; u += ogrid()) {
    if (u < N_MOD) {
      const int layer = u / 48, cb = u % 48;
      float* sl = (float*)lds;
      for (int i = tid; i < 5120; i += NT) {
        const int bb = i >> 10, k = i & 1023;
        const float cv = bb < 4 ? p.c[bb * 1024 + k] : p.c_ctx[k];
        sl[i] = silu(cv);
      }
      __syncthreads();
      const int col = cb * 64 + (tid & 63), kg = tid >> 6;
      float a0 = 0, a1 = 0, a2 = 0, a3 = 0, a4 = 0;
      const float* wp = p.ada_w + (size_t)layer * 1024 * 3072 + col;
#pragma unroll 32
      for (int k = kg * 128; k < kg * 128 + 128; ++k) {
        const float wv = wp[(size_t)k * 3072];
        a0 += sl[k] * wv; a1 += sl[1024 + k] * wv; a2 += sl[2048 + k] * wv; a3 += sl[3072 + k] * wv; a4 += sl[4096 + k] * wv;
      }
      float* red = (float*)(lds + 20480);
      red[(kg * 5 + 0) * 64 + (tid & 63)] = a0; red[(kg * 5 + 1) * 64 + (tid & 63)] = a1; red[(kg * 5 + 2) * 64 + (tid & 63)] = a2;
      red[(kg * 5 + 3) * 64 + (tid & 63)] = a3; red[(kg * 5 + 4) * 64 + (tid & 63)] = a4;
      __syncthreads();
      if (tid < 64) {
        float* mod = (float*)(p.ws + OFF_MOD);
        const float bias = p.ada_b[layer * 3072 + col];
#pragma unroll
        for (int bb = 0; bb < 5; ++bb) {
          float s = bias;
#pragma unroll
          for (int g = 0; g < 8; ++g) s += red[(g * 5 + bb) * 64 + tid];
          mod[(size_t)(layer * 5 + bb) * 3072 + col] = s;
        }
      }
      __syncthreads();
    } else if (u < N_MOD + N_TR) {
    } else {
      const int idx = (u - N_MOD - N_TR) * NT + tid;
      float* ropeA = (float*)(p.ws + OFF_ROPE);
      float* ropeB = ropeA + 2 * 8192 * 32;
      if (idx < 8192 * 32) {
        const int pos = idx >> 5, pr = idx & 31;
        const float pv = pr < 16 ? (float)(pos >> 6) : (float)(pos & 63);
        const float inv = exp2f(-(float)(pr & 15) * (13.287712379549449f / 16.f));
        const float ang = pv * inv;
        ropeA[idx] = cosf(ang); ropeA[8192 * 32 + idx] = sinf(ang);
      } else {
        const int j = idx - 8192 * 32;
        const int pos = j >> 4, pr = j & 15;
        const float pv = pr < 8 ? (float)(pos >> 6) : (float)(pos & 63);
        const float inv = exp2f(-(float)(pr & 7) * (13.287712379549449f / 8.f));
        const float ang = pv * inv;
        ropeB[j] = cosf(ang); ropeB[8192 * 16 + j] = sinf(ang);
      }
    }
  }
  {
    const int G = ogrid();
    int t = obid();
    float v[8], nv[8];
    TJob cur, nxt;
    if (t < N_TR) { cur = tr_job(p, t); tr_load(cur, tid, v); }
    int buf = 0;
    for (; t < N_TR; t += G) {
      const bool more = t + G < N_TR;
      if (more) { nxt = tr_job(p, t + G); tr_load(nxt, tid, nv); }
      float* tile = (float*)(lds + buf * 16640);
#pragma unroll
      for (int i = 0; i < 8; ++i) tile[((tid >> 6) + 8 * i) * 65 + (tid & 63)] = v[i];
      __syncthreads();
      {
        const int nn = tid & 63, k8 = (tid >> 6) * 8;
        int n = cur.tn * 64 + nn;
        if (cur.perm) n = ((n & 64) ? 512 : 0) + (n >> 7) * 64 + (n & 63);
        u32x4 w;
        w.x = pack_bf16(tile[(k8 + 0) * 65 + nn], tile[(k8 + 1) * 65 + nn]); w.y = pack_bf16(tile[(k8 + 2) * 65 + nn], tile[(k8 + 3) * 65 + nn]);
        w.z = pack_bf16(tile[(k8 + 4) * 65 + nn], tile[(k8 + 5) * 65 + nn]); w.w = pack_bf16(tile[(k8 + 6) * 65 + nn], tile[(k8 + 7) * 65 + nn]);
        *(u32x4*)(cur.dst + ((size_t)((n >> 8) * (cur.K >> 6) + cur.tk) << 14) + ((n & 255) << 6) + k8) = w;
      }
      buf ^= 1;
      if (more) {
        cur = nxt;
#pragma unroll
        for (int i = 0; i < 8; ++i) v[i] = nv[i];
      }
    }
    __syncthreads();
  }
}

DI float wave_sum(float v) {
#pragma unroll
  for (int o = 32; o >= 1; o >>= 1) v += __shfl_xor(v, o);
  return v;
}

DI void norm_phase(const Params& p, int layer) {
  const int lane = otid() & 63;
  const int wave = obid() * 8 + (otid() >> 6), nw = ogrid() * 8;
  const float* g = p.norm_g + layer * 1024;
  const float* mod = (const float*)(p.ws + OFF_MOD) + (size_t)layer * 5 * 3072;
  bf16_t* U = (bf16_t*)(p.ws + OFF_UG);
  f32x4 gv[4];
#pragma unroll
  for (int i = 0; i < 4; ++i) gv[i] = *(const f32x4*)(g + lane * 4 + 256 * i);
  f32x4 nv[4];
  if (wave < T_ALL) {
    const float* s0 = h_src(p, layer, wave);
#pragma unroll
    for (int i = 0; i < 4; ++i) nv[i] = *(const f32x4*)(s0 + lane * 4 + 256 * i);
  }
  for (int row = wave; row < T_ALL; row += nw) {
    const int bb = row < T_LAT ? (row >> 13) : 4;
    f32x4 v[4];
#pragma unroll
    for (int i = 0; i < 4; ++i) v[i] = nv[i];
    if (row + nw < T_ALL) {
      const float* s1 = h_src(p, layer, row + nw);
#pragma unroll
      for (int i = 0; i < 4; ++i) nv[i] = *(const f32x4*)(s1 + lane * 4 + 256 * i);
    }
    float ss = 0.f;
#pragma unroll
    for (int i = 0; i < 4; ++i) ss += v[i][0] * v[i][0] + v[i][1] * v[i][1] + v[i][2] * v[i][2] + v[i][3] * v[i][3];
    ss = wave_sum(ss);
    const float rstd = rsqrtf(ss * (1.f / 1024.f) + 1e-6f);
    const float* mrow = mod + bb * 3072;
#pragma unroll
    for (int i = 0; i < 4; ++i) {
      const int cidx = lane * 4 + 256 * i;
      const f32x4 sh = *(const f32x4*)(mrow + cidx), sc = *(const f32x4*)(mrow + 1024 + cidx);
      f32x4 o = (v[i] * rstd) * gv[i] * (sc + 1.f) + sh;
      u32x2 w; w.x = pack_bf16(o[0], o[1]); w.y = pack_bf16(o[2], o[3]);
      *(u32x2*)(U + ablk(row, cidx)) = w;
    }
  }
}

DI void final_phase(const Params& p) {
  const int lane = otid() & 63;
  const int wave = obid() * 8 + (otid() >> 6), nw = ogrid() * 8;
  f32x4 gv[4];
#pragma unroll
  for (int i = 0; i < 4; ++i) gv[i] = *(const f32x4*)(p.final_g + lane * 4 + 256 * i);
  f32x4 nv[4];
  if (wave < T_LAT) {
#pragma unroll
    for (int i = 0; i < 4; ++i) nv[i] = *(const f32x4*)(p.out + (size_t)wave * 1024 + lane * 4 + 256 * i);
  }
  for (int row = wave; row < T_LAT; row += nw) {
    float* src = p.out + (size_t)row * 1024;
    f32x4 v[4];
#pragma unroll
    for (int i = 0; i < 4; ++i) v[i] = nv[i];
    if (row + nw < T_LAT) {
#pragma unroll
      for (int i = 0; i < 4; ++i) nv[i] = *(const f32x4*)(p.out + (size_t)(row + nw) * 1024 + lane * 4 + 256 * i);
    }
    float ss = 0.f;
#pragma unroll
    for (int i = 0; i < 4; ++i) ss += v[i][0] * v[i][0] + v[i][1] * v[i][1] + v[i][2] * v[i][2] + v[i][3] * v[i][3];
    ss = wave_sum(ss);
    const float rstd = rsqrtf(ss * (1.f / 1024.f) + 1e-6f);
#pragma unroll
    for (int i = 0; i < 4; ++i) *(f32x4*)(src + lane * 4 + 256 * i) = (v[i] * rstd) * gv[i];
  }
}

enum { EPI_AB_IN = 0, EPI_QB = 1, EPI_KVB = 2, EPI_C_IN = 3, EPI_OUT = 4 };
constexpr int G_STR = 144;
constexpr int G_OPER = 256 * G_STR;
constexpr int G_STAGE = 2 * G_OPER;
constexpr int OFF_RSTD = 2 * G_STAGE;
constexpr int LDS_BYTES = OFF_RSTD + 1024;

DI void rope2(float& v0, float& v1, float& v2, float& v3, const float* cs, const float* sn) {
  const f32x2 c = *(const f32x2*)cs, s = *(const f32x2*)sn;
  const float a0 = v0 * c.x - v1 * s.x, a1 = v0 * s.x + v1 * c.x, a2 = v2 * c.y - v3 * s.y, a3 = v2 * s.y + v3 * c.y;
  v0 = a0; v1 = a1; v2 = a2; v3 = a3;
}

template <int EPI>
DI void epi_math(const Params& p, int tok, int f0, float& v0, float& v1, float& v2, float& v3, float rs) {
  const float* ropeA = (const float*)(p.ws + OFF_ROPE);
  const float* ropeB = ropeA + 2 * 8192 * 32;
  const bool lat = tok < T_LAT;
  const int pos = tok & 8191;
  if (EPI == EPI_AB_IN) {
    if (f0 < 640) {
      if (lat) { const int p0 = (f0 & 63) >> 1; rope2(v0, v1, v2, v3, ropeA + pos * 32 + p0, ropeA + 8192 * 32 + pos * 32 + p0); }
      if (f0 < 512) { v0 *= QSCALE_A; v1 *= QSCALE_A; v2 *= QSCALE_A; v3 *= QSCALE_A; }
    } else if (f0 >= 1920 && f0 < 1952) {
      if (lat) { const int p0 = (f0 - 1920) >> 1; rope2(v0, v1, v2, v3, ropeB + pos * 16 + p0, ropeB + 8192 * 16 + pos * 16 + p0); }
    }
  } else if (EPI == EPI_QB) {
    const float s = rs * QSCALE_B;
    v0 *= s; v1 *= s; v2 *= s; v3 *= s;
    const int fh = f0 % 96;
    if (fh >= 64 && lat) { const int p0 = (fh - 64) >> 1; rope2(v0, v1, v2, v3, ropeB + pos * 16 + p0, ropeB + 8192 * 16 + pos * 16 + p0); }
  } else if (EPI == EPI_KVB) {
    v0 *= rs; v1 *= rs; v2 *= rs; v3 *= rs;
  } else if (EPI == EPI_C_IN) {
    if (f0 < 1024) { v0 *= QSCALE_A; v1 *= QSCALE_A; v2 *= QSCALE_A; v3 *= QSCALE_A; }
  }
}

template <int EPI>
DI bf16_t* dst_tr(const Params& p, int tok, int col) {
  if (EPI == EPI_AB_IN) return col < 2464 ? (bf16_t*)(p.ws + OFF_P) + (size_t)tok * 2560 + col : nullptr;
  if (EPI == EPI_QB) return (bf16_t*)(p.ws + OFF_QB) + (size_t)tok * 768 + col;
  if (EPI == EPI_KVB) return (bf16_t*)(p.ws + OFF_KB) + (size_t)tok * 512 + col;
  return (bf16_t*)(p.ws + OFF_P) + (size_t)tok * 3072 + (col >= 3072 ? col - 1024 : col);
}
template <int EPI>
DI bf16_t* dst_v(const Params& p, int t0, int col) {
  int b, key; tok_bk(t0, b, key);
  if (EPI == EPI_KVB) return (bf16_t*)(p.ws + OFF_VTB) + ((size_t)(b * 8 + ((col - 512) >> 6)) * 64 + (col & 63)) * NKEY + key;
  return (bf16_t*)(p.ws + OFF_VT) + ((size_t)(b * 16 + ((col - 2048) >> 6)) * 64 + (col & 63)) * NKEY + key;
}

struct TilePf { bool pre; bool has_next; int nm0, nnt; };
template <int EPI, int TM>
DI void gemm_tile(const Params& p, int layer, const bf16_t* __restrict__ A, int lda, const bf16_t* __restrict__ Bt, int K, int m0, int nt, char* lds,
                  u32x4 (&ra)[TM / 64], u32x4 (&rb)[4], const TilePf pf) {
  constexpr int NJ = TM == 256 ? 4 : 2, NI = TM == 256 ? 2 : 1, NA = TM / 64;
  const int tid = otid(), lane = tid & 63, w = tid >> 6;
  const int wm = TM == 256 ? (w >> 2) : 0, wn = TM == 256 ? (w & 3) : w;
  const int fb = TM == 256 ? wn * 64 : wn * 32, tb = TM == 256 ? wm * 128 : 0;
  const int l31 = lane & 31, hh = lane >> 5;
  const int n0 = nt * 256;
  float* rstd = (float*)(lds + OFF_RSTD);
  const int srow = tid >> 3, scc = tid & 7;
  const bool ablocked = (lda == 0);
  const int nkb = K >> 6;
  const bf16_t* ag = ablocked ? A + ((size_t)((m0 >> 8) * 16) << 14) + (m0 & 255) * 64 + tid * 8 : A + (size_t)(m0 + srow) * lda + scc * 8;
  const size_t a_i = ablocked ? 4096 : (size_t)64 * lda, a_k = ablocked ? 16384 : 64;
  const bf16_t* bg = Bt + ((size_t)(nt * nkb) << 14) + tid * 8;

  if (EPI == EPI_QB || EPI == EPI_KVB) {
    __syncthreads();
    if (tid < 2 * TM) {
      const int r = tid >> 1, half = tid & 1;
      const bf16_t* ap = A + (size_t)(m0 + r) * lda + half * (K / 2);
      float ss = 0.f;
#pragma unroll 8
      for (int cidx = 0; cidx < K / 2; cidx += 8) {
        const u32x4 v = *(const u32x4*)(ap + cidx);
#pragma unroll
        for (int e = 0; e < 4; ++e) { const float a = bf_lo(v[e]), b2 = bf_hi(v[e]); ss += a * a + b2 * b2; }
      }
      ss += __shfl_xor(ss, 1);
      if (half == 0) rstd[r] = rsqrtf(ss / (float)K + 1e-6f);
    }
  }

  f32x16 acc[NI][NJ];
#pragma unroll
  for (int i = 0; i < NI; ++i)
#pragma unroll
    for (int j = 0; j < NJ; ++j)
#pragma unroll
      for (int r = 0; r < 16; ++r) acc[i][j][r] = 0.f;

  const int nk = K >> 6;
  if (!pf.pre) {
#pragma unroll
    for (int i = 0; i < NA; ++i) ra[i] = *(const u32x4*)(ag + i * a_i);
#pragma unroll
    for (int i = 0; i < 4; ++i) rb[i] = *(const u32x4*)(bg + i * 4096);
  }
#pragma unroll
  for (int i = 0; i < NA; ++i) *(u32x4*)(lds + (srow + 64 * i) * G_STR + scc * 16) = ra[i];
#pragma unroll
  for (int i = 0; i < 4; ++i) *(u32x4*)(lds + G_OPER + (srow + 64 * i) * G_STR + scc * 16) = rb[i];
#pragma unroll
  for (int i = 0; i < NA; ++i) ra[i] = *(const u32x4*)(ag + i * a_i + a_k);
#pragma unroll
  for (int i = 0; i < 4; ++i) rb[i] = *(const u32x4*)(bg + i * 4096 + 16384);
  __syncthreads();
  for (int kt = 0; kt < nk; ++kt) {
    {
      char* st = lds + ((kt + 1) & 1) * G_STAGE;
#pragma unroll
      for (int i = 0; i < NA; ++i) *(u32x4*)(st + (srow + 64 * i) * G_STR + scc * 16) = ra[i];
#pragma unroll
      for (int i = 0; i < 4; ++i) *(u32x4*)(st + G_OPER + (srow + 64 * i) * G_STR + scc * 16) = rb[i];
    }
    if (kt + 2 < nk) {
#pragma unroll
      for (int i = 0; i < NA; ++i) ra[i] = *(const u32x4*)(ag + i * a_i + (size_t)(kt + 2) * a_k);
#pragma unroll
      for (int i = 0; i < 4; ++i) rb[i] = *(const u32x4*)(bg + i * 4096 + ((size_t)(kt + 2) << 14));
    }
    __builtin_amdgcn_sched_barrier(0);
    const char* as = lds + (kt & 1) * G_STAGE;
    const char* fp = as + G_OPER + (fb + l31) * G_STR + hh * 16;
    const char* sp = as + (tb + l31) * G_STR + hh * 16;
#pragma unroll
    for (int ks = 0; ks < 4; ++ks) {
      bf16x8 f[NI], s[NJ];
#pragma unroll
      for (int i = 0; i < NI; ++i) f[i] = *(const bf16x8*)(fp + i * 32 * G_STR + ks * 32);
#pragma unroll
      for (int j = 0; j < NJ; ++j) s[j] = *(const bf16x8*)(sp + j * 32 * G_STR + ks * 32);
#pragma unroll
      for (int j = 0; j < NJ; ++j)
#pragma unroll
        for (int i = 0; i < NI; ++i) acc[i][j] = MFMA32(f[i], s[j], acc[i][j]);
    }
    __syncthreads();
  }

  auto prefetch_next = [&]() {
    if (TM == 256 && pf.has_next) {
      const bf16_t* nag = ablocked ? A + ((size_t)((pf.nm0 >> 8) * 16) << 14) + (pf.nm0 & 255) * 64 + tid * 8 : A + (size_t)(pf.nm0 + srow) * lda + scc * 8;
      const bf16_t* nbg = Bt + ((size_t)(pf.nnt * nkb) << 14) + tid * 8;
#pragma unroll
      for (int i = 0; i < NA; ++i) ra[i] = *(const u32x4*)(nag + i * a_i);
#pragma unroll
      for (int i = 0; i < 4; ++i) rb[i] = *(const u32x4*)(nbg + i * 4096);
      __builtin_amdgcn_sched_barrier(0);
    }
  };
  constexpr int SB = 528;
  constexpr int SV = TM * 2 + 16;
  constexpr int NIT = TM * 32 / NT;
  if (EPI == EPI_OUT) {
    const int bb = m0 < T_LAT ? (m0 >> 13) : 4;
    constexpr int SF = 1040;
    constexpr int JH = NJ / 2;
    constexpr int NITO = (TM / 2) * 64 / NT;
    const float* gate = (const float*)(p.ws + OFF_MOD) + (size_t)(layer * 5 + bb) * 3072 + 2048 + n0;
#pragma unroll
    for (int h = 0; h < 2; ++h) {
#pragma unroll
      for (int jj = 0; jj < JH; ++jj)
#pragma unroll
        for (int i = 0; i < NI; ++i)
#pragma unroll
          for (int g = 0; g < 4; ++g) {
            const int j = h * JH + jj;
            f32x4 v; v[0] = acc[i][j][4 * g]; v[1] = acc[i][j][4 * g + 1]; v[2] = acc[i][j][4 * g + 2]; v[3] = acc[i][j][4 * g + 3];
            *(f32x4*)(lds + ((TM == 256 ? wm * 64 : 0) + jj * 32 + l31) * SF + (fb + i * 32 + 8 * g + 4 * hh) * 4) = v;
          }
      if (h == 1) prefetch_next();
      __syncthreads();
      const f32x4 gt = *(const f32x4*)(gate + (tid & 63) * 4);
#pragma unroll
      for (int i0 = 0; i0 < NITO; i0 += 8) {
        f32x4 oldv[8];
#pragma unroll
        for (int k = 0; k < 8; ++k)
          if (i0 + k < NITO) {
            const int cidx = tid + NT * (i0 + k), row = cidx >> 6, ch = cidx & 63;
            const int tok = m0 + (TM == 256 ? (row >> 6) * 128 + h * 64 + (row & 63) : h * 32 + row);
            oldv[k] = *(const f32x4*)(h_src(p, layer, tok) + n0 + ch * 4);
          }
#pragma unroll
        for (int k = 0; k < 8; ++k)
          if (i0 + k < NITO) {
            const int cidx = tid + NT * (i0 + k), row = cidx >> 6, ch = cidx & 63;
            const int tok = m0 + (TM == 256 ? (row >> 6) * 128 + h * 64 + (row & 63) : h * 32 + row);
            const f32x4 y = *(const f32x4*)(lds + row * SF + ch * 16);
            *(f32x4*)(h_dst(p, tok) + n0 + ch * 4) = oldv[k] + gt * y;
          }
      }
      __syncthreads();
    }
  } else {
    const bool vt = (EPI == EPI_KVB && nt >= 2) || (EPI == EPI_C_IN && nt >= 8 && nt < 12);
#pragma unroll
    for (int j = 0; j < NJ; ++j) {
      const int rl = tb + j * 32 + l31;
      float rs = 1.f;
      if (EPI == EPI_QB || EPI == EPI_KVB) rs = rstd[rl];
#pragma unroll
      for (int i = 0; i < NI; ++i)
#pragma unroll
        for (int g = 0; g < 4; ++g) {
          const int fl = fb + i * 32 + 8 * g + 4 * hh;
          float v0 = acc[i][j][4 * g], v1 = acc[i][j][4 * g + 1], v2 = acc[i][j][4 * g + 2], v3 = acc[i][j][4 * g + 3];
          epi_math<EPI>(p, m0 + rl, n0 + fl, v0, v1, v2, v3, rs);
          const unsigned w01 = pack_bf16(v0, v1), w23 = pack_bf16(v2, v3);
          if (!vt) {
            u32x2 wv; wv.x = w01; wv.y = w23;
            *(u32x2*)(lds + rl * SB + fl * 2) = wv;
          } else {
            *(bf16_t*)(lds + (fl + 0) * SV + rl * 2) = (bf16_t)(w01 & 0xffffu);
            *(bf16_t*)(lds + (fl + 1) * SV + rl * 2) = (bf16_t)(w01 >> 16);
            *(bf16_t*)(lds + (fl + 2) * SV + rl * 2) = (bf16_t)(w23 & 0xffffu);
            *(bf16_t*)(lds + (fl + 3) * SV + rl * 2) = (bf16_t)(w23 >> 16);
          }
        }
    }
    prefetch_next();
    __syncthreads();
#pragma unroll 4
    for (int it = 0; it < NIT; ++it) {
      const int cidx = tid + NT * it;
      if (vt) {
        const int row = cidx / (TM / 8), ch = cidx % (TM / 8);
        *(u32x4*)dst_v<EPI>(p, m0 + ch * 8, n0 + row) = *(const u32x4*)(lds + row * SV + ch * 16);
      } else {
        const int row = cidx >> 5, ch = cidx & 31;
        bf16_t* d = dst_tr<EPI>(p, m0 + row, n0 + ch * 8);
        if (d) *(u32x4*)d = *(const u32x4*)(lds + row * SB + ch * 16);
      }
    }
    __syncthreads();
  }
}

template <int EPI>
DI void gemm_phase(const Params& p, int layer, const bf16_t* A, int lda, const bf16_t* Bt, int K, int mtiles, int ntiles, bool ctx, bool reverse, char* lds) {
  const int G = ogrid();
  const int bid = reverse ? (G - 1 - obid()) : obid();
  u32x4 ra[4], rb[4];
  const bool simple = (G & 7) != 0;
  const int xcd = bid & 7, local = simple ? bid : (bid >> 3), nlocal = simple ? G : (G >> 3);
  const int mlo = simple ? 0 : ((xcd * mtiles) >> 3), cnt = simple ? mtiles : ((((xcd + 1) * mtiles) >> 3) - mlo);
  const int total = cnt * ntiles, gsize = 4 * ntiles;
  auto tile_of = [&](int j, int& m0, int& nt) {
    const int g = j / gsize, r = j - g * gsize;
    int gm = cnt - g * 4; gm = gm > 4 ? 4 : gm;
    m0 = (mlo + g * 4 + (r % gm)) * 256; nt = r / gm;
  };
  bool pre = false;
  for (int j = local; j < total; j += nlocal) {
    int m0, nt; tile_of(j, m0, nt);
    TilePf pf; pf.pre = pre; pf.has_next = (j + nlocal < total); pf.nm0 = 0; pf.nnt = 0;
    if (pf.has_next) tile_of(j + nlocal, pf.nm0, pf.nnt);
    gemm_tile<EPI, 256>(p, layer, A, lda, Bt, K, m0, nt, lds, ra, rb, pf);
    pre = pf.has_next;
  }
  if (ctx) {
    const int b2 = G - 1 - bid;
    u32x4 ra1[1];
    TilePf pf; pf.pre = false; pf.has_next = false; pf.nm0 = 0; pf.nnt = 0;
    for (int u = b2; u < 16 * ntiles; u += G) gemm_tile<EPI, 64>(p, layer, A, lda, Bt, K, T_LAT + (u & 15) * 64, u >> 4, lds, ra1, rb, pf);
  }
}

DI void vta_phase(const Params& p, char* lds) {
  const int tid = otid();
  const bf16_t* Pb = (const bf16_t*)(p.ws + OFF_P);
  for (int u = ogrid() - 1 - obid(); u < T_ALL / 64; u += ogrid()) {
    const int t0 = u * 64;
#pragma unroll
    for (int it = 0; it < 2; ++it) {
      const int cidx = tid + NT * it, row = cidx >> 4, ch = cidx & 15;
      *(u32x4*)(lds + row * 272 + ch * 16) = *(const u32x4*)(Pb + (size_t)(t0 + row) * 2560 + 640 + ch * 8);
    }
    __syncthreads();
    int b, key; tok_bk(t0, b, key);
#pragma unroll
    for (int it = 0; it < 2; ++it) {
      const int cidx = tid + NT * it, f = cidx & 127, tc = cidx >> 7;
      unsigned short e[8];
#pragma unroll
      for (int k = 0; k < 8; ++k) e[k] = *(const bf16_t*)(lds + (tc * 8 + k) * 272 + f * 2);
      u32x4 v; v.x = e[0] | ((unsigned)e[1] << 16); v.y = e[2] | ((unsigned)e[3] << 16); v.z = e[4] | ((unsigned)e[5] << 16); v.w = e[6] | ((unsigned)e[7] << 16);
      *(u32x4*)((bf16_t*)(p.ws + OFF_VT) + ((size_t)(b * 2 + (f >> 6)) * 64 + (f & 63)) * NKEY + key + tc * 8) = v;
    }
    __syncthreads();
  }
}

template <int MODE>
DI void attn_item(const Params& p, int layer, int b, int qt, int head, bool is_ctx, char* lds) {
  constexpr int DK = (MODE == 1) ? 96 : 64;
  constexpr int NKS = DK / 16;
  constexpr int KSTR = DK * 2 + 16;
  constexpr int VSTR = 144;
  constexpr int KBYTES = 64 * KSTR;
  constexpr int STAGE = KBYTES + 64 * VSTR;
  constexpr int QPB = 256;
  constexpr int NKC = DK / 8;
  constexpr int KCH = 64 * NKC;
  constexpr int OSTR = 272;
  constexpr float MASKV = -1e30f;
  float* rpbs = (float*)(lds + 4 * STAGE);
  char* ostage = lds;

  const int tid = otid(), lane = tid & 63, w = tid >> 6, l31 = lane & 31, hh = lane >> 5;
  const int i2 = layer >> 1;
  const bf16_t* Pb = (const bf16_t*)(p.ws + OFF_P);
  bf16_t* UG = (bf16_t*)(p.ws + OFF_UG);
  const bf16_t *Qp, *Kp, *Krp = nullptr, *Zp, *Vt;
  int ldq, ldk, ldz, gcol;
  if (MODE == 0) {
    Qp = Pb + head * 64; ldq = 2560; Kp = Pb + 512 + (head >> 2) * 64; ldk = 2560;
    Vt = (const bf16_t*)(p.ws + OFF_VT) + (size_t)(b * 2 + (head >> 2)) * 64 * NKEY;
    Zp = Pb + 768 + head * 64; ldz = 2560; gcol = head * 64;
  } else if (MODE == 1) {
    Qp = (const bf16_t*)(p.ws + OFF_QB) + head * 96; ldq = 768; Kp = (const bf16_t*)(p.ws + OFF_KB) + head * 64; ldk = 512; Krp = Pb + 1920;
    Vt = (const bf16_t*)(p.ws + OFF_VTB) + (size_t)(b * 8 + head) * 64 * NKEY;
    Zp = Pb + 1952 + head * 64; ldz = 2560; gcol = 512 + head * 64;
  } else {
    Qp = Pb + head * 64; ldq = 3072; Kp = Pb + 1024 + head * 64; ldk = 3072;
    Vt = (const bf16_t*)(p.ws + OFF_VT) + (size_t)(b * 16 + head) * 64 * NKEY;
    Zp = Pb + 2048 + head * 64; ldz = 3072; gcol = head * 64;
  }
  const int qtok0 = is_ctx ? T_LAT + b * 256 : b * 8192 + qt * QPB;

  int lat_lo = 0, nlat = 0;
  if (!is_ctx) {
    if (MODE == 0) {
      int lo = 4 * qt - 2; if (lo < 0) lo = 0;
      int hi = 4 * qt + 5; if (hi > 127) hi = 127;
      lat_lo = lo; nlat = hi - lo + 1;
    } else if (MODE == 1) { lat_lo = 0; nlat = 128; }
    else {
      int lo = 4 * qt - 4; lo = lo < 0 ? 0 : (lo > 120 ? 120 : lo);
      int hi = 4 * qt + 3 - 4; hi = hi < 0 ? 0 : (hi > 120 ? 120 : hi); hi += 7;
      lat_lo = lo; nlat = hi - lo + 1;
    }
  }
  const int ntiles = nlat + 4;

  const bool nat2 = (MODE == 2) && !is_ctx;
  auto tokmap = [&](int row) { return nat2 ? qtok0 + ((w >> 2) * 2 + (row >> 4)) * 64 + (w & 3) * 16 + (row & 15) : qtok0 + w * 32 + row; };
  const int qtok = tokmap(l31);
  bf16x8 qf[NKS];
#pragma unroll
  for (int ks = 0; ks < NKS; ++ks) qf[ks] = *(const bf16x8*)(Qp + (size_t)qtok * ldq + ks * 16 + hh * 8);
  if (MODE == 2 && !is_ctx) {
    for (int i = tid; i < 465; i += NT) rpbs[i] = p.c_rpb[(size_t)(i2 * 16 + head) * 465 + i] * LOG2E;
  }
  float m_ = (MODE == 0) ? p.a_sink[i2 * 8 + head] * LOG2E : MASKV;
  float l_ = (MODE == 0 && hh == 0) ? 1.f : 0.f;
  f32x16 O[2];
#pragma unroll
  for (int dh = 0; dh < 2; ++dh)
#pragma unroll
    for (int r = 0; r < 16; ++r) O[dh][r] = 0.f;

  const int k0row = tid / NKC, k0cc = tid % NKC;
  const int k1row = (tid + NT) / NKC, k1cc = (tid + NT) % NKC;
  const bool k1 = (KCH > NT) && (tid + NT < KCH);
  struct Stg { u32x4 k0, k1, v; };
  Stg R0, R1;
  R0.k1 = (u32x4){0u, 0u, 0u, 0u}; R1.k1 = R0.k1;
  auto tile_kt = [&](int i) { return i < nlat ? lat_lo + i : 128 + (i - nlat); };
  auto kload = [&](int krow0, int row, int cc) -> u32x4 {
    if (MODE == 1 && cc >= 8) return *(const u32x4*)(Krp + (size_t)(krow0 + row) * 2560 + (cc - 8) * 8);
    return *(const u32x4*)(Kp + (size_t)(krow0 + row) * ldk + cc * 8);
  };
  auto gload = [&](int i, Stg& r) {
    const int kt = tile_kt(i < ntiles ? i : ntiles - 1);
    const int krow0 = kt < 128 ? b * 8192 + kt * 64 : T_LAT + b * 256 + (kt - 128) * 64;
    r.k0 = kload(krow0, k0row, k0cc);
    if (k1) r.k1 = kload(krow0, k1row, k1cc);
    r.v = *(const u32x4*)(Vt + (size_t)(tid >> 3) * NKEY + kt * 64 + (tid & 7) * 8);
  };
  auto lstore = [&](int st, const Stg& r) {
    char* kb = lds + st * STAGE;
    *(u32x4*)(kb + k0row * KSTR + k0cc * 16) = r.k0;
    if (k1) *(u32x4*)(kb + k1row * KSTR + k1cc * 16) = r.k1;
    *(u32x4*)(kb + KBYTES + (tid >> 3) * VSTR + (tid & 7) * 16) = r.v;
  };

  const int pr = (l31 & ~12) | ((l31 & 4) << 1) | ((l31 & 8) >> 1);
  int qr = 0, qc = 0, rs0 = 0, cs = 0, csw = 0, wlo = 0, whi = 0;
  if (MODE == 2) {
    qr = qt * 4 + (w >> 2) * 2 + (l31 >> 4); qc = (w & 3) * 16 + (l31 & 15);
    rs0 = qr - 4; rs0 = rs0 < 0 ? 0 : (rs0 > 120 ? 120 : rs0);
    cs = qc - 8; cs = cs < 0 ? 0 : (cs > 48 ? 48 : cs);
    csw = (w & 3) * 16 - 8; csw = csw < 0 ? 0 : (csw > 32 ? 32 : csw);
    const int r_lo = qt * 4 + (w >> 2) * 2;
    wlo = r_lo - 4; wlo = wlo < 0 ? 0 : (wlo > 120 ? 120 : wlo);
    whi = r_lo + 1 - 4; whi = whi < 0 ? 0 : (whi > 120 ? 120 : whi); whi += 7;
  }
  const int s0w = qt * QPB + w * 32;
  const int nsup = (ntiles + 1) >> 1;
  __syncthreads();
  gload(0, R0); gload(1, R1);
  lstore(0, R0); lstore(1, R1);
  gload(2, R0); gload(3, R1);
  __syncthreads();
  auto body = [&](int it, const char* kb) {
    const char* vb = kb + KBYTES;
    const int kt = tile_kt(it);
    const bool lat_tile = it < nlat;
    bool skip = (it >= ntiles);
    if (MODE == 2 && lat_tile) skip = (kt < wlo) || (kt > whi);
    if (MODE == 0 && lat_tile) skip = (kt * 64 + 63 < s0w - 128) || (kt * 64 > s0w + 31 + 128);
    const int nsub = (MODE == 2 && lat_tile) ? 1 : 2;
    const int krb = (MODE == 2 && lat_tile) ? csw : 0;
    if (!skip) {
      f32x16 S[2];
#pragma unroll
      for (int t = 0; t < 2; ++t)
#pragma unroll
        for (int r = 0; r < 16; ++r) S[t][r] = 0.f;
#pragma unroll
      for (int ks = 0; ks < NKS; ++ks) {
        const bf16x8 a0 = *(const bf16x8*)(kb + (krb + pr) * KSTR + ks * 32 + hh * 16);
        S[0] = MFMA32(a0, qf[ks], S[0]);
        if (nsub == 2) {
          const bf16x8 a1 = *(const bf16x8*)(kb + (32 + pr) * KSTR + ks * 32 + hh * 16);
          S[1] = MFMA32(a1, qf[ks], S[1]);
        }
      }
      if (MODE == 0 && lat_tile) {
        const int s = qt * QPB + w * 32 + l31;
#pragma unroll
        for (int t = 0; t < 2; ++t)
#pragma unroll
          for (int r = 0; r < 16; ++r) {
            const int kk = kt * 64 + t * 32 + 16 * (r >> 3) + 8 * hh + (r & 7);
            const int d = kk - s;
            if (d > 128 || d < -128) S[t][r] = MASKV;
          }
      }
      if (MODE == 2 && lat_tile) {
        int ri = kt - qr + 7; ri = ri < 0 ? 0 : (ri > 14 ? 14 : ri);
        const float* brow = rpbs + ri * 31;
        const bool rok = (kt >= rs0) && (kt <= rs0 + 7);
        float bv[16];
#pragma unroll
        for (int r = 0; r < 16; ++r) {
          const int kc = csw + 16 * (r >> 3) + 8 * hh + (r & 7);
          int bi = kc - qc + 15; bi = bi < 0 ? 0 : (bi > 30 ? 30 : bi);
          bv[r] = brow[bi];
        }
#pragma unroll
        for (int r = 0; r < 16; ++r) asm volatile("" : "+v"(bv[r]));
#pragma unroll
        for (int r = 0; r < 16; ++r) {
          const int kc = csw + 16 * (r >> 3) + 8 * hh + (r & 7);
          const bool ok = rok && (kc >= cs) && (kc < cs + 16);
          S[0][r] = ok ? S[0][r] + bv[r] : MASKV;
        }
      }
      float mx = S[0][0];
#pragma unroll
      for (int r = 0; r < 16; ++r) mx = fmaxf(mx, S[0][r]);
      if (nsub == 2) {
#pragma unroll
        for (int r = 0; r < 16; ++r) mx = fmaxf(mx, S[1][r]);
      }
      mx = fmaxf(mx, __shfl_xor(mx, 32));
      if (__any(mx > m_ + 8.f)) {
        const float mnew = fmaxf(m_, mx);
        const float alpha = fexp2(m_ - mnew);
        m_ = mnew;
        l_ *= alpha;
#pragma unroll
        for (int dh = 0; dh < 2; ++dh)
#pragma unroll
          for (int r = 0; r < 16; ++r) O[dh][r] *= alpha;
      }
      float rsum = 0.f;
#pragma unroll
      for (int t = 0; t < 2; ++t)
        if (t < nsub) {
#pragma unroll
          for (int r = 0; r < 16; ++r) { const float e = fexp2(S[t][r] - m_); S[t][r] = e; rsum += e; }
        }
      l_ += rsum;
#pragma unroll
      for (int t = 0; t < 2; ++t)
       if (t < nsub)
#pragma unroll
        for (int s = 0; s < 2; ++s) {
          u32x4 u;
          u.x = pack_bf16(S[t][8 * s + 0], S[t][8 * s + 1]); u.y = pack_bf16(S[t][8 * s + 2], S[t][8 * s + 3]);
          u.z = pack_bf16(S[t][8 * s + 4], S[t][8 * s + 5]); u.w = pack_bf16(S[t][8 * s + 6], S[t][8 * s + 7]);
          const bf16x8 pf = __builtin_bit_cast(bf16x8, u);
#pragma unroll
          for (int dh = 0; dh < 2; ++dh) {
            const bf16x8 v = *(const bf16x8*)(vb + (dh * 32 + l31) * VSTR + (krb + t * 32 + s * 16 + hh * 8) * 2);
            O[dh] = MFMA32(v, pf, O[dh]);
          }
        }
    }
  };
  for (int j = 0; j < nsup; ++j) {
    const char* sb = lds + (j & 1) * 2 * STAGE;
    body(2 * j, sb);
    body(2 * j + 1, sb + STAGE);
    __builtin_amdgcn_sched_barrier(0);
    {
      const int so = ((j + 1) & 1) * 2;
      lstore(so, R0); lstore(so + 1, R1);
      gload(2 * j + 4, R0); gload(2 * j + 5, R1);
    }
    __syncthreads();
  }

  {
    const float lt = l_ + __shfl_xor(l_, 32);
    const float inv = 1.f / lt;
    char* orow = ostage + (w * 32) * OSTR;
#pragma unroll
    for (int dh = 0; dh < 2; ++dh)
#pragma unroll
      for (int g = 0; g < 4; ++g) {
        f32x4 v; v[0] = O[dh][4 * g] * inv; v[1] = O[dh][4 * g + 1] * inv; v[2] = O[dh][4 * g + 2] * inv; v[3] = O[dh][4 * g + 3] * inv;
        *(f32x4*)(orow + l31 * OSTR + (dh * 32 + 8 * g + 4 * hh) * 4) = v;
      }
    __builtin_amdgcn_s_waitcnt(0xc07f);
#pragma unroll
    for (int it = 0; it < 4; ++it) {
      const int cidx = lane + 64 * it, row = cidx >> 3, ch = cidx & 7;
      const f32x4 o0 = *(const f32x4*)(orow + row * OSTR + ch * 32), o1 = *(const f32x4*)(orow + row * OSTR + ch * 32 + 16);
      const int tok = tokmap(row);
      const u32x4 z = *(const u32x4*)(Zp + (size_t)tok * ldz + ch * 8);
      u32x4 wv;
      wv.x = pack_bf16(o0[0] * silu(bf_lo(z.x)), o0[1] * silu(bf_hi(z.x)));
      wv.y = pack_bf16(o0[2] * silu(bf_lo(z.y)), o0[3] * silu(bf_hi(z.y)));
      wv.z = pack_bf16(o1[0] * silu(bf_lo(z.z)), o1[1] * silu(bf_hi(z.z)));
      wv.w = pack_bf16(o1[2] * silu(bf_lo(z.w)), o1[3] * silu(bf_hi(z.w)));
      *(u32x4*)(UG + ablk(tok, gcol + ch * 8)) = wv;
    }
  }
}

DI void mla_item2(const Params& p, int layer, int b, int qt, int head, char* lds) {
  constexpr int DK = 96, NKS = 6, KSTR = DK * 2 + 16, VSTR = 144, KBYTES = 64 * KSTR, STAGE = KBYTES + 64 * VSTR;
  constexpr int NKC = 12, KCH = 64 * NKC, OSTR = 272, QG = 2, NTILES = 132;
  constexpr float MASKV = -1e30f;
  char* ostage = lds;
  const int tid = otid(), lane = tid & 63, w = tid >> 6, l31 = lane & 31, hh = lane >> 5;
  const bf16_t* Pb = (const bf16_t*)(p.ws + OFF_P);
  bf16_t* UG = (bf16_t*)(p.ws + OFF_UG);
  const bf16_t* Qp = (const bf16_t*)(p.ws + OFF_QB) + head * 96;
  const bf16_t* Kp = (const bf16_t*)(p.ws + OFF_KB) + head * 64;
  const bf16_t* Krp = Pb + 1920;
  const bf16_t* Vt = (const bf16_t*)(p.ws + OFF_VTB) + (size_t)(b * 8 + head) * 64 * NKEY;
  const bf16_t* Zp = Pb + 1952 + head * 64;
  const int gcol = 512 + head * 64;
  const int qtok0 = b * 8192 + qt * 512;
  bf16x8 qf[QG][NKS];
#pragma unroll
  for (int qg = 0; qg < QG; ++qg)
#pragma unroll
    for (int ks = 0; ks < NKS; ++ks) qf[qg][ks] = *(const bf16x8*)(Qp + (size_t)(qtok0 + qg * 256 + w * 32 + l31) * 768 + ks * 16 + hh * 8);
  float m_[QG], l_[QG];
  f32x16 O[QG][2];
#pragma unroll
  for (int qg = 0; qg < QG; ++qg) {
    m_[qg] = MASKV; l_[qg] = 0.f;
#pragma unroll
    for (int dh = 0; dh < 2; ++dh)
#pragma unroll
      for (int r = 0; r < 16; ++r) O[qg][dh][r] = 0.f;
  }
  const int k0row = tid / NKC, k0cc = tid % NKC;
  const int k1row = (tid + NT) / NKC, k1cc = (tid + NT) % NKC;
  const bool k1 = (tid + NT < KCH);
  struct Stg { u32x4 k0, k1, v; };
  Stg R0;
  R0.k1 = (u32x4){0u, 0u, 0u, 0u};
  auto kload = [&](int krow0, int row, int cc) -> u32x4 {
    if (cc >= 8) return *(const u32x4*)(Krp + (size_t)(krow0 + row) * 2560 + (cc - 8) * 8);
    return *(const u32x4*)(Kp + (size_t)(krow0 + row) * 512 + cc * 8);
  };
  auto gload = [&](int i, Stg& r) {
    const int kt = i < NTILES ? i : NTILES - 1;
    const int krow0 = kt < 128 ? b * 8192 + kt * 64 : T_LAT + b * 256 + (kt - 128) * 64;
    r.k0 = kload(krow0, k0row, k0cc);
    if (k1) r.k1 = kload(krow0, k1row, k1cc);
    r.v = *(const u32x4*)(Vt + (size_t)(tid >> 3) * NKEY + kt * 64 + (tid & 7) * 8);
  };
  auto lstore = [&](int st, const Stg& r) {
    char* kb = lds + st * STAGE;
    *(u32x4*)(kb + k0row * KSTR + k0cc * 16) = r.k0;
    if (k1) *(u32x4*)(kb + k1row * KSTR + k1cc * 16) = r.k1;
    *(u32x4*)(kb + KBYTES + (tid >> 3) * VSTR + (tid & 7) * 16) = r.v;
  };
  const int pr = (l31 & ~12) | ((l31 & 4) << 1) | ((l31 & 8) >> 1);
  __syncthreads();
  gload(0, R0); lstore(0, R0);
  gload(1, R0);
  __syncthreads();
  auto body = [&](const char* kb) {
    const char* vb = kb + KBYTES;
    f32x16 S[QG][2];
#pragma unroll
    for (int qg = 0; qg < QG; ++qg)
#pragma unroll
      for (int t = 0; t < 2; ++t)
#pragma unroll
        for (int r = 0; r < 16; ++r) S[qg][t][r] = 0.f;
#pragma unroll
    for (int ks = 0; ks < NKS; ++ks) {
      const bf16x8 a0 = *(const bf16x8*)(kb + pr * KSTR + ks * 32 + hh * 16);
      const bf16x8 a1 = *(const bf16x8*)(kb + (32 + pr) * KSTR + ks * 32 + hh * 16);
#pragma unroll
      for (int qg = 0; qg < QG; ++qg) { S[qg][0] = MFMA32(a0, qf[qg][ks], S[qg][0]); S[qg][1] = MFMA32(a1, qf[qg][ks], S[qg][1]); }
    }
#pragma unroll
    for (int qg = 0; qg < QG; ++qg) {
      float mx = S[qg][0][0];
#pragma unroll
      for (int t = 0; t < 2; ++t)
#pragma unroll
        for (int r = 0; r < 16; ++r) mx = fmaxf(mx, S[qg][t][r]);
      mx = fmaxf(mx, __shfl_xor(mx, 32));
      if (__any(mx > m_[qg] + 8.f)) {
        const float mnew = fmaxf(m_[qg], mx);
        const float alpha = fexp2(m_[qg] - mnew);
        m_[qg] = mnew;
        l_[qg] *= alpha;
#pragma unroll
        for (int dh = 0; dh < 2; ++dh)
#pragma unroll
          for (int r = 0; r < 16; ++r) O[qg][dh][r] *= alpha;
      }
      float rsum = 0.f;
#pragma unroll
      for (int t = 0; t < 2; ++t)
#pragma unroll
        for (int r = 0; r < 16; ++r) { const float e = fexp2(S[qg][t][r] - m_[qg]); S[qg][t][r] = e; rsum += e; }
      l_[qg] += rsum;
    }
#pragma unroll
    for (int t = 0; t < 2; ++t)
#pragma unroll
      for (int s = 0; s < 2; ++s) {
        bf16x8 pf[QG];
#pragma unroll
        for (int qg = 0; qg < QG; ++qg) {
          u32x4 u;
          u.x = pack_bf16(S[qg][t][8 * s + 0], S[qg][t][8 * s + 1]); u.y = pack_bf16(S[qg][t][8 * s + 2], S[qg][t][8 * s + 3]);
          u.z = pack_bf16(S[qg][t][8 * s + 4], S[qg][t][8 * s + 5]); u.w = pack_bf16(S[qg][t][8 * s + 6], S[qg][t][8 * s + 7]);
          pf[qg] = __builtin_bit_cast(bf16x8, u);
        }
#pragma unroll
        for (int dh = 0; dh < 2; ++dh) {
          const bf16x8 v = *(const bf16x8*)(vb + (dh * 32 + l31) * VSTR + (t * 32 + s * 16 + hh * 8) * 2);
#pragma unroll
          for (int qg = 0; qg < QG; ++qg) O[qg][dh] = MFMA32(v, pf[qg], O[qg][dh]);
        }
      }
  };
  if (w >= 4) __builtin_amdgcn_s_setprio(2);
  for (int j = 0; j < NTILES; ++j) {
    body(lds + (j & 1) * STAGE);
    __builtin_amdgcn_sched_barrier(0);
    lstore((j + 1) & 1, R0);
    gload(j + 2, R0);
    __syncthreads();
  }
  __builtin_amdgcn_s_setprio(0);
#pragma unroll
  for (int qg = 0; qg < QG; ++qg) {
    const float lt = l_[qg] + __shfl_xor(l_[qg], 32);
    const float inv = 1.f / lt;
    char* orow = ostage + (w * 32) * OSTR;
#pragma unroll
    for (int dh = 0; dh < 2; ++dh)
#pragma unroll
      for (int g = 0; g < 4; ++g) {
        f32x4 v; v[0] = O[qg][dh][4 * g] * inv; v[1] = O[qg][dh][4 * g + 1] * inv; v[2] = O[qg][dh][4 * g + 2] * inv; v[3] = O[qg][dh][4 * g + 3] * inv;
        *(f32x4*)(orow + l31 * OSTR + (dh * 32 + 8 * g + 4 * hh) * 4) = v;
      }
    __builtin_amdgcn_s_waitcnt(0xc07f);
#pragma unroll
    for (int it = 0; it < 4; ++it) {
      const int cidx = lane + 64 * it, row = cidx >> 3, ch = cidx & 7;
      const f32x4 o0 = *(const f32x4*)(orow + row * OSTR + ch * 32), o1 = *(const f32x4*)(orow + row * OSTR + ch * 32 + 16);
      const int tok = qtok0 + qg * 256 + w * 32 + row;
      const u32x4 z = *(const u32x4*)(Zp + (size_t)tok * 2560 + ch * 8);
      u32x4 wv;
      wv.x = pack_bf16(o0[0] * silu(bf_lo(z.x)), o0[1] * silu(bf_hi(z.x)));
      wv.y = pack_bf16(o0[2] * silu(bf_lo(z.y)), o0[3] * silu(bf_hi(z.y)));
      wv.z = pack_bf16(o1[0] * silu(bf_lo(z.z)), o1[1] * silu(bf_hi(z.z)));
      wv.w = pack_bf16(o1[2] * silu(bf_lo(z.w)), o1[3] * silu(bf_hi(z.w)));
      *(u32x4*)(UG + ablk(tok, gcol + ch * 8)) = wv;
    }
    __builtin_amdgcn_s_waitcnt(0xc07f);
  }
}

DI void attn_phase_ab(const Params& p, int layer, char* lds) {
  const int G = ogrid();
  for (int v = obid(); v < 512; v += G) {
    const int xcd = v & 7, s = v >> 3;
    const int grp = (s >> 4) * 8 + xcd, qt = s & 15;
    mla_item2(p, layer, grp >> 3, qt, grp & 7, lds);
  }
  for (int v = obid(); v < 32; v += G) attn_item<1>(p, layer, v >> 3, 0, v & 7, true, lds);
  for (int v = obid(); v < 1024 + 32; v += G) {
    if (v < 1024) attn_item<0>(p, layer, v >> 8, v & 31, (v >> 5) & 7, false, lds);
    else { const int c = v - 1024; attn_item<0>(p, layer, c >> 3, 0, c & 7, true, lds); }
  }
}

DI void attn_phase_c(const Params& p, int layer, char* lds) {
  const int G = ogrid();
  const int nctx = (layer == 3) ? 0 : 64;
  for (int v = obid(); v < 2048 + nctx; v += G) {
    if (v < 2048) attn_item<2>(p, layer, v >> 9, v & 31, (v >> 5) & 15, false, lds);
    else { const int c = v - 2048; attn_item<2>(p, layer, c >> 4, 0, c & 15, true, lds); }
  }
}

__global__ void __launch_bounds__(512, 2) fwd_megakernel(Params p) {
  __shared__ __attribute__((aligned(16))) char lds[LDS_BYTES];
  __shared__ uint4 xb_words;
  if (threadIdx.x == 0) xb_words = make_uint4(0u, 0u, 0u, 0u);
  __syncthreads();
  if (obid() == 0) { unsigned* bw = (unsigned*)(p.ws + OFF_BAR); for (int i = otid(); i < 4096; i += NT) bw[i] = 0u; }
  XcdBarrier xb; xb.bar = (unsigned*)(p.ws + OFF_BAR); xb.x = 0; xb.st = (volatile LAS unsigned*)&xb_words;
  bool first = true, posted = false;
  for (int ph = p.ph_begin; ph < p.ph_end; ++ph) {
    const int layer = (ph - 1) / 5, s = (ph - 1) % 5;
    const bool even = (layer & 1) == 0;
    const int i2 = layer >> 1;
    if (ph >= 1 && ph <= 20 && s == 2 && !even) continue;
    if (!first) {
      if (!posted) { cg::this_grid().sync(); xb = xcd_barrier_post((unsigned*)(p.ws + OFF_BAR), (volatile LAS unsigned*)&xb_words); posted = true; }
      else xcd_barrier(xb);
    }
    first = false;
    if (ph == 0) prologue_phase(p, lds);
    else if (ph == 21) final_phase(p);
    else if (s == 0) norm_phase(p, layer);
    else if (s == 1) {
      const bf16_t* U = (const bf16_t*)(p.ws + OFF_UG);
      if (even) gemm_phase<EPI_AB_IN>(p, layer, U, 0, (const bf16_t*)(p.ws + OFF_W_IN) + (size_t)i2 * 2560 * 1024, 1024, 128, 10, true, false, lds);
      else gemm_phase<EPI_C_IN>(p, layer, U, 0, (const bf16_t*)(p.ws + OFF_W_CIN) + (size_t)i2 * 4096 * 1024, 1024, 128, 16, true, false, lds);
    } else if (s == 2) {
      const bf16_t* Pb = (const bf16_t*)(p.ws + OFF_P);
      gemm_phase<EPI_QB>(p, layer, Pb + 1280, 2560, (const bf16_t*)(p.ws + OFF_W_UQ) + (size_t)i2 * 768 * 384, 384, 128, 3, true, false, lds);
      gemm_phase<EPI_KVB>(p, layer, Pb + 1664, 2560, (const bf16_t*)(p.ws + OFF_W_UKV) + (size_t)i2 * 1024 * 256, 256, 128, 4, true, true, lds);
      vta_phase(p, lds);
    } else if (s == 3) {
      if (even) attn_phase_ab(p, layer, lds); else attn_phase_c(p, layer, lds);
    } else {
      const bf16_t* Gm = (const bf16_t*)(p.ws + OFF_UG);
      const bf16_t* W = even ? (const bf16_t*)(p.ws + OFF_W_OUT) + (size_t)i2 * 1024 * 1024 : (const bf16_t*)(p.ws + OFF_W_COUT) + (size_t)i2 * 1024 * 1024;
      gemm_phase<EPI_OUT>(p, layer, Gm, 0, W, 1024, 128, 4, layer != 3, false, lds);
    }
  }
}

extern "C" void kernel_launch(void* const* d_in, const int* in_sizes, int n_in, void* d_out, int out_size, void* d_ws, size_t ws_size,
                              hipStream_t stream) {
  static int grid_blocks = 0;
  if (!grid_blocks) {
    int dev = 0, cus = 0, per_cu = 0;
    hipGetDevice(&dev);
    hipDeviceGetAttribute(&cus, hipDeviceAttributeMultiprocessorCount, dev);
    hipOccupancyMaxActiveBlocksPerMultiprocessor(&per_cu, fwd_megakernel, NT, 0);
    per_cu = 1;
    grid_blocks = cus * per_cu;
    if (ws_size < OFF_END) fprintf(stderr, "kernel_launch: workspace too small: %zu < %zu\n", ws_size, (size_t)OFF_END);
  }
  Params p{};
  const float** f = (const float**)&p;
  for (int i = 0; i < 18; ++i) f[i] = (const float*)d_in[i];
  p.out = (float*)d_out;
  p.ws = (char*)d_ws;
#if MK_MULTI_LAUNCH
  for (int ph = 0; ph < 22; ++ph) {
    if (ph >= 1 && ph <= 20 && ((ph - 1) % 5) == 2 && (((ph - 1) / 5) & 1)) continue;
    p.ph_begin = ph; p.ph_end = ph + 1;
    hipLaunchKernelGGL(fwd_megakernel, dim3(grid_blocks), dim3(NT), 0, stream, p);
  }
#else
  p.ph_begin = 0; p.ph_end = 22;
  void* args[] = {&p};
  hipError_t e = hipLaunchCooperativeKernel((void*)fwd_megakernel, dim3(grid_blocks), dim3(NT), args, 0, stream);
  if (e != hipSuccess) fprintf(stderr, "cooperative launch failed: %s (grid %d)\n", hipGetErrorString(e), grid_blocks);
#endif
}
```

```cpp
#include <hip/hip_runtime.h>
#include <hip/hip_cooperative_groups.h>
#include <stdint.h>
#include <stdio.h>
namespace cg = cooperative_groups;

#ifndef MK_MULTI_LAUNCH
#define MK_MULTI_LAUNCH 0
#endif

typedef unsigned short bf16_t;
typedef short bf16x8 __attribute__((ext_vector_type(8)));
typedef float f32x16 __attribute__((ext_vector_type(16)));
typedef float f32x4 __attribute__((ext_vector_type(4)));
typedef float f32x2 __attribute__((ext_vector_type(2)));
typedef unsigned u32x4 __attribute__((ext_vector_type(4)));
typedef unsigned u32x2 __attribute__((ext_vector_type(2)));

#define DI __device__ __forceinline__
#define MFMA32(a, b, c) __builtin_amdgcn_mfma_f32_32x32x16_bf16((a), (b), (c), 0, 0, 0)

constexpr int T_LAT = 32768, T_ALL = 33792, NKEY = 8448, NT = 512;
constexpr float LOG2E = 1.4426950408889634f;
constexpr float QSCALE_A = 0.125f * LOG2E;
constexpr float QSCALE_B = 0.10206207261596575f * LOG2E;

constexpr size_t OFF_HC   = 0;
constexpr size_t OFF_UG   = OFF_HC + 1024ull * 1024 * 4;
constexpr size_t OFF_P    = OFF_UG + (size_t)T_ALL * 1024 * 2;
constexpr size_t OFF_QB   = OFF_P + (size_t)T_ALL * 2560 * 2;
constexpr size_t OFF_KB   = OFF_QB + (size_t)T_ALL * 768 * 2;
constexpr size_t OFF_VT   = OFF_KB + (size_t)T_ALL * 512 * 2;
constexpr size_t OFF_VTB  = OFF_VT + 4ull * 2 * 64 * NKEY * 2;
constexpr size_t OFF_W    = OFF_VT + 4ull * 16 * 64 * NKEY * 2;
constexpr size_t OFF_W_IN   = OFF_W;
constexpr size_t OFF_W_OUT  = OFF_W_IN + 2ull * 2560 * 1024 * 2;
constexpr size_t OFF_W_UQ   = OFF_W_OUT + 2ull * 1024 * 1024 * 2;
constexpr size_t OFF_W_UKV  = OFF_W_UQ + 2ull * 768 * 384 * 2;
constexpr size_t OFF_W_CIN  = OFF_W_UKV + 2ull * 1024 * 256 * 2;
constexpr size_t OFF_W_COUT = OFF_W_CIN + 2ull * 4096 * 1024 * 2;
constexpr size_t OFF_MOD    = OFF_W_COUT + 2ull * 1024 * 1024 * 2;
constexpr size_t OFF_ROPE   = OFF_MOD + 4ull * 5 * 3072 * 4;
constexpr size_t OFF_BAR    = OFF_ROPE + 2ull * 8192 * 32 * 4 + 2ull * 8192 * 16 * 4;
constexpr size_t OFF_END    = OFF_BAR + 16384;

struct Params {
  const float *x, *c, *ctx, *c_ctx, *ada_w, *ada_b, *norm_g, *ab_in_w, *ab_out_w, *a_sink, *b_qn_g, *b_w_uq, *b_kvn_g, *b_w_ukv,
      *c_in_w, *c_out_w, *c_rpb, *final_g;
  float* out;
  char* ws;
  int ph_begin, ph_end;
};

DI int otid() { int t = threadIdx.x; asm volatile("" : "+v"(t)); return t; }
DI int obid() { int t = blockIdx.x; asm volatile("" : "+s"(t)); return t; }
DI int ogrid() { int t = gridDim.x; asm volatile("" : "+s"(t)); return t; }
DI unsigned pack_bf16(float lo, float hi) { unsigned r; asm("v_cvt_pk_bf16_f32 %0, %1, %2" : "=v"(r) : "v"(lo), "v"(hi)); return r; }
DI float bf_lo(unsigned u) { return __uint_as_float(u << 16); }
DI float bf_hi(unsigned u) { return __uint_as_float(u & 0xffff0000u); }
DI float fexp2(float x) { return __builtin_amdgcn_exp2f(x); }
DI float pair_max(float x) {
  const unsigned u = __float_as_uint(x);
  const auto r = __builtin_amdgcn_permlane32_swap(u, u, false, false);
  return fmaxf(__uint_as_float(r[0]), __uint_as_float(r[1]));
}
DI float silu(float z) { return z * __builtin_amdgcn_rcpf(1.f + __expf(-z)); }

DI size_t ablk(int tok, int k) { return ((size_t)((tok >> 8) * 16 + (k >> 6)) << 14) + ((tok & 255) << 6) + (k & 63); }
DI void tok_bk(int tok, int& b, int& key) {
  if (tok < T_LAT) { b = tok >> 13; key = tok & 8191; } else { int r = tok - T_LAT; b = r >> 8; key = 8192 + (r & 255); }
}
DI const float* h_src(const Params& p, int layer, int tok) {
  if (layer == 0) return tok < T_LAT ? p.x + (size_t)tok * 1024 : p.ctx + (size_t)(tok - T_LAT) * 1024;
  return tok < T_LAT ? p.out + (size_t)tok * 1024 : (const float*)(p.ws + OFF_HC) + (size_t)(tok - T_LAT) * 1024;
}
DI float* h_dst(const Params& p, int tok) {
  return tok < T_LAT ? p.out + (size_t)tok * 1024 : (float*)(p.ws + OFF_HC) + (size_t)(tok - T_LAT) * 1024;
}

#define XB_TMO      128
#define XB_XCNT(j)  (256  + 64 * (j))
#define XB_XSUB(j)  (1280 + 64 * (j))
#define XB_XGEN(j)  (2304 + 64 * (j))
#define XB_TOP      3328
#define XB_TOPGEN   3392
#define XCD_BAR_WORDS 3456
#define XB_SPIN_CAP (1u << 22)
#define LAS __attribute__((address_space(3)))
DI unsigned xb_ld(unsigned* p) { return __hip_atomic_load(p, __ATOMIC_RELAXED, __HIP_MEMORY_SCOPE_AGENT); }
DI unsigned xb_add(unsigned* p, unsigned v) { return __hip_atomic_fetch_add(p, v, __ATOMIC_RELAXED, __HIP_MEMORY_SCOPE_AGENT); }
DI unsigned xb_xcc_id() { return (unsigned)__builtin_amdgcn_s_getreg((3 << 11) | 20) & 0xFu; }
#define XB_SPIN(cond, bar) do { unsigned _sp = 0; while (cond) { __builtin_amdgcn_s_sleep(1); \
    if ((++_sp & 255u) == 0u) { if (xb_ld(&(bar)[XB_TMO])) break; if (_sp > XB_SPIN_CAP) { atomicAdd(&(bar)[XB_TMO], 1u); break; } } } } while (0)
struct XcdBarrier { unsigned* bar; unsigned x; volatile LAS unsigned* st; };
DI XcdBarrier xcd_barrier_post(unsigned* bar, volatile LAS unsigned* st) {
  XcdBarrier b; b.bar = bar; b.x = xb_xcc_id(); b.st = st;
  if (threadIdx.x == 0) (void)xb_add(&bar[XB_XCNT(b.x)], 1u);
  return b;
}
DI void xcd_barrier_complete(unsigned* bar, unsigned x, unsigned& nloc, unsigned& nx) {
  const unsigned G = gridDim.x * gridDim.y * gridDim.z;
  unsigned sum, cnt, mine, sp = 0u;
  for (;;) {
    sum = 0u; cnt = 0u; mine = 0u;
#pragma unroll
    for (unsigned j = 0; j < 16; ++j) { const unsigned c = xb_ld(&bar[XB_XCNT(j)]); sum += c; cnt += (c > 0u) ? 1u : 0u; mine = (j == x) ? c : mine; }
    if (sum == G) break;
    __builtin_amdgcn_s_sleep(1);
    if ((++sp & 255u) == 0u) { if (xb_ld(&bar[XB_TMO])) break; if (sp > XB_SPIN_CAP) { atomicAdd(&bar[XB_TMO], 1u); break; } }
  }
  nloc = mine > 0u ? mine : 1u; nx = cnt > 0u ? cnt : 1u;
}
DI void xcd_barrier(const XcdBarrier& b) {
  asm volatile("s_waitcnt vmcnt(0)" ::: "memory");
  __syncthreads();
  if (threadIdx.x == 0) {
    unsigned* bar = b.bar;
    __builtin_amdgcn_s_waitcnt(0);
    unsigned nloc = b.st[0], nx = b.st[1];
    if (nloc == 0u) { xcd_barrier_complete(bar, b.x, nloc, nx); b.st[0] = nloc; b.st[1] = nx; }
    const unsigned old = xb_add(&bar[XB_XSUB(b.x)], 1u);
    const unsigned gen = old / nloc;
    if (old + 1u == (gen + 1u) * nloc) {
      __builtin_amdgcn_fence(__ATOMIC_RELEASE, "agent");
      asm volatile("s_waitcnt vmcnt(0)" ::: "memory");
      const unsigned og = xb_add(&bar[XB_TOP], 1u);
      const unsigned tg = og / nx;
      if (og + 1u == (tg + 1u) * nx) xb_add(&bar[XB_TOPGEN], 1u);
      else XB_SPIN(xb_ld(&bar[XB_TOPGEN]) == tg, bar);
      __builtin_amdgcn_fence(__ATOMIC_ACQUIRE, "agent");
      xb_add(&bar[XB_XGEN(b.x)], 1u);
      asm volatile("s_waitcnt vmcnt(0)" ::: "memory");
    } else {
      XB_SPIN(xb_ld(&bar[XB_XGEN(b.x)]) == gen, bar);
      __builtin_amdgcn_fence(__ATOMIC_ACQUIRE, "agent");
      asm volatile("s_waitcnt vmcnt(0)" ::: "memory");
    }
  }
  __syncthreads();
}

struct TJob { const float* src; const float* rs; bf16_t* dst; int K, N, tk, tn, perm; };
DI TJob tr_job(const Params& p, int t) {
  TJob j; j.rs = nullptr; j.perm = 0;
  const int i2 = t / 2312; t -= i2 * 2312;
  if (t < 640) { j.src = p.ab_in_w + (size_t)i2 * 1024 * 2464; j.K = 1024; j.N = 2464; j.dst = (bf16_t*)(p.ws + OFF_W_IN) + (size_t)i2 * 2560 * 1024; j.tk = t / 40; j.tn = t % 40; }
  else if ((t -= 640) < 256) { j.src = p.ab_out_w + (size_t)i2 * 1024 * 1024; j.K = 1024; j.N = 1024; j.dst = (bf16_t*)(p.ws + OFF_W_OUT) + (size_t)i2 * 1024 * 1024; j.tk = t / 16; j.tn = t % 16; }
  else if ((t -= 256) < 72) { j.src = p.b_w_uq + (size_t)i2 * 384 * 768; j.K = 384; j.N = 768; j.dst = (bf16_t*)(p.ws + OFF_W_UQ) + (size_t)i2 * 768 * 384; j.rs = p.b_qn_g + i2 * 384; j.tk = t / 12; j.tn = t % 12; }
  else if ((t -= 72) < 64) { j.src = p.b_w_ukv + (size_t)i2 * 256 * 1024; j.K = 256; j.N = 1024; j.dst = (bf16_t*)(p.ws + OFF_W_UKV) + (size_t)i2 * 1024 * 256; j.rs = p.b_kvn_g + i2 * 256; j.tk = t / 16; j.tn = t % 16; j.perm = 1; }
  else if ((t -= 64) < 1024) { j.src = p.c_in_w + (size_t)i2 * 1024 * 4096; j.K = 1024; j.N = 4096; j.dst = (bf16_t*)(p.ws + OFF_W_CIN) + (size_t)i2 * 4096 * 1024; j.tk = t / 64; j.tn = t % 64; }
  else { t -= 1024; j.src = p.c_out_w + (size_t)i2 * 1024 * 1024; j.K = 1024; j.N = 1024; j.dst = (bf16_t*)(p.ws + OFF_W_COUT) + (size_t)i2 * 1024 * 1024; j.tk = t / 16; j.tn = t % 16; }
  return j;
}
DI void tr_load(const TJob& j, int tid, float (&v)[8]) {
#pragma unroll
  for (int i = 0; i < 8; ++i) {
    const int kk = (tid >> 6) + 8 * i, n = j.tn * 64 + (tid & 63);
    float x = (n < j.N) ? j.src[(size_t)(j.tk * 64 + kk) * j.N + n] : 0.f;
    if (j.rs) x *= j.rs[j.tk * 64 + kk];
    v[i] = x;
  }
}

DI void prologue_phase(const Params& p, char* lds) {
  const int tid = otid();
  constexpr int N_MOD = 192, N_TR = 4624, N_ROPE = 768;
  for (int u = obid(); u < N_MOD + N_TR + N_ROPE; u += ogrid()) {
    if (u < N_MOD) {
      const int layer = u / 48, cb = u % 48;
      float* sl = (float*)lds;
      for (int i = tid; i < 5120; i += NT) {
        const int bb = i >> 10, k = i & 1023;
        const float cv = bb < 4 ? p.c[bb * 1024 + k] : p.c_ctx[k];
        sl[i] = silu(cv);
      }
      __syncthreads();
      const int col = cb * 64 + (tid & 63), kg = tid >> 6;
      float a0 = 0, a1 = 0, a2 = 0, a3 = 0, a4 = 0;
      const float* wp = p.ada_w + (size_t)layer * 1024 * 3072 + col;
#pragma unroll 32
      for (int k = kg * 128; k < kg * 128 + 128; ++k) {
        const float wv = wp[(size_t)k * 3072];
        a0 += sl[k] * wv; a1 += sl[1024 + k] * wv; a2 += sl[2048 + k] * wv; a3 += sl[3072 + k] * wv; a4 += sl[4096 + k] * wv;
      }
      float* red = (float*)(lds + 20480);
      red[(kg * 5 + 0) * 64 + (tid & 63)] = a0; red[(kg * 5 + 1) * 64 + (tid & 63)] = a1; red[(kg * 5 + 2) * 64 + (tid & 63)] = a2;
      red[(kg * 5 + 3) * 64 + (tid & 63)] = a3; red[(kg * 5 + 4) * 64 + (tid & 63)] = a4;
      __syncthreads();
      if (tid < 64) {
        float* mod = (float*)(p.ws + OFF_MOD);
        const float bias = p.ada_b[layer * 3072 + col];
#pragma unroll
        for (int bb = 0; bb < 5; ++bb) {
          float s = bias;
#pragma unroll
          for (int g = 0; g < 8; ++g) s += red[(g * 5 + bb) * 64 + tid];
          mod[(size_t)(layer * 5 + bb) * 3072 + col] = s;
        }
      }
      __syncthreads();
    } else if (u < N_MOD + N_TR) {
    } else {
      const int idx = (u - N_MOD - N_TR) * NT + tid;
      float* ropeA = (float*)(p.ws + OFF_ROPE);
      float* ropeB = ropeA + 2 * 8192 * 32;
      if (idx < 8192 * 32) {
        const int pos = idx >> 5, pr = idx & 31;
        const float pv = pr < 16 ? (float)(pos >> 6) : (float)(pos & 63);
        const float inv = exp2f(-(float)(pr & 15) * (13.287712379549449f / 16.f));
        const float ang = pv * inv;
        ropeA[idx] = cosf(ang); ropeA[8192 * 32 + idx] = sinf(ang);
      } else {
        const int j = idx - 8192 * 32;
        const int pos = j >> 4, pr = j & 15;
        const float pv = pr < 8 ? (float)(pos >> 6) : (float)(pos & 63);
        const float inv = exp2f(-(float)(pr & 7) * (13.287712379549449f / 8.f));
        const float ang = pv * inv;
        ropeB[j] = cosf(ang); ropeB[8192 * 16 + j] = sinf(ang);
      }
    }
  }
  {
    const int G = ogrid();
    int t = obid();
    float v[8], nv[8];
    TJob cur, nxt;
    if (t < N_TR) { cur = tr_job(p, t); tr_load(cur, tid, v); }
    int buf = 0;
    for (; t < N_TR; t += G) {
      const bool more = t + G < N_TR;
      if (more) { nxt = tr_job(p, t + G); tr_load(nxt, tid, nv); }
      float* tile = (float*)(lds + buf * 16640);
#pragma unroll
      for (int i = 0; i < 8; ++i) tile[((tid >> 6) + 8 * i) * 65 + (tid & 63)] = v[i];
      __syncthreads();
      {
        const int nn = tid & 63, k8 = (tid >> 6) * 8;
        int n = cur.tn * 64 + nn;
        if (cur.perm) n = ((n & 64) ? 512 : 0) + (n >> 7) * 64 + (n & 63);
        u32x4 w;
        w.x = pack_bf16(tile[(k8 + 0) * 65 + nn], tile[(k8 + 1) * 65 + nn]); w.y = pack_bf16(tile[(k8 + 2) * 65 + nn], tile[(k8 + 3) * 65 + nn]);
        w.z = pack_bf16(tile[(k8 + 4) * 65 + nn], tile[(k8 + 5) * 65 + nn]); w.w = pack_bf16(tile[(k8 + 6) * 65 + nn], tile[(k8 + 7) * 65 + nn]);
        *(u32x4*)(cur.dst + ((size_t)((n >> 8) * (cur.K >> 6) + cur.tk) << 14) + ((n & 255) << 6) + k8) = w;
      }
      buf ^= 1;
      if (more) {
        cur = nxt;
#pragma unroll
        for (int i = 0; i < 8; ++i) v[i] = nv[i];
      }
    }
    __syncthreads();
  }
}

DI float wave_sum(float v) {
#pragma unroll
  for (int o = 32; o >= 1; o >>= 1) v += __shfl_xor(v, o);
  return v;
}

DI void norm_phase(const Params& p, int layer) {
  const int lane = otid() & 63;
  const int wave = obid() * 8 + (otid() >> 6), nw = ogrid() * 8;
  const float* g = p.norm_g + layer * 1024;
  const float* mod = (const float*)(p.ws + OFF_MOD) + (size_t)layer * 5 * 3072;
  bf16_t* U = (bf16_t*)(p.ws + OFF_UG);
  f32x4 gv[4];
#pragma unroll
  for (int i = 0; i < 4; ++i) gv[i] = *(const f32x4*)(g + lane * 4 + 256 * i);
  f32x4 nv[4];
  if (wave < T_ALL) {
    const float* s0 = h_src(p, layer, wave);
#pragma unroll
    for (int i = 0; i < 4; ++i) nv[i] = *(const f32x4*)(s0 + lane * 4 + 256 * i);
  }
  for (int row = wave; row < T_ALL; row += nw) {
    const int bb = row < T_LAT ? (row >> 13) : 4;
    f32x4 v[4];
#pragma unroll
    for (int i = 0; i < 4; ++i) v[i] = nv[i];
    if (row + nw < T_ALL) {
      const float* s1 = h_src(p, layer, row + nw);
#pragma unroll
      for (int i = 0; i < 4; ++i) nv[i] = *(const f32x4*)(s1 + lane * 4 + 256 * i);
    }
    float ss = 0.f;
#pragma unroll
    for (int i = 0; i < 4; ++i) ss += v[i][0] * v[i][0] + v[i][1] * v[i][1] + v[i][2] * v[i][2] + v[i][3] * v[i][3];
    ss = wave_sum(ss);
    const float rstd = rsqrtf(ss * (1.f / 1024.f) + 1e-6f);
    const float* mrow = mod + bb * 3072;
#pragma unroll
    for (int i = 0; i < 4; ++i) {
      const int cidx = lane * 4 + 256 * i;
      const f32x4 sh = *(const f32x4*)(mrow + cidx), sc = *(const f32x4*)(mrow + 1024 + cidx);
      f32x4 o = (v[i] * rstd) * gv[i] * (sc + 1.f) + sh;
      u32x2 w; w.x = pack_bf16(o[0], o[1]); w.y = pack_bf16(o[2], o[3]);
      *(u32x2*)(U + ablk(row, cidx)) = w;
    }
  }
}

DI void final_phase(const Params& p) {
  const int lane = otid() & 63;
  const int wave = obid() * 8 + (otid() >> 6), nw = ogrid() * 8;
  f32x4 gv[4];
#pragma unroll
  for (int i = 0; i < 4; ++i) gv[i] = *(const f32x4*)(p.final_g + lane * 4 + 256 * i);
  f32x4 nv[4];
  if (wave < T_LAT) {
#pragma unroll
    for (int i = 0; i < 4; ++i) nv[i] = *(const f32x4*)(p.out + (size_t)wave * 1024 + lane * 4 + 256 * i);
  }
  for (int row = wave; row < T_LAT; row += nw) {
    float* src = p.out + (size_t)row * 1024;
    f32x4 v[4];
#pragma unroll
    for (int i = 0; i < 4; ++i) v[i] = nv[i];
    if (row + nw < T_LAT) {
#pragma unroll
      for (int i = 0; i < 4; ++i) nv[i] = *(const f32x4*)(p.out + (size_t)(row + nw) * 1024 + lane * 4 + 256 * i);
    }
    float ss = 0.f;
#pragma unroll
    for (int i = 0; i < 4; ++i) ss += v[i][0] * v[i][0] + v[i][1] * v[i][1] + v[i][2] * v[i][2] + v[i][3] * v[i][3];
    ss = wave_sum(ss);
    const float rstd = rsqrtf(ss * (1.f / 1024.f) + 1e-6f);
#pragma unroll
    for (int i = 0; i < 4; ++i) *(f32x4*)(src + lane * 4 + 256 * i) = (v[i] * rstd) * gv[i];
  }
}

enum { EPI_AB_IN = 0, EPI_QB = 1, EPI_KVB = 2, EPI_C_IN = 3, EPI_OUT = 4 };
constexpr int G_STR = 144;
constexpr int G_OPER = 256 * G_STR;
constexpr int G_STAGE = 2 * G_OPER;
constexpr int OFF_RSTD = 2 * G_STAGE;
constexpr int LDS_BYTES = OFF_RSTD + 1024;

DI void rope2(float& v0, float& v1, float& v2, float& v3, const float* cs, const float* sn) {
  const f32x2 c = *(const f32x2*)cs, s = *(const f32x2*)sn;
  const float a0 = v0 * c.x - v1 * s.x, a1 = v0 * s.x + v1 * c.x, a2 = v2 * c.y - v3 * s.y, a3 = v2 * s.y + v3 * c.y;
  v0 = a0; v1 = a1; v2 = a2; v3 = a3;
}

template <int EPI>
DI void epi_math(const Params& p, int tok, int f0, float& v0, float& v1, float& v2, float& v3, float rs) {
  const float* ropeA = (const float*)(p.ws + OFF_ROPE);
  const float* ropeB = ropeA + 2 * 8192 * 32;
  const bool lat = tok < T_LAT;
  const int pos = tok & 8191;
  if (EPI == EPI_AB_IN) {
    if (f0 < 640) {
      if (lat) { const int p0 = (f0 & 63) >> 1; rope2(v0, v1, v2, v3, ropeA + pos * 32 + p0, ropeA + 8192 * 32 + pos * 32 + p0); }
      if (f0 < 512) { v0 *= QSCALE_A; v1 *= QSCALE_A; v2 *= QSCALE_A; v3 *= QSCALE_A; }
    } else if (f0 >= 1920 && f0 < 1952) {
      if (lat) { const int p0 = (f0 - 1920) >> 1; rope2(v0, v1, v2, v3, ropeB + pos * 16 + p0, ropeB + 8192 * 16 + pos * 16 + p0); }
    }
  } else if (EPI == EPI_QB) {
    const float s = rs * QSCALE_B;
    v0 *= s; v1 *= s; v2 *= s; v3 *= s;
    const int fh = f0 % 96;
    if (fh >= 64 && lat) { const int p0 = (fh - 64) >> 1; rope2(v0, v1, v2, v3, ropeB + pos * 16 + p0, ropeB + 8192 * 16 + pos * 16 + p0); }
  } else if (EPI == EPI_KVB) {
    v0 *= rs; v1 *= rs; v2 *= rs; v3 *= rs;
  } else if (EPI == EPI_C_IN) {
    if (f0 < 1024) { v0 *= QSCALE_A; v1 *= QSCALE_A; v2 *= QSCALE_A; v3 *= QSCALE_A; }
  }
}

template <int EPI>
DI bf16_t* dst_tr(const Params& p, int tok, int col) {
  if (EPI == EPI_AB_IN) return col < 2464 ? (bf16_t*)(p.ws + OFF_P) + (size_t)tok * 2560 + col : nullptr;
  if (EPI == EPI_QB) return (bf16_t*)(p.ws + OFF_QB) + (size_t)tok * 768 + col;
  if (EPI == EPI_KVB) return (bf16_t*)(p.ws + OFF_KB) + (size_t)tok * 512 + col;
  return (bf16_t*)(p.ws + OFF_P) + (size_t)tok * 3072 + (col >= 3072 ? col - 1024 : col);
}
template <int EPI>
DI bf16_t* dst_v(const Params& p, int t0, int col) {
  int b, key; tok_bk(t0, b, key);
  if (EPI == EPI_KVB) return (bf16_t*)(p.ws + OFF_VTB) + ((size_t)(b * 8 + ((col - 512) >> 6)) * 64 + (col & 63)) * NKEY + key;
  return (bf16_t*)(p.ws + OFF_VT) + ((size_t)(b * 16 + ((col - 2048) >> 6)) * 64 + (col & 63)) * NKEY + key;
}

struct TilePf { bool pre; bool has_next; int nm0, nnt; };
template <int EPI, int TM>
DI void gemm_tile(const Params& p, int layer, const bf16_t* __restrict__ A, int lda, const bf16_t* __restrict__ Bt, int K, int m0, int nt, char* lds,
                  u32x4 (&ra)[TM / 64], u32x4 (&rb)[4], const TilePf pf) {
  constexpr int NJ = TM == 256 ? 4 : 2, NI = TM == 256 ? 2 : 1, NA = TM / 64;
  const int tid = otid(), lane = tid & 63, w = tid >> 6;
  const int wm = TM == 256 ? (w >> 2) : 0, wn = TM == 256 ? (w & 3) : w;
  const int fb = TM == 256 ? wn * 64 : wn * 32, tb = TM == 256 ? wm * 128 : 0;
  const int l31 = lane & 31, hh = lane >> 5;
  const int n0 = nt * 256;
  float* rstd = (float*)(lds + OFF_RSTD);
  const int srow = tid >> 3, scc = tid & 7;
  const bool ablocked = (lda == 0);
  const int nkb = K >> 6;
  const bf16_t* ag = ablocked ? A + ((size_t)((m0 >> 8) * 16) << 14) + (m0 & 255) * 64 + tid * 8 : A + (size_t)(m0 + srow) * lda + scc * 8;
  const size_t a_i = ablocked ? 4096 : (size_t)64 * lda, a_k = ablocked ? 16384 : 64;
  const bf16_t* bg = Bt + ((size_t)(nt * nkb) << 14) + tid * 8;

  if (EPI == EPI_QB || EPI == EPI_KVB) {
    __syncthreads();
    if (tid < 2 * TM) {
      const int r = tid >> 1, half = tid & 1;
      const bf16_t* ap = A + (size_t)(m0 + r) * lda + half * (K / 2);
      float ss = 0.f;
#pragma unroll 8
      for (int cidx = 0; cidx < K / 2; cidx += 8) {
        const u32x4 v = *(const u32x4*)(ap + cidx);
#pragma unroll
        for (int e = 0; e < 4; ++e) { const float a = bf_lo(v[e]), b2 = bf_hi(v[e]); ss += a * a + b2 * b2; }
      }
      ss += __shfl_xor(ss, 1);
      if (half == 0) rstd[r] = rsqrtf(ss / (float)K + 1e-6f);
    }
  }

  f32x16 acc[NI][NJ];
#pragma unroll
  for (int i = 0; i < NI; ++i)
#pragma unroll
    for (int j = 0; j < NJ; ++j)
#pragma unroll
      for (int r = 0; r < 16; ++r) acc[i][j][r] = 0.f;

  const int nk = K >> 6;
  if (!pf.pre) {
#pragma unroll
    for (int i = 0; i < NA; ++i) ra[i] = *(const u32x4*)(ag + i * a_i);
#pragma unroll
    for (int i = 0; i < 4; ++i) rb[i] = *(const u32x4*)(bg + i * 4096);
  }
#pragma unroll
  for (int i = 0; i < NA; ++i) *(u32x4*)(lds + (srow + 64 * i) * G_STR + scc * 16) = ra[i];
#pragma unroll
  for (int i = 0; i < 4; ++i) *(u32x4*)(lds + G_OPER + (srow + 64 * i) * G_STR + scc * 16) = rb[i];
#pragma unroll
  for (int i = 0; i < NA; ++i) ra[i] = *(const u32x4*)(ag + i * a_i + a_k);
#pragma unroll
  for (int i = 0; i < 4; ++i) rb[i] = *(const u32x4*)(bg + i * 4096 + 16384);
  __syncthreads();
  for (int kt = 0; kt < nk; ++kt) {
    {
      char* st = lds + ((kt + 1) & 1) * G_STAGE;
#pragma unroll
      for (int i = 0; i < NA; ++i) *(u32x4*)(st + (srow + 64 * i) * G_STR + scc * 16) = ra[i];
#pragma unroll
      for (int i = 0; i < 4; ++i) *(u32x4*)(st + G_OPER + (srow + 64 * i) * G_STR + scc * 16) = rb[i];
    }
    if (kt + 2 < nk) {
#pragma unroll
      for (int i = 0; i < NA; ++i) ra[i] = *(const u32x4*)(ag + i * a_i + (size_t)(kt + 2) * a_k);
#pragma unroll
      for (int i = 0; i < 4; ++i) rb[i] = *(const u32x4*)(bg + i * 4096 + ((size_t)(kt + 2) << 14));
    }
    __builtin_amdgcn_sched_barrier(0);
    const char* as = lds + (kt & 1) * G_STAGE;
    const char* fp = as + G_OPER + (fb + l31) * G_STR + hh * 16;
    const char* sp = as + (tb + l31) * G_STR + hh * 16;
#pragma unroll
    for (int ks = 0; ks < 4; ++ks) {
      bf16x8 f[NI], s[NJ];
#pragma unroll
      for (int i = 0; i < NI; ++i) f[i] = *(const bf16x8*)(fp + i * 32 * G_STR + ks * 32);
#pragma unroll
      for (int j = 0; j < NJ; ++j) s[j] = *(const bf16x8*)(sp + j * 32 * G_STR + ks * 32);
#pragma unroll
      for (int j = 0; j < NJ; ++j)
#pragma unroll
        for (int i = 0; i < NI; ++i) acc[i][j] = MFMA32(f[i], s[j], acc[i][j]);
    }
    __syncthreads();
  }

  auto prefetch_next = [&]() {
    if (TM == 256 && pf.has_next) {
      const bf16_t* nag = ablocked ? A + ((size_t)((pf.nm0 >> 8) * 16) << 14) + (pf.nm0 & 255) * 64 + tid * 8 : A + (size_t)(pf.nm0 + srow) * lda + scc * 8;
      const bf16_t* nbg = Bt + ((size_t)(pf.nnt * nkb) << 14) + tid * 8;
#pragma unroll
      for (int i = 0; i < NA; ++i) ra[i] = *(const u32x4*)(nag + i * a_i);
#pragma unroll
      for (int i = 0; i < 4; ++i) rb[i] = *(const u32x4*)(nbg + i * 4096);
      __builtin_amdgcn_sched_barrier(0);
    }
  };
  constexpr int SB = 528;
  constexpr int SV = TM * 2 + 16;
  constexpr int NIT = TM * 32 / NT;
  if (EPI == EPI_OUT) {
    const int bb = m0 < T_LAT ? (m0 >> 13) : 4;
    constexpr int SF = 1040;
    constexpr int JH = NJ / 2;
    constexpr int NITO = (TM / 2) * 64 / NT;
    const float* gate = (const float*)(p.ws + OFF_MOD) + (size_t)(layer * 5 + bb) * 3072 + 2048 + n0;
#pragma unroll
    for (int h = 0; h < 2; ++h) {
#pragma unroll
      for (int jj = 0; jj < JH; ++jj)
#pragma unroll
        for (int i = 0; i < NI; ++i)
#pragma unroll
          for (int g = 0; g < 4; ++g) {
            const int j = h * JH + jj;
            f32x4 v; v[0] = acc[i][j][4 * g]; v[1] = acc[i][j][4 * g + 1]; v[2] = acc[i][j][4 * g + 2]; v[3] = acc[i][j][4 * g + 3];
            *(f32x4*)(lds + ((TM == 256 ? wm * 64 : 0) + jj * 32 + l31) * SF + (fb + i * 32 + 8 * g + 4 * hh) * 4) = v;
          }
      if (h == 1) prefetch_next();
      __syncthreads();
      const f32x4 gt = *(const f32x4*)(gate + (tid & 63) * 4);
#pragma unroll
      for (int i0 = 0; i0 < NITO; i0 += 8) {
        f32x4 oldv[8];
#pragma unroll
        for (int k = 0; k < 8; ++k)
          if (i0 + k < NITO) {
            const int cidx = tid + NT * (i0 + k), row = cidx >> 6, ch = cidx & 63;
            const int tok = m0 + (TM == 256 ? (row >> 6) * 128 + h * 64 + (row & 63) : h * 32 + row);
            oldv[k] = *(const f32x4*)(h_src(p, layer, tok) + n0 + ch * 4);
          }
#pragma unroll
        for (int k = 0; k < 8; ++k)
          if (i0 + k < NITO) {
            const int cidx = tid + NT * (i0 + k), row = cidx >> 6, ch = cidx & 63;
            const int tok = m0 + (TM == 256 ? (row >> 6) * 128 + h * 64 + (row & 63) : h * 32 + row);
            const f32x4 y = *(const f32x4*)(lds + row * SF + ch * 16);
            *(f32x4*)(h_dst(p, tok) + n0 + ch * 4) = oldv[k] + gt * y;
          }
      }
      __syncthreads();
    }
  } else {
    const bool vt = (EPI == EPI_KVB && nt >= 2) || (EPI == EPI_C_IN && nt >= 8 && nt < 12);
#pragma unroll
    for (int j = 0; j < NJ; ++j) {
      const int rl = tb + j * 32 + l31;
      float rs = 1.f;
      if (EPI == EPI_QB || EPI == EPI_KVB) rs = rstd[rl];
#pragma unroll
      for (int i = 0; i < NI; ++i)
#pragma unroll
        for (int g = 0; g < 4; ++g) {
          const int fl = fb + i * 32 + 8 * g + 4 * hh;
          float v0 = acc[i][j][4 * g], v1 = acc[i][j][4 * g + 1], v2 = acc[i][j][4 * g + 2], v3 = acc[i][j][4 * g + 3];
          epi_math<EPI>(p, m0 + rl, n0 + fl, v0, v1, v2, v3, rs);
          const unsigned w01 = pack_bf16(v0, v1), w23 = pack_bf16(v2, v3);
          if (!vt) {
            u32x2 wv; wv.x = w01; wv.y = w23;
            *(u32x2*)(lds + rl * SB + fl * 2) = wv;
          } else {
            *(bf16_t*)(lds + (fl + 0) * SV + rl * 2) = (bf16_t)(w01 & 0xffffu);
            *(bf16_t*)(lds + (fl + 1) * SV + rl * 2) = (bf16_t)(w01 >> 16);
            *(bf16_t*)(lds + (fl + 2) * SV + rl * 2) = (bf16_t)(w23 & 0xffffu);
            *(bf16_t*)(lds + (fl + 3) * SV + rl * 2) = (bf16_t)(w23 >> 16);
          }
        }
    }
    prefetch_next();
    __syncthreads();
#pragma unroll 4
    for (int it = 0; it < NIT; ++it) {
      const int cidx = tid + NT * it;
      if (vt) {
        const int row = cidx / (TM / 8), ch = cidx % (TM / 8);
        *(u32x4*)dst_v<EPI>(p, m0 + ch * 8, n0 + row) = *(const u32x4*)(lds + row * SV + ch * 16);
      } else {
        const int row = cidx >> 5, ch = cidx & 31;
        bf16_t* d = dst_tr<EPI>(p, m0 + row, n0 + ch * 8);
        if (d) *(u32x4*)d = *(const u32x4*)(lds + row * SB + ch * 16);
      }
    }
    __syncthreads();
  }
}

template <int EPI>
DI void gemm_phase(const Params& p, int layer, const bf16_t* A, int lda, const bf16_t* Bt, int K, int mtiles, int ntiles, bool ctx, bool reverse, char* lds) {
  const int G = ogrid();
  const int bid = reverse ? (G - 1 - obid()) : obid();
  u32x4 ra[4], rb[4];
  const bool simple = (G & 7) != 0;
  const int xcd = bid & 7, local = simple ? bid : (bid >> 3), nlocal = simple ? G : (G >> 3);
  const int mlo = simple ? 0 : ((xcd * mtiles) >> 3), cnt = simple ? mtiles : ((((xcd + 1) * mtiles) >> 3) - mlo);
  const int total = cnt * ntiles, gsize = 4 * ntiles;
  auto tile_of = [&](int j, int& m0, int& nt) {
    const int g = j / gsize, r = j - g * gsize;
    int gm = cnt - g * 4; gm = gm > 4 ? 4 : gm;
    m0 = (mlo + g * 4 + (r % gm)) * 256; nt = r / gm;
  };
  bool pre = false;
  for (int j = local; j < total; j += nlocal) {
    int m0, nt; tile_of(j, m0, nt);
    TilePf pf; pf.pre = pre; pf.has_next = (j + nlocal < total); pf.nm0 = 0; pf.nnt = 0;
    if (pf.has_next) tile_of(j + nlocal, pf.nm0, pf.nnt);
    gemm_tile<EPI, 256>(p, layer, A, lda, Bt, K, m0, nt, lds, ra, rb, pf);
    pre = pf.has_next;
  }
  if (ctx) {
    const int b2 = G - 1 - bid;
    u32x4 ra1[1];
    TilePf pf; pf.pre = false; pf.has_next = false; pf.nm0 = 0; pf.nnt = 0;
    for (int u = b2; u < 16 * ntiles; u += G) gemm_tile<EPI, 64>(p, layer, A, lda, Bt, K, T_LAT + (u & 15) * 64, u >> 4, lds, ra1, rb, pf);
  }
}

DI void vta_phase(const Params& p, char* lds) {
  const int tid = otid();
  const bf16_t* Pb = (const bf16_t*)(p.ws + OFF_P);
  for (int u = ogrid() - 1 - obid(); u < T_ALL / 64; u += ogrid()) {
    const int t0 = u * 64;
#pragma unroll
    for (int it = 0; it < 2; ++it) {
      const int cidx = tid + NT * it, row = cidx >> 4, ch = cidx & 15;
      *(u32x4*)(lds + row * 272 + ch * 16) = *(const u32x4*)(Pb + (size_t)(t0 + row) * 2560 + 640 + ch * 8);
    }
    __syncthreads();
    int b, key; tok_bk(t0, b, key);
#pragma unroll
    for (int it = 0; it < 2; ++it) {
      const int cidx = tid + NT * it, f = cidx & 127, tc = cidx >> 7;
      unsigned short e[8];
#pragma unroll
      for (int k = 0; k < 8; ++k) e[k] = *(const bf16_t*)(lds + (tc * 8 + k) * 272 + f * 2);
      u32x4 v; v.x = e[0] | ((unsigned)e[1] << 16); v.y = e[2] | ((unsigned)e[3] << 16); v.z = e[4] | ((unsigned)e[5] << 16); v.w = e[6] | ((unsigned)e[7] << 16);
      *(u32x4*)((bf16_t*)(p.ws + OFF_VT) + ((size_t)(b * 2 + (f >> 6)) * 64 + (f & 63)) * NKEY + key + tc * 8) = v;
    }
    __syncthreads();
  }
}

template <int MODE>
DI void attn_item(const Params& p, int layer, int b, int qt, int head, bool is_ctx, char* lds) {
  constexpr int DK = (MODE == 1) ? 96 : 64;
  constexpr int NKS = DK / 16;
  constexpr int KSTR = DK * 2 + 16;
  constexpr int VSTR = 144;
  constexpr int KBYTES = 64 * KSTR;
  constexpr int STAGE = KBYTES + 64 * VSTR;
  constexpr int QPB = 256;
  constexpr int NKC = DK / 8;
  constexpr int KCH = 64 * NKC;
  constexpr int OSTR = 272;
  constexpr float MASKV = -1e30f;
  float* rpbs = (float*)(lds + 4 * STAGE);
  char* ostage = lds;

  const int tid = otid(), lane = tid & 63, w = tid >> 6, l31 = lane & 31, hh = lane >> 5;
  const int i2 = layer >> 1;
  const bf16_t* Pb = (const bf16_t*)(p.ws + OFF_P);
  bf16_t* UG = (bf16_t*)(p.ws + OFF_UG);
  const bf16_t *Qp, *Kp, *Krp = nullptr, *Zp, *Vt;
  int ldq, ldk, ldz, gcol;
  if (MODE == 0) {
    Qp = Pb + head * 64; ldq = 2560; Kp = Pb + 512 + (head >> 2) * 64; ldk = 2560;
    Vt = (const bf16_t*)(p.ws + OFF_VT) + (size_t)(b * 2 + (head >> 2)) * 64 * NKEY;
    Zp = Pb + 768 + head * 64; ldz = 2560; gcol = head * 64;
  } else if (MODE == 1) {
    Qp = (const bf16_t*)(p.ws + OFF_QB) + head * 96; ldq = 768; Kp = (const bf16_t*)(p.ws + OFF_KB) + head * 64; ldk = 512; Krp = Pb + 1920;
    Vt = (const bf16_t*)(p.ws + OFF_VTB) + (size_t)(b * 8 + head) * 64 * NKEY;
    Zp = Pb + 1952 + head * 64; ldz = 2560; gcol = 512 + head * 64;
  } else {
    Qp = Pb + head * 64; ldq = 3072; Kp = Pb + 1024 + head * 64; ldk = 3072;
    Vt = (const bf16_t*)(p.ws + OFF_VT) + (size_t)(b * 16 + head) * 64 * NKEY;
    Zp = Pb + 2048 + head * 64; ldz = 3072; gcol = head * 64;
  }
  const int qtok0 = is_ctx ? T_LAT + b * 256 : b * 8192 + qt * QPB;

  int lat_lo = 0, nlat = 0;
  if (!is_ctx) {
    if (MODE == 0) {
      int lo = 4 * qt - 2; if (lo < 0) lo = 0;
      int hi = 4 * qt + 5; if (hi > 127) hi = 127;
      lat_lo = lo; nlat = hi - lo + 1;
    } else if (MODE == 1) { lat_lo = 0; nlat = 128; }
    else {
      int lo = 4 * qt - 4; lo = lo < 0 ? 0 : (lo > 120 ? 120 : lo);
      int hi = 4 * qt + 3 - 4; hi = hi < 0 ? 0 : (hi > 120 ? 120 : hi); hi += 7;
      lat_lo = lo; nlat = hi - lo + 1;
    }
  }
  const int ntiles = nlat + 4;

  const bool nat2 = (MODE == 2) && !is_ctx;
  auto tokmap = [&](int row) { return nat2 ? qtok0 + ((w >> 2) * 2 + (row >> 4)) * 64 + (w & 3) * 16 + (row & 15) : qtok0 + w * 32 + row; };
  const int qtok = tokmap(l31);
  bf16x8 qf[NKS];
#pragma unroll
  for (int ks = 0; ks < NKS; ++ks) qf[ks] = *(const bf16x8*)(Qp + (size_t)qtok * ldq + ks * 16 + hh * 8);
  if (MODE == 2 && !is_ctx) {
    for (int i = tid; i < 465; i += NT) rpbs[i] = p.c_rpb[(size_t)(i2 * 16 + head) * 465 + i] * LOG2E;
  }
  float m_ = (MODE == 0) ? p.a_sink[i2 * 8 + head] * LOG2E : MASKV;
  float l_ = (MODE == 0 && hh == 0) ? 1.f : 0.f;
  f32x16 O[2];
#pragma unroll
  for (int dh = 0; dh < 2; ++dh)
#pragma unroll
    for (int r = 0; r < 16; ++r) O[dh][r] = 0.f;

  const int k0row = tid / NKC, k0cc = tid % NKC;
  const int k1row = (tid + NT) / NKC, k1cc = (tid + NT) % NKC;
  const bool k1 = (KCH > NT) && (tid + NT < KCH);
  struct Stg { u32x4 k0, k1, v; };
  Stg R0, R1;
  R0.k1 = (u32x4){0u, 0u, 0u, 0u}; R1.k1 = R0.k1;
  auto tile_kt = [&](int i) { return i < nlat ? lat_lo + i : 128 + (i - nlat); };
  auto kload = [&](int krow0, int row, int cc) -> u32x4 {
    if (MODE == 1 && cc >= 8) return *(const u32x4*)(Krp + (size_t)(krow0 + row) * 2560 + (cc - 8) * 8);
    return *(const u32x4*)(Kp + (size_t)(krow0 + row) * ldk + cc * 8);
  };
  auto gload = [&](int i, Stg& r) {
    const int kt = tile_kt(i < ntiles ? i : ntiles - 1);
    const int krow0 = kt < 128 ? b * 8192 + kt * 64 : T_LAT + b * 256 + (kt - 128) * 64;
    r.k0 = kload(krow0, k0row, k0cc);
    if (k1) r.k1 = kload(krow0, k1row, k1cc);
    r.v = *(const u32x4*)(Vt + (size_t)(tid >> 3) * NKEY + kt * 64 + (tid & 7) * 8);
  };
  auto lstore = [&](int st, const Stg& r) {
    char* kb = lds + st * STAGE;
    *(u32x4*)(kb + k0row * KSTR + k0cc * 16) = r.k0;
    if (k1) *(u32x4*)(kb + k1row * KSTR + k1cc * 16) = r.k1;
    *(u32x4*)(kb + KBYTES + (tid >> 3) * VSTR + (tid & 7) * 16) = r.v;
  };

  const int pr = (l31 & ~12) | ((l31 & 4) << 1) | ((l31 & 8) >> 1);
  int qr = 0, qc = 0, rs0 = 0, cs = 0, csw = 0, wlo = 0, whi = 0;
  if (MODE == 2) {
    qr = qt * 4 + (w >> 2) * 2 + (l31 >> 4); qc = (w & 3) * 16 + (l31 & 15);
    rs0 = qr - 4; rs0 = rs0 < 0 ? 0 : (rs0 > 120 ? 120 : rs0);
    cs = qc - 8; cs = cs < 0 ? 0 : (cs > 48 ? 48 : cs);
    csw = (w & 3) * 16 - 8; csw = csw < 0 ? 0 : (csw > 32 ? 32 : csw);
    const int r_lo = qt * 4 + (w >> 2) * 2;
    wlo = r_lo - 4; wlo = wlo < 0 ? 0 : (wlo > 120 ? 120 : wlo);
    whi = r_lo + 1 - 4; whi = whi < 0 ? 0 : (whi > 120 ? 120 : whi); whi += 7;
  }
  const int s0w = qt * QPB + w * 32;
  const int nsup = (ntiles + 1) >> 1;
  __syncthreads();
  gload(0, R0); gload(1, R1);
  lstore(0, R0); lstore(1, R1);
  gload(2, R0); gload(3, R1);
  __syncthreads();
  auto body = [&](int it, const char* kb) {
    const char* vb = kb + KBYTES;
    const int kt = tile_kt(it);
    const bool lat_tile = it < nlat;
    bool skip = (it >= ntiles);
    if (MODE == 2 && lat_tile) skip = (kt < wlo) || (kt > whi);
    if (MODE == 0 && lat_tile) skip = (kt * 64 + 63 < s0w - 128) || (kt * 64 > s0w + 31 + 128);
    const int nsub = (MODE == 2 && lat_tile) ? 1 : 2;
    const int krb = (MODE == 2 && lat_tile) ? csw : 0;
    if (!skip) {
      f32x16 S[2];
#pragma unroll
      for (int t = 0; t < 2; ++t)
#pragma unroll
        for (int r = 0; r < 16; ++r) S[t][r] = 0.f;
#pragma unroll
      for (int ks = 0; ks < NKS; ++ks) {
        const bf16x8 a0 = *(const bf16x8*)(kb + (krb + pr) * KSTR + ks * 32 + hh * 16);
        S[0] = MFMA32(a0, qf[ks], S[0]);
        if (nsub == 2) {
          const bf16x8 a1 = *(const bf16x8*)(kb + (32 + pr) * KSTR + ks * 32 + hh * 16);
          S[1] = MFMA32(a1, qf[ks], S[1]);
        }
      }
      if (MODE == 0 && lat_tile) {
        const int s = qt * QPB + w * 32 + l31;
#pragma unroll
        for (int t = 0; t < 2; ++t)
#pragma unroll
          for (int r = 0; r < 16; ++r) {
            const int kk = kt * 64 + t * 32 + 16 * (r >> 3) + 8 * hh + (r & 7);
            const int d = kk - s;
            if (d > 128 || d < -128) S[t][r] = MASKV;
          }
      }
      if (MODE == 2 && lat_tile) {
        int ri = kt - qr + 7; ri = ri < 0 ? 0 : (ri > 14 ? 14 : ri);
        const float* brow = rpbs + ri * 31;
        const bool rok = (kt >= rs0) && (kt <= rs0 + 7);
        float bv[16];
#pragma unroll
        for (int r = 0; r < 16; ++r) {
          const int kc = csw + 16 * (r >> 3) + 8 * hh + (r & 7);
          int bi = kc - qc + 15; bi = bi < 0 ? 0 : (bi > 30 ? 30 : bi);
          bv[r] = brow[bi];
        }
#pragma unroll
        for (int r = 0; r < 16; ++r) asm volatile("" : "+v"(bv[r]));
#pragma unroll
        for (int r = 0; r < 16; ++r) {
          const int kc = csw + 16 * (r >> 3) + 8 * hh + (r & 7);
          const bool ok = rok && (kc >= cs) && (kc < cs + 16);
          S[0][r] = ok ? S[0][r] + bv[r] : MASKV;
        }
      }
      float mx = S[0][0];
#pragma unroll
      for (int r = 0; r < 16; ++r) mx = fmaxf(mx, S[0][r]);
      if (nsub == 2) {
#pragma unroll
        for (int r = 0; r < 16; ++r) mx = fmaxf(mx, S[1][r]);
      }
      mx = pair_max(mx);
      if (__any(mx > m_ + 8.f)) {
        const float mnew = fmaxf(m_, mx);
        const float alpha = fexp2(m_ - mnew);
        m_ = mnew;
        l_ *= alpha;
#pragma unroll
        for (int dh = 0; dh < 2; ++dh)
#pragma unroll
          for (int r = 0; r < 16; ++r) O[dh][r] *= alpha;
      }
      float rsum = 0.f;
#pragma unroll
      for (int t = 0; t < 2; ++t)
        if (t < nsub) {
#pragma unroll
          for (int r = 0; r < 16; ++r) { const float e = fexp2(S[t][r] - m_); S[t][r] = e; rsum += e; }
        }
      l_ += rsum;
#pragma unroll
      for (int t = 0; t < 2; ++t)
       if (t < nsub)
#pragma unroll
        for (int s = 0; s < 2; ++s) {
          u32x4 u;
          u.x = pack_bf16(S[t][8 * s + 0], S[t][8 * s + 1]); u.y = pack_bf16(S[t][8 * s + 2], S[t][8 * s + 3]);
          u.z = pack_bf16(S[t][8 * s + 4], S[t][8 * s + 5]); u.w = pack_bf16(S[t][8 * s + 6], S[t][8 * s + 7]);
          const bf16x8 pf = __builtin_bit_cast(bf16x8, u);
#pragma unroll
          for (int dh = 0; dh < 2; ++dh) {
            const bf16x8 v = *(const bf16x8*)(vb + (dh * 32 + l31) * VSTR + (krb + t * 32 + s * 16 + hh * 8) * 2);
            O[dh] = MFMA32(v, pf, O[dh]);
          }
        }
    }
  };
  for (int j = 0; j < nsup; ++j) {
    const char* sb = lds + (j & 1) * 2 * STAGE;
    body(2 * j, sb);
    body(2 * j + 1, sb + STAGE);
    __builtin_amdgcn_sched_barrier(0);
    {
      const int so = ((j + 1) & 1) * 2;
      lstore(so, R0); lstore(so + 1, R1);
      gload(2 * j + 4, R0); gload(2 * j + 5, R1);
    }
    __syncthreads();
  }

  {
    const float lt = l_ + __shfl_xor(l_, 32);
    const float inv = 1.f / lt;
    char* orow = ostage + (w * 32) * OSTR;
#pragma unroll
    for (int dh = 0; dh < 2; ++dh)
#pragma unroll
      for (int g = 0; g < 4; ++g) {
        f32x4 v; v[0] = O[dh][4 * g] * inv; v[1] = O[dh][4 * g + 1] * inv; v[2] = O[dh][4 * g + 2] * inv; v[3] = O[dh][4 * g + 3] * inv;
        *(f32x4*)(orow + l31 * OSTR + (dh * 32 + 8 * g + 4 * hh) * 4) = v;
      }
    __builtin_amdgcn_s_waitcnt(0xc07f);
#pragma unroll
    for (int it = 0; it < 4; ++it) {
      const int cidx = lane + 64 * it, row = cidx >> 3, ch = cidx & 7;
      const f32x4 o0 = *(const f32x4*)(orow + row * OSTR + ch * 32), o1 = *(const f32x4*)(orow + row * OSTR + ch * 32 + 16);
      const int tok = tokmap(row);
      const u32x4 z = *(const u32x4*)(Zp + (size_t)tok * ldz + ch * 8);
      u32x4 wv;
      wv.x = pack_bf16(o0[0] * silu(bf_lo(z.x)), o0[1] * silu(bf_hi(z.x)));
      wv.y = pack_bf16(o0[2] * silu(bf_lo(z.y)), o0[3] * silu(bf_hi(z.y)));
      wv.z = pack_bf16(o1[0] * silu(bf_lo(z.z)), o1[1] * silu(bf_hi(z.z)));
      wv.w = pack_bf16(o1[2] * silu(bf_lo(z.w)), o1[3] * silu(bf_hi(z.w)));
      *(u32x4*)(UG + ablk(tok, gcol + ch * 8)) = wv;
    }
  }
}

DI void mla_item2(const Params& p, int layer, int b, int qt, int head, char* lds) {
  constexpr int DK = 96, NKS = 6, KSTR = DK * 2 + 16, VSTR = 144, KBYTES = 64 * KSTR, STAGE = KBYTES + 64 * VSTR;
  constexpr int NKC = 12, KCH = 64 * NKC, OSTR = 272, QG = 2, NTILES = 132;
  constexpr float MASKV = -1e30f;
  char* ostage = lds;
  const int tid = otid(), lane = tid & 63, w = tid >> 6, l31 = lane & 31, hh = lane >> 5;
  const bf16_t* Pb = (const bf16_t*)(p.ws + OFF_P);
  bf16_t* UG = (bf16_t*)(p.ws + OFF_UG);
  const bf16_t* Qp = (const bf16_t*)(p.ws + OFF_QB) + head * 96;
  const bf16_t* Kp = (const bf16_t*)(p.ws + OFF_KB) + head * 64;
  const bf16_t* Krp = Pb + 1920;
  const bf16_t* Vt = (const bf16_t*)(p.ws + OFF_VTB) + (size_t)(b * 8 + head) * 64 * NKEY;
  const bf16_t* Zp = Pb + 1952 + head * 64;
  const int gcol = 512 + head * 64;
  const int qtok0 = b * 8192 + qt * 512;
  bf16x8 qf[QG][NKS];
#pragma unroll
  for (int qg = 0; qg < QG; ++qg)
#pragma unroll
    for (int ks = 0; ks < NKS; ++ks) qf[qg][ks] = *(const bf16x8*)(Qp + (size_t)(qtok0 + qg * 256 + w * 32 + l31) * 768 + ks * 16 + hh * 8);
  float m_[QG], l_[QG];
  f32x16 O[QG][2];
#pragma unroll
  for (int qg = 0; qg < QG; ++qg) {
    m_[qg] = MASKV; l_[qg] = 0.f;
#pragma unroll
    for (int dh = 0; dh < 2; ++dh)
#pragma unroll
      for (int r = 0; r < 16; ++r) O[qg][dh][r] = 0.f;
  }
  const int k0row = tid / NKC, k0cc = tid % NKC;
  const int k1row = (tid + NT) / NKC, k1cc = (tid + NT) % NKC;
  const bool k1 = (tid + NT < KCH);
  struct Stg { u32x4 k0, k1, v; };
  Stg R0;
  R0.k1 = (u32x4){0u, 0u, 0u, 0u};
  auto kload = [&](int krow0, int row, int cc) -> u32x4 {
    if (cc >= 8) return *(const u32x4*)(Krp + (size_t)(krow0 + row) * 2560 + (cc - 8) * 8);
    return *(const u32x4*)(Kp + (size_t)(krow0 + row) * 512 + cc * 8);
  };
  auto gload = [&](int i, Stg& r) {
    const int kt = i < NTILES ? i : NTILES - 1;
    const int krow0 = kt < 128 ? b * 8192 + kt * 64 : T_LAT + b * 256 + (kt - 128) * 64;
    r.k0 = kload(krow0, k0row, k0cc);
    if (k1) r.k1 = kload(krow0, k1row, k1cc);
    r.v = *(const u32x4*)(Vt + (size_t)(tid >> 3) * NKEY + kt * 64 + (tid & 7) * 8);
  };
  auto lstore = [&](int st, const Stg& r) {
    char* kb = lds + st * STAGE;
    *(u32x4*)(kb + k0row * KSTR + k0cc * 16) = r.k0;
    if (k1) *(u32x4*)(kb + k1row * KSTR + k1cc * 16) = r.k1;
    *(u32x4*)(kb + KBYTES + (tid >> 3) * VSTR + (tid & 7) * 16) = r.v;
  };
  const int pr = (l31 & ~12) | ((l31 & 4) << 1) | ((l31 & 8) >> 1);
  __syncthreads();
  gload(0, R0); lstore(0, R0);
  gload(1, R0);
  __syncthreads();
  auto body = [&](const char* kb) {
    const char* vb = kb + KBYTES;
    f32x16 S[QG][2];
#pragma unroll
    for (int qg = 0; qg < QG; ++qg)
#pragma unroll
      for (int t = 0; t < 2; ++t)
#pragma unroll
        for (int r = 0; r < 16; ++r) S[qg][t][r] = 0.f;
#pragma unroll
    for (int ks = 0; ks < NKS; ++ks) {
      const bf16x8 a0 = *(const bf16x8*)(kb + pr * KSTR + ks * 32 + hh * 16);
      const bf16x8 a1 = *(const bf16x8*)(kb + (32 + pr) * KSTR + ks * 32 + hh * 16);
#pragma unroll
      for (int qg = 0; qg < QG; ++qg) { S[qg][0] = MFMA32(a0, qf[qg][ks], S[qg][0]); S[qg][1] = MFMA32(a1, qf[qg][ks], S[qg][1]); }
    }
#pragma unroll
    for (int qg = 0; qg < QG; ++qg) {
      float mx = S[qg][0][0];
#pragma unroll
      for (int t = 0; t < 2; ++t)
#pragma unroll
        for (int r = 0; r < 16; ++r) mx = fmaxf(mx, S[qg][t][r]);
      mx = pair_max(mx);
      if (__any(mx > m_[qg] + 8.f)) {
        const float mnew = fmaxf(m_[qg], mx);
        const float alpha = fexp2(m_[qg] - mnew);
        m_[qg] = mnew;
        l_[qg] *= alpha;
#pragma unroll
        for (int dh = 0; dh < 2; ++dh)
#pragma unroll
          for (int r = 0; r < 16; ++r) O[qg][dh][r] *= alpha;
      }
      float rsum = 0.f;
#pragma unroll
      for (int t = 0; t < 2; ++t)
#pragma unroll
        for (int r = 0; r < 16; ++r) { const float e = fexp2(S[qg][t][r] - m_[qg]); S[qg][t][r] = e; rsum += e; }
      l_[qg] += rsum;
    }
#pragma unroll
    for (int t = 0; t < 2; ++t)
#pragma unroll
      for (int s = 0; s < 2; ++s) {
        bf16x8 pf[QG];
#pragma unroll
        for (int qg = 0; qg < QG; ++qg) {
          u32x4 u;
          u.x = pack_bf16(S[qg][t][8 * s + 0], S[qg][t][8 * s + 1]); u.y = pack_bf16(S[qg][t][8 * s + 2], S[qg][t][8 * s + 3]);
          u.z = pack_bf16(S[qg][t][8 * s + 4], S[qg][t][8 * s + 5]); u.w = pack_bf16(S[qg][t][8 * s + 6], S[qg][t][8 * s + 7]);
          pf[qg] = __builtin_bit_cast(bf16x8, u);
        }
#pragma unroll
        for (int dh = 0; dh < 2; ++dh) {
          const bf16x8 v = *(const bf16x8*)(vb + (dh * 32 + l31) * VSTR + (t * 32 + s * 16 + hh * 8) * 2);
#pragma unroll
          for (int qg = 0; qg < QG; ++qg) O[qg][dh] = MFMA32(v, pf[qg], O[qg][dh]);
        }
      }
  };
  if (w >= 4) __builtin_amdgcn_s_setprio(2);
  for (int j = 0; j < NTILES; ++j) {
    body(lds + (j & 1) * STAGE);
    __builtin_amdgcn_sched_barrier(0);
    lstore((j + 1) & 1, R0);
    gload(j + 2, R0);
    __syncthreads();
  }
  __builtin_amdgcn_s_setprio(0);
#pragma unroll
  for (int qg = 0; qg < QG; ++qg) {
    const float lt = l_[qg] + __shfl_xor(l_[qg], 32);
    const float inv = 1.f / lt;
    char* orow = ostage + (w * 32) * OSTR;
#pragma unroll
    for (int dh = 0; dh < 2; ++dh)
#pragma unroll
      for (int g = 0; g < 4; ++g) {
        f32x4 v; v[0] = O[qg][dh][4 * g] * inv; v[1] = O[qg][dh][4 * g + 1] * inv; v[2] = O[qg][dh][4 * g + 2] * inv; v[3] = O[qg][dh][4 * g + 3] * inv;
        *(f32x4*)(orow + l31 * OSTR + (dh * 32 + 8 * g + 4 * hh) * 4) = v;
      }
    __builtin_amdgcn_s_waitcnt(0xc07f);
#pragma unroll
    for (int it = 0; it < 4; ++it) {
      const int cidx = lane + 64 * it, row = cidx >> 3, ch = cidx & 7;
      const f32x4 o0 = *(const f32x4*)(orow + row * OSTR + ch * 32), o1 = *(const f32x4*)(orow + row * OSTR + ch * 32 + 16);
      const int tok = qtok0 + qg * 256 + w * 32 + row;
      const u32x4 z = *(const u32x4*)(Zp + (size_t)tok * 2560 + ch * 8);
      u32x4 wv;
      wv.x = pack_bf16(o0[0] * silu(bf_lo(z.x)), o0[1] * silu(bf_hi(z.x)));
      wv.y = pack_bf16(o0[2] * silu(bf_lo(z.y)), o0[3] * silu(bf_hi(z.y)));
      wv.z = pack_bf16(o1[0] * silu(bf_lo(z.z)), o1[1] * silu(bf_hi(z.z)));
      wv.w = pack_bf16(o1[2] * silu(bf_lo(z.w)), o1[3] * silu(bf_hi(z.w)));
      *(u32x4*)(UG + ablk(tok, gcol + ch * 8)) = wv;
    }
    __builtin_amdgcn_s_waitcnt(0xc07f);
  }
}

DI void attn_phase_ab(const Params& p, int layer, char* lds) {
  const int G = ogrid();
  for (int v = obid(); v < 512; v += G) {
    const int xcd = v & 7, s = v >> 3;
    const int grp = (s >> 4) * 8 + xcd, qt = s & 15;
    mla_item2(p, layer, grp >> 3, qt, grp & 7, lds);
  }
  for (int v = obid(); v < 32; v += G) attn_item<1>(p, layer, v >> 3, 0, v & 7, true, lds);
  for (int v = obid(); v < 1024 + 32; v += G) {
    if (v < 1024) attn_item<0>(p, layer, v >> 8, v & 31, (v >> 5) & 7, false, lds);
    else { const int c = v - 1024; attn_item<0>(p, layer, c >> 3, 0, c & 7, true, lds); }
  }
}

DI void attn_phase_c(const Params& p, int layer, char* lds) {
  const int G = ogrid();
  const int nctx = (layer == 3) ? 0 : 64;
  for (int v = obid(); v < 2048 + nctx; v += G) {
    if (v < 2048) attn_item<2>(p, layer, v >> 9, v & 31, (v >> 5) & 15, false, lds);
    else { const int c = v - 2048; attn_item<2>(p, layer, c >> 4, 0, c & 15, true, lds); }
  }
}

__global__ void __launch_bounds__(512, 2) fwd_megakernel(Params p) {
  __shared__ __attribute__((aligned(16))) char lds[LDS_BYTES];
  __shared__ uint4 xb_words;
  if (threadIdx.x == 0) xb_words = make_uint4(0u, 0u, 0u, 0u);
  __syncthreads();
  if (obid() == 0) { unsigned* bw = (unsigned*)(p.ws + OFF_BAR); for (int i = otid(); i < 4096; i += NT) bw[i] = 0u; }
  XcdBarrier xb; xb.bar = (unsigned*)(p.ws + OFF_BAR); xb.x = 0; xb.st = (volatile LAS unsigned*)&xb_words;
  bool first = true, posted = false;
  for (int ph = p.ph_begin; ph < p.ph_end; ++ph) {
    const int layer = (ph - 1) / 5, s = (ph - 1) % 5;
    const bool even = (layer & 1) == 0;
    const int i2 = layer >> 1;
    if (ph >= 1 && ph <= 20 && s == 2 && !even) continue;
    if (!first) {
      if (!posted) { cg::this_grid().sync(); xb = xcd_barrier_post((unsigned*)(p.ws + OFF_BAR), (volatile LAS unsigned*)&xb_words); posted = true; }
      else xcd_barrier(xb);
    }
    first = false;
    if (ph == 0) prologue_phase(p, lds);
    else if (ph == 21) final_phase(p);
    else if (s == 0) norm_phase(p, layer);
    else if (s == 1) {
      const bf16_t* U = (const bf16_t*)(p.ws + OFF_UG);
      if (even) gemm_phase<EPI_AB_IN>(p, layer, U, 0, (const bf16_t*)(p.ws + OFF_W_IN) + (size_t)i2 * 2560 * 1024, 1024, 128, 10, true, false, lds);
      else gemm_phase<EPI_C_IN>(p, layer, U, 0, (const bf16_t*)(p.ws + OFF_W_CIN) + (size_t)i2 * 4096 * 1024, 1024, 128, 16, true, false, lds);
    } else if (s == 2) {
      const bf16_t* Pb = (const bf16_t*)(p.ws + OFF_P);
      gemm_phase<EPI_QB>(p, layer, Pb + 1280, 2560, (const bf16_t*)(p.ws + OFF_W_UQ) + (size_t)i2 * 768 * 384, 384, 128, 3, true, false, lds);
      gemm_phase<EPI_KVB>(p, layer, Pb + 1664, 2560, (const bf16_t*)(p.ws + OFF_W_UKV) + (size_t)i2 * 1024 * 256, 256, 128, 4, true, true, lds);
      vta_phase(p, lds);
    } else if (s == 3) {
      if (even) attn_phase_ab(p, layer, lds); else attn_phase_c(p, layer, lds);
    } else {
      const bf16_t* Gm = (const bf16_t*)(p.ws + OFF_UG);
      const bf16_t* W = even ? (const bf16_t*)(p.ws + OFF_W_OUT) + (size_t)i2 * 1024 * 1024 : (const bf16_t*)(p.ws + OFF_W_COUT) + (size_t)i2 * 1024 * 1024;
      gemm_phase<EPI_OUT>(p, layer, Gm, 0, W, 1024, 128, 4, layer != 3, false, lds);
    }
  }
}

extern "C" void kernel_launch(void* const* d_in, const int* in_sizes, int n_in, void* d_out, int out_size, void* d_ws, size_t ws_size,
                              hipStream_t stream) {
  static int grid_blocks = 0;
  if (!grid_blocks) {
    int dev = 0, cus = 0, per_cu = 0;
    hipGetDevice(&dev);
    hipDeviceGetAttribute(&cus, hipDeviceAttributeMultiprocessorCount, dev);
    hipOccupancyMaxActiveBlocksPerMultiprocessor(&per_cu, fwd_megakernel, NT, 0);
    per_cu = 1;
    grid_blocks = cus * per_cu;
    if (ws_size < OFF_END) fprintf(stderr, "kernel_launch: workspace too small: %zu < %zu\n", ws_size, (size_t)OFF_END);
  }
  Params p{};
  const float** f = (const float**)&p;
  for (int i = 0; i < 18; ++i) f[i] = (const float*)d_in[i];
  p.out = (float*)d_out;
  p.ws = (char*)d_ws;
#if MK_MULTI_LAUNCH
  for (int ph = 0; ph < 22; ++ph) {
    if (ph >= 1 && ph <= 20 && ((ph - 1) % 5) == 2 && (((ph - 1) / 5) & 1)) continue;
    p.ph_begin = ph; p.ph_end = ph + 1;
    hipLaunchKernelGGL(fwd_megakernel, dim3(grid_blocks), dim3(NT), 0, stream, p);
  }
#else
  p.ph_begin = 0; p.ph_end = 22;
  void* args[] = {&p};
  hipError_t e = hipLaunchCooperativeKernel((void*)fwd_megakernel, dim3(grid_blocks), dim3(NT), args, 0, stream);
  if (e != hipSuccess) fprintf(stderr, "cooperative launch failed: %s (grid %d)\n", hipGetErrorString(e), grid_blocks);
#endif
}
```

```cpp
#include <hip/hip_runtime.h>
#include <hip/hip_cooperative_groups.h>
#include <stdint.h>
#include <stdio.h>
namespace cg = cooperative_groups;

#ifndef MK_MULTI_LAUNCH
#define MK_MULTI_LAUNCH 0
#endif

typedef unsigned short bf16_t;
typedef short bf16x8 __attribute__((ext_vector_type(8)));
typedef float f32x16 __attribute__((ext_vector_type(16)));
typedef float f32x4 __attribute__((ext_vector_type(4)));
typedef float f32x2 __attribute__((ext_vector_type(2)));
typedef unsigned u32x4 __attribute__((ext_vector_type(4)));
typedef unsigned u32x2 __attribute__((ext_vector_type(2)));

#define DI __device__ __forceinline__
#define MFMA32(a, b, c) __builtin_amdgcn_mfma_f32_32x32x16_bf16((a), (b), (c), 0, 0, 0)

constexpr int T_LAT = 32768, T_ALL = 33792, NKEY = 8448, NT = 512;
constexpr float LOG2E = 1.4426950408889634f;
constexpr float QSCALE_A = 0.125f * LOG2E;
constexpr float QSCALE_B = 0.10206207261596575f * LOG2E;

constexpr size_t OFF_HC   = 0;
constexpr size_t OFF_UG   = OFF_HC + 1024ull * 1024 * 4;
constexpr size_t OFF_P    = OFF_UG + (size_t)T_ALL * 1024 * 2;
constexpr size_t OFF_QB   = OFF_P + (size_t)T_ALL * 2560 * 2;
constexpr size_t OFF_KB   = OFF_QB + (size_t)T_ALL * 768 * 2;
constexpr size_t OFF_VT   = OFF_KB + (size_t)T_ALL * 512 * 2;
constexpr size_t OFF_VTB  = OFF_VT + 4ull * 2 * 64 * NKEY * 2;
constexpr size_t OFF_W    = OFF_VT + 4ull * 16 * 64 * NKEY * 2;
constexpr size_t OFF_W_IN   = OFF_W;
constexpr size_t OFF_W_OUT  = OFF_W_IN + 2ull * 2560 * 1024 * 2;
constexpr size_t OFF_W_UQ   = OFF_W_OUT + 2ull * 1024 * 1024 * 2;
constexpr size_t OFF_W_UKV  = OFF_W_UQ + 2ull * 768 * 384 * 2;
constexpr size_t OFF_W_CIN  = OFF_W_UKV + 2ull * 1024 * 256 * 2;
constexpr size_t OFF_W_COUT = OFF_W_CIN + 2ull * 4096 * 1024 * 2;
constexpr size_t OFF_MOD    = OFF_W_COUT + 2ull * 1024 * 1024 * 2;
constexpr size_t OFF_ROPE   = OFF_MOD + 4ull * 5 * 3072 * 4;
constexpr size_t OFF_BAR    = OFF_ROPE + 2ull * 8192 * 32 * 4 + 2ull * 8192 * 16 * 4;
constexpr size_t OFF_END    = OFF_BAR + 16384;

struct Params {
  const float *x, *c, *ctx, *c_ctx, *ada_w, *ada_b, *norm_g, *ab_in_w, *ab_out_w, *a_sink, *b_qn_g, *b_w_uq, *b_kvn_g, *b_w_ukv,
      *c_in_w, *c_out_w, *c_rpb, *final_g;
  float* out;
  char* ws;
  int ph_begin, ph_end;
};

DI int otid() { int t = threadIdx.x; asm volatile("" : "+v"(t)); return t; }
DI int obid() { int t = blockIdx.x; asm volatile("" : "+s"(t)); return t; }
DI int ogrid() { int t = gridDim.x; asm volatile("" : "+s"(t)); return t; }
DI unsigned pack_bf16(float lo, float hi) { unsigned r; asm("v_cvt_pk_bf16_f32 %0, %1, %2" : "=v"(r) : "v"(lo), "v"(hi)); return r; }
DI float bf_lo(unsigned u) { return __uint_as_float(u << 16); }
DI float bf_hi(unsigned u) { return __uint_as_float(u & 0xffff0000u); }
DI float fexp2(float x) { return __builtin_amdgcn_exp2f(x); }
DI float pair_max(float x) {
  const unsigned u = __float_as_uint(x);
  const auto r = __builtin_amdgcn_permlane32_swap(u, u, false, false);
  return fmaxf(__uint_as_float(r[0]), __uint_as_float(r[1]));
}
DI float silu(float z) { return z * __builtin_amdgcn_rcpf(1.f + __expf(-z)); }

DI size_t ablk(int tok, int k) { return ((size_t)((tok >> 8) * 16 + (k >> 6)) << 14) + ((tok & 255) << 6) + (k & 63); }
DI void tok_bk(int tok, int& b, int& key) {
  if (tok < T_LAT) { b = tok >> 13; key = tok & 8191; } else { int r = tok - T_LAT; b = r >> 8; key = 8192 + (r & 255); }
}
DI const float* h_src(const Params& p, int layer, int tok) {
  if (layer == 0) return tok < T_LAT ? p.x + (size_t)tok * 1024 : p.ctx + (size_t)(tok - T_LAT) * 1024;
  return tok < T_LAT ? p.out + (size_t)tok * 1024 : (const float*)(p.ws + OFF_HC) + (size_t)(tok - T_LAT) * 1024;
}
DI float* h_dst(const Params& p, int tok) {
  return tok < T_LAT ? p.out + (size_t)tok * 1024 : (float*)(p.ws + OFF_HC) + (size_t)(tok - T_LAT) * 1024;
}

#define XB_TMO      128
#define XB_XCNT(j)  (256  + 64 * (j))
#define XB_XSUB(j)  (1280 + 64 * (j))
#define XB_XGEN(j)  (2304 + 64 * (j))
#define XB_TOP      3328
#define XB_TOPGEN   3392
#define XCD_BAR_WORDS 3456
#define XB_SPIN_CAP (1u << 22)
#define LAS __attribute__((address_space(3)))
DI unsigned xb_ld(unsigned* p) { return __hip_atomic_load(p, __ATOMIC_RELAXED, __HIP_MEMORY_SCOPE_AGENT); }
DI unsigned xb_add(unsigned* p, unsigned v) { return __hip_atomic_fetch_add(p, v, __ATOMIC_RELAXED, __HIP_MEMORY_SCOPE_AGENT); }
DI unsigned xb_xcc_id() { return (unsigned)__builtin_amdgcn_s_getreg((3 << 11) | 20) & 0xFu; }
#define XB_SPIN(cond, bar) do { unsigned _sp = 0; while (cond) { __builtin_amdgcn_s_sleep(1); \
    if ((++_sp & 255u) == 0u) { if (xb_ld(&(bar)[XB_TMO])) break; if (_sp > XB_SPIN_CAP) { atomicAdd(&(bar)[XB_TMO], 1u); break; } } } } while (0)
struct XcdBarrier { unsigned* bar; unsigned x; volatile LAS unsigned* st; };
DI XcdBarrier xcd_barrier_post(unsigned* bar, volatile LAS unsigned* st) {
  XcdBarrier b; b.bar = bar; b.x = xb_xcc_id(); b.st = st;
  if (threadIdx.x == 0) (void)xb_add(&bar[XB_XCNT(b.x)], 1u);
  return b;
}
DI void xcd_barrier_complete(unsigned* bar, unsigned x, unsigned& nloc, unsigned& nx) {
  const unsigned G = gridDim.x * gridDim.y * gridDim.z;
  unsigned sum, cnt, mine, sp = 0u;
  for (;;) {
    sum = 0u; cnt = 0u; mine = 0u;
#pragma unroll
    for (unsigned j = 0; j < 16; ++j) { const unsigned c = xb_ld(&bar[XB_XCNT(j)]); sum += c; cnt += (c > 0u) ? 1u : 0u; mine = (j == x) ? c : mine; }
    if (sum == G) break;
    __builtin_amdgcn_s_sleep(1);
    if ((++sp & 255u) == 0u) { if (xb_ld(&bar[XB_TMO])) break; if (sp > XB_SPIN_CAP) { atomicAdd(&bar[XB_TMO], 1u); break; } }
  }
  nloc = mine > 0u ? mine : 1u; nx = cnt > 0u ? cnt : 1u;
}
DI void xcd_barrier(const XcdBarrier& b) {
  asm volatile("s_waitcnt vmcnt(0)" ::: "memory");
  __syncthreads();
  if (threadIdx.x == 0) {
    unsigned* bar = b.bar;
    __builtin_amdgcn_s_waitcnt(0);
    unsigned nloc = b.st[0], nx = b.st[1];
    if (nloc == 0u) { xcd_barrier_complete(bar, b.x, nloc, nx); b.st[0] = nloc; b.st[1] = nx; }
    const unsigned old = xb_add(&bar[XB_XSUB(b.x)], 1u);
    const unsigned gen = old / nloc;
    if (old + 1u == (gen + 1u) * nloc) {
      __builtin_amdgcn_fence(__ATOMIC_RELEASE, "agent");
      asm volatile("s_waitcnt vmcnt(0)" ::: "memory");
      const unsigned og = xb_add(&bar[XB_TOP], 1u);
      const unsigned tg = og / nx;
      if (og + 1u == (tg + 1u) * nx) xb_add(&bar[XB_TOPGEN], 1u);
      else XB_SPIN(xb_ld(&bar[XB_TOPGEN]) == tg, bar);
      __builtin_amdgcn_fence(__ATOMIC_ACQUIRE, "agent");
      xb_add(&bar[XB_XGEN(b.x)], 1u);
      asm volatile("s_waitcnt vmcnt(0)" ::: "memory");
    } else {
      XB_SPIN(xb_ld(&bar[XB_XGEN(b.x)]) == gen, bar);
      __builtin_amdgcn_fence(__ATOMIC_ACQUIRE, "agent");
      asm volatile("s_waitcnt vmcnt(0)" ::: "memory");
    }
  }
  __syncthreads();
}

struct TJob { const float* src; const float* rs; bf16_t* dst; int K, N, tk, tn, perm; };
DI TJob tr_job(const Params& p, int t) {
  TJob j; j.rs = nullptr; j.perm = 0;
  const int i2 = t / 2312; t -= i2 * 2312;
  if (t < 640) { j.src = p.ab_in_w + (size_t)i2 * 1024 * 2464; j.K = 1024; j.N = 2464; j.dst = (bf16_t*)(p.ws + OFF_W_IN) + (size_t)i2 * 2560 * 1024; j.tk = t / 40; j.tn = t % 40; }
  else if ((t -= 640) < 256) { j.src = p.ab_out_w + (size_t)i2 * 1024 * 1024; j.K = 1024; j.N = 1024; j.dst = (bf16_t*)(p.ws + OFF_W_OUT) + (size_t)i2 * 1024 * 1024; j.tk = t / 16; j.tn = t % 16; }
  else if ((t -= 256) < 72) { j.src = p.b_w_uq + (size_t)i2 * 384 * 768; j.K = 384; j.N = 768; j.dst = (bf16_t*)(p.ws + OFF_W_UQ) + (size_t)i2 * 768 * 384; j.rs = p.b_qn_g + i2 * 384; j.tk = t / 12; j.tn = t % 12; }
  else if ((t -= 72) < 64) { j.src = p.b_w_ukv + (size_t)i2 * 256 * 1024; j.K = 256; j.N = 1024; j.dst = (bf16_t*)(p.ws + OFF_W_UKV) + (size_t)i2 * 1024 * 256; j.rs = p.b_kvn_g + i2 * 256; j.tk = t / 16; j.tn = t % 16; j.perm = 1; }
  else if ((t -= 64) < 1024) { j.src = p.c_in_w + (size_t)i2 * 1024 * 4096; j.K = 1024; j.N = 4096; j.dst = (bf16_t*)(p.ws + OFF_W_CIN) + (size_t)i2 * 4096 * 1024; j.tk = t / 64; j.tn = t % 64; }
  else { t -= 1024; j.src = p.c_out_w + (size_t)i2 * 1024 * 1024; j.K = 1024; j.N = 1024; j.dst = (bf16_t*)(p.ws + OFF_W_COUT) + (size_t)i2 * 1024 * 1024; j.tk = t / 16; j.tn = t % 16; }
  return j;
}
DI void tr_load(const TJob& j, int tid, float (&v)[8]) {
#pragma unroll
  for (int i = 0; i < 8; ++i) {
    const int kk = (tid >> 6) + 8 * i, n = j.tn * 64 + (tid & 63);
    float x = (n < j.N) ? j.src[(size_t)(j.tk * 64 + kk) * j.N + n] : 0.f;
    if (j.rs) x *= j.rs[j.tk * 64 + kk];
    v[i] = x;
  }
}

DI void prologue_phase(const Params& p, char* lds) {
  const int tid = otid();
  constexpr int N_MOD = 192, N_TR = 4624, N_ROPE = 768;
  for (int u = obid(); u < N_MOD + N_TR + N_ROPE; u += ogrid()) {
    if (u < N_MOD) {
      const int layer = u / 48, cb = u % 48;
      float* sl = (float*)lds;
      for (int i = tid; i < 5120; i += NT) {
        const int bb = i >> 10, k = i & 1023;
        const float cv = bb < 4 ? p.c[bb * 1024 + k] : p.c_ctx[k];
        sl[i] = silu(cv);
      }
      __syncthreads();
      const int col = cb * 64 + (tid & 63), kg = tid >> 6;
      float a0 = 0, a1 = 0, a2 = 0, a3 = 0, a4 = 0;
      const float* wp = p.ada_w + (size_t)layer * 1024 * 3072 + col;
#pragma unroll 32
      for (int k = kg * 128; k < kg * 128 + 128; ++k) {
        const float wv = wp[(size_t)k * 3072];
        a0 += sl[k] * wv; a1 += sl[1024 + k] * wv; a2 += sl[2048 + k] * wv; a3 += sl[3072 + k] * wv; a4 += sl[4096 + k] * wv;
      }
      float* red = (float*)(lds + 20480);
      red[(kg * 5 + 0) * 64 + (tid & 63)] = a0; red[(kg * 5 + 1) * 64 + (tid & 63)] = a1; red[(kg * 5 + 2) * 64 + (tid & 63)] = a2;
      red[(kg * 5 + 3) * 64 + (tid & 63)] = a3; red[(kg * 5 + 4) * 64 + (tid & 63)] = a4;
      __syncthreads();
      if (tid < 64) {
        float* mod = (float*)(p.ws + OFF_MOD);
        const float bias = p.ada_b[layer * 3072 + col];
#pragma unroll
        for (int bb = 0; bb < 5; ++bb) {
          float s = bias;
#pragma unroll
          for (int g = 0; g < 8; ++g) s += red[(g * 5 + bb) * 64 + tid];
          mod[(size_t)(layer * 5 + bb) * 3072 + col] = s;
        }
      }
      __syncthreads();
    } else if (u < N_MOD + N_TR) {
    } else {
      const int idx = (u - N_MOD - N_TR) * NT + tid;
      float* ropeA = (float*)(p.ws + OFF_ROPE);
      float* ropeB = ropeA + 2 * 8192 * 32;
      if (idx < 8192 * 32) {
        const int pos = idx >> 5, pr = idx & 31;
        const float pv = pr < 16 ? (float)(pos >> 6) : (float)(pos & 63);
        const float inv = exp2f(-(float)(pr & 15) * (13.287712379549449f / 16.f));
        const float ang = pv * inv;
        ropeA[idx] = cosf(ang); ropeA[8192 * 32 + idx] = sinf(ang);
      } else {
        const int j = idx - 8192 * 32;
        const int pos = j >> 4, pr = j & 15;
        const float pv = pr < 8 ? (float)(pos >> 6) : (float)(pos & 63);
        const float inv = exp2f(-(float)(pr & 7) * (13.287712379549449f / 8.f));
        const float ang = pv * inv;
        ropeB[j] = cosf(ang); ropeB[8192 * 16 + j] = sinf(ang);
      }
    }
  }
  {
    const int G = ogrid();
    int t = obid();
    float v[8], nv[8];
    TJob cur, nxt;
    if (t < N_TR) { cur = tr_job(p, t); tr_load(cur, tid, v); }
    int buf = 0;
    for (; t < N_TR; t += G) {
      const bool more = t + G < N_TR;
      if (more) { nxt = tr_job(p, t + G); tr_load(nxt, tid, nv); }
      float* tile = (float*)(lds + buf * 16640);
#pragma unroll
      for (int i = 0; i < 8; ++i) tile[((tid >> 6) + 8 * i) * 65 + (tid & 63)] = v[i];
      __syncthreads();
      {
        const int nn = tid & 63, k8 = (tid >> 6) * 8;
        int n = cur.tn * 64 + nn;
        if (cur.perm) n = ((n & 64) ? 512 : 0) + (n >> 7) * 64 + (n & 63);
        u32x4 w;
        w.x = pack_bf16(tile[(k8 + 0) * 65 + nn], tile[(k8 + 1) * 65 + nn]); w.y = pack_bf16(tile[(k8 + 2) * 65 + nn], tile[(k8 + 3) * 65 + nn]);
        w.z = pack_bf16(tile[(k8 + 4) * 65 + nn], tile[(k8 + 5) * 65 + nn]); w.w = pack_bf16(tile[(k8 + 6) * 65 + nn], tile[(k8 + 7) * 65 + nn]);
        *(u32x4*)(cur.dst + ((size_t)((n >> 8) * (cur.K >> 6) + cur.tk) << 14) + ((n & 255) << 6) + k8) = w;
      }
      buf ^= 1;
      if (more) {
        cur = nxt;
#pragma unroll
        for (int i = 0; i < 8; ++i) v[i] = nv[i];
      }
    }
    __syncthreads();
  }
}

DI float wave_sum(float v) {
#pragma unroll
  for (int o = 32; o >= 1; o >>= 1) v += __shfl_xor(v, o);
  return v;
}

DI void norm_phase(const Params& p, int layer) {
  const int lane = otid() & 63;
  const int wave = obid() * 8 + (otid() >> 6), nw = ogrid() * 8;
  const float* g = p.norm_g + layer * 1024;
  const float* mod = (const float*)(p.ws + OFF_MOD) + (size_t)layer * 5 * 3072;
  bf16_t* U = (bf16_t*)(p.ws + OFF_UG);
  f32x4 gv[4];
#pragma unroll
  for (int i = 0; i < 4; ++i) gv[i] = *(const f32x4*)(g + lane * 4 + 256 * i);
  f32x4 nv[4];
  if (wave < T_ALL) {
    const float* s0 = h_src(p, layer, wave);
#pragma unroll
    for (int i = 0; i < 4; ++i) nv[i] = *(const f32x4*)(s0 + lane * 4 + 256 * i);
  }
  for (int row = wave; row < T_ALL; row += nw) {
    const int bb = row < T_LAT ? (row >> 13) : 4;
    f32x4 v[4];
#pragma unroll
    for (int i = 0; i < 4; ++i) v[i] = nv[i];
    if (row + nw < T_ALL) {
      const float* s1 = h_src(p, layer, row + nw);
#pragma unroll
      for (int i = 0; i < 4; ++i) nv[i] = *(const f32x4*)(s1 + lane * 4 + 256 * i);
    }
    float ss = 0.f;
#pragma unroll
    for (int i = 0; i < 4; ++i) ss += v[i][0] * v[i][0] + v[i][1] * v[i][1] + v[i][2] * v[i][2] + v[i][3] * v[i][3];
    ss = wave_sum(ss);
    const float rstd = rsqrtf(ss * (1.f / 1024.f) + 1e-6f);
    const float* mrow = mod + bb * 3072;
#pragma unroll
    for (int i = 0; i < 4; ++i) {
      const int cidx = lane * 4 + 256 * i;
      const f32x4 sh = *(const f32x4*)(mrow + cidx), sc = *(const f32x4*)(mrow + 1024 + cidx);
      f32x4 o = (v[i] * rstd) * gv[i] * (sc + 1.f) + sh;
      u32x2 w; w.x = pack_bf16(o[0], o[1]); w.y = pack_bf16(o[2], o[3]);
      *(u32x2*)(U + ablk(row, cidx)) = w;
    }
  }
}

DI void final_phase(const Params& p) {
  const int lane = otid() & 63;
  const int wave = obid() * 8 + (otid() >> 6), nw = ogrid() * 8;
  f32x4 gv[4];
#pragma unroll
  for (int i = 0; i < 4; ++i) gv[i] = *(const f32x4*)(p.final_g + lane * 4 + 256 * i);
  f32x4 nv[4];
  if (wave < T_LAT) {
#pragma unroll
    for (int i = 0; i < 4; ++i) nv[i] = *(const f32x4*)(p.out + (size_t)wave * 1024 + lane * 4 + 256 * i);
  }
  for (int row = wave; row < T_LAT; row += nw) {
    float* src = p.out + (size_t)row * 1024;
    f32x4 v[4];
#pragma unroll
    for (int i = 0; i < 4; ++i) v[i] = nv[i];
    if (row + nw < T_LAT) {
#pragma unroll
      for (int i = 0; i < 4; ++i) nv[i] = *(const f32x4*)(p.out + (size_t)(row + nw) * 1024 + lane * 4 + 256 * i);
    }
    float ss = 0.f;
#pragma unroll
    for (int i = 0; i < 4; ++i) ss += v[i][0] * v[i][0] + v[i][1] * v[i][1] + v[i][2] * v[i][2] + v[i][3] * v[i][3];
    ss = wave_sum(ss);
    const float rstd = rsqrtf(ss * (1.f / 1024.f) + 1e-6f);
#pragma unroll
    for (int i = 0; i < 4; ++i) *(f32x4*)(src + lane * 4 + 256 * i) = (v[i] * rstd) * gv[i];
  }
}

enum { EPI_AB_IN = 0, EPI_QB = 1, EPI_KVB = 2, EPI_C_IN = 3, EPI_OUT = 4 };
constexpr int G_STR = 144;
constexpr int G_OPER = 256 * G_STR;
constexpr int G_STAGE = 2 * G_OPER;
constexpr int OFF_RSTD = 2 * G_STAGE;
constexpr int LDS_BYTES = OFF_RSTD + 1024;

DI void rope2(float& v0, float& v1, float& v2, float& v3, const float* cs, const float* sn) {
  const f32x2 c = *(const f32x2*)cs, s = *(const f32x2*)sn;
  const float a0 = v0 * c.x - v1 * s.x, a1 = v0 * s.x + v1 * c.x, a2 = v2 * c.y - v3 * s.y, a3 = v2 * s.y + v3 * c.y;
  v0 = a0; v1 = a1; v2 = a2; v3 = a3;
}

template <int EPI>
DI void epi_math(const Params& p, int tok, int f0, float& v0, float& v1, float& v2, float& v3, float rs) {
  const float* ropeA = (const float*)(p.ws + OFF_ROPE);
  const float* ropeB = ropeA + 2 * 8192 * 32;
  const bool lat = tok < T_LAT;
  const int pos = tok & 8191;
  if (EPI == EPI_AB_IN) {
    if (f0 < 640) {
      if (lat) { const int p0 = (f0 & 63) >> 1; rope2(v0, v1, v2, v3, ropeA + pos * 32 + p0, ropeA + 8192 * 32 + pos * 32 + p0); }
      if (f0 < 512) { v0 *= QSCALE_A; v1 *= QSCALE_A; v2 *= QSCALE_A; v3 *= QSCALE_A; }
    } else if (f0 >= 1920 && f0 < 1952) {
      if (lat) { const int p0 = (f0 - 1920) >> 1; rope2(v0, v1, v2, v3, ropeB + pos * 16 + p0, ropeB + 8192 * 16 + pos * 16 + p0); }
    }
  } else if (EPI == EPI_QB) {
    const float s = rs * QSCALE_B;
    v0 *= s; v1 *= s; v2 *= s; v3 *= s;
    const int fh = f0 % 96;
    if (fh >= 64 && lat) { const int p0 = (fh - 64) >> 1; rope2(v0, v1, v2, v3, ropeB + pos * 16 + p0, ropeB + 8192 * 16 + pos * 16 + p0); }
  } else if (EPI == EPI_KVB) {
    v0 *= rs; v1 *= rs; v2 *= rs; v3 *= rs;
  } else if (EPI == EPI_C_IN) {
    if (f0 < 1024) { v0 *= QSCALE_A; v1 *= QSCALE_A; v2 *= QSCALE_A; v3 *= QSCALE_A; }
  }
}

template <int EPI>
DI bf16_t* dst_tr(const Params& p, int tok, int col) {
  if (EPI == EPI_AB_IN) return col < 2464 ? (bf16_t*)(p.ws + OFF_P) + (size_t)tok * 2560 + col : nullptr;
  if (EPI == EPI_QB) return (bf16_t*)(p.ws + OFF_QB) + (size_t)tok * 768 + col;
  if (EPI == EPI_KVB) return (bf16_t*)(p.ws + OFF_KB) + (size_t)tok * 512 + col;
  return (bf16_t*)(p.ws + OFF_P) + (size_t)tok * 3072 + (col >= 3072 ? col - 1024 : col);
}
template <int EPI>
DI bf16_t* dst_v(const Params& p, int t0, int col) {
  int b, key; tok_bk(t0, b, key);
  if (EPI == EPI_KVB) return (bf16_t*)(p.ws + OFF_VTB) + ((size_t)(b * 8 + ((col - 512) >> 6)) * 64 + (col & 63)) * NKEY + key;
  return (bf16_t*)(p.ws + OFF_VT) + ((size_t)(b * 16 + ((col - 2048) >> 6)) * 64 + (col & 63)) * NKEY + key;
}

struct TilePf { bool pre; bool has_next; int nm0, nnt; };
template <int EPI, int TM>
DI void gemm_tile(const Params& p, int layer, const bf16_t* __restrict__ A, int lda, const bf16_t* __restrict__ Bt, int K, int m0, int nt, char* lds,
                  u32x4 (&ra)[TM / 64], u32x4 (&rb)[4], const TilePf pf) {
  constexpr int NJ = TM == 256 ? 4 : 2, NI = TM == 256 ? 2 : 1, NA = TM / 64;
  const int tid = otid(), lane = tid & 63, w = tid >> 6;
  const int wm = TM == 256 ? (w >> 2) : 0, wn = TM == 256 ? (w & 3) : w;
  const int fb = TM == 256 ? wn * 64 : wn * 32, tb = TM == 256 ? wm * 128 : 0;
  const int l31 = lane & 31, hh = lane >> 5;
  const int n0 = nt * 256;
  float* rstd = (float*)(lds + OFF_RSTD);
  const int srow = tid >> 3, scc = tid & 7;
  const bool ablocked = (lda == 0);
  const int nkb = K >> 6;
  const bf16_t* ag = ablocked ? A + ((size_t)((m0 >> 8) * 16) << 14) + (m0 & 255) * 64 + tid * 8 : A + (size_t)(m0 + srow) * lda + scc * 8;
  const size_t a_i = ablocked ? 4096 : (size_t)64 * lda, a_k = ablocked ? 16384 : 64;
  const bf16_t* bg = Bt + ((size_t)(nt * nkb) << 14) + tid * 8;

  if (EPI == EPI_QB || EPI == EPI_KVB) {
    __syncthreads();
    if (tid < 2 * TM) {
      const int r = tid >> 1, half = tid & 1;
      const bf16_t* ap = A + (size_t)(m0 + r) * lda + half * (K / 2);
      float ss = 0.f;
#pragma unroll 8
      for (int cidx = 0; cidx < K / 2; cidx += 8) {
        const u32x4 v = *(const u32x4*)(ap + cidx);
#pragma unroll
        for (int e = 0; e < 4; ++e) { const float a = bf_lo(v[e]), b2 = bf_hi(v[e]); ss += a * a + b2 * b2; }
      }
      ss += __shfl_xor(ss, 1);
      if (half == 0) rstd[r] = rsqrtf(ss / (float)K + 1e-6f);
    }
  }

  f32x16 acc[NI][NJ];
#pragma unroll
  for (int i = 0; i < NI; ++i)
#pragma unroll
    for (int j = 0; j < NJ; ++j)
#pragma unroll
      for (int r = 0; r < 16; ++r) acc[i][j][r] = 0.f;

  const int nk = K >> 6;
  if (!pf.pre) {
#pragma unroll
    for (int i = 0; i < NA; ++i) ra[i] = *(const u32x4*)(ag + i * a_i);
#pragma unroll
    for (int i = 0; i < 4; ++i) rb[i] = *(const u32x4*)(bg + i * 4096);
  }
#pragma unroll
  for (int i = 0; i < NA; ++i) *(u32x4*)(lds + (srow + 64 * i) * G_STR + scc * 16) = ra[i];
#pragma unroll
  for (int i = 0; i < 4; ++i) *(u32x4*)(lds + G_OPER + (srow + 64 * i) * G_STR + scc * 16) = rb[i];
#pragma unroll
  for (int i = 0; i < NA; ++i) ra[i] = *(const u32x4*)(ag + i * a_i + a_k);
#pragma unroll
  for (int i = 0; i < 4; ++i) rb[i] = *(const u32x4*)(bg + i * 4096 + 16384);
  __syncthreads();
  for (int kt = 0; kt < nk; ++kt) {
    {
      char* st = lds + ((kt + 1) & 1) * G_STAGE;
#pragma unroll
      for (int i = 0; i < NA; ++i) *(u32x4*)(st + (srow + 64 * i) * G_STR + scc * 16) = ra[i];
#pragma unroll
      for (int i = 0; i < 4; ++i) *(u32x4*)(st + G_OPER + (srow + 64 * i) * G_STR + scc * 16) = rb[i];
    }
    if (kt + 2 < nk) {
#pragma unroll
      for (int i = 0; i < NA; ++i) ra[i] = *(const u32x4*)(ag + i * a_i + (size_t)(kt + 2) * a_k);
#pragma unroll
      for (int i = 0; i < 4; ++i) rb[i] = *(const u32x4*)(bg + i * 4096 + ((size_t)(kt + 2) << 14));
    }
    __builtin_amdgcn_sched_barrier(0);
    const char* as = lds + (kt & 1) * G_STAGE;
    const char* fp = as + G_OPER + (fb + l31) * G_STR + hh * 16;
    const char* sp = as + (tb + l31) * G_STR + hh * 16;
#pragma unroll
    for (int ks = 0; ks < 4; ++ks) {
      bf16x8 f[NI], s[NJ];
#pragma unroll
      for (int i = 0; i < NI; ++i) f[i] = *(const bf16x8*)(fp + i * 32 * G_STR + ks * 32);
#pragma unroll
      for (int j = 0; j < NJ; ++j) s[j] = *(const bf16x8*)(sp + j * 32 * G_STR + ks * 32);
#pragma unroll
      for (int j = 0; j < NJ; ++j)
#pragma unroll
        for (int i = 0; i < NI; ++i) acc[i][j] = MFMA32(f[i], s[j], acc[i][j]);
    }
    __syncthreads();
  }

  auto prefetch_next = [&]() {
    if (TM == 256 && pf.has_next) {
      const bf16_t* nag = ablocked ? A + ((size_t)((pf.nm0 >> 8) * 16) << 14) + (pf.nm0 & 255) * 64 + tid * 8 : A + (size_t)(pf.nm0 + srow) * lda + scc * 8;
      const bf16_t* nbg = Bt + ((size_t)(pf.nnt * nkb) << 14) + tid * 8;
#pragma unroll
      for (int i = 0; i < NA; ++i) ra[i] = *(const u32x4*)(nag + i * a_i);
#pragma unroll
      for (int i = 0; i < 4; ++i) rb[i] = *(const u32x4*)(nbg + i * 4096);
      __builtin_amdgcn_sched_barrier(0);
    }
  };
  constexpr int SB = 528;
  constexpr int SV = TM * 2 + 16;
  constexpr int NIT = TM * 32 / NT;
  if (EPI == EPI_OUT) {
    const int bb = m0 < T_LAT ? (m0 >> 13) : 4;
    constexpr int SF = 1040;
    constexpr int JH = NJ / 2;
    constexpr int NITO = (TM / 2) * 64 / NT;
    const float* gate = (const float*)(p.ws + OFF_MOD) + (size_t)(layer * 5 + bb) * 3072 + 2048 + n0;
#pragma unroll
    for (int h = 0; h < 2; ++h) {
#pragma unroll
      for (int jj = 0; jj < JH; ++jj)
#pragma unroll
        for (int i = 0; i < NI; ++i)
#pragma unroll
          for (int g = 0; g < 4; ++g) {
            const int j = h * JH + jj;
            f32x4 v; v[0] = acc[i][j][4 * g]; v[1] = acc[i][j][4 * g + 1]; v[2] = acc[i][j][4 * g + 2]; v[3] = acc[i][j][4 * g + 3];
            *(f32x4*)(lds + ((TM == 256 ? wm * 64 : 0) + jj * 32 + l31) * SF + (fb + i * 32 + 8 * g + 4 * hh) * 4) = v;
          }
      if (h == 1) prefetch_next();
      __syncthreads();
      const f32x4 gt = *(const f32x4*)(gate + (tid & 63) * 4);
#pragma unroll
      for (int i0 = 0; i0 < NITO; i0 += 8) {
        f32x4 oldv[8];
#pragma unroll
        for (int k = 0; k < 8; ++k)
          if (i0 + k < NITO) {
            const int cidx = tid + NT * (i0 + k), row = cidx >> 6, ch = cidx & 63;
            const int tok = m0 + (TM == 256 ? (row >> 6) * 128 + h * 64 + (row & 63) : h * 32 + row);
            oldv[k] = *(const f32x4*)(h_src(p, layer, tok) + n0 + ch * 4);
          }
#pragma unroll
        for (int k = 0; k < 8; ++k)
          if (i0 + k < NITO) {
            const int cidx = tid + NT * (i0 + k), row = cidx >> 6, ch = cidx & 63;
            const int tok = m0 + (TM == 256 ? (row >> 6) * 128 + h * 64 + (row & 63) : h * 32 + row);
            const f32x4 y = *(const f32x4*)(lds + row * SF + ch * 16);
            *(f32x4*)(h_dst(p, tok) + n0 + ch * 4) = oldv[k] + gt * y;
          }
      }
      __syncthreads();
    }
  } else {
    const bool vt = (EPI == EPI_KVB && nt >= 2) || (EPI == EPI_C_IN && nt >= 8 && nt < 12);
#pragma unroll
    for (int j = 0; j < NJ; ++j) {
      const int rl = tb + j * 32 + l31;
      float rs = 1.f;
      if (EPI == EPI_QB || EPI == EPI_KVB) rs = rstd[rl];
#pragma unroll
      for (int i = 0; i < NI; ++i)
#pragma unroll
        for (int g = 0; g < 4; ++g) {
          const int fl = fb + i * 32 + 8 * g + 4 * hh;
          float v0 = acc[i][j][4 * g], v1 = acc[i][j][4 * g + 1], v2 = acc[i][j][4 * g + 2], v3 = acc[i][j][4 * g + 3];
          epi_math<EPI>(p, m0 + rl, n0 + fl, v0, v1, v2, v3, rs);
          const unsigned w01 = pack_bf16(v0, v1), w23 = pack_bf16(v2, v3);
          if (!vt) {
            u32x2 wv; wv.x = w01; wv.y = w23;
            *(u32x2*)(lds + rl * SB + fl * 2) = wv;
          } else {
            *(bf16_t*)(lds + (fl + 0) * SV + rl * 2) = (bf16_t)(w01 & 0xffffu);
            *(bf16_t*)(lds + (fl + 1) * SV + rl * 2) = (bf16_t)(w01 >> 16);
            *(bf16_t*)(lds + (fl + 2) * SV + rl * 2) = (bf16_t)(w23 & 0xffffu);
            *(bf16_t*)(lds + (fl + 3) * SV + rl * 2) = (bf16_t)(w23 >> 16);
          }
        }
    }
    prefetch_next();
    __syncthreads();
#pragma unroll 4
    for (int it = 0; it < NIT; ++it) {
      const int cidx = tid + NT * it;
      if (vt) {
        const int row = cidx / (TM / 8), ch = cidx % (TM / 8);
        *(u32x4*)dst_v<EPI>(p, m0 + ch * 8, n0 + row) = *(const u32x4*)(lds + row * SV + ch * 16);
      } else {
        const int row = cidx >> 5, ch = cidx & 31;
        bf16_t* d = dst_tr<EPI>(p, m0 + row, n0 + ch * 8);
        if (d) *(u32x4*)d = *(const u32x4*)(lds + row * SB + ch * 16);
      }
    }
    __syncthreads();
  }
}

template <int EPI>
DI void gemm_phase(const Params& p, int layer, const bf16_t* A, int lda, const bf16_t* Bt, int K, int mtiles, int ntiles, bool ctx, bool reverse, char* lds,
                   int ctx_nt0 = 0, int ctx_ntn = -1) {
  const int G = ogrid();
  const int bid = reverse ? (G - 1 - obid()) : obid();
  u32x4 ra[4], rb[4];
  const bool simple = (G & 7) != 0;
  const int xcd = bid & 7, local = simple ? bid : (bid >> 3), nlocal = simple ? G : (G >> 3);
  const int mlo = simple ? 0 : ((xcd * mtiles) >> 3), cnt = simple ? mtiles : ((((xcd + 1) * mtiles) >> 3) - mlo);
  const int total = cnt * ntiles, gsize = 4 * ntiles;
  auto tile_of = [&](int j, int& m0, int& nt) {
    const int g = j / gsize, r = j - g * gsize;
    int gm = cnt - g * 4; gm = gm > 4 ? 4 : gm;
    m0 = (mlo + g * 4 + (r % gm)) * 256; nt = r / gm;
  };
  bool pre = false;
  for (int j = local; j < total; j += nlocal) {
    int m0, nt; tile_of(j, m0, nt);
    TilePf pf; pf.pre = pre; pf.has_next = (j + nlocal < total); pf.nm0 = 0; pf.nnt = 0;
    if (pf.has_next) tile_of(j + nlocal, pf.nm0, pf.nnt);
    gemm_tile<EPI, 256>(p, layer, A, lda, Bt, K, m0, nt, lds, ra, rb, pf);
    pre = pf.has_next;
  }
  if (ctx) {
    const int b2 = G - 1 - bid;
    u32x4 ra1[1];
    TilePf pf; pf.pre = false; pf.has_next = false; pf.nm0 = 0; pf.nnt = 0;
    const int cn = ctx_ntn < 0 ? ntiles : ctx_ntn;
    for (int u = b2; u < 16 * cn; u += G) gemm_tile<EPI, 64>(p, layer, A, lda, Bt, K, T_LAT + (u & 15) * 64, ctx_nt0 + (u >> 4), lds, ra1, rb, pf);
  }
}

DI void vta_phase(const Params& p, char* lds) {
  const int tid = otid();
  const bf16_t* Pb = (const bf16_t*)(p.ws + OFF_P);
  for (int u = ogrid() - 1 - obid(); u < T_ALL / 64; u += ogrid()) {
    const int t0 = u * 64;
#pragma unroll
    for (int it = 0; it < 2; ++it) {
      const int cidx = tid + NT * it, row = cidx >> 4, ch = cidx & 15;
      *(u32x4*)(lds + row * 272 + ch * 16) = *(const u32x4*)(Pb + (size_t)(t0 + row) * 2560 + 640 + ch * 8);
    }
    __syncthreads();
    int b, key; tok_bk(t0, b, key);
#pragma unroll
    for (int it = 0; it < 2; ++it) {
      const int cidx = tid + NT * it, f = cidx & 127, tc = cidx >> 7;
      unsigned short e[8];
#pragma unroll
      for (int k = 0; k < 8; ++k) e[k] = *(const bf16_t*)(lds + (tc * 8 + k) * 272 + f * 2);
      u32x4 v; v.x = e[0] | ((unsigned)e[1] << 16); v.y = e[2] | ((unsigned)e[3] << 16); v.z = e[4] | ((unsigned)e[5] << 16); v.w = e[6] | ((unsigned)e[7] << 16);
      *(u32x4*)((bf16_t*)(p.ws + OFF_VT) + ((size_t)(b * 2 + (f >> 6)) * 64 + (f & 63)) * NKEY + key + tc * 8) = v;
    }
    __syncthreads();
  }
}

template <int MODE>
DI void attn_item(const Params& p, int layer, int b, int qt, int head, bool is_ctx, char* lds) {
  constexpr int DK = (MODE == 1) ? 96 : 64;
  constexpr int NKS = DK / 16;
  constexpr int KSTR = DK * 2 + 16;
  constexpr int VSTR = 144;
  constexpr int KBYTES = 64 * KSTR;
  constexpr int STAGE = KBYTES + 64 * VSTR;
  constexpr int QPB = 256;
  constexpr int NKC = DK / 8;
  constexpr int KCH = 64 * NKC;
  constexpr int OSTR = 272;
  constexpr float MASKV = -1e30f;
  float* rpbs = (float*)(lds + 4 * STAGE);
  char* ostage = lds;

  const int tid = otid(), lane = tid & 63, w = tid >> 6, l31 = lane & 31, hh = lane >> 5;
  const int i2 = layer >> 1;
  const bf16_t* Pb = (const bf16_t*)(p.ws + OFF_P);
  bf16_t* UG = (bf16_t*)(p.ws + OFF_UG);
  const bf16_t *Qp, *Kp, *Krp = nullptr, *Zp, *Vt;
  int ldq, ldk, ldz, gcol;
  if (MODE == 0) {
    Qp = Pb + head * 64; ldq = 2560; Kp = Pb + 512 + (head >> 2) * 64; ldk = 2560;
    Vt = (const bf16_t*)(p.ws + OFF_VT) + (size_t)(b * 2 + (head >> 2)) * 64 * NKEY;
    Zp = Pb + 768 + head * 64; ldz = 2560; gcol = head * 64;
  } else if (MODE == 1) {
    Qp = (const bf16_t*)(p.ws + OFF_QB) + head * 96; ldq = 768; Kp = (const bf16_t*)(p.ws + OFF_KB) + head * 64; ldk = 512; Krp = Pb + 1920;
    Vt = (const bf16_t*)(p.ws + OFF_VTB) + (size_t)(b * 8 + head) * 64 * NKEY;
    Zp = Pb + 1952 + head * 64; ldz = 2560; gcol = 512 + head * 64;
  } else {
    Qp = Pb + head * 64; ldq = 3072; Kp = Pb + 1024 + head * 64; ldk = 3072;
    Vt = (const bf16_t*)(p.ws + OFF_VT) + (size_t)(b * 16 + head) * 64 * NKEY;
    Zp = Pb + 2048 + head * 64; ldz = 3072; gcol = head * 64;
  }
  const int qtok0 = is_ctx ? T_LAT + b * 256 : b * 8192 + qt * QPB;

  int lat_lo = 0, nlat = 0;
  if (!is_ctx) {
    if (MODE == 0) {
      int lo = 4 * qt - 2; if (lo < 0) lo = 0;
      int hi = 4 * qt + 5; if (hi > 127) hi = 127;
      lat_lo = lo; nlat = hi - lo + 1;
    } else if (MODE == 1) { lat_lo = 0; nlat = 128; }
    else {
      int lo = 4 * qt - 4; lo = lo < 0 ? 0 : (lo > 120 ? 120 : lo);
      int hi = 4 * qt + 3 - 4; hi = hi < 0 ? 0 : (hi > 120 ? 120 : hi); hi += 7;
      lat_lo = lo; nlat = hi - lo + 1;
    }
  }
  const int ntiles = nlat + 4;

  const bool nat2 = (MODE == 2) && !is_ctx;
  auto tokmap = [&](int row) { return nat2 ? qtok0 + ((w >> 2) * 2 + (row >> 4)) * 64 + (w & 3) * 16 + (row & 15) : qtok0 + w * 32 + row; };
  const int qtok = tokmap(l31);
  bf16x8 qf[NKS];
#pragma unroll
  for (int ks = 0; ks < NKS; ++ks) qf[ks] = *(const bf16x8*)(Qp + (size_t)qtok * ldq + ks * 16 + hh * 8);
  if (MODE == 2 && !is_ctx) {
    for (int i = tid; i < 465; i += NT) rpbs[i] = p.c_rpb[(size_t)(i2 * 16 + head) * 465 + i] * LOG2E;
  }
  float m_ = (MODE == 0) ? p.a_sink[i2 * 8 + head] * LOG2E : MASKV;
  float l_ = (MODE == 0 && hh == 0) ? 1.f : 0.f;
  f32x16 O[2];
#pragma unroll
  for (int dh = 0; dh < 2; ++dh)
#pragma unroll
    for (int r = 0; r < 16; ++r) O[dh][r] = 0.f;

  const int k0row = tid / NKC, k0cc = tid % NKC;
  const int k1row = (tid + NT) / NKC, k1cc = (tid + NT) % NKC;
  const bool k1 = (KCH > NT) && (tid + NT < KCH);
  struct Stg { u32x4 k0, k1, v; };
  Stg R0, R1;
  R0.k1 = (u32x4){0u, 0u, 0u, 0u}; R1.k1 = R0.k1;
  auto tile_kt = [&](int i) { return i < nlat ? lat_lo + i : 128 + (i - nlat); };
  auto kload = [&](int krow0, int row, int cc) -> u32x4 {
    if (MODE == 1 && cc >= 8) return *(const u32x4*)(Krp + (size_t)(krow0 + row) * 2560 + (cc - 8) * 8);
    return *(const u32x4*)(Kp + (size_t)(krow0 + row) * ldk + cc * 8);
  };
  auto gload = [&](int i, Stg& r) {
    const int kt = tile_kt(i < ntiles ? i : ntiles - 1);
    const int krow0 = kt < 128 ? b * 8192 + kt * 64 : T_LAT + b * 256 + (kt - 128) * 64;
    r.k0 = kload(krow0, k0row, k0cc);
    if (k1) r.k1 = kload(krow0, k1row, k1cc);
    r.v = *(const u32x4*)(Vt + (size_t)(tid >> 3) * NKEY + kt * 64 + (tid & 7) * 8);
  };
  auto lstore = [&](int st, const Stg& r) {
    char* kb = lds + st * STAGE;
    *(u32x4*)(kb + k0row * KSTR + k0cc * 16) = r.k0;
    if (k1) *(u32x4*)(kb + k1row * KSTR + k1cc * 16) = r.k1;
    *(u32x4*)(kb + KBYTES + (tid >> 3) * VSTR + (tid & 7) * 16) = r.v;
  };

  const int pr = (l31 & ~12) | ((l31 & 4) << 1) | ((l31 & 8) >> 1);
  int qr = 0, qc = 0, rs0 = 0, cs = 0, csw = 0, wlo = 0, whi = 0;
  if (MODE == 2) {
    qr = qt * 4 + (w >> 2) * 2 + (l31 >> 4); qc = (w & 3) * 16 + (l31 & 15);
    rs0 = qr - 4; rs0 = rs0 < 0 ? 0 : (rs0 > 120 ? 120 : rs0);
    cs = qc - 8; cs = cs < 0 ? 0 : (cs > 48 ? 48 : cs);
    csw = (w & 3) * 16 - 8; csw = csw < 0 ? 0 : (csw > 32 ? 32 : csw);
    const int r_lo = qt * 4 + (w >> 2) * 2;
    wlo = r_lo - 4; wlo = wlo < 0 ? 0 : (wlo > 120 ? 120 : wlo);
    whi = r_lo + 1 - 4; whi = whi < 0 ? 0 : (whi > 120 ? 120 : whi); whi += 7;
  }
  const int s0w = qt * QPB + w * 32;
  const int nsup = (ntiles + 1) >> 1;
  __syncthreads();
  gload(0, R0); gload(1, R1);
  lstore(0, R0); lstore(1, R1);
  gload(2, R0); gload(3, R1);
  __syncthreads();
  auto body = [&](int it, const char* kb) {
    const char* vb = kb + KBYTES;
    const int kt = tile_kt(it);
    const bool lat_tile = it < nlat;
    bool skip = (it >= ntiles);
    if (MODE == 2 && lat_tile) skip = (kt < wlo) || (kt > whi);
    if (MODE == 0 && lat_tile) skip = (kt * 64 + 63 < s0w - 128) || (kt * 64 > s0w + 31 + 128);
    const int nsub = (MODE == 2 && lat_tile) ? 1 : 2;
    const int krb = (MODE == 2 && lat_tile) ? csw : 0;
    if (!skip) {
      f32x16 S[2];
#pragma unroll
      for (int t = 0; t < 2; ++t)
#pragma unroll
        for (int r = 0; r < 16; ++r) S[t][r] = 0.f;
#pragma unroll
      for (int ks = 0; ks < NKS; ++ks) {
        const bf16x8 a0 = *(const bf16x8*)(kb + (krb + pr) * KSTR + ks * 32 + hh * 16);
        S[0] = MFMA32(a0, qf[ks], S[0]);
        if (nsub == 2) {
          const bf16x8 a1 = *(const bf16x8*)(kb + (32 + pr) * KSTR + ks * 32 + hh * 16);
          S[1] = MFMA32(a1, qf[ks], S[1]);
        }
      }
      if (MODE == 0 && lat_tile) {
        const int s = qt * QPB + w * 32 + l31;
#pragma unroll
        for (int t = 0; t < 2; ++t)
#pragma unroll
          for (int r = 0; r < 16; ++r) {
            const int kk = kt * 64 + t * 32 + 16 * (r >> 3) + 8 * hh + (r & 7);
            const int d = kk - s;
            if (d > 128 || d < -128) S[t][r] = MASKV;
          }
      }
      if (MODE == 2 && lat_tile) {
        int ri = kt - qr + 7; ri = ri < 0 ? 0 : (ri > 14 ? 14 : ri);
        const float* brow = rpbs + ri * 31;
        const bool rok = (kt >= rs0) && (kt <= rs0 + 7);
        float bv[16];
#pragma unroll
        for (int r = 0; r < 16; ++r) {
          const int kc = csw + 16 * (r >> 3) + 8 * hh + (r & 7);
          int bi = kc - qc + 15; bi = bi < 0 ? 0 : (bi > 30 ? 30 : bi);
          bv[r] = brow[bi];
        }
#pragma unroll
        for (int r = 0; r < 16; ++r) asm volatile("" : "+v"(bv[r]));
#pragma unroll
        for (int r = 0; r < 16; ++r) {
          const int kc = csw + 16 * (r >> 3) + 8 * hh + (r & 7);
          const bool ok = rok && (kc >= cs) && (kc < cs + 16);
          S[0][r] = ok ? S[0][r] + bv[r] : MASKV;
        }
      }
      float mx = S[0][0];
#pragma unroll
      for (int r = 0; r < 16; ++r) mx = fmaxf(mx, S[0][r]);
      if (nsub == 2) {
#pragma unroll
        for (int r = 0; r < 16; ++r) mx = fmaxf(mx, S[1][r]);
      }
      mx = pair_max(mx);
      if (__any(mx > m_ + 8.f)) {
        const float mnew = fmaxf(m_, mx);
        const float alpha = fexp2(m_ - mnew);
        m_ = mnew;
        l_ *= alpha;
#pragma unroll
        for (int dh = 0; dh < 2; ++dh)
#pragma unroll
          for (int r = 0; r < 16; ++r) O[dh][r] *= alpha;
      }
      float rsum = 0.f;
#pragma unroll
      for (int t = 0; t < 2; ++t)
        if (t < nsub) {
#pragma unroll
          for (int r = 0; r < 16; ++r) { const float e = fexp2(S[t][r] - m_); S[t][r] = e; rsum += e; }
        }
      l_ += rsum;
#pragma unroll
      for (int t = 0; t < 2; ++t)
       if (t < nsub)
#pragma unroll
        for (int s = 0; s < 2; ++s) {
          u32x4 u;
          u.x = pack_bf16(S[t][8 * s + 0], S[t][8 * s + 1]); u.y = pack_bf16(S[t][8 * s + 2], S[t][8 * s + 3]);
          u.z = pack_bf16(S[t][8 * s + 4], S[t][8 * s + 5]); u.w = pack_bf16(S[t][8 * s + 6], S[t][8 * s + 7]);
          const bf16x8 pf = __builtin_bit_cast(bf16x8, u);
#pragma unroll
          for (int dh = 0; dh < 2; ++dh) {
            const bf16x8 v = *(const bf16x8*)(vb + (dh * 32 + l31) * VSTR + (krb + t * 32 + s * 16 + hh * 8) * 2);
            O[dh] = MFMA32(v, pf, O[dh]);
          }
        }
    }
  };
  for (int j = 0; j < nsup; ++j) {
    const char* sb = lds + (j & 1) * 2 * STAGE;
    body(2 * j, sb);
    body(2 * j + 1, sb + STAGE);
    __builtin_amdgcn_sched_barrier(0);
    {
      const int so = ((j + 1) & 1) * 2;
      lstore(so, R0); lstore(so + 1, R1);
      gload(2 * j + 4, R0); gload(2 * j + 5, R1);
    }
    __syncthreads();
  }

  {
    const float lt = l_ + __shfl_xor(l_, 32);
    const float inv = 1.f / lt;
    char* orow = ostage + (w * 32) * OSTR;
#pragma unroll
    for (int dh = 0; dh < 2; ++dh)
#pragma unroll
      for (int g = 0; g < 4; ++g) {
        f32x4 v; v[0] = O[dh][4 * g] * inv; v[1] = O[dh][4 * g + 1] * inv; v[2] = O[dh][4 * g + 2] * inv; v[3] = O[dh][4 * g + 3] * inv;
        *(f32x4*)(orow + l31 * OSTR + (dh * 32 + 8 * g + 4 * hh) * 4) = v;
      }
    __builtin_amdgcn_s_waitcnt(0xc07f);
#pragma unroll
    for (int it = 0; it < 4; ++it) {
      const int cidx = lane + 64 * it, row = cidx >> 3, ch = cidx & 7;
      const f32x4 o0 = *(const f32x4*)(orow + row * OSTR + ch * 32), o1 = *(const f32x4*)(orow + row * OSTR + ch * 32 + 16);
      const int tok = tokmap(row);
      const u32x4 z = *(const u32x4*)(Zp + (size_t)tok * ldz + ch * 8);
      u32x4 wv;
      wv.x = pack_bf16(o0[0] * silu(bf_lo(z.x)), o0[1] * silu(bf_hi(z.x)));
      wv.y = pack_bf16(o0[2] * silu(bf_lo(z.y)), o0[3] * silu(bf_hi(z.y)));
      wv.z = pack_bf16(o1[0] * silu(bf_lo(z.z)), o1[1] * silu(bf_hi(z.z)));
      wv.w = pack_bf16(o1[2] * silu(bf_lo(z.w)), o1[3] * silu(bf_hi(z.w)));
      *(u32x4*)(UG + ablk(tok, gcol + ch * 8)) = wv;
    }
  }
}

DI void mla_item2(const Params& p, int layer, int b, int qt, int head, char* lds) {
  constexpr int DK = 96, NKS = 6, KSTR = DK * 2 + 16, VSTR = 144, KBYTES = 64 * KSTR, STAGE = KBYTES + 64 * VSTR;
  constexpr int NKC = 12, KCH = 64 * NKC, OSTR = 272, QG = 2, NTILES = 132;
  constexpr float MASKV = -1e30f;
  char* ostage = lds;
  const int tid = otid(), lane = tid & 63, w = tid >> 6, l31 = lane & 31, hh = lane >> 5;
  const bf16_t* Pb = (const bf16_t*)(p.ws + OFF_P);
  bf16_t* UG = (bf16_t*)(p.ws + OFF_UG);
  const bf16_t* Qp = (const bf16_t*)(p.ws + OFF_QB) + head * 96;
  const bf16_t* Kp = (const bf16_t*)(p.ws + OFF_KB) + head * 64;
  const bf16_t* Krp = Pb + 1920;
  const bf16_t* Vt = (const bf16_t*)(p.ws + OFF_VTB) + (size_t)(b * 8 + head) * 64 * NKEY;
  const bf16_t* Zp = Pb + 1952 + head * 64;
  const int gcol = 512 + head * 64;
  const int qtok0 = b * 8192 + qt * 512;
  bf16x8 qf[QG][NKS];
#pragma unroll
  for (int qg = 0; qg < QG; ++qg)
#pragma unroll
    for (int ks = 0; ks < NKS; ++ks) qf[qg][ks] = *(const bf16x8*)(Qp + (size_t)(qtok0 + qg * 256 + w * 32 + l31) * 768 + ks * 16 + hh * 8);
  float m_[QG], l_[QG];
  f32x16 O[QG][2];
#pragma unroll
  for (int qg = 0; qg < QG; ++qg) {
    m_[qg] = MASKV; l_[qg] = 0.f;
#pragma unroll
    for (int dh = 0; dh < 2; ++dh)
#pragma unroll
      for (int r = 0; r < 16; ++r) O[qg][dh][r] = 0.f;
  }
  const int k0row = tid / NKC, k0cc = tid % NKC;
  const int k1row = (tid + NT) / NKC, k1cc = (tid + NT) % NKC;
  const bool k1 = (tid + NT < KCH);
  struct Stg { u32x4 k0, k1, v; };
  Stg R0;
  R0.k1 = (u32x4){0u, 0u, 0u, 0u};
  auto kload = [&](int krow0, int row, int cc) -> u32x4 {
    if (cc >= 8) return *(const u32x4*)(Krp + (size_t)(krow0 + row) * 2560 + (cc - 8) * 8);
    return *(const u32x4*)(Kp + (size_t)(krow0 + row) * 512 + cc * 8);
  };
  auto gload = [&](int i, Stg& r) {
    const int kt = i < NTILES ? i : NTILES - 1;
    const int krow0 = kt < 128 ? b * 8192 + kt * 64 : T_LAT + b * 256 + (kt - 128) * 64;
    r.k0 = kload(krow0, k0row, k0cc);
    if (k1) r.k1 = kload(krow0, k1row, k1cc);
    r.v = *(const u32x4*)(Vt + (size_t)(tid >> 3) * NKEY + kt * 64 + (tid & 7) * 8);
  };
  auto lstore = [&](int st, const Stg& r) {
    char* kb = lds + st * STAGE;
    *(u32x4*)(kb + k0row * KSTR + k0cc * 16) = r.k0;
    if (k1) *(u32x4*)(kb + k1row * KSTR + k1cc * 16) = r.k1;
    *(u32x4*)(kb + KBYTES + (tid >> 3) * VSTR + (tid & 7) * 16) = r.v;
  };
  const int pr = (l31 & ~12) | ((l31 & 4) << 1) | ((l31 & 8) >> 1);
  __syncthreads();
  gload(0, R0); lstore(0, R0);
  gload(1, R0);
  __syncthreads();
  auto body = [&](const char* kb) {
    const char* vb = kb + KBYTES;
    f32x16 S[QG][2];
#pragma unroll
    for (int qg = 0; qg < QG; ++qg)
#pragma unroll
      for (int t = 0; t < 2; ++t)
#pragma unroll
        for (int r = 0; r < 16; ++r) S[qg][t][r] = 0.f;
#pragma unroll
    for (int ks = 0; ks < NKS; ++ks) {
      const bf16x8 a0 = *(const bf16x8*)(kb + pr * KSTR + ks * 32 + hh * 16);
      const bf16x8 a1 = *(const bf16x8*)(kb + (32 + pr) * KSTR + ks * 32 + hh * 16);
#pragma unroll
      for (int qg = 0; qg < QG; ++qg) { S[qg][0] = MFMA32(a0, qf[qg][ks], S[qg][0]); S[qg][1] = MFMA32(a1, qf[qg][ks], S[qg][1]); }
    }
#pragma unroll
    for (int qg = 0; qg < QG; ++qg) {
      float mx = S[qg][0][0];
#pragma unroll
      for (int t = 0; t < 2; ++t)
#pragma unroll
        for (int r = 0; r < 16; ++r) mx = fmaxf(mx, S[qg][t][r]);
      mx = pair_max(mx);
      if (__any(mx > m_[qg] + 8.f)) {
        const float mnew = fmaxf(m_[qg], mx);
        const float alpha = fexp2(m_[qg] - mnew);
        m_[qg] = mnew;
        l_[qg] *= alpha;
#pragma unroll
        for (int dh = 0; dh < 2; ++dh)
#pragma unroll
          for (int r = 0; r < 16; ++r) O[qg][dh][r] *= alpha;
      }
      float rsum = 0.f;
#pragma unroll
      for (int t = 0; t < 2; ++t)
#pragma unroll
        for (int r = 0; r < 16; ++r) { const float e = fexp2(S[qg][t][r] - m_[qg]); S[qg][t][r] = e; rsum += e; }
      l_[qg] += rsum;
    }
#pragma unroll
    for (int t = 0; t < 2; ++t)
#pragma unroll
      for (int s = 0; s < 2; ++s) {
        bf16x8 pf[QG];
#pragma unroll
        for (int qg = 0; qg < QG; ++qg) {
          u32x4 u;
          u.x = pack_bf16(S[qg][t][8 * s + 0], S[qg][t][8 * s + 1]); u.y = pack_bf16(S[qg][t][8 * s + 2], S[qg][t][8 * s + 3]);
          u.z = pack_bf16(S[qg][t][8 * s + 4], S[qg][t][8 * s + 5]); u.w = pack_bf16(S[qg][t][8 * s + 6], S[qg][t][8 * s + 7]);
          pf[qg] = __builtin_bit_cast(bf16x8, u);
        }
#pragma unroll
        for (int dh = 0; dh < 2; ++dh) {
          const bf16x8 v = *(const bf16x8*)(vb + (dh * 32 + l31) * VSTR + (t * 32 + s * 16 + hh * 8) * 2);
#pragma unroll
          for (int qg = 0; qg < QG; ++qg) O[qg][dh] = MFMA32(v, pf[qg], O[qg][dh]);
        }
      }
  };
  if (w >= 4) __builtin_amdgcn_s_setprio(2);
  for (int j = 0; j < NTILES; ++j) {
    body(lds + (j & 1) * STAGE);
    __builtin_amdgcn_sched_barrier(0);
    lstore((j + 1) & 1, R0);
    gload(j + 2, R0);
    __syncthreads();
  }
  __builtin_amdgcn_s_setprio(0);
#pragma unroll
  for (int qg = 0; qg < QG; ++qg) {
    const float lt = l_[qg] + __shfl_xor(l_[qg], 32);
    const float inv = 1.f / lt;
    char* orow = ostage + (w * 32) * OSTR;
#pragma unroll
    for (int dh = 0; dh < 2; ++dh)
#pragma unroll
      for (int g = 0; g < 4; ++g) {
        f32x4 v; v[0] = O[qg][dh][4 * g] * inv; v[1] = O[qg][dh][4 * g + 1] * inv; v[2] = O[qg][dh][4 * g + 2] * inv; v[3] = O[qg][dh][4 * g + 3] * inv;
        *(f32x4*)(orow + l31 * OSTR + (dh * 32 + 8 * g + 4 * hh) * 4) = v;
      }
    __builtin_amdgcn_s_waitcnt(0xc07f);
#pragma unroll
    for (int it = 0; it < 4; ++it) {
      const int cidx = lane + 64 * it, row = cidx >> 3, ch = cidx & 7;
      const f32x4 o0 = *(const f32x4*)(orow + row * OSTR + ch * 32), o1 = *(const f32x4*)(orow + row * OSTR + ch * 32 + 16);
      const int tok = qtok0 + qg * 256 + w * 32 + row;
      const u32x4 z = *(const u32x4*)(Zp + (size_t)tok * 2560 + ch * 8);
      u32x4 wv;
      wv.x = pack_bf16(o0[0] * silu(bf_lo(z.x)), o0[1] * silu(bf_hi(z.x)));
      wv.y = pack_bf16(o0[2] * silu(bf_lo(z.y)), o0[3] * silu(bf_hi(z.y)));
      wv.z = pack_bf16(o1[0] * silu(bf_lo(z.z)), o1[1] * silu(bf_hi(z.z)));
      wv.w = pack_bf16(o1[2] * silu(bf_lo(z.w)), o1[3] * silu(bf_hi(z.w)));
      *(u32x4*)(UG + ablk(tok, gcol + ch * 8)) = wv;
    }
    __builtin_amdgcn_s_waitcnt(0xc07f);
  }
}

DI void attn_phase_ab(const Params& p, int layer, char* lds) {
  const int G = ogrid();
  for (int v = obid(); v < 512; v += G) {
    const int xcd = v & 7, s = v >> 3;
    const int grp = (s >> 4) * 8 + xcd, qt = s & 15;
    mla_item2(p, layer, grp >> 3, qt, grp & 7, lds);
  }
  for (int v = obid(); v < 32; v += G) attn_item<1>(p, layer, v >> 3, 0, v & 7, true, lds);
  for (int v = obid(); v < 1024; v += G) {
    attn_item<0>(p, layer, v >> 8, v & 31, (v >> 5) & 7, false, lds);
  }
  for (int v = obid() - 32; v < 32; v += G) if (v >= 0) attn_item<0>(p, layer, v >> 3, 0, v & 7, true, lds);
}

DI void attn_phase_c(const Params& p, int layer, char* lds) {
  const int G = ogrid();
  const int nctx = (layer == 3) ? 0 : 64;
  for (int v = obid(); v < 2048 + nctx; v += G) {
    if (v < 2048) attn_item<2>(p, layer, v >> 9, v & 31, (v >> 5) & 15, false, lds);
    else { const int c = v - 2048; attn_item<2>(p, layer, c >> 4, 0, c & 15, true, lds); }
  }
}

__global__ void __launch_bounds__(512, 2) fwd_megakernel(Params p) {
  __shared__ __attribute__((aligned(16))) char lds[LDS_BYTES];
  __shared__ uint4 xb_words;
  if (threadIdx.x == 0) xb_words = make_uint4(0u, 0u, 0u, 0u);
  __syncthreads();
  if (obid() == 0) { unsigned* bw = (unsigned*)(p.ws + OFF_BAR); for (int i = otid(); i < 4096; i += NT) bw[i] = 0u; }
  XcdBarrier xb; xb.bar = (unsigned*)(p.ws + OFF_BAR); xb.x = 0; xb.st = (volatile LAS unsigned*)&xb_words;
  bool first = true, posted = false;
  for (int ph = p.ph_begin; ph < p.ph_end; ++ph) {
    const int layer = (ph - 1) / 5, s = (ph - 1) % 5;
    const bool even = (layer & 1) == 0;
    const int i2 = layer >> 1;
    if (ph >= 1 && ph <= 20 && s == 2 && !even) continue;
    if (!first) {
      if (!posted) { cg::this_grid().sync(); xb = xcd_barrier_post((unsigned*)(p.ws + OFF_BAR), (volatile LAS unsigned*)&xb_words); posted = true; }
      else xcd_barrier(xb);
    }
    first = false;
    if (ph == 0) prologue_phase(p, lds);
    else if (ph == 21) final_phase(p);
    else if (s == 0) norm_phase(p, layer);
    else if (s == 1) {
      const bf16_t* U = (const bf16_t*)(p.ws + OFF_UG);
      if (even) gemm_phase<EPI_AB_IN>(p, layer, U, 0, (const bf16_t*)(p.ws + OFF_W_IN) + (size_t)i2 * 2560 * 1024, 1024, 128, 10, true, false, lds);
      else if (layer == 3)
        gemm_phase<EPI_C_IN>(p, layer, U, 0, (const bf16_t*)(p.ws + OFF_W_CIN) + (size_t)i2 * 4096 * 1024, 1024, 128, 16, true, false, lds, 4, 8);
      else gemm_phase<EPI_C_IN>(p, layer, U, 0, (const bf16_t*)(p.ws + OFF_W_CIN) + (size_t)i2 * 4096 * 1024, 1024, 128, 16, true, false, lds);
    } else if (s == 2) {
      const bf16_t* Pb = (const bf16_t*)(p.ws + OFF_P);
      gemm_phase<EPI_QB>(p, layer, Pb + 1280, 2560, (const bf16_t*)(p.ws + OFF_W_UQ) + (size_t)i2 * 768 * 384, 384, 128, 3, true, false, lds);
      gemm_phase<EPI_KVB>(p, layer, Pb + 1664, 2560, (const bf16_t*)(p.ws + OFF_W_UKV) + (size_t)i2 * 1024 * 256, 256, 128, 4, true, true, lds);
      vta_phase(p, lds);
    } else if (s == 3) {
      if (even) attn_phase_ab(p, layer, lds); else attn_phase_c(p, layer, lds);
    } else {
      const bf16_t* Gm = (const bf16_t*)(p.ws + OFF_UG);
      const bf16_t* W = even ? (const bf16_t*)(p.ws + OFF_W_OUT) + (size_t)i2 * 1024 * 1024 : (const bf16_t*)(p.ws + OFF_W_COUT) + (size_t)i2 * 1024 * 1024;
      gemm_phase<EPI_OUT>(p, layer, Gm, 0, W, 1024, 128, 4, layer != 3, false, lds);
    }
  }
}

extern "C" void kernel_launch(void* const* d_in, const int* in_sizes, int n_in, void* d_out, int out_size, void* d_ws, size_t ws_size,
                              hipStream_t stream) {
  static int grid_blocks = 0;
  if (!grid_blocks) {
    int dev = 0, cus = 0, per_cu = 0;
    hipGetDevice(&dev);
    hipDeviceGetAttribute(&cus, hipDeviceAttributeMultiprocessorCount, dev);
    hipOccupancyMaxActiveBlocksPerMultiprocessor(&per_cu, fwd_megakernel, NT, 0);
    per_cu = 1;
    grid_blocks = cus * per_cu;
    if (ws_size < OFF_END) fprintf(stderr, "kernel_launch: workspace too small: %zu < %zu\n", ws_size, (size_t)OFF_END);
  }
  Params p{};
  const float** f = (const float**)&p;
  for (int i = 0; i < 18; ++i) f[i] = (const float*)d_in[i];
  p.out = (float*)d_out;
  p.ws = (char*)d_ws;
#if MK_MULTI_LAUNCH
  for (int ph = 0; ph < 22; ++ph) {
    if (ph >= 1 && ph <= 20 && ((ph - 1) % 5) == 2 && (((ph - 1) / 5) & 1)) continue;
    p.ph_begin = ph; p.ph_end = ph + 1;
    hipLaunchKernelGGL(fwd_megakernel, dim3(grid_blocks), dim3(NT), 0, stream, p);
  }
#else
  p.ph_begin = 0; p.ph_end = 22;
  void* args[] = {&p};
  hipError_t e = hipLaunchCooperativeKernel((void*)fwd_megakernel, dim3(grid_blocks), dim3(NT), args, 0, stream);
  if (e != hipSuccess) fprintf(stderr, "cooperative launch failed: %s (grid %d)\n", hipGetErrorString(e), grid_blocks);
#endif
}
```

```cpp
#include <hip/hip_runtime.h>
#include <hip/hip_cooperative_groups.h>
#include <stdint.h>
#include <stdio.h>
namespace cg = cooperative_groups;

#ifndef MK_MULTI_LAUNCH
#define MK_MULTI_LAUNCH 0
#endif

typedef unsigned short bf16_t;
typedef short bf16x8 __attribute__((ext_vector_type(8)));
typedef float f32x16 __attribute__((ext_vector_type(16)));
typedef float f32x4 __attribute__((ext_vector_type(4)));
typedef float f32x2 __attribute__((ext_vector_type(2)));
typedef unsigned u32x4 __attribute__((ext_vector_type(4)));
typedef unsigned u32x2 __attribute__((ext_vector_type(2)));

#define DI __device__ __forceinline__
#define MFMA32(a, b, c) __builtin_amdgcn_mfma_f32_32x32x16_bf16((a), (b), (c), 0, 0, 0)

constexpr int T_LAT = 32768, T_ALL = 33792, NKEY = 8448, NT = 512;
constexpr float LOG2E = 1.4426950408889634f;
constexpr float QSCALE_A = 0.125f * LOG2E;
constexpr float QSCALE_B = 0.10206207261596575f * LOG2E;

constexpr size_t OFF_HC   = 0;
constexpr size_t OFF_UG   = OFF_HC + 1024ull * 1024 * 4;
constexpr size_t OFF_P    = OFF_UG + (size_t)T_ALL * 1024 * 2;
constexpr size_t OFF_QB   = OFF_P + (size_t)T_ALL * 2560 * 2;
constexpr size_t OFF_KB   = OFF_QB + (size_t)T_ALL * 768 * 2;
constexpr size_t OFF_VT   = OFF_KB + (size_t)T_ALL * 512 * 2;
constexpr size_t OFF_VTB  = OFF_VT + 4ull * 2 * 64 * NKEY * 2;
constexpr size_t OFF_W    = OFF_VT + 4ull * 16 * 64 * NKEY * 2;
constexpr size_t OFF_W_IN   = OFF_W;
constexpr size_t OFF_W_OUT  = OFF_W_IN + 2ull * 2560 * 1024 * 2;
constexpr size_t OFF_W_UQ   = OFF_W_OUT + 2ull * 1024 * 1024 * 2;
constexpr size_t OFF_W_UKV  = OFF_W_UQ + 2ull * 768 * 384 * 2;
constexpr size_t OFF_W_CIN  = OFF_W_UKV + 2ull * 1024 * 256 * 2;
constexpr size_t OFF_W_COUT = OFF_W_CIN + 2ull * 4096 * 1024 * 2;
constexpr size_t OFF_MOD    = OFF_W_COUT + 2ull * 1024 * 1024 * 2;
constexpr size_t OFF_ROPE   = OFF_MOD + 4ull * 5 * 3072 * 4;
constexpr size_t OFF_BAR    = OFF_ROPE + 2ull * 8192 * 32 * 4 + 2ull * 8192 * 16 * 4;
constexpr size_t OFF_END    = OFF_BAR + 16384;

struct Params {
  const float *x, *c, *ctx, *c_ctx, *ada_w, *ada_b, *norm_g, *ab_in_w, *ab_out_w, *a_sink, *b_qn_g, *b_w_uq, *b_kvn_g, *b_w_ukv,
      *c_in_w, *c_out_w, *c_rpb, *final_g;
  float* out;
  char* ws;
  int ph_begin, ph_end;
};

DI int otid() { int t = threadIdx.x; asm volatile("" : "+v"(t)); return t; }
DI int obid() { int t = blockIdx.x; asm volatile("" : "+s"(t)); return t; }
DI int ogrid() { int t = gridDim.x; asm volatile("" : "+s"(t)); return t; }
DI unsigned pack_bf16(float lo, float hi) { unsigned r; asm("v_cvt_pk_bf16_f32 %0, %1, %2" : "=v"(r) : "v"(lo), "v"(hi)); return r; }
DI float bf_lo(unsigned u) { return __uint_as_float(u << 16); }
DI float bf_hi(unsigned u) { return __uint_as_float(u & 0xffff0000u); }
DI float fexp2(float x) { return __builtin_amdgcn_exp2f(x); }
DI float pair_max(float x) {
  const unsigned u = __float_as_uint(x);
  const auto r = __builtin_amdgcn_permlane32_swap(u, u, false, false);
  return fmaxf(__uint_as_float(r[0]), __uint_as_float(r[1]));
}
DI float silu(float z) { return z * __builtin_amdgcn_rcpf(1.f + __expf(-z)); }

DI size_t ablk(int tok, int k) { return ((size_t)((tok >> 8) * 16 + (k >> 6)) << 14) + ((tok & 255) << 6) + (k & 63); }
DI void tok_bk(int tok, int& b, int& key) {
  if (tok < T_LAT) { b = tok >> 13; key = tok & 8191; } else { int r = tok - T_LAT; b = r >> 8; key = 8192 + (r & 255); }
}
DI const float* h_src(const Params& p, int layer, int tok) {
  if (layer == 0) return tok < T_LAT ? p.x + (size_t)tok * 1024 : p.ctx + (size_t)(tok - T_LAT) * 1024;
  return tok < T_LAT ? p.out + (size_t)tok * 1024 : (const float*)(p.ws + OFF_HC) + (size_t)(tok - T_LAT) * 1024;
}
DI float* h_dst(const Params& p, int tok) {
  return tok < T_LAT ? p.out + (size_t)tok * 1024 : (float*)(p.ws + OFF_HC) + (size_t)(tok - T_LAT) * 1024;
}

#define XB_TMO      128
#define XB_XCNT(j)  (256  + 64 * (j))
#define XB_XSUB(j)  (1280 + 64 * (j))
#define XB_XGEN(j)  (2304 + 64 * (j))
#define XB_TOP      3328
#define XB_TOPGEN   3392
#define XCD_BAR_WORDS 3456
#define XB_SPIN_CAP (1u << 22)
#define LAS __attribute__((address_space(3)))
DI unsigned xb_ld(unsigned* p) { return __hip_atomic_load(p, __ATOMIC_RELAXED, __HIP_MEMORY_SCOPE_AGENT); }
DI unsigned xb_add(unsigned* p, unsigned v) { return __hip_atomic_fetch_add(p, v, __ATOMIC_RELAXED, __HIP_MEMORY_SCOPE_AGENT); }
DI unsigned xb_xcc_id() { return (unsigned)__builtin_amdgcn_s_getreg((3 << 11) | 20) & 0xFu; }
#define XB_SPIN(cond, bar) do { unsigned _sp = 0; while (cond) { __builtin_amdgcn_s_sleep(1); \
    if ((++_sp & 255u) == 0u) { if (xb_ld(&(bar)[XB_TMO])) break; if (_sp > XB_SPIN_CAP) { atomicAdd(&(bar)[XB_TMO], 1u); break; } } } } while (0)
struct XcdBarrier { unsigned* bar; unsigned x; volatile LAS unsigned* st; };
DI XcdBarrier xcd_barrier_post(unsigned* bar, volatile LAS unsigned* st) {
  XcdBarrier b; b.bar = bar; b.x = xb_xcc_id(); b.st = st;
  if (threadIdx.x == 0) (void)xb_add(&bar[XB_XCNT(b.x)], 1u);
  return b;
}
DI void xcd_barrier_complete(unsigned* bar, unsigned x, unsigned& nloc, unsigned& nx) {
  const unsigned G = gridDim.x * gridDim.y * gridDim.z;
  unsigned sum, cnt, mine, sp = 0u;
  for (;;) {
    sum = 0u; cnt = 0u; mine = 0u;
#pragma unroll
    for (unsigned j = 0; j < 16; ++j) { const unsigned c = xb_ld(&bar[XB_XCNT(j)]); sum += c; cnt += (c > 0u) ? 1u : 0u; mine = (j == x) ? c : mine; }
    if (sum == G) break;
    __builtin_amdgcn_s_sleep(1);
    if ((++sp & 255u) == 0u) { if (xb_ld(&bar[XB_TMO])) break; if (sp > XB_SPIN_CAP) { atomicAdd(&bar[XB_TMO], 1u); break; } }
  }
  nloc = mine > 0u ? mine : 1u; nx = cnt > 0u ? cnt : 1u;
}
DI void xcd_barrier(const XcdBarrier& b) {
  asm volatile("s_waitcnt vmcnt(0)" ::: "memory");
  __syncthreads();
  if (threadIdx.x == 0) {
    unsigned* bar = b.bar;
    __builtin_amdgcn_s_waitcnt(0);
    unsigned nloc = b.st[0], nx = b.st[1];
    if (nloc == 0u) { xcd_barrier_complete(bar, b.x, nloc, nx); b.st[0] = nloc; b.st[1] = nx; }
    const unsigned old = xb_add(&bar[XB_XSUB(b.x)], 1u);
    const unsigned gen = old / nloc;
    if (old + 1u == (gen + 1u) * nloc) {
      __builtin_amdgcn_fence(__ATOMIC_RELEASE, "agent");
      asm volatile("s_waitcnt vmcnt(0)" ::: "memory");
      const unsigned og = xb_add(&bar[XB_TOP], 1u);
      const unsigned tg = og / nx;
      if (og + 1u == (tg + 1u) * nx) xb_add(&bar[XB_TOPGEN], 1u);
      else XB_SPIN(xb_ld(&bar[XB_TOPGEN]) == tg, bar);
      __builtin_amdgcn_fence(__ATOMIC_ACQUIRE, "agent");
      xb_add(&bar[XB_XGEN(b.x)], 1u);
      asm volatile("s_waitcnt vmcnt(0)" ::: "memory");
    } else {
      XB_SPIN(xb_ld(&bar[XB_XGEN(b.x)]) == gen, bar);
      __builtin_amdgcn_fence(__ATOMIC_ACQUIRE, "agent");
      asm volatile("s_waitcnt vmcnt(0)" ::: "memory");
    }
  }
  __syncthreads();
}

struct TJob { const float* src; const float* rs; bf16_t* dst; int K, N, tk, tn, perm; };
DI TJob tr_job(const Params& p, int t) {
  TJob j; j.rs = nullptr; j.perm = 0;
  const int i2 = t / 2312; t -= i2 * 2312;
  if (t < 640) { j.src = p.ab_in_w + (size_t)i2 * 1024 * 2464; j.K = 1024; j.N = 2464; j.dst = (bf16_t*)(p.ws + OFF_W_IN) + (size_t)i2 * 2560 * 1024; j.tk = t / 40; j.tn = t % 40; }
  else if ((t -= 640) < 256) { j.src = p.ab_out_w + (size_t)i2 * 1024 * 1024; j.K = 1024; j.N = 1024; j.dst = (bf16_t*)(p.ws + OFF_W_OUT) + (size_t)i2 * 1024 * 1024; j.tk = t / 16; j.tn = t % 16; }
  else if ((t -= 256) < 72) { j.src = p.b_w_uq + (size_t)i2 * 384 * 768; j.K = 384; j.N = 768; j.dst = (bf16_t*)(p.ws + OFF_W_UQ) + (size_t)i2 * 768 * 384; j.rs = p.b_qn_g + i2 * 384; j.tk = t / 12; j.tn = t % 12; }
  else if ((t -= 72) < 64) { j.src = p.b_w_ukv + (size_t)i2 * 256 * 1024; j.K = 256; j.N = 1024; j.dst = (bf16_t*)(p.ws + OFF_W_UKV) + (size_t)i2 * 1024 * 256; j.rs = p.b_kvn_g + i2 * 256; j.tk = t / 16; j.tn = t % 16; j.perm = 1; }
  else if ((t -= 64) < 1024) { j.src = p.c_in_w + (size_t)i2 * 1024 * 4096; j.K = 1024; j.N = 4096; j.dst = (bf16_t*)(p.ws + OFF_W_CIN) + (size_t)i2 * 4096 * 1024; j.tk = t / 64; j.tn = t % 64; }
  else { t -= 1024; j.src = p.c_out_w + (size_t)i2 * 1024 * 1024; j.K = 1024; j.N = 1024; j.dst = (bf16_t*)(p.ws + OFF_W_COUT) + (size_t)i2 * 1024 * 1024; j.tk = t / 16; j.tn = t % 16; }
  return j;
}
DI void tr_load(const TJob& j, int tid, float (&v)[8]) {
#pragma unroll
  for (int i = 0; i < 8; ++i) {
    const int kk = (tid >> 6) + 8 * i, n = j.tn * 64 + (tid & 63);
    float x = (n < j.N) ? j.src[(size_t)(j.tk * 64 + kk) * j.N + n] : 0.f;
    if (j.rs) x *= j.rs[j.tk * 64 + kk];
    v[i] = x;
  }
}

DI void prologue_phase(const Params& p, char* lds) {
  const int tid = otid();
  constexpr int N_MOD = 192, N_TR = 4624, N_ROPE = 768;
  for (int u = obid(); u < N_MOD + N_TR + N_ROPE; u += ogrid()) {
    if (u < N_MOD) {
      const int layer = u / 48, cb = u % 48;
      float* sl = (float*)lds;
      for (int i = tid; i < 5120; i += NT) {
        const int bb = i >> 10, k = i & 1023;
        const float cv = bb < 4 ? p.c[bb * 1024 + k] : p.c_ctx[k];
        sl[i] = silu(cv);
      }
      __syncthreads();
      const int col = cb * 64 + (tid & 63), kg = tid >> 6;
      float a0 = 0, a1 = 0, a2 = 0, a3 = 0, a4 = 0;
      const float* wp = p.ada_w + (size_t)layer * 1024 * 3072 + col;
#pragma unroll 32
      for (int k = kg * 128; k < kg * 128 + 128; ++k) {
        const float wv = wp[(size_t)k * 3072];
        a0 += sl[k] * wv; a1 += sl[1024 + k] * wv; a2 += sl[2048 + k] * wv; a3 += sl[3072 + k] * wv; a4 += sl[4096 + k] * wv;
      }
      float* red = (float*)(lds + 20480);
      red[(kg * 5 + 0) * 64 + (tid & 63)] = a0; red[(kg * 5 + 1) * 64 + (tid & 63)] = a1; red[(kg * 5 + 2) * 64 + (tid & 63)] = a2;
      red[(kg * 5 + 3) * 64 + (tid & 63)] = a3; red[(kg * 5 + 4) * 64 + (tid & 63)] = a4;
      __syncthreads();
      if (tid < 64) {
        float* mod = (float*)(p.ws + OFF_MOD);
        const float bias = p.ada_b[layer * 3072 + col];
#pragma unroll
        for (int bb = 0; bb < 5; ++bb) {
          float s = bias;
#pragma unroll
          for (int g = 0; g < 8; ++g) s += red[(g * 5 + bb) * 64 + tid];
          mod[(size_t)(layer * 5 + bb) * 3072 + col] = s;
        }
      }
      __syncthreads();
    } else if (u < N_MOD + N_TR) {
    } else {
      const int idx = (u - N_MOD - N_TR) * NT + tid;
      float* ropeA = (float*)(p.ws + OFF_ROPE);
      float* ropeB = ropeA + 2 * 8192 * 32;
      if (idx < 8192 * 32) {
        const int pos = idx >> 5, pr = idx & 31;
        const float pv = pr < 16 ? (float)(pos >> 6) : (float)(pos & 63);
        const float inv = exp2f(-(float)(pr & 15) * (13.287712379549449f / 16.f));
        const float ang = pv * inv;
        ropeA[idx] = cosf(ang); ropeA[8192 * 32 + idx] = sinf(ang);
      } else {
        const int j = idx - 8192 * 32;
        const int pos = j >> 4, pr = j & 15;
        const float pv = pr < 8 ? (float)(pos >> 6) : (float)(pos & 63);
        const float inv = exp2f(-(float)(pr & 7) * (13.287712379549449f / 8.f));
        const float ang = pv * inv;
        ropeB[j] = cosf(ang); ropeB[8192 * 16 + j] = sinf(ang);
      }
    }
  }
  {
    const int G = ogrid();
    int t = obid();
    float v[8], nv[8];
    TJob cur, nxt;
    if (t < N_TR) { cur = tr_job(p, t); tr_load(cur, tid, v); }
    int buf = 0;
    for (; t < N_TR; t += G) {
      const bool more = t + G < N_TR;
      if (more) { nxt = tr_job(p, t + G); tr_load(nxt, tid, nv); }
      float* tile = (float*)(lds + buf * 16640);
#pragma unroll
      for (int i = 0; i < 8; ++i) tile[((tid >> 6) + 8 * i) * 65 + (tid & 63)] = v[i];
      __syncthreads();
      {
        const int nn = tid & 63, k8 = (tid >> 6) * 8;
        int n = cur.tn * 64 + nn;
        if (cur.perm) n = ((n & 64) ? 512 : 0) + (n >> 7) * 64 + (n & 63);
        u32x4 w;
        w.x = pack_bf16(tile[(k8 + 0) * 65 + nn], tile[(k8 + 1) * 65 + nn]); w.y = pack_bf16(tile[(k8 + 2) * 65 + nn], tile[(k8 + 3) * 65 + nn]);
        w.z = pack_bf16(tile[(k8 + 4) * 65 + nn], tile[(k8 + 5) * 65 + nn]); w.w = pack_bf16(tile[(k8 + 6) * 65 + nn], tile[(k8 + 7) * 65 + nn]);
        *(u32x4*)(cur.dst + ((size_t)((n >> 8) * (cur.K >> 6) + cur.tk) << 14) + ((n & 255) << 6) + k8) = w;
      }
      buf ^= 1;
      if (more) {
        cur = nxt;
#pragma unroll
        for (int i = 0; i < 8; ++i) v[i] = nv[i];
      }
    }
    __syncthreads();
  }
}

DI float wave_sum(float v) {
#pragma unroll
  for (int o = 32; o >= 1; o >>= 1) v += __shfl_xor(v, o);
  return v;
}

DI void norm_phase(const Params& p, int layer) {
  const int lane = otid() & 63;
  const int wave = obid() * 8 + (otid() >> 6), nw = ogrid() * 8;
  const float* g = p.norm_g + layer * 1024;
  const float* mod = (const float*)(p.ws + OFF_MOD) + (size_t)layer * 5 * 3072;
  bf16_t* U = (bf16_t*)(p.ws + OFF_UG);
  f32x4 gv[4];
#pragma unroll
  for (int i = 0; i < 4; ++i) gv[i] = *(const f32x4*)(g + lane * 4 + 256 * i);
  f32x4 nv[4];
  if (wave < T_ALL) {
    const float* s0 = h_src(p, layer, wave);
#pragma unroll
    for (int i = 0; i < 4; ++i) nv[i] = *(const f32x4*)(s0 + lane * 4 + 256 * i);
  }
  for (int row = wave; row < T_ALL; row += nw) {
    const int bb = row < T_LAT ? (row >> 13) : 4;
    f32x4 v[4];
#pragma unroll
    for (int i = 0; i < 4; ++i) v[i] = nv[i];
    if (row + nw < T_ALL) {
      const float* s1 = h_src(p, layer, row + nw);
#pragma unroll
      for (int i = 0; i < 4; ++i) nv[i] = *(const f32x4*)(s1 + lane * 4 + 256 * i);
    }
    float ss = 0.f;
#pragma unroll
    for (int i = 0; i < 4; ++i) ss += v[i][0] * v[i][0] + v[i][1] * v[i][1] + v[i][2] * v[i][2] + v[i][3] * v[i][3];
    ss = wave_sum(ss);
    const float rstd = rsqrtf(ss * (1.f / 1024.f) + 1e-6f);
    const float* mrow = mod + bb * 3072;
#pragma unroll
    for (int i = 0; i < 4; ++i) {
      const int cidx = lane * 4 + 256 * i;
      const f32x4 sh = *(const f32x4*)(mrow + cidx), sc = *(const f32x4*)(mrow + 1024 + cidx);
      f32x4 o = (v[i] * rstd) * gv[i] * (sc + 1.f) + sh;
      u32x2 w; w.x = pack_bf16(o[0], o[1]); w.y = pack_bf16(o[2], o[3]);
      *(u32x2*)(U + ablk(row, cidx)) = w;
    }
  }
}

DI void final_phase(const Params& p) {
  const int lane = otid() & 63;
  const int wave = obid() * 8 + (otid() >> 6), nw = ogrid() * 8;
  f32x4 gv[4];
#pragma unroll
  for (int i = 0; i < 4; ++i) gv[i] = *(const f32x4*)(p.final_g + lane * 4 + 256 * i);
  f32x4 nv[4];
  if (wave < T_LAT) {
#pragma unroll
    for (int i = 0; i < 4; ++i) nv[i] = *(const f32x4*)(p.out + (size_t)wave * 1024 + lane * 4 + 256 * i);
  }
  for (int row = wave; row < T_LAT; row += nw) {
    float* src = p.out + (size_t)row * 1024;
    f32x4 v[4];
#pragma unroll
    for (int i = 0; i < 4; ++i) v[i] = nv[i];
    if (row + nw < T_LAT) {
#pragma unroll
      for (int i = 0; i < 4; ++i) nv[i] = *(const f32x4*)(p.out + (size_t)(row + nw) * 1024 + lane * 4 + 256 * i);
    }
    float ss = 0.f;
#pragma unroll
    for (int i = 0; i < 4; ++i) ss += v[i][0] * v[i][0] + v[i][1] * v[i][1] + v[i][2] * v[i][2] + v[i][3] * v[i][3];
    ss = wave_sum(ss);
    const float rstd = rsqrtf(ss * (1.f / 1024.f) + 1e-6f);
#pragma unroll
    for (int i = 0; i < 4; ++i) *(f32x4*)(src + lane * 4 + 256 * i) = (v[i] * rstd) * gv[i];
  }
}

enum { EPI_AB_IN = 0, EPI_QB = 1, EPI_KVB = 2, EPI_C_IN = 3, EPI_OUT = 4 };
constexpr int G_STR = 144;
constexpr int G_OPER = 256 * G_STR;
constexpr int G_STAGE = 2 * G_OPER;
constexpr int OFF_RSTD = 2 * G_STAGE;
constexpr int LDS_BYTES = OFF_RSTD + 1024;

DI void rope2(float& v0, float& v1, float& v2, float& v3, const float* cs, const float* sn) {
  const f32x2 c = *(const f32x2*)cs, s = *(const f32x2*)sn;
  const float a0 = v0 * c.x - v1 * s.x, a1 = v0 * s.x + v1 * c.x, a2 = v2 * c.y - v3 * s.y, a3 = v2 * s.y + v3 * c.y;
  v0 = a0; v1 = a1; v2 = a2; v3 = a3;
}

template <int EPI>
DI void epi_math(const Params& p, int tok, int f0, float& v0, float& v1, float& v2, float& v3, float rs) {
  const float* ropeA = (const float*)(p.ws + OFF_ROPE);
  const float* ropeB = ropeA + 2 * 8192 * 32;
  const bool lat = tok < T_LAT;
  const int pos = tok & 8191;
  if (EPI == EPI_AB_IN) {
    if (f0 < 640) {
      if (lat) { const int p0 = (f0 & 63) >> 1; rope2(v0, v1, v2, v3, ropeA + pos * 32 + p0, ropeA + 8192 * 32 + pos * 32 + p0); }
      if (f0 < 512) { v0 *= QSCALE_A; v1 *= QSCALE_A; v2 *= QSCALE_A; v3 *= QSCALE_A; }
    } else if (f0 >= 1920 && f0 < 1952) {
      if (lat) { const int p0 = (f0 - 1920) >> 1; rope2(v0, v1, v2, v3, ropeB + pos * 16 + p0, ropeB + 8192 * 16 + pos * 16 + p0); }
    }
  } else if (EPI == EPI_QB) {
    const float s = rs * QSCALE_B;
    v0 *= s; v1 *= s; v2 *= s; v3 *= s;
    const int fh = f0 % 96;
    if (fh >= 64 && lat) { const int p0 = (fh - 64) >> 1; rope2(v0, v1, v2, v3, ropeB + pos * 16 + p0, ropeB + 8192 * 16 + pos * 16 + p0); }
  } else if (EPI == EPI_KVB) {
    v0 *= rs; v1 *= rs; v2 *= rs; v3 *= rs;
  } else if (EPI == EPI_C_IN) {
    if (f0 < 1024) { v0 *= QSCALE_A; v1 *= QSCALE_A; v2 *= QSCALE_A; v3 *= QSCALE_A; }
  }
}

template <int EPI>
DI bf16_t* dst_tr(const Params& p, int tok, int col) {
  if (EPI == EPI_AB_IN) return col < 2464 ? (bf16_t*)(p.ws + OFF_P) + (size_t)tok * 2560 + col : nullptr;
  if (EPI == EPI_QB) return (bf16_t*)(p.ws + OFF_QB) + (size_t)tok * 768 + col;
  if (EPI == EPI_KVB) return (bf16_t*)(p.ws + OFF_KB) + (size_t)tok * 512 + col;
  return (bf16_t*)(p.ws + OFF_P) + (size_t)tok * 3072 + (col >= 3072 ? col - 1024 : col);
}
template <int EPI>
DI bf16_t* dst_v(const Params& p, int t0, int col) {
  int b, key; tok_bk(t0, b, key);
  if (EPI == EPI_KVB) return (bf16_t*)(p.ws + OFF_VTB) + ((size_t)(b * 8 + ((col - 512) >> 6)) * 64 + (col & 63)) * NKEY + key;
  return (bf16_t*)(p.ws + OFF_VT) + ((size_t)(b * 16 + ((col - 2048) >> 6)) * 64 + (col & 63)) * NKEY + key;
}

struct TilePf { bool pre; bool has_next; int nm0, nnt; };
template <int EPI, int TM>
DI void gemm_tile(const Params& p, int layer, const bf16_t* __restrict__ A, int lda, const bf16_t* __restrict__ Bt, int K, int m0, int nt, char* lds,
                  u32x4 (&ra)[TM / 64], u32x4 (&rb)[4], const TilePf pf) {
  constexpr int NJ = TM == 256 ? 4 : 2, NI = TM == 256 ? 2 : 1, NA = TM / 64;
  const int tid = otid(), lane = tid & 63, w = tid >> 6;
  const int wm = TM == 256 ? (w >> 2) : 0, wn = TM == 256 ? (w & 3) : w;
  const int fb = TM == 256 ? wn * 64 : wn * 32, tb = TM == 256 ? wm * 128 : 0;
  const int l31 = lane & 31, hh = lane >> 5;
  const int n0 = nt * 256;
  float* rstd = (float*)(lds + OFF_RSTD);
  const int srow = tid >> 3, scc = tid & 7;
  const bool ablocked = (lda == 0);
  const int nkb = K >> 6;
  const bf16_t* ag = ablocked ? A + ((size_t)((m0 >> 8) * 16) << 14) + (m0 & 255) * 64 + tid * 8 : A + (size_t)(m0 + srow) * lda + scc * 8;
  const size_t a_i = ablocked ? 4096 : (size_t)64 * lda, a_k = ablocked ? 16384 : 64;
  const bf16_t* bg = Bt + ((size_t)(nt * nkb) << 14) + tid * 8;

  if (EPI == EPI_QB || EPI == EPI_KVB) {
    __syncthreads();
    if (tid < 2 * TM) {
      const int r = tid >> 1, half = tid & 1;
      const bf16_t* ap = A + (size_t)(m0 + r) * lda + half * (K / 2);
      float ss = 0.f;
#pragma unroll 8
      for (int cidx = 0; cidx < K / 2; cidx += 8) {
        const u32x4 v = *(const u32x4*)(ap + cidx);
#pragma unroll
        for (int e = 0; e < 4; ++e) { const float a = bf_lo(v[e]), b2 = bf_hi(v[e]); ss += a * a + b2 * b2; }
      }
      ss += __shfl_xor(ss, 1);
      if (half == 0) rstd[r] = rsqrtf(ss / (float)K + 1e-6f);
    }
  }

  f32x16 acc[NI][NJ];
#pragma unroll
  for (int i = 0; i < NI; ++i)
#pragma unroll
    for (int j = 0; j < NJ; ++j)
#pragma unroll
      for (int r = 0; r < 16; ++r) acc[i][j][r] = 0.f;

  const int nk = K >> 6;
  if (!pf.pre) {
#pragma unroll
    for (int i = 0; i < NA; ++i) ra[i] = *(const u32x4*)(ag + i * a_i);
#pragma unroll
    for (int i = 0; i < 4; ++i) rb[i] = *(const u32x4*)(bg + i * 4096);
  }
#pragma unroll
  for (int i = 0; i < NA; ++i) *(u32x4*)(lds + (srow + 64 * i) * G_STR + scc * 16) = ra[i];
#pragma unroll
  for (int i = 0; i < 4; ++i) *(u32x4*)(lds + G_OPER + (srow + 64 * i) * G_STR + scc * 16) = rb[i];
#pragma unroll
  for (int i = 0; i < NA; ++i) ra[i] = *(const u32x4*)(ag + i * a_i + a_k);
#pragma unroll
  for (int i = 0; i < 4; ++i) rb[i] = *(const u32x4*)(bg + i * 4096 + 16384);
  __syncthreads();
  for (int kt = 0; kt < nk; ++kt) {
    const char* as = lds + (kt & 1) * G_STAGE;
    char* st = lds + ((kt + 1) & 1) * G_STAGE;
    const char* fp = as + G_OPER + (fb + l31) * G_STR + hh * 16;
    const char* sp = as + (tb + l31) * G_STR + hh * 16;
    const bool more = kt + 2 < nk;
#pragma unroll
    for (int ks = 0; ks < 4; ++ks) {
      bf16x8 f[NI], s[NJ];
#pragma unroll
      for (int i = 0; i < NI; ++i) f[i] = *(const bf16x8*)(fp + i * 32 * G_STR + ks * 32);
#pragma unroll
      for (int j = 0; j < NJ; ++j) s[j] = *(const bf16x8*)(sp + j * 32 * G_STR + ks * 32);
#pragma unroll
      for (int j = 0; j < NJ; ++j)
#pragma unroll
        for (int i = 0; i < NI; ++i) acc[i][j] = MFMA32(f[i], s[j], acc[i][j]);
      if (ks < NA) *(u32x4*)(st + (srow + 64 * ks) * G_STR + scc * 16) = ra[ks < NA ? ks : 0];
      *(u32x4*)(st + G_OPER + (srow + 64 * ks) * G_STR + scc * 16) = rb[ks];
      if (more) {
        if (ks < NA) ra[ks < NA ? ks : 0] = *(const u32x4*)(ag + (ks < NA ? ks : 0) * a_i + (size_t)(kt + 2) * a_k);
        rb[ks] = *(const u32x4*)(bg + ks * 4096 + ((size_t)(kt + 2) << 14));
      }
      __builtin_amdgcn_sched_barrier(0);
    }
    __syncthreads();
  }

  auto prefetch_next = [&]() {
    if (TM == 256 && pf.has_next) {
      const bf16_t* nag = ablocked ? A + ((size_t)((pf.nm0 >> 8) * 16) << 14) + (pf.nm0 & 255) * 64 + tid * 8 : A + (size_t)(pf.nm0 + srow) * lda + scc * 8;
      const bf16_t* nbg = Bt + ((size_t)(pf.nnt * nkb) << 14) + tid * 8;
#pragma unroll
      for (int i = 0; i < NA; ++i) ra[i] = *(const u32x4*)(nag + i * a_i);
#pragma unroll
      for (int i = 0; i < 4; ++i) rb[i] = *(const u32x4*)(nbg + i * 4096);
      __builtin_amdgcn_sched_barrier(0);
    }
  };
  constexpr int SB = 528;
  constexpr int SV = TM * 2 + 16;
  constexpr int NIT = TM * 32 / NT;
  if (EPI == EPI_OUT) {
    const int bb = m0 < T_LAT ? (m0 >> 13) : 4;
    constexpr int SF = 1040;
    constexpr int JH = NJ / 2;
    constexpr int NITO = (TM / 2) * 64 / NT;
    const float* gate = (const float*)(p.ws + OFF_MOD) + (size_t)(layer * 5 + bb) * 3072 + 2048 + n0;
#pragma unroll
    for (int h = 0; h < 2; ++h) {
#pragma unroll
      for (int jj = 0; jj < JH; ++jj)
#pragma unroll
        for (int i = 0; i < NI; ++i)
#pragma unroll
          for (int g = 0; g < 4; ++g) {
            const int j = h * JH + jj;
            f32x4 v; v[0] = acc[i][j][4 * g]; v[1] = acc[i][j][4 * g + 1]; v[2] = acc[i][j][4 * g + 2]; v[3] = acc[i][j][4 * g + 3];
            *(f32x4*)(lds + ((TM == 256 ? wm * 64 : 0) + jj * 32 + l31) * SF + (fb + i * 32 + 8 * g + 4 * hh) * 4) = v;
          }
      if (h == 1) prefetch_next();
      __syncthreads();
      const f32x4 gt = *(const f32x4*)(gate + (tid & 63) * 4);
#pragma unroll
      for (int i0 = 0; i0 < NITO; i0 += 8) {
        f32x4 oldv[8];
#pragma unroll
        for (int k = 0; k < 8; ++k)
          if (i0 + k < NITO) {
            const int cidx = tid + NT * (i0 + k), row = cidx >> 6, ch = cidx & 63;
            const int tok = m0 + (TM == 256 ? (row >> 6) * 128 + h * 64 + (row & 63) : h * 32 + row);
            oldv[k] = *(const f32x4*)(h_src(p, layer, tok) + n0 + ch * 4);
          }
#pragma unroll
        for (int k = 0; k < 8; ++k)
          if (i0 + k < NITO) {
            const int cidx = tid + NT * (i0 + k), row = cidx >> 6, ch = cidx & 63;
            const int tok = m0 + (TM == 256 ? (row >> 6) * 128 + h * 64 + (row & 63) : h * 32 + row);
            const f32x4 y = *(const f32x4*)(lds + row * SF + ch * 16);
            *(f32x4*)(h_dst(p, tok) + n0 + ch * 4) = oldv[k] + gt * y;
          }
      }
      __syncthreads();
    }
  } else {
    const bool vt = (EPI == EPI_KVB && nt >= 2) || (EPI == EPI_C_IN && nt >= 8 && nt < 12);
#pragma unroll
    for (int j = 0; j < NJ; ++j) {
      const int rl = tb + j * 32 + l31;
      float rs = 1.f;
      if (EPI == EPI_QB || EPI == EPI_KVB) rs = rstd[rl];
#pragma unroll
      for (int i = 0; i < NI; ++i)
#pragma unroll
        for (int g = 0; g < 4; ++g) {
          const int fl = fb + i * 32 + 8 * g + 4 * hh;
          float v0 = acc[i][j][4 * g], v1 = acc[i][j][4 * g + 1], v2 = acc[i][j][4 * g + 2], v3 = acc[i][j][4 * g + 3];
          epi_math<EPI>(p, m0 + rl, n0 + fl, v0, v1, v2, v3, rs);
          const unsigned w01 = pack_bf16(v0, v1), w23 = pack_bf16(v2, v3);
          if (!vt) {
            u32x2 wv; wv.x = w01; wv.y = w23;
            *(u32x2*)(lds + rl * SB + fl * 2) = wv;
          } else {
            *(bf16_t*)(lds + (fl + 0) * SV + rl * 2) = (bf16_t)(w01 & 0xffffu);
            *(bf16_t*)(lds + (fl + 1) * SV + rl * 2) = (bf16_t)(w01 >> 16);
            *(bf16_t*)(lds + (fl + 2) * SV + rl * 2) = (bf16_t)(w23 & 0xffffu);
            *(bf16_t*)(lds + (fl + 3) * SV + rl * 2) = (bf16_t)(w23 >> 16);
          }
        }
    }
    prefetch_next();
    __syncthreads();
#pragma unroll 4
    for (int it = 0; it < NIT; ++it) {
      const int cidx = tid + NT * it;
      if (vt) {
        const int row = cidx / (TM / 8), ch = cidx % (TM / 8);
        *(u32x4*)dst_v<EPI>(p, m0 + ch * 8, n0 + row) = *(const u32x4*)(lds + row * SV + ch * 16);
      } else {
        const int row = cidx >> 5, ch = cidx & 31;
        bf16_t* d = dst_tr<EPI>(p, m0 + row, n0 + ch * 8);
        if (d) *(u32x4*)d = *(const u32x4*)(lds + row * SB + ch * 16);
      }
    }
    __syncthreads();
  }
}

template <int EPI>
DI void gemm_phase(const Params& p, int layer, const bf16_t* A, int lda, const bf16_t* Bt, int K, int mtiles, int ntiles, bool ctx, bool reverse, char* lds,
                   int ctx_nt0 = 0, int ctx_ntn = -1) {
  const int G = ogrid();
  const int bid = reverse ? (G - 1 - obid()) : obid();
  u32x4 ra[4], rb[4];
  const bool simple = (G & 7) != 0;
  const int xcd = bid & 7, local = simple ? bid : (bid >> 3), nlocal = simple ? G : (G >> 3);
  const int mlo = simple ? 0 : ((xcd * mtiles) >> 3), cnt = simple ? mtiles : ((((xcd + 1) * mtiles) >> 3) - mlo);
  const int total = cnt * ntiles, gsize = 4 * ntiles;
  auto tile_of = [&](int j, int& m0, int& nt) {
    const int g = j / gsize, r = j - g * gsize;
    int gm = cnt - g * 4; gm = gm > 4 ? 4 : gm;
    m0 = (mlo + g * 4 + (r % gm)) * 256; nt = r / gm;
  };
  bool pre = false;
  for (int j = local; j < total; j += nlocal) {
    int m0, nt; tile_of(j, m0, nt);
    TilePf pf; pf.pre = pre; pf.has_next = (j + nlocal < total); pf.nm0 = 0; pf.nnt = 0;
    if (pf.has_next) tile_of(j + nlocal, pf.nm0, pf.nnt);
    gemm_tile<EPI, 256>(p, layer, A, lda, Bt, K, m0, nt, lds, ra, rb, pf);
    pre = pf.has_next;
  }
  if (ctx) {
    const int b2 = G - 1 - bid;
    u32x4 ra1[1];
    TilePf pf; pf.pre = false; pf.has_next = false; pf.nm0 = 0; pf.nnt = 0;
    const int cn = ctx_ntn < 0 ? ntiles : ctx_ntn;
    for (int u = b2; u < 16 * cn; u += G) gemm_tile<EPI, 64>(p, layer, A, lda, Bt, K, T_LAT + (u & 15) * 64, ctx_nt0 + (u >> 4), lds, ra1, rb, pf);
  }
}

DI void vta_phase(const Params& p, char* lds) {
  const int tid = otid();
  const bf16_t* Pb = (const bf16_t*)(p.ws + OFF_P);
  for (int u = ogrid() - 1 - obid(); u < T_ALL / 64; u += ogrid()) {
    const int t0 = u * 64;
#pragma unroll
    for (int it = 0; it < 2; ++it) {
      const int cidx = tid + NT * it, row = cidx >> 4, ch = cidx & 15;
      *(u32x4*)(lds + row * 272 + ch * 16) = *(const u32x4*)(Pb + (size_t)(t0 + row) * 2560 + 640 + ch * 8);
    }
    __syncthreads();
    int b, key; tok_bk(t0, b, key);
#pragma unroll
    for (int it = 0; it < 2; ++it) {
      const int cidx = tid + NT * it, f = cidx & 127, tc = cidx >> 7;
      unsigned short e[8];
#pragma unroll
      for (int k = 0; k < 8; ++k) e[k] = *(const bf16_t*)(lds + (tc * 8 + k) * 272 + f * 2);
      u32x4 v; v.x = e[0] | ((unsigned)e[1] << 16); v.y = e[2] | ((unsigned)e[3] << 16); v.z = e[4] | ((unsigned)e[5] << 16); v.w = e[6] | ((unsigned)e[7] << 16);
      *(u32x4*)((bf16_t*)(p.ws + OFF_VT) + ((size_t)(b * 2 + (f >> 6)) * 64 + (f & 63)) * NKEY + key + tc * 8) = v;
    }
    __syncthreads();
  }
}

template <int MODE>
DI void attn_item(const Params& p, int layer, int b, int qt, int head, bool is_ctx, char* lds) {
  constexpr int DK = (MODE == 1) ? 96 : 64;
  constexpr int NKS = DK / 16;
  constexpr int KSTR = DK * 2 + 16;
  constexpr int VSTR = 144;
  constexpr int KBYTES = 64 * KSTR;
  constexpr int STAGE = KBYTES + 64 * VSTR;
  constexpr int QPB = 256;
  constexpr int NKC = DK / 8;
  constexpr int KCH = 64 * NKC;
  constexpr int OSTR = 272;
  constexpr float MASKV = -1e30f;
  float* rpbs = (float*)(lds + 4 * STAGE);
  char* ostage = lds;

  const int tid = otid(), lane = tid & 63, w = tid >> 6, l31 = lane & 31, hh = lane >> 5;
  const int i2 = layer >> 1;
  const bf16_t* Pb = (const bf16_t*)(p.ws + OFF_P);
  bf16_t* UG = (bf16_t*)(p.ws + OFF_UG);
  const bf16_t *Qp, *Kp, *Krp = nullptr, *Zp, *Vt;
  int ldq, ldk, ldz, gcol;
  if (MODE == 0) {
    Qp = Pb + head * 64; ldq = 2560; Kp = Pb + 512 + (head >> 2) * 64; ldk = 2560;
    Vt = (const bf16_t*)(p.ws + OFF_VT) + (size_t)(b * 2 + (head >> 2)) * 64 * NKEY;
    Zp = Pb + 768 + head * 64; ldz = 2560; gcol = head * 64;
  } else if (MODE == 1) {
    Qp = (const bf16_t*)(p.ws + OFF_QB) + head * 96; ldq = 768; Kp = (const bf16_t*)(p.ws + OFF_KB) + head * 64; ldk = 512; Krp = Pb + 1920;
    Vt = (const bf16_t*)(p.ws + OFF_VTB) + (size_t)(b * 8 + head) * 64 * NKEY;
    Zp = Pb + 1952 + head * 64; ldz = 2560; gcol = 512 + head * 64;
  } else {
    Qp = Pb + head * 64; ldq = 3072; Kp = Pb + 1024 + head * 64; ldk = 3072;
    Vt = (const bf16_t*)(p.ws + OFF_VT) + (size_t)(b * 16 + head) * 64 * NKEY;
    Zp = Pb + 2048 + head * 64; ldz = 3072; gcol = head * 64;
  }
  const int qtok0 = is_ctx ? T_LAT + b * 256 : b * 8192 + qt * QPB;

  int lat_lo = 0, nlat = 0;
  if (!is_ctx) {
    if (MODE == 0) {
      int lo = 4 * qt - 2; if (lo < 0) lo = 0;
      int hi = 4 * qt + 5; if (hi > 127) hi = 127;
      lat_lo = lo; nlat = hi - lo + 1;
    } else if (MODE == 1) { lat_lo = 0; nlat = 128; }
    else {
      int lo = 4 * qt - 4; lo = lo < 0 ? 0 : (lo > 120 ? 120 : lo);
      int hi = 4 * qt + 3 - 4; hi = hi < 0 ? 0 : (hi > 120 ? 120 : hi); hi += 7;
      lat_lo = lo; nlat = hi - lo + 1;
    }
  }
  const int ntiles = nlat + 4;

  const bool nat2 = (MODE == 2) && !is_ctx;
  auto tokmap = [&](int row) { return nat2 ? qtok0 + ((w >> 2) * 2 + (row >> 4)) * 64 + (w & 3) * 16 + (row & 15) : qtok0 + w * 32 + row; };
  const int qtok = tokmap(l31);
  bf16x8 qf[NKS];
#pragma unroll
  for (int ks = 0; ks < NKS; ++ks) qf[ks] = *(const bf16x8*)(Qp + (size_t)qtok * ldq + ks * 16 + hh * 8);
  if (MODE == 2 && !is_ctx) {
    for (int i = tid; i < 465; i += NT) rpbs[i] = p.c_rpb[(size_t)(i2 * 16 + head) * 465 + i] * LOG2E;
  }
  float m_ = (MODE == 0) ? p.a_sink[i2 * 8 + head] * LOG2E : MASKV;
  float l_ = (MODE == 0 && hh == 0) ? 1.f : 0.f;
  f32x16 O[2];
#pragma unroll
  for (int dh = 0; dh < 2; ++dh)
#pragma unroll
    for (int r = 0; r < 16; ++r) O[dh][r] = 0.f;

  const int k0row = tid / NKC, k0cc = tid % NKC;
  const int k1row = (tid + NT) / NKC, k1cc = (tid + NT) % NKC;
  const bool k1 = (KCH > NT) && (tid + NT < KCH);
  struct Stg { u32x4 k0, k1, v; };
  Stg R0, R1;
  R0.k1 = (u32x4){0u, 0u, 0u, 0u}; R1.k1 = R0.k1;
  auto tile_kt = [&](int i) { return i < nlat ? lat_lo + i : 128 + (i - nlat); };
  auto kload = [&](int krow0, int row, int cc) -> u32x4 {
    if (MODE == 1 && cc >= 8) return *(const u32x4*)(Krp + (size_t)(krow0 + row) * 2560 + (cc - 8) * 8);
    return *(const u32x4*)(Kp + (size_t)(krow0 + row) * ldk + cc * 8);
  };
  auto gload = [&](int i, Stg& r) {
    const int kt = tile_kt(i < ntiles ? i : ntiles - 1);
    const int krow0 = kt < 128 ? b * 8192 + kt * 64 : T_LAT + b * 256 + (kt - 128) * 64;
    r.k0 = kload(krow0, k0row, k0cc);
    if (k1) r.k1 = kload(krow0, k1row, k1cc);
    r.v = *(const u32x4*)(Vt + (size_t)(tid >> 3) * NKEY + kt * 64 + (tid & 7) * 8);
  };
  auto lstore = [&](int st, const Stg& r) {
    char* kb = lds + st * STAGE;
    *(u32x4*)(kb + k0row * KSTR + k0cc * 16) = r.k0;
    if (k1) *(u32x4*)(kb + k1row * KSTR + k1cc * 16) = r.k1;
    *(u32x4*)(kb + KBYTES + (tid >> 3) * VSTR + (tid & 7) * 16) = r.v;
  };

  const int pr = (l31 & ~12) | ((l31 & 4) << 1) | ((l31 & 8) >> 1);
  int qr = 0, qc = 0, rs0 = 0, cs = 0, csw = 0, wlo = 0, whi = 0;
  if (MODE == 2) {
    qr = qt * 4 + (w >> 2) * 2 + (l31 >> 4); qc = (w & 3) * 16 + (l31 & 15);
    rs0 = qr - 4; rs0 = rs0 < 0 ? 0 : (rs0 > 120 ? 120 : rs0);
    cs = qc - 8; cs = cs < 0 ? 0 : (cs > 48 ? 48 : cs);
    csw = (w & 3) * 16 - 8; csw = csw < 0 ? 0 : (csw > 32 ? 32 : csw);
    const int r_lo = qt * 4 + (w >> 2) * 2;
    wlo = r_lo - 4; wlo = wlo < 0 ? 0 : (wlo > 120 ? 120 : wlo);
    whi = r_lo + 1 - 4; whi = whi < 0 ? 0 : (whi > 120 ? 120 : whi); whi += 7;
  }
  const int s0w = qt * QPB + w * 32;
  const int nsup = (ntiles + 1) >> 1;
  __syncthreads();
  gload(0, R0); gload(1, R1);
  lstore(0, R0); lstore(1, R1);
  gload(2, R0); gload(3, R1);
  __syncthreads();
  auto body = [&](int it, const char* kb) {
    const char* vb = kb + KBYTES;
    const int kt = tile_kt(it);
    const bool lat_tile = it < nlat;
    bool skip = (it >= ntiles);
    if (MODE == 2 && lat_tile) skip = (kt < wlo) || (kt > whi);
    if (MODE == 0 && lat_tile) skip = (kt * 64 + 63 < s0w - 128) || (kt * 64 > s0w + 31 + 128);
    const int nsub = (MODE == 2 && lat_tile) ? 1 : 2;
    const int krb = (MODE == 2 && lat_tile) ? csw : 0;
    if (!skip) {
      f32x16 S[2];
#pragma unroll
      for (int t = 0; t < 2; ++t)
#pragma unroll
        for (int r = 0; r < 16; ++r) S[t][r] = 0.f;
#pragma unroll
      for (int ks = 0; ks < NKS; ++ks) {
        const bf16x8 a0 = *(const bf16x8*)(kb + (krb + pr) * KSTR + ks * 32 + hh * 16);
        S[0] = MFMA32(a0, qf[ks], S[0]);
        if (nsub == 2) {
          const bf16x8 a1 = *(const bf16x8*)(kb + (32 + pr) * KSTR + ks * 32 + hh * 16);
          S[1] = MFMA32(a1, qf[ks], S[1]);
        }
      }
      if (MODE == 0 && lat_tile) {
        const int s = qt * QPB + w * 32 + l31;
#pragma unroll
        for (int t = 0; t < 2; ++t)
#pragma unroll
          for (int r = 0; r < 16; ++r) {
            const int kk = kt * 64 + t * 32 + 16 * (r >> 3) + 8 * hh + (r & 7);
            const int d = kk - s;
            if (d > 128 || d < -128) S[t][r] = MASKV;
          }
      }
      if (MODE == 2 && lat_tile) {
        int ri = kt - qr + 7; ri = ri < 0 ? 0 : (ri > 14 ? 14 : ri);
        const float* brow = rpbs + ri * 31;
        const bool rok = (kt >= rs0) && (kt <= rs0 + 7);
        float bv[16];
#pragma unroll
        for (int r = 0; r < 16; ++r) {
          const int kc = csw + 16 * (r >> 3) + 8 * hh + (r & 7);
          int bi = kc - qc + 15; bi = bi < 0 ? 0 : (bi > 30 ? 30 : bi);
          bv[r] = brow[bi];
        }
#pragma unroll
        for (int r = 0; r < 16; ++r) asm volatile("" : "+v"(bv[r]));
#pragma unroll
        for (int r = 0; r < 16; ++r) {
          const int kc = csw + 16 * (r >> 3) + 8 * hh + (r & 7);
          const bool ok = rok && (kc >= cs) && (kc < cs + 16);
          S[0][r] = ok ? S[0][r] + bv[r] : MASKV;
        }
      }
      float mx = S[0][0];
#pragma unroll
      for (int r = 0; r < 16; ++r) mx = fmaxf(mx, S[0][r]);
      if (nsub == 2) {
#pragma unroll
        for (int r = 0; r < 16; ++r) mx = fmaxf(mx, S[1][r]);
      }
      mx = pair_max(mx);
      if (__any(mx > m_ + 8.f)) {
        const float mnew = fmaxf(m_, mx);
        const float alpha = fexp2(m_ - mnew);
        m_ = mnew;
        l_ *= alpha;
#pragma unroll
        for (int dh = 0; dh < 2; ++dh)
#pragma unroll
          for (int r = 0; r < 16; ++r) O[dh][r] *= alpha;
      }
      float rsum = 0.f;
#pragma unroll
      for (int t = 0; t < 2; ++t)
        if (t < nsub) {
#pragma unroll
          for (int r = 0; r < 16; ++r) { const float e = fexp2(S[t][r] - m_); S[t][r] = e; rsum += e; }
        }
      l_ += rsum;
#pragma unroll
      for (int t = 0; t < 2; ++t)
       if (t < nsub)
#pragma unroll
        for (int s = 0; s < 2; ++s) {
          u32x4 u;
          u.x = pack_bf16(S[t][8 * s + 0], S[t][8 * s + 1]); u.y = pack_bf16(S[t][8 * s + 2], S[t][8 * s + 3]);
          u.z = pack_bf16(S[t][8 * s + 4], S[t][8 * s + 5]); u.w = pack_bf16(S[t][8 * s + 6], S[t][8 * s + 7]);
          const bf16x8 pf = __builtin_bit_cast(bf16x8, u);
#pragma unroll
          for (int dh = 0; dh < 2; ++dh) {
            const bf16x8 v = *(const bf16x8*)(vb + (dh * 32 + l31) * VSTR + (krb + t * 32 + s * 16 + hh * 8) * 2);
            O[dh] = MFMA32(v, pf, O[dh]);
          }
        }
    }
  };
  for (int j = 0; j < nsup; ++j) {
    const char* sb = lds + (j & 1) * 2 * STAGE;
    body(2 * j, sb);
    body(2 * j + 1, sb + STAGE);
    __builtin_amdgcn_sched_barrier(0);
    {
      const int so = ((j + 1) & 1) * 2;
      lstore(so, R0); lstore(so + 1, R1);
      gload(2 * j + 4, R0); gload(2 * j + 5, R1);
    }
    __syncthreads();
  }

  {
    const float lt = l_ + __shfl_xor(l_, 32);
    const float inv = 1.f / lt;
    char* orow = ostage + (w * 32) * OSTR;
#pragma unroll
    for (int dh = 0; dh < 2; ++dh)
#pragma unroll
      for (int g = 0; g < 4; ++g) {
        f32x4 v; v[0] = O[dh][4 * g] * inv; v[1] = O[dh][4 * g + 1] * inv; v[2] = O[dh][4 * g + 2] * inv; v[3] = O[dh][4 * g + 3] * inv;
        *(f32x4*)(orow + l31 * OSTR + (dh * 32 + 8 * g + 4 * hh) * 4) = v;
      }
    __builtin_amdgcn_s_waitcnt(0xc07f);
#pragma unroll
    for (int it = 0; it < 4; ++it) {
      const int cidx = lane + 64 * it, row = cidx >> 3, ch = cidx & 7;
      const f32x4 o0 = *(const f32x4*)(orow + row * OSTR + ch * 32), o1 = *(const f32x4*)(orow + row * OSTR + ch * 32 + 16);
      const int tok = tokmap(row);
      const u32x4 z = *(const u32x4*)(Zp + (size_t)tok * ldz + ch * 8);
      u32x4 wv;
      wv.x = pack_bf16(o0[0] * silu(bf_lo(z.x)), o0[1] * silu(bf_hi(z.x)));
      wv.y = pack_bf16(o0[2] * silu(bf_lo(z.y)), o0[3] * silu(bf_hi(z.y)));
      wv.z = pack_bf16(o1[0] * silu(bf_lo(z.z)), o1[1] * silu(bf_hi(z.z)));
      wv.w = pack_bf16(o1[2] * silu(bf_lo(z.w)), o1[3] * silu(bf_hi(z.w)));
      *(u32x4*)(UG + ablk(tok, gcol + ch * 8)) = wv;
    }
  }
}

DI void mla_item2(const Params& p, int layer, int b, int qt, int head, char* lds) {
  constexpr int DK = 96, NKS = 6, KSTR = DK * 2 + 16, VSTR = 144, KBYTES = 64 * KSTR, STAGE = KBYTES + 64 * VSTR;
  constexpr int NKC = 12, KCH = 64 * NKC, OSTR = 272, QG = 2, NTILES = 132;
  constexpr float MASKV = -1e30f;
  char* ostage = lds;
  const int tid = otid(), lane = tid & 63, w = tid >> 6, l31 = lane & 31, hh = lane >> 5;
  const bf16_t* Pb = (const bf16_t*)(p.ws + OFF_P);
  bf16_t* UG = (bf16_t*)(p.ws + OFF_UG);
  const bf16_t* Qp = (const bf16_t*)(p.ws + OFF_QB) + head * 96;
  const bf16_t* Kp = (const bf16_t*)(p.ws + OFF_KB) + head * 64;
  const bf16_t* Krp = Pb + 1920;
  const bf16_t* Vt = (const bf16_t*)(p.ws + OFF_VTB) + (size_t)(b * 8 + head) * 64 * NKEY;
  const bf16_t* Zp = Pb + 1952 + head * 64;
  const int gcol = 512 + head * 64;
  const int qtok0 = b * 8192 + qt * 512;
  bf16x8 qf[QG][NKS];
#pragma unroll
  for (int qg = 0; qg < QG; ++qg)
#pragma unroll
    for (int ks = 0; ks < NKS; ++ks) qf[qg][ks] = *(const bf16x8*)(Qp + (size_t)(qtok0 + qg * 256 + w * 32 + l31) * 768 + ks * 16 + hh * 8);
  float m_[QG], l_[QG];
  f32x16 O[QG][2];
#pragma unroll
  for (int qg = 0; qg < QG; ++qg) {
    m_[qg] = MASKV; l_[qg] = 0.f;
#pragma unroll
    for (int dh = 0; dh < 2; ++dh)
#pragma unroll
      for (int r = 0; r < 16; ++r) O[qg][dh][r] = 0.f;
  }
  const int k0row = tid / NKC, k0cc = tid % NKC;
  const int k1row = (tid + NT) / NKC, k1cc = (tid + NT) % NKC;
  const bool k1 = (tid + NT < KCH);
  struct Stg { u32x4 k0, k1, v; };
  Stg R0;
  R0.k1 = (u32x4){0u, 0u, 0u, 0u};
  auto kload = [&](int krow0, int row, int cc) -> u32x4 {
    if (cc >= 8) return *(const u32x4*)(Krp + (size_t)(krow0 + row) * 2560 + (cc - 8) * 8);
    return *(const u32x4*)(Kp + (size_t)(krow0 + row) * 512 + cc * 8);
  };
  auto gload = [&](int i, Stg& r) {
    const int kt = i < NTILES ? i : NTILES - 1;
    const int krow0 = kt < 128 ? b * 8192 + kt * 64 : T_LAT + b * 256 + (kt - 128) * 64;
    r.k0 = kload(krow0, k0row, k0cc);
    if (k1) r.k1 = kload(krow0, k1row, k1cc);
    r.v = *(const u32x4*)(Vt + (size_t)(tid >> 3) * NKEY + kt * 64 + (tid & 7) * 8);
  };
  auto lstore = [&](int st, const Stg& r) {
    char* kb = lds + st * STAGE;
    *(u32x4*)(kb + k0row * KSTR + k0cc * 16) = r.k0;
    if (k1) *(u32x4*)(kb + k1row * KSTR + k1cc * 16) = r.k1;
    *(u32x4*)(kb + KBYTES + (tid >> 3) * VSTR + (tid & 7) * 16) = r.v;
  };
  const int pr = (l31 & ~12) | ((l31 & 4) << 1) | ((l31 & 8) >> 1);
  __syncthreads();
  gload(0, R0); lstore(0, R0);
  gload(1, R0);
  __syncthreads();
  auto body = [&](const char* kb) {
    const char* vb = kb + KBYTES;
    f32x16 S[QG][2];
#pragma unroll
    for (int qg = 0; qg < QG; ++qg)
#pragma unroll
      for (int t = 0; t < 2; ++t)
#pragma unroll
        for (int r = 0; r < 16; ++r) S[qg][t][r] = 0.f;
#pragma unroll
    for (int ks = 0; ks < NKS; ++ks) {
      const bf16x8 a0 = *(const bf16x8*)(kb + pr * KSTR + ks * 32 + hh * 16);
      const bf16x8 a1 = *(const bf16x8*)(kb + (32 + pr) * KSTR + ks * 32 + hh * 16);
#pragma unroll
      for (int qg = 0; qg < QG; ++qg) { S[qg][0] = MFMA32(a0, qf[qg][ks], S[qg][0]); S[qg][1] = MFMA32(a1, qf[qg][ks], S[qg][1]); }
    }
#pragma unroll
    for (int qg = 0; qg < QG; ++qg) {
      float mx = S[qg][0][0];
#pragma unroll
      for (int t = 0; t < 2; ++t)
#pragma unroll
        for (int r = 0; r < 16; ++r) mx = fmaxf(mx, S[qg][t][r]);
      mx = pair_max(mx);
      if (__any(mx > m_[qg] + 8.f)) {
        const float mnew = fmaxf(m_[qg], mx);
        const float alpha = fexp2(m_[qg] - mnew);
        m_[qg] = mnew;
        l_[qg] *= alpha;
#pragma unroll
        for (int dh = 0; dh < 2; ++dh)
#pragma unroll
          for (int r = 0; r < 16; ++r) O[qg][dh][r] *= alpha;
      }
      float rsum = 0.f;
#pragma unroll
      for (int t = 0; t < 2; ++t)
#pragma unroll
        for (int r = 0; r < 16; ++r) { const float e = fexp2(S[qg][t][r] - m_[qg]); S[qg][t][r] = e; rsum += e; }
      l_[qg] += rsum;
    }
#pragma unroll
    for (int t = 0; t < 2; ++t)
#pragma unroll
      for (int s = 0; s < 2; ++s) {
        bf16x8 pf[QG];
#pragma unroll
        for (int qg = 0; qg < QG; ++qg) {
          u32x4 u;
          u.x = pack_bf16(S[qg][t][8 * s + 0], S[qg][t][8 * s + 1]); u.y = pack_bf16(S[qg][t][8 * s + 2], S[qg][t][8 * s + 3]);
          u.z = pack_bf16(S[qg][t][8 * s + 4], S[qg][t][8 * s + 5]); u.w = pack_bf16(S[qg][t][8 * s + 6], S[qg][t][8 * s + 7]);
          pf[qg] = __builtin_bit_cast(bf16x8, u);
        }
#pragma unroll
        for (int dh = 0; dh < 2; ++dh) {
          const bf16x8 v = *(const bf16x8*)(vb + (dh * 32 + l31) * VSTR + (t * 32 + s * 16 + hh * 8) * 2);
#pragma unroll
          for (int qg = 0; qg < QG; ++qg) O[qg][dh] = MFMA32(v, pf[qg], O[qg][dh]);
        }
      }
  };
  if (w >= 4) __builtin_amdgcn_s_setprio(2);
  for (int j = 0; j < NTILES; ++j) {
    body(lds + (j & 1) * STAGE);
    __builtin_amdgcn_sched_barrier(0);
    lstore((j + 1) & 1, R0);
    gload(j + 2, R0);
    __syncthreads();
  }
  __builtin_amdgcn_s_setprio(0);
#pragma unroll
  for (int qg = 0; qg < QG; ++qg) {
    const float lt = l_[qg] + __shfl_xor(l_[qg], 32);
    const float inv = 1.f / lt;
    char* orow = ostage + (w * 32) * OSTR;
#pragma unroll
    for (int dh = 0; dh < 2; ++dh)
#pragma unroll
      for (int g = 0; g < 4; ++g) {
        f32x4 v; v[0] = O[qg][dh][4 * g] * inv; v[1] = O[qg][dh][4 * g + 1] * inv; v[2] = O[qg][dh][4 * g + 2] * inv; v[3] = O[qg][dh][4 * g + 3] * inv;
        *(f32x4*)(orow + l31 * OSTR + (dh * 32 + 8 * g + 4 * hh) * 4) = v;
      }
    __builtin_amdgcn_s_waitcnt(0xc07f);
#pragma unroll
    for (int it = 0; it < 4; ++it) {
      const int cidx = lane + 64 * it, row = cidx >> 3, ch = cidx & 7;
      const f32x4 o0 = *(const f32x4*)(orow + row * OSTR + ch * 32), o1 = *(const f32x4*)(orow + row * OSTR + ch * 32 + 16);
      const int tok = qtok0 + qg * 256 + w * 32 + row;
      const u32x4 z = *(const u32x4*)(Zp + (size_t)tok * 2560 + ch * 8);
      u32x4 wv;
      wv.x = pack_bf16(o0[0] * silu(bf_lo(z.x)), o0[1] * silu(bf_hi(z.x)));
      wv.y = pack_bf16(o0[2] * silu(bf_lo(z.y)), o0[3] * silu(bf_hi(z.y)));
      wv.z = pack_bf16(o1[0] * silu(bf_lo(z.z)), o1[1] * silu(bf_hi(z.z)));
      wv.w = pack_bf16(o1[2] * silu(bf_lo(z.w)), o1[3] * silu(bf_hi(z.w)));
      *(u32x4*)(UG + ablk(tok, gcol + ch * 8)) = wv;
    }
    __builtin_amdgcn_s_waitcnt(0xc07f);
  }
}

DI void attn_phase_ab(const Params& p, int layer, char* lds) {
  const int G = ogrid();
  for (int v = obid(); v < 512; v += G) {
    const int xcd = v & 7, s = v >> 3;
    const int grp = (s >> 4) * 8 + xcd, qt = s & 15;
    mla_item2(p, layer, grp >> 3, qt, grp & 7, lds);
  }
  for (int v = obid(); v < 32; v += G) attn_item<1>(p, layer, v >> 3, 0, v & 7, true, lds);
  for (int v = obid(); v < 1024; v += G) {
    attn_item<0>(p, layer, v >> 8, v & 31, (v >> 5) & 7, false, lds);
  }
  for (int v = obid() - 32; v < 32; v += G) if (v >= 0) attn_item<0>(p, layer, v >> 3, 0, v & 7, true, lds);
}

DI void attn_phase_c(const Params& p, int layer, char* lds) {
  const int G = ogrid();
  const int nctx = (layer == 3) ? 0 : 64;
  for (int v = obid(); v < 2048 + nctx; v += G) {
    if (v < 2048) attn_item<2>(p, layer, v >> 9, v & 31, (v >> 5) & 15, false, lds);
    else { const int c = v - 2048; attn_item<2>(p, layer, c >> 4, 0, c & 15, true, lds); }
  }
}

__global__ void __launch_bounds__(512, 2) fwd_megakernel(Params p) {
  __shared__ __attribute__((aligned(16))) char lds[LDS_BYTES];
  __shared__ uint4 xb_words;
  if (threadIdx.x == 0) xb_words = make_uint4(0u, 0u, 0u, 0u);
  __syncthreads();
  if (obid() == 0) { unsigned* bw = (unsigned*)(p.ws + OFF_BAR); for (int i = otid(); i < 4096; i += NT) bw[i] = 0u; }
  XcdBarrier xb; xb.bar = (unsigned*)(p.ws + OFF_BAR); xb.x = 0; xb.st = (volatile LAS unsigned*)&xb_words;
  bool first = true, posted = false;
  for (int ph = p.ph_begin; ph < p.ph_end; ++ph) {
    const int layer = (ph - 1) / 5, s = (ph - 1) % 5;
    const bool even = (layer & 1) == 0;
    const int i2 = layer >> 1;
    if (ph >= 1 && ph <= 20 && s == 2 && !even) continue;
    if (!first) {
      if (!posted) { cg::this_grid().sync(); xb = xcd_barrier_post((unsigned*)(p.ws + OFF_BAR), (volatile LAS unsigned*)&xb_words); posted = true; }
      else xcd_barrier(xb);
    }
    first = false;
    if (ph == 0) prologue_phase(p, lds);
    else if (ph == 21) final_phase(p);
    else if (s == 0) norm_phase(p, layer);
    else if (s == 1) {
      const bf16_t* U = (const bf16_t*)(p.ws + OFF_UG);
      if (even) gemm_phase<EPI_AB_IN>(p, layer, U, 0, (const bf16_t*)(p.ws + OFF_W_IN) + (size_t)i2 * 2560 * 1024, 1024, 128, 10, true, false, lds);
      else if (layer == 3)
        gemm_phase<EPI_C_IN>(p, layer, U, 0, (const bf16_t*)(p.ws + OFF_W_CIN) + (size_t)i2 * 4096 * 1024, 1024, 128, 16, true, false, lds, 4, 8);
      else gemm_phase<EPI_C_IN>(p, layer, U, 0, (const bf16_t*)(p.ws + OFF_W_CIN) + (size_t)i2 * 4096 * 1024, 1024, 128, 16, true, false, lds);
    } else if (s == 2) {
      const bf16_t* Pb = (const bf16_t*)(p.ws + OFF_P);
      gemm_phase<EPI_QB>(p, layer, Pb + 1280, 2560, (const bf16_t*)(p.ws + OFF_W_UQ) + (size_t)i2 * 768 * 384, 384, 128, 3, true, false, lds);
      gemm_phase<EPI_KVB>(p, layer, Pb + 1664, 2560, (const bf16_t*)(p.ws + OFF_W_UKV) + (size_t)i2 * 1024 * 256, 256, 128, 4, true, true, lds);
      vta_phase(p, lds);
    } else if (s == 3) {
      if (even) attn_phase_ab(p, layer, lds); else attn_phase_c(p, layer, lds);
    } else {
      const bf16_t* Gm = (const bf16_t*)(p.ws + OFF_UG);
      const bf16_t* W = even ? (const bf16_t*)(p.ws + OFF_W_OUT) + (size_t)i2 * 1024 * 1024 : (const bf16_t*)(p.ws + OFF_W_COUT) + (size_t)i2 * 1024 * 1024;
      gemm_phase<EPI_OUT>(p, layer, Gm, 0, W, 1024, 128, 4, layer != 3, false, lds);
    }
  }
}

extern "C" void kernel_launch(void* const* d_in, const int* in_sizes, int n_in, void* d_out, int out_size, void* d_ws, size_t ws_size,
                              hipStream_t stream) {
  static int grid_blocks = 0;
  if (!grid_blocks) {
    int dev = 0, cus = 0, per_cu = 0;
    hipGetDevice(&dev);
    hipDeviceGetAttribute(&cus, hipDeviceAttributeMultiprocessorCount, dev);
    hipOccupancyMaxActiveBlocksPerMultiprocessor(&per_cu, fwd_megakernel, NT, 0);
    per_cu = 1;
    grid_blocks = cus * per_cu;
    if (ws_size < OFF_END) fprintf(stderr, "kernel_launch: workspace too small: %zu < %zu\n", ws_size, (size_t)OFF_END);
  }
  Params p{};
  const float** f = (const float**)&p;
  for (int i = 0; i < 18; ++i) f[i] = (const float*)d_in[i];
  p.out = (float*)d_out;
  p.ws = (char*)d_ws;
#if MK_MULTI_LAUNCH
  for (int ph = 0; ph < 22; ++ph) {
    if (ph >= 1 && ph <= 20 && ((ph - 1) % 5) == 2 && (((ph - 1) / 5) & 1)) continue;
    p.ph_begin = ph; p.ph_end = ph + 1;
    hipLaunchKernelGGL(fwd_megakernel, dim3(grid_blocks), dim3(NT), 0, stream, p);
  }
#else
  p.ph_begin = 0; p.ph_end = 22;
  void* args[] = {&p};
  hipError_t e = hipLaunchCooperativeKernel((void*)fwd_megakernel, dim3(grid_blocks), dim3(NT), args, 0, stream);
  if (e != hipSuccess) fprintf(stderr, "cooperative launch failed: %s (grid %d)\n", hipGetErrorString(e), grid_blocks);
#endif
}
```

```cpp
#include <hip/hip_runtime.h>
#include <hip/hip_cooperative_groups.h>
#include <stdint.h>
#include <stdio.h>
namespace cg = cooperative_groups;

#ifndef MK_MULTI_LAUNCH
#define MK_MULTI_LAUNCH 0
#endif

typedef unsigned short bf16_t;
typedef short bf16x8 __attribute__((ext_vector_type(8)));
typedef float f32x16 __attribute__((ext_vector_type(16)));
typedef float f32x4 __attribute__((ext_vector_type(4)));
typedef float f32x2 __attribute__((ext_vector_type(2)));
typedef unsigned u32x4 __attribute__((ext_vector_type(4)));
typedef unsigned u32x2 __attribute__((ext_vector_type(2)));

#define DI __device__ __forceinline__
#define MFMA32(a, b, c) __builtin_amdgcn_mfma_f32_32x32x16_bf16((a), (b), (c), 0, 0, 0)

constexpr int T_LAT = 32768, T_ALL = 33792, NKEY = 8448, NT = 512;
constexpr float LOG2E = 1.4426950408889634f;
constexpr float QSCALE_A = 0.125f * LOG2E;
constexpr float QSCALE_B = 0.10206207261596575f * LOG2E;

constexpr size_t OFF_HC   = 0;
constexpr size_t OFF_UG   = OFF_HC + 1024ull * 1024 * 4;
constexpr size_t OFF_P    = OFF_UG + (size_t)T_ALL * 1024 * 2;
constexpr size_t OFF_QB   = OFF_P + (size_t)T_ALL * 2560 * 2;
constexpr size_t OFF_KB   = OFF_QB + (size_t)T_ALL * 768 * 2;
constexpr size_t OFF_VT   = OFF_KB + (size_t)T_ALL * 512 * 2;
constexpr size_t OFF_VTB  = OFF_VT + 4ull * 2 * 64 * NKEY * 2;
constexpr size_t OFF_W    = OFF_VT + 4ull * 16 * 64 * NKEY * 2;
constexpr size_t OFF_W_IN   = OFF_W;
constexpr size_t OFF_W_OUT  = OFF_W_IN + 2ull * 2560 * 1024 * 2;
constexpr size_t OFF_W_UQ   = OFF_W_OUT + 2ull * 1024 * 1024 * 2;
constexpr size_t OFF_W_UKV  = OFF_W_UQ + 2ull * 768 * 384 * 2;
constexpr size_t OFF_W_CIN  = OFF_W_UKV + 2ull * 1024 * 256 * 2;
constexpr size_t OFF_W_COUT = OFF_W_CIN + 2ull * 4096 * 1024 * 2;
constexpr size_t OFF_MOD    = OFF_W_COUT + 2ull * 1024 * 1024 * 2;
constexpr size_t OFF_ROPE   = OFF_MOD + 4ull * 5 * 3072 * 4;
constexpr size_t OFF_BAR    = OFF_ROPE + 2ull * 8192 * 32 * 4 + 2ull * 8192 * 16 * 4;
constexpr size_t OFF_END    = OFF_BAR + 16384;

struct Params {
  const float *x, *c, *ctx, *c_ctx, *ada_w, *ada_b, *norm_g, *ab_in_w, *ab_out_w, *a_sink, *b_qn_g, *b_w_uq, *b_kvn_g, *b_w_ukv,
      *c_in_w, *c_out_w, *c_rpb, *final_g;
  float* out;
  char* ws;
  int ph_begin, ph_end;
};

DI int otid() { int t = threadIdx.x; asm volatile("" : "+v"(t)); return t; }
DI int obid() { int t = blockIdx.x; asm volatile("" : "+s"(t)); return t; }
DI int ogrid() { int t = gridDim.x; asm volatile("" : "+s"(t)); return t; }
DI unsigned pack_bf16(float lo, float hi) { unsigned r; asm("v_cvt_pk_bf16_f32 %0, %1, %2" : "=v"(r) : "v"(lo), "v"(hi)); return r; }
DI float bf_lo(unsigned u) { return __uint_as_float(u << 16); }
DI float bf_hi(unsigned u) { return __uint_as_float(u & 0xffff0000u); }
DI float fexp2(float x) { return __builtin_amdgcn_exp2f(x); }
DI float pair_max(float x) {
  const unsigned u = __float_as_uint(x);
  const auto r = __builtin_amdgcn_permlane32_swap(u, u, false, false);
  return fmaxf(__uint_as_float(r[0]), __uint_as_float(r[1]));
}
DI float silu(float z) { return z * __builtin_amdgcn_rcpf(1.f + __expf(-z)); }

DI size_t ablk(int tok, int k) { return ((size_t)((tok >> 8) * 16 + (k >> 6)) << 14) + ((tok & 255) << 6) + (k & 63); }
DI void tok_bk(int tok, int& b, int& key) {
  if (tok < T_LAT) { b = tok >> 13; key = tok & 8191; } else { int r = tok - T_LAT; b = r >> 8; key = 8192 + (r & 255); }
}
DI const float* h_src(const Params& p, int layer, int tok) {
  if (layer == 0) return tok < T_LAT ? p.x + (size_t)tok * 1024 : p.ctx + (size_t)(tok - T_LAT) * 1024;
  return tok < T_LAT ? p.out + (size_t)tok * 1024 : (const float*)(p.ws + OFF_HC) + (size_t)(tok - T_LAT) * 1024;
}
DI float* h_dst(const Params& p, int tok) {
  return tok < T_LAT ? p.out + (size_t)tok * 1024 : (float*)(p.ws + OFF_HC) + (size_t)(tok - T_LAT) * 1024;
}

#define XB_TMO      128
#define XB_XCNT(j)  (256  + 64 * (j))
#define XB_XSUB(j)  (1280 + 64 * (j))
#define XB_XGEN(j)  (2304 + 64 * (j))
#define XB_TOP      3328
#define XB_TOPGEN   3392
#define XCD_BAR_WORDS 3456
#define XB_SPIN_CAP (1u << 22)
#define LAS __attribute__((address_space(3)))
DI unsigned xb_ld(unsigned* p) { return __hip_atomic_load(p, __ATOMIC_RELAXED, __HIP_MEMORY_SCOPE_AGENT); }
DI unsigned xb_add(unsigned* p, unsigned v) { return __hip_atomic_fetch_add(p, v, __ATOMIC_RELAXED, __HIP_MEMORY_SCOPE_AGENT); }
DI unsigned xb_xcc_id() { return (unsigned)__builtin_amdgcn_s_getreg((3 << 11) | 20) & 0xFu; }
#define XB_SPIN(cond, bar) do { unsigned _sp = 0; while (cond) { __builtin_amdgcn_s_sleep(1); \
    if ((++_sp & 255u) == 0u) { if (xb_ld(&(bar)[XB_TMO])) break; if (_sp > XB_SPIN_CAP) { atomicAdd(&(bar)[XB_TMO], 1u); break; } } } } while (0)
struct XcdBarrier { unsigned* bar; unsigned x; volatile LAS unsigned* st; };
DI XcdBarrier xcd_barrier_post(unsigned* bar, volatile LAS unsigned* st) {
  XcdBarrier b; b.bar = bar; b.x = xb_xcc_id(); b.st = st;
  if (threadIdx.x == 0) (void)xb_add(&bar[XB_XCNT(b.x)], 1u);
  return b;
}
DI void xcd_barrier_complete(unsigned* bar, unsigned x, unsigned& nloc, unsigned& nx) {
  const unsigned G = gridDim.x * gridDim.y * gridDim.z;
  unsigned sum, cnt, mine, sp = 0u;
  for (;;) {
    sum = 0u; cnt = 0u; mine = 0u;
#pragma unroll
    for (unsigned j = 0; j < 16; ++j) { const unsigned c = xb_ld(&bar[XB_XCNT(j)]); sum += c; cnt += (c > 0u) ? 1u : 0u; mine = (j == x) ? c : mine; }
    if (sum == G) break;
    __builtin_amdgcn_s_sleep(1);
    if ((++sp & 255u) == 0u) { if (xb_ld(&bar[XB_TMO])) break; if (sp > XB_SPIN_CAP) { atomicAdd(&bar[XB_TMO], 1u); break; } }
  }
  nloc = mine > 0u ? mine : 1u; nx = cnt > 0u ? cnt : 1u;
}
DI void xcd_barrier(const XcdBarrier& b) {
  asm volatile("s_waitcnt vmcnt(0)" ::: "memory");
  __syncthreads();
  if (threadIdx.x == 0) {
    unsigned* bar = b.bar;
    __builtin_amdgcn_s_waitcnt(0);
    unsigned nloc = b.st[0], nx = b.st[1];
    if (nloc == 0u) { xcd_barrier_complete(bar, b.x, nloc, nx); b.st[0] = nloc; b.st[1] = nx; }
    const unsigned old = xb_add(&bar[XB_XSUB(b.x)], 1u);
    const unsigned gen = old / nloc;
    if (old + 1u == (gen + 1u) * nloc) {
      __builtin_amdgcn_fence(__ATOMIC_RELEASE, "agent");
      asm volatile("s_waitcnt vmcnt(0)" ::: "memory");
      const unsigned og = xb_add(&bar[XB_TOP], 1u);
      const unsigned tg = og / nx;
      if (og + 1u == (tg + 1u) * nx) xb_add(&bar[XB_TOPGEN], 1u);
      else XB_SPIN(xb_ld(&bar[XB_TOPGEN]) == tg, bar);
      __builtin_amdgcn_fence(__ATOMIC_ACQUIRE, "agent");
      xb_add(&bar[XB_XGEN(b.x)], 1u);
      asm volatile("s_waitcnt vmcnt(0)" ::: "memory");
    } else {
      XB_SPIN(xb_ld(&bar[XB_XGEN(b.x)]) == gen, bar);
      __builtin_amdgcn_fence(__ATOMIC_ACQUIRE, "agent");
      asm volatile("s_waitcnt vmcnt(0)" ::: "memory");
    }
  }
  __syncthreads();
}

struct TJob { const float* src; const float* rs; bf16_t* dst; int K, N, tk, tn, perm; };
DI TJob tr_job(const Params& p, int t) {
  TJob j; j.rs = nullptr; j.perm = 0;
  const int i2 = t / 2312; t -= i2 * 2312;
  if (t < 640) { j.src = p.ab_in_w + (size_t)i2 * 1024 * 2464; j.K = 1024; j.N = 2464; j.dst = (bf16_t*)(p.ws + OFF_W_IN) + (size_t)i2 * 2560 * 1024; j.tk = t / 40; j.tn = t % 40; }
  else if ((t -= 640) < 256) { j.src = p.ab_out_w + (size_t)i2 * 1024 * 1024; j.K = 1024; j.N = 1024; j.dst = (bf16_t*)(p.ws + OFF_W_OUT) + (size_t)i2 * 1024 * 1024; j.tk = t / 16; j.tn = t % 16; }
  else if ((t -= 256) < 72) { j.src = p.b_w_uq + (size_t)i2 * 384 * 768; j.K = 384; j.N = 768; j.dst = (bf16_t*)(p.ws + OFF_W_UQ) + (size_t)i2 * 768 * 384; j.rs = p.b_qn_g + i2 * 384; j.tk = t / 12; j.tn = t % 12; }
  else if ((t -= 72) < 64) { j.src = p.b_w_ukv + (size_t)i2 * 256 * 1024; j.K = 256; j.N = 1024; j.dst = (bf16_t*)(p.ws + OFF_W_UKV) + (size_t)i2 * 1024 * 256; j.rs = p.b_kvn_g + i2 * 256; j.tk = t / 16; j.tn = t % 16; j.perm = 1; }
  else if ((t -= 64) < 1024) { j.src = p.c_in_w + (size_t)i2 * 1024 * 4096; j.K = 1024; j.N = 4096; j.dst = (bf16_t*)(p.ws + OFF_W_CIN) + (size_t)i2 * 4096 * 1024; j.tk = t / 64; j.tn = t % 64; }
  else { t -= 1024; j.src = p.c_out_w + (size_t)i2 * 1024 * 1024; j.K = 1024; j.N = 1024; j.dst = (bf16_t*)(p.ws + OFF_W_COUT) + (size_t)i2 * 1024 * 1024; j.tk = t / 16; j.tn = t % 16; }
  return j;
}
DI void tr_load(const TJob& j, int tid, float (&v)[8]) {
#pragma unroll
  for (int i = 0; i < 8; ++i) {
    const int kk = (tid >> 6) + 8 * i, n = j.tn * 64 + (tid & 63);
    float x = (n < j.N) ? j.src[(size_t)(j.tk * 64 + kk) * j.N + n] : 0.f;
    if (j.rs) x *= j.rs[j.tk * 64 + kk];
    v[i] = x;
  }
}

DI void prologue_phase(const Params& p, char* lds) {
  const int tid = otid();
  constexpr int N_MOD = 192, N_TR = 4624, N_ROPE = 768;
  for (int u = obid(); u < N_MOD + N_TR + N_ROPE; u += ogrid()) {
    if (u < N_MOD) {
      const int layer = u / 48, cb = u % 48;
      float* sl = (float*)lds;
      for (int i = tid; i < 5120; i += NT) {
        const int bb = i >> 10, k = i & 1023;
        const float cv = bb < 4 ? p.c[bb * 1024 + k] : p.c_ctx[k];
        sl[i] = silu(cv);
      }
      __syncthreads();
      const int col = cb * 64 + (tid & 63), kg = tid >> 6;
      float a0 = 0, a1 = 0, a2 = 0, a3 = 0, a4 = 0;
      const float* wp = p.ada_w + (size_t)layer * 1024 * 3072 + col;
#pragma unroll 32
      for (int k = kg * 128; k < kg * 128 + 128; ++k) {
        const float wv = wp[(size_t)k * 3072];
        a0 += sl[k] * wv; a1 += sl[1024 + k] * wv; a2 += sl[2048 + k] * wv; a3 += sl[3072 + k] * wv; a4 += sl[4096 + k] * wv;
      }
      float* red = (float*)(lds + 20480);
      red[(kg * 5 + 0) * 64 + (tid & 63)] = a0; red[(kg * 5 + 1) * 64 + (tid & 63)] = a1; red[(kg * 5 + 2) * 64 + (tid & 63)] = a2;
      red[(kg * 5 + 3) * 64 + (tid & 63)] = a3; red[(kg * 5 + 4) * 64 + (tid & 63)] = a4;
      __syncthreads();
      if (tid < 64) {
        float* mod = (float*)(p.ws + OFF_MOD);
        const float bias = p.ada_b[layer * 3072 + col];
#pragma unroll
        for (int bb = 0; bb < 5; ++bb) {
          float s = bias;
#pragma unroll
          for (int g = 0; g < 8; ++g) s += red[(g * 5 + bb) * 64 + tid];
          mod[(size_t)(layer * 5 + bb) * 3072 + col] = s;
        }
      }
      __syncthreads();
    } else if (u < N_MOD + N_TR) {
    } else {
      const int idx = (u - N_MOD - N_TR) * NT + tid;
      float* ropeA = (float*)(p.ws + OFF_ROPE);
      float* ropeB = ropeA + 2 * 8192 * 32;
      if (idx < 8192 * 32) {
        const int pos = idx >> 5, pr = idx & 31;
        const float pv = pr < 16 ? (float)(pos >> 6) : (float)(pos & 63);
        const float inv = exp2f(-(float)(pr & 15) * (13.287712379549449f / 16.f));
        const float ang = pv * inv;
        ropeA[idx] = cosf(ang); ropeA[8192 * 32 + idx] = sinf(ang);
      } else {
        const int j = idx - 8192 * 32;
        const int pos = j >> 4, pr = j & 15;
        const float pv = pr < 8 ? (float)(pos >> 6) : (float)(pos & 63);
        const float inv = exp2f(-(float)(pr & 7) * (13.287712379549449f / 8.f));
        const float ang = pv * inv;
        ropeB[j] = cosf(ang); ropeB[8192 * 16 + j] = sinf(ang);
      }
    }
  }
  {
    const int G = ogrid();
    int t = obid();
    float v[8], nv[8];
    TJob cur, nxt;
    if (t < N_TR) { cur = tr_job(p, t); tr_load(cur, tid, v); }
    int buf = 0;
    for (; t < N_TR; t += G) {
      const bool more = t + G < N_TR;
      if (more) { nxt = tr_job(p, t + G); tr_load(nxt, tid, nv); }
      float* tile = (float*)(lds + buf * 16640);
#pragma unroll
      for (int i = 0; i < 8; ++i) tile[((tid >> 6) + 8 * i) * 65 + (tid & 63)] = v[i];
      __syncthreads();
      {
        const int nn = tid & 63, k8 = (tid >> 6) * 8;
        int n = cur.tn * 64 + nn;
        if (cur.perm) n = ((n & 64) ? 512 : 0) + (n >> 7) * 64 + (n & 63);
        u32x4 w;
        w.x = pack_bf16(tile[(k8 + 0) * 65 + nn], tile[(k8 + 1) * 65 + nn]); w.y = pack_bf16(tile[(k8 + 2) * 65 + nn], tile[(k8 + 3) * 65 + nn]);
        w.z = pack_bf16(tile[(k8 + 4) * 65 + nn], tile[(k8 + 5) * 65 + nn]); w.w = pack_bf16(tile[(k8 + 6) * 65 + nn], tile[(k8 + 7) * 65 + nn]);
        *(u32x4*)(cur.dst + ((size_t)((n >> 8) * (cur.K >> 6) + cur.tk) << 14) + ((n & 255) << 6) + k8) = w;
      }
      buf ^= 1;
      if (more) {
        cur = nxt;
#pragma unroll
        for (int i = 0; i < 8; ++i) v[i] = nv[i];
      }
    }
    __syncthreads();
  }
}

DI float wave_sum(float v) {
#pragma unroll
  for (int o = 32; o >= 1; o >>= 1) v += __shfl_xor(v, o);
  return v;
}

DI void norm_phase(const Params& p, int layer) {
  const int lane = otid() & 63;
  const int wave = obid() * 8 + (otid() >> 6), nw = ogrid() * 8;
  const float* g = p.norm_g + layer * 1024;
  const float* mod = (const float*)(p.ws + OFF_MOD) + (size_t)layer * 5 * 3072;
  bf16_t* U = (bf16_t*)(p.ws + OFF_UG);
  f32x4 gv[4];
#pragma unroll
  for (int i = 0; i < 4; ++i) gv[i] = *(const f32x4*)(g + lane * 4 + 256 * i);
  f32x4 nv[4];
  if (wave < T_ALL) {
    const float* s0 = h_src(p, layer, wave);
#pragma unroll
    for (int i = 0; i < 4; ++i) nv[i] = *(const f32x4*)(s0 + lane * 4 + 256 * i);
  }
  for (int row = wave; row < T_ALL; row += nw) {
    const int bb = row < T_LAT ? (row >> 13) : 4;
    f32x4 v[4];
#pragma unroll
    for (int i = 0; i < 4; ++i) v[i] = nv[i];
    if (row + nw < T_ALL) {
      const float* s1 = h_src(p, layer, row + nw);
#pragma unroll
      for (int i = 0; i < 4; ++i) nv[i] = *(const f32x4*)(s1 + lane * 4 + 256 * i);
    }
    float ss = 0.f;
#pragma unroll
    for (int i = 0; i < 4; ++i) ss += v[i][0] * v[i][0] + v[i][1] * v[i][1] + v[i][2] * v[i][2] + v[i][3] * v[i][3];
    ss = wave_sum(ss);
    const float rstd = rsqrtf(ss * (1.f / 1024.f) + 1e-6f);
    const float* mrow = mod + bb * 3072;
#pragma unroll
    for (int i = 0; i < 4; ++i) {
      const int cidx = lane * 4 + 256 * i;
      const f32x4 sh = *(const f32x4*)(mrow + cidx), sc = *(const f32x4*)(mrow + 1024 + cidx);
      f32x4 o = (v[i] * rstd) * gv[i] * (sc + 1.f) + sh;
      u32x2 w; w.x = pack_bf16(o[0], o[1]); w.y = pack_bf16(o[2], o[3]);
      *(u32x2*)(U + ablk(row, cidx)) = w;
    }
  }
}

DI void final_phase(const Params& p) {
  const int lane = otid() & 63;
  const int wave = obid() * 8 + (otid() >> 6), nw = ogrid() * 8;
  f32x4 gv[4];
#pragma unroll
  for (int i = 0; i < 4; ++i) gv[i] = *(const f32x4*)(p.final_g + lane * 4 + 256 * i);
  f32x4 nv[4];
  if (wave < T_LAT) {
#pragma unroll
    for (int i = 0; i < 4; ++i) nv[i] = *(const f32x4*)(p.out + (size_t)wave * 1024 + lane * 4 + 256 * i);
  }
  for (int row = wave; row < T_LAT; row += nw) {
    float* src = p.out + (size_t)row * 1024;
    f32x4 v[4];
#pragma unroll
    for (int i = 0; i < 4; ++i) v[i] = nv[i];
    if (row + nw < T_LAT) {
#pragma unroll
      for (int i = 0; i < 4; ++i) nv[i] = *(const f32x4*)(p.out + (size_t)(row + nw) * 1024 + lane * 4 + 256 * i);
    }
    float ss = 0.f;
#pragma unroll
    for (int i = 0; i < 4; ++i) ss += v[i][0] * v[i][0] + v[i][1] * v[i][1] + v[i][2] * v[i][2] + v[i][3] * v[i][3];
    ss = wave_sum(ss);
    const float rstd = rsqrtf(ss * (1.f / 1024.f) + 1e-6f);
#pragma unroll
    for (int i = 0; i < 4; ++i) *(f32x4*)(src + lane * 4 + 256 * i) = (v[i] * rstd) * gv[i];
  }
}

enum { EPI_AB_IN = 0, EPI_QB = 1, EPI_KVB = 2, EPI_C_IN = 3, EPI_OUT = 4 };
constexpr int G_STR = 144;
constexpr int G_OPER = 256 * G_STR;
constexpr int G_STAGE = 2 * G_OPER;
constexpr int OFF_RSTD = 2 * G_STAGE;
constexpr int LDS_BYTES = OFF_RSTD + 1024;

DI void rope2(float& v0, float& v1, float& v2, float& v3, const float* cs, const float* sn) {
  const f32x2 c = *(const f32x2*)cs, s = *(const f32x2*)sn;
  const float a0 = v0 * c.x - v1 * s.x, a1 = v0 * s.x + v1 * c.x, a2 = v2 * c.y - v3 * s.y, a3 = v2 * s.y + v3 * c.y;
  v0 = a0; v1 = a1; v2 = a2; v3 = a3;
}

template <int EPI>
DI void epi_math(const Params& p, int tok, int f0, float& v0, float& v1, float& v2, float& v3, float rs) {
  const float* ropeA = (const float*)(p.ws + OFF_ROPE);
  const float* ropeB = ropeA + 2 * 8192 * 32;
  const bool lat = tok < T_LAT;
  const int pos = tok & 8191;
  if (EPI == EPI_AB_IN) {
    if (f0 < 640) {
      if (lat) { const int p0 = (f0 & 63) >> 1; rope2(v0, v1, v2, v3, ropeA + pos * 32 + p0, ropeA + 8192 * 32 + pos * 32 + p0); }
      if (f0 < 512) { v0 *= QSCALE_A; v1 *= QSCALE_A; v2 *= QSCALE_A; v3 *= QSCALE_A; }
    } else if (f0 >= 1920 && f0 < 1952) {
      if (lat) { const int p0 = (f0 - 1920) >> 1; rope2(v0, v1, v2, v3, ropeB + pos * 16 + p0, ropeB + 8192 * 16 + pos * 16 + p0); }
    }
  } else if (EPI == EPI_QB) {
    const float s = rs * QSCALE_B;
    v0 *= s; v1 *= s; v2 *= s; v3 *= s;
    const int fh = f0 % 96;
    if (fh >= 64 && lat) { const int p0 = (fh - 64) >> 1; rope2(v0, v1, v2, v3, ropeB + pos * 16 + p0, ropeB + 8192 * 16 + pos * 16 + p0); }
  } else if (EPI == EPI_KVB) {
    v0 *= rs; v1 *= rs; v2 *= rs; v3 *= rs;
  } else if (EPI == EPI_C_IN) {
    if (f0 < 1024) { v0 *= QSCALE_A; v1 *= QSCALE_A; v2 *= QSCALE_A; v3 *= QSCALE_A; }
  }
}

template <int EPI>
DI bf16_t* dst_tr(const Params& p, int tok, int col) {
  if (EPI == EPI_AB_IN) return col < 2464 ? (bf16_t*)(p.ws + OFF_P) + (size_t)tok * 2560 + col : nullptr;
  if (EPI == EPI_QB) return (bf16_t*)(p.ws + OFF_QB) + (size_t)tok * 768 + col;
  if (EPI == EPI_KVB) return (bf16_t*)(p.ws + OFF_KB) + (size_t)tok * 512 + col;
  return (bf16_t*)(p.ws + OFF_P) + (size_t)tok * 3072 + (col >= 3072 ? col - 1024 : col);
}
template <int EPI>
DI bf16_t* dst_v(const Params& p, int t0, int col) {
  int b, key; tok_bk(t0, b, key);
  if (EPI == EPI_KVB) return (bf16_t*)(p.ws + OFF_VTB) + ((size_t)(b * 8 + ((col - 512) >> 6)) * 64 + (col & 63)) * NKEY + key;
  return (bf16_t*)(p.ws + OFF_VT) + ((size_t)(b * 16 + ((col - 2048) >> 6)) * 64 + (col & 63)) * NKEY + key;
}

struct TilePf { bool pre; bool has_next; int nm0, nnt; };
template <int EPI, int TM>
DI void gemm_tile(const Params& p, int layer, const bf16_t* __restrict__ A, int lda, const bf16_t* __restrict__ Bt, int K, int m0, int nt, char* lds,
                  u32x4 (&ra)[TM / 64], u32x4 (&rb)[4], const TilePf pf) {
  constexpr int NJ = TM == 256 ? 4 : 2, NI = TM == 256 ? 2 : 1, NA = TM / 64;
  const int tid = otid(), lane = tid & 63, w = tid >> 6;
  const int wm = TM == 256 ? (w >> 2) : 0, wn = TM == 256 ? (w & 3) : w;
  const int fb = TM == 256 ? wn * 64 : wn * 32, tb = TM == 256 ? wm * 128 : 0;
  const int l31 = lane & 31, hh = lane >> 5;
  const int n0 = nt * 256;
  float* rstd = (float*)(lds + OFF_RSTD);
  const int srow = tid >> 3, scc = tid & 7;
  const bool ablocked = (lda == 0);
  const int nkb = K >> 6;
  const bf16_t* ag = ablocked ? A + ((size_t)((m0 >> 8) * 16) << 14) + (m0 & 255) * 64 + tid * 8 : A + (size_t)(m0 + srow) * lda + scc * 8;
  const size_t a_i = ablocked ? 4096 : (size_t)64 * lda, a_k = ablocked ? 16384 : 64;
  const bf16_t* bg = Bt + ((size_t)(nt * nkb) << 14) + tid * 8;

  if (EPI == EPI_QB || EPI == EPI_KVB) {
    __syncthreads();
    if (tid < 2 * TM) {
      const int r = tid >> 1, half = tid & 1;
      const bf16_t* ap = A + (size_t)(m0 + r) * lda + half * (K / 2);
      float ss = 0.f;
#pragma unroll 8
      for (int cidx = 0; cidx < K / 2; cidx += 8) {
        const u32x4 v = *(const u32x4*)(ap + cidx);
#pragma unroll
        for (int e = 0; e < 4; ++e) { const float a = bf_lo(v[e]), b2 = bf_hi(v[e]); ss += a * a + b2 * b2; }
      }
      ss += __shfl_xor(ss, 1);
      if (half == 0) rstd[r] = rsqrtf(ss / (float)K + 1e-6f);
    }
  }

  f32x16 acc[NI][NJ];
#pragma unroll
  for (int i = 0; i < NI; ++i)
#pragma unroll
    for (int j = 0; j < NJ; ++j)
#pragma unroll
      for (int r = 0; r < 16; ++r) acc[i][j][r] = 0.f;

  const int nk = K >> 6;
  if (!pf.pre) {
#pragma unroll
    for (int i = 0; i < NA; ++i) ra[i] = *(const u32x4*)(ag + i * a_i);
#pragma unroll
    for (int i = 0; i < 4; ++i) rb[i] = *(const u32x4*)(bg + i * 4096);
  }
#pragma unroll
  for (int i = 0; i < NA; ++i) *(u32x4*)(lds + (srow + 64 * i) * G_STR + scc * 16) = ra[i];
#pragma unroll
  for (int i = 0; i < 4; ++i) *(u32x4*)(lds + G_OPER + (srow + 64 * i) * G_STR + scc * 16) = rb[i];
#pragma unroll
  for (int i = 0; i < NA; ++i) ra[i] = *(const u32x4*)(ag + i * a_i + a_k);
#pragma unroll
  for (int i = 0; i < 4; ++i) rb[i] = *(const u32x4*)(bg + i * 4096 + 16384);
  __syncthreads();
  for (int kt = 0; kt < nk; ++kt) {
    const char* as = lds + (kt & 1) * G_STAGE;
    char* st = lds + ((kt + 1) & 1) * G_STAGE;
    const char* fp = as + G_OPER + (fb + l31) * G_STR + hh * 16;
    const char* sp = as + (tb + l31) * G_STR + hh * 16;
    const bool more = kt + 2 < nk;
#pragma unroll
    for (int ks = 0; ks < 4; ++ks) {
      bf16x8 f[NI], s[NJ];
#pragma unroll
      for (int i = 0; i < NI; ++i) f[i] = *(const bf16x8*)(fp + i * 32 * G_STR + ks * 32);
#pragma unroll
      for (int j = 0; j < NJ; ++j) s[j] = *(const bf16x8*)(sp + j * 32 * G_STR + ks * 32);
#pragma unroll
      for (int j = 0; j < NJ / 2; ++j)
#pragma unroll
        for (int i = 0; i < NI; ++i) acc[i][j] = MFMA32(f[i], s[j], acc[i][j]);
      if (ks < NA) *(u32x4*)(st + (srow + 64 * ks) * G_STR + scc * 16) = ra[ks < NA ? ks : 0];
      if (more && ks < NA) ra[ks < NA ? ks : 0] = *(const u32x4*)(ag + (ks < NA ? ks : 0) * a_i + (size_t)(kt + 2) * a_k);
      __builtin_amdgcn_sched_barrier(0);
#pragma unroll
      for (int j = NJ / 2; j < NJ; ++j)
#pragma unroll
        for (int i = 0; i < NI; ++i) acc[i][j] = MFMA32(f[i], s[j], acc[i][j]);
      *(u32x4*)(st + G_OPER + (srow + 64 * ks) * G_STR + scc * 16) = rb[ks];
      if (more) rb[ks] = *(const u32x4*)(bg + ks * 4096 + ((size_t)(kt + 2) << 14));
      __builtin_amdgcn_sched_barrier(0);
    }
    __syncthreads();
  }

  auto prefetch_next = [&]() {
    if (TM == 256 && pf.has_next) {
      const bf16_t* nag = ablocked ? A + ((size_t)((pf.nm0 >> 8) * 16) << 14) + (pf.nm0 & 255) * 64 + tid * 8 : A + (size_t)(pf.nm0 + srow) * lda + scc * 8;
      const bf16_t* nbg = Bt + ((size_t)(pf.nnt * nkb) << 14) + tid * 8;
#pragma unroll
      for (int i = 0; i < NA; ++i) ra[i] = *(const u32x4*)(nag + i * a_i);
#pragma unroll
      for (int i = 0; i < 4; ++i) rb[i] = *(const u32x4*)(nbg + i * 4096);
      __builtin_amdgcn_sched_barrier(0);
    }
  };
  constexpr int SB = 528;
  constexpr int SV = TM * 2 + 16;
  constexpr int NIT = TM * 32 / NT;
  if (EPI == EPI_OUT) {
    const int bb = m0 < T_LAT ? (m0 >> 13) : 4;
    constexpr int SF = 1040;
    constexpr int JH = NJ / 2;
    constexpr int NITO = (TM / 2) * 64 / NT;
    const float* gate = (const float*)(p.ws + OFF_MOD) + (size_t)(layer * 5 + bb) * 3072 + 2048 + n0;
#pragma unroll
    for (int h = 0; h < 2; ++h) {
#pragma unroll
      for (int jj = 0; jj < JH; ++jj)
#pragma unroll
        for (int i = 0; i < NI; ++i)
#pragma unroll
          for (int g = 0; g < 4; ++g) {
            const int j = h * JH + jj;
            f32x4 v; v[0] = acc[i][j][4 * g]; v[1] = acc[i][j][4 * g + 1]; v[2] = acc[i][j][4 * g + 2]; v[3] = acc[i][j][4 * g + 3];
            *(f32x4*)(lds + ((TM == 256 ? wm * 64 : 0) + jj * 32 + l31) * SF + (fb + i * 32 + 8 * g + 4 * hh) * 4) = v;
          }
      if (h == 1) prefetch_next();
      __syncthreads();
      const f32x4 gt = *(const f32x4*)(gate + (tid & 63) * 4);
#pragma unroll
      for (int i0 = 0; i0 < NITO; i0 += 8) {
        f32x4 oldv[8];
#pragma unroll
        for (int k = 0; k < 8; ++k)
          if (i0 + k < NITO) {
            const int cidx = tid + NT * (i0 + k), row = cidx >> 6, ch = cidx & 63;
            const int tok = m0 + (TM == 256 ? (row >> 6) * 128 + h * 64 + (row & 63) : h * 32 + row);
            oldv[k] = *(const f32x4*)(h_src(p, layer, tok) + n0 + ch * 4);
          }
#pragma unroll
        for (int k = 0; k < 8; ++k)
          if (i0 + k < NITO) {
            const int cidx = tid + NT * (i0 + k), row = cidx >> 6, ch = cidx & 63;
            const int tok = m0 + (TM == 256 ? (row >> 6) * 128 + h * 64 + (row & 63) : h * 32 + row);
            const f32x4 y = *(const f32x4*)(lds + row * SF + ch * 16);
            *(f32x4*)(h_dst(p, tok) + n0 + ch * 4) = oldv[k] + gt * y;
          }
      }
      __syncthreads();
    }
  } else {
    const bool vt = (EPI == EPI_KVB && nt >= 2) || (EPI == EPI_C_IN && nt >= 8 && nt < 12);
#pragma unroll
    for (int j = 0; j < NJ; ++j) {
      const int rl = tb + j * 32 + l31;
      float rs = 1.f;
      if (EPI == EPI_QB || EPI == EPI_KVB) rs = rstd[rl];
#pragma unroll
      for (int i = 0; i < NI; ++i)
#pragma unroll
        for (int g = 0; g < 4; ++g) {
          const int fl = fb + i * 32 + 8 * g + 4 * hh;
          float v0 = acc[i][j][4 * g], v1 = acc[i][j][4 * g + 1], v2 = acc[i][j][4 * g + 2], v3 = acc[i][j][4 * g + 3];
          epi_math<EPI>(p, m0 + rl, n0 + fl, v0, v1, v2, v3, rs);
          const unsigned w01 = pack_bf16(v0, v1), w23 = pack_bf16(v2, v3);
          if (!vt) {
            u32x2 wv; wv.x = w01; wv.y = w23;
            *(u32x2*)(lds + rl * SB + fl * 2) = wv;
          } else {
            *(bf16_t*)(lds + (fl + 0) * SV + rl * 2) = (bf16_t)(w01 & 0xffffu);
            *(bf16_t*)(lds + (fl + 1) * SV + rl * 2) = (bf16_t)(w01 >> 16);
            *(bf16_t*)(lds + (fl + 2) * SV + rl * 2) = (bf16_t)(w23 & 0xffffu);
            *(bf16_t*)(lds + (fl + 3) * SV + rl * 2) = (bf16_t)(w23 >> 16);
          }
        }
    }
    prefetch_next();
    __syncthreads();
#pragma unroll 4
    for (int it = 0; it < NIT; ++it) {
      const int cidx = tid + NT * it;
      if (vt) {
        const int row = cidx / (TM / 8), ch = cidx % (TM / 8);
        *(u32x4*)dst_v<EPI>(p, m0 + ch * 8, n0 + row) = *(const u32x4*)(lds + row * SV + ch * 16);
      } else {
        const int row = cidx >> 5, ch = cidx & 31;
        bf16_t* d = dst_tr<EPI>(p, m0 + row, n0 + ch * 8);
        if (d) *(u32x4*)d = *(const u32x4*)(lds + row * SB + ch * 16);
      }
    }
    __syncthreads();
  }
}

template <int EPI>
DI void gemm_phase(const Params& p, int layer, const bf16_t* A, int lda, const bf16_t* Bt, int K, int mtiles, int ntiles, bool ctx, bool reverse, char* lds,
                   int ctx_nt0 = 0, int ctx_ntn = -1) {
  const int G = ogrid();
  const int bid = reverse ? (G - 1 - obid()) : obid();
  u32x4 ra[4], rb[4];
  const bool simple = (G & 7) != 0;
  const int xcd = bid & 7, local = simple ? bid : (bid >> 3), nlocal = simple ? G : (G >> 3);
  const int mlo = simple ? 0 : ((xcd * mtiles) >> 3), cnt = simple ? mtiles : ((((xcd + 1) * mtiles) >> 3) - mlo);
  const int total = cnt * ntiles, gsize = 4 * ntiles;
  auto tile_of = [&](int j, int& m0, int& nt) {
    const int g = j / gsize, r = j - g * gsize;
    int gm = cnt - g * 4; gm = gm > 4 ? 4 : gm;
    m0 = (mlo + g * 4 + (r % gm)) * 256; nt = r / gm;
  };
  bool pre = false;
  for (int j = local; j < total; j += nlocal) {
    int m0, nt; tile_of(j, m0, nt);
    TilePf pf; pf.pre = pre; pf.has_next = (j + nlocal < total); pf.nm0 = 0; pf.nnt = 0;
    if (pf.has_next) tile_of(j + nlocal, pf.nm0, pf.nnt);
    gemm_tile<EPI, 256>(p, layer, A, lda, Bt, K, m0, nt, lds, ra, rb, pf);
    pre = pf.has_next;
  }
  if (ctx) {
    const int b2 = G - 1 - bid;
    u32x4 ra1[1];
    TilePf pf; pf.pre = false; pf.has_next = false; pf.nm0 = 0; pf.nnt = 0;
    const int cn = ctx_ntn < 0 ? ntiles : ctx_ntn;
    for (int u = b2; u < 16 * cn; u += G) gemm_tile<EPI, 64>(p, layer, A, lda, Bt, K, T_LAT + (u & 15) * 64, ctx_nt0 + (u >> 4), lds, ra1, rb, pf);
  }
}

DI void vta_phase(const Params& p, char* lds) {
  const int tid = otid();
  const bf16_t* Pb = (const bf16_t*)(p.ws + OFF_P);
  for (int u = ogrid() - 1 - obid(); u < T_ALL / 64; u += ogrid()) {
    const int t0 = u * 64;
#pragma unroll
    for (int it = 0; it < 2; ++it) {
      const int cidx = tid + NT * it, row = cidx >> 4, ch = cidx & 15;
      *(u32x4*)(lds + row * 272 + ch * 16) = *(const u32x4*)(Pb + (size_t)(t0 + row) * 2560 + 640 + ch * 8);
    }
    __syncthreads();
    int b, key; tok_bk(t0, b, key);
#pragma unroll
    for (int it = 0; it < 2; ++it) {
      const int cidx = tid + NT * it, f = cidx & 127, tc = cidx >> 7;
      unsigned short e[8];
#pragma unroll
      for (int k = 0; k < 8; ++k) e[k] = *(const bf16_t*)(lds + (tc * 8 + k) * 272 + f * 2);
      u32x4 v; v.x = e[0] | ((unsigned)e[1] << 16); v.y = e[2] | ((unsigned)e[3] << 16); v.z = e[4] | ((unsigned)e[5] << 16); v.w = e[6] | ((unsigned)e[7] << 16);
      *(u32x4*)((bf16_t*)(p.ws + OFF_VT) + ((size_t)(b * 2 + (f >> 6)) * 64 + (f & 63)) * NKEY + key + tc * 8) = v;
    }
    __syncthreads();
  }
}

template <int MODE>
DI void attn_item(const Params& p, int layer, int b, int qt, int head, bool is_ctx, char* lds) {
  constexpr int DK = (MODE == 1) ? 96 : 64;
  constexpr int NKS = DK / 16;
  constexpr int KSTR = DK * 2 + 16;
  constexpr int VSTR = 144;
  constexpr int KBYTES = 64 * KSTR;
  constexpr int STAGE = KBYTES + 64 * VSTR;
  constexpr int QPB = 256;
  constexpr int NKC = DK / 8;
  constexpr int KCH = 64 * NKC;
  constexpr int OSTR = 272;
  constexpr float MASKV = -1e30f;
  float* rpbs = (float*)(lds + 4 * STAGE);
  char* ostage = lds;

  const int tid = otid(), lane = tid & 63, w = tid >> 6, l31 = lane & 31, hh = lane >> 5;
  const int i2 = layer >> 1;
  const bf16_t* Pb = (const bf16_t*)(p.ws + OFF_P);
  bf16_t* UG = (bf16_t*)(p.ws + OFF_UG);
  const bf16_t *Qp, *Kp, *Krp = nullptr, *Zp, *Vt;
  int ldq, ldk, ldz, gcol;
  if (MODE == 0) {
    Qp = Pb + head * 64; ldq = 2560; Kp = Pb + 512 + (head >> 2) * 64; ldk = 2560;
    Vt = (const bf16_t*)(p.ws + OFF_VT) + (size_t)(b * 2 + (head >> 2)) * 64 * NKEY;
    Zp = Pb + 768 + head * 64; ldz = 2560; gcol = head * 64;
  } else if (MODE == 1) {
    Qp = (const bf16_t*)(p.ws + OFF_QB) + head * 96; ldq = 768; Kp = (const bf16_t*)(p.ws + OFF_KB) + head * 64; ldk = 512; Krp = Pb + 1920;
    Vt = (const bf16_t*)(p.ws + OFF_VTB) + (size_t)(b * 8 + head) * 64 * NKEY;
    Zp = Pb + 1952 + head * 64; ldz = 2560; gcol = 512 + head * 64;
  } else {
    Qp = Pb + head * 64; ldq = 3072; Kp = Pb + 1024 + head * 64; ldk = 3072;
    Vt = (const bf16_t*)(p.ws + OFF_VT) + (size_t)(b * 16 + head) * 64 * NKEY;
    Zp = Pb + 2048 + head * 64; ldz = 3072; gcol = head * 64;
  }
  const int qtok0 = is_ctx ? T_LAT + b * 256 : b * 8192 + qt * QPB;

  int lat_lo = 0, nlat = 0;
  if (!is_ctx) {
    if (MODE == 0) {
      int lo = 4 * qt - 2; if (lo < 0) lo = 0;
      int hi = 4 * qt + 5; if (hi > 127) hi = 127;
      lat_lo = lo; nlat = hi - lo + 1;
    } else if (MODE == 1) { lat_lo = 0; nlat = 128; }
    else {
      int lo = 4 * qt - 4; lo = lo < 0 ? 0 : (lo > 120 ? 120 : lo);
      int hi = 4 * qt + 3 - 4; hi = hi < 0 ? 0 : (hi > 120 ? 120 : hi); hi += 7;
      lat_lo = lo; nlat = hi - lo + 1;
    }
  }
  const int ntiles = nlat + 4;

  const bool nat2 = (MODE == 2) && !is_ctx;
  auto tokmap = [&](int row) { return nat2 ? qtok0 + ((w >> 2) * 2 + (row >> 4)) * 64 + (w & 3) * 16 + (row & 15) : qtok0 + w * 32 + row; };
  const int qtok = tokmap(l31);
  bf16x8 qf[NKS];
#pragma unroll
  for (int ks = 0; ks < NKS; ++ks) qf[ks] = *(const bf16x8*)(Qp + (size_t)qtok * ldq + ks * 16 + hh * 8);
  if (MODE == 2 && !is_ctx) {
    for (int i = tid; i < 465; i += NT) rpbs[i] = p.c_rpb[(size_t)(i2 * 16 + head) * 465 + i] * LOG2E;
  }
  float m_ = (MODE == 0) ? p.a_sink[i2 * 8 + head] * LOG2E : MASKV;
  float l_ = (MODE == 0 && hh == 0) ? 1.f : 0.f;
  f32x16 O[2];
#pragma unroll
  for (int dh = 0; dh < 2; ++dh)
#pragma unroll
    for (int r = 0; r < 16; ++r) O[dh][r] = 0.f;

  const int k0row = tid / NKC, k0cc = tid % NKC;
  const int k1row = (tid + NT) / NKC, k1cc = (tid + NT) % NKC;
  const bool k1 = (KCH > NT) && (tid + NT < KCH);
  struct Stg { u32x4 k0, k1, v; };
  Stg R0, R1;
  R0.k1 = (u32x4){0u, 0u, 0u, 0u}; R1.k1 = R0.k1;
  auto tile_kt = [&](int i) { return i < nlat ? lat_lo + i : 128 + (i - nlat); };
  auto kload = [&](int krow0, int row, int cc) -> u32x4 {
    if (MODE == 1 && cc >= 8) return *(const u32x4*)(Krp + (size_t)(krow0 + row) * 2560 + (cc - 8) * 8);
    return *(const u32x4*)(Kp + (size_t)(krow0 + row) * ldk + cc * 8);
  };
  auto gload = [&](int i, Stg& r) {
    const int kt = tile_kt(i < ntiles ? i : ntiles - 1);
    const int krow0 = kt < 128 ? b * 8192 + kt * 64 : T_LAT + b * 256 + (kt - 128) * 64;
    r.k0 = kload(krow0, k0row, k0cc);
    if (k1) r.k1 = kload(krow0, k1row, k1cc);
    r.v = *(const u32x4*)(Vt + (size_t)(tid >> 3) * NKEY + kt * 64 + (tid & 7) * 8);
  };
  auto lstore = [&](int st, const Stg& r) {
    char* kb = lds + st * STAGE;
    *(u32x4*)(kb + k0row * KSTR + k0cc * 16) = r.k0;
    if (k1) *(u32x4*)(kb + k1row * KSTR + k1cc * 16) = r.k1;
    *(u32x4*)(kb + KBYTES + (tid >> 3) * VSTR + (tid & 7) * 16) = r.v;
  };

  const int pr = (l31 & ~12) | ((l31 & 4) << 1) | ((l31 & 8) >> 1);
  int qr = 0, qc = 0, rs0 = 0, cs = 0, csw = 0, wlo = 0, whi = 0;
  if (MODE == 2) {
    qr = qt * 4 + (w >> 2) * 2 + (l31 >> 4); qc = (w & 3) * 16 + (l31 & 15);
    rs0 = qr - 4; rs0 = rs0 < 0 ? 0 : (rs0 > 120 ? 120 : rs0);
    cs = qc - 8; cs = cs < 0 ? 0 : (cs > 48 ? 48 : cs);
    csw = (w & 3) * 16 - 8; csw = csw < 0 ? 0 : (csw > 32 ? 32 : csw);
    const int r_lo = qt * 4 + (w >> 2) * 2;
    wlo = r_lo - 4; wlo = wlo < 0 ? 0 : (wlo > 120 ? 120 : wlo);
    whi = r_lo + 1 - 4; whi = whi < 0 ? 0 : (whi > 120 ? 120 : whi); whi += 7;
  }
  const int s0w = qt * QPB + w * 32;
  const int nsup = (ntiles + 1) >> 1;
  __syncthreads();
  gload(0, R0); gload(1, R1);
  lstore(0, R0); lstore(1, R1);
  gload(2, R0); gload(3, R1);
  __syncthreads();
  auto body = [&](int it, const char* kb) {
    const char* vb = kb + KBYTES;
    const int kt = tile_kt(it);
    const bool lat_tile = it < nlat;
    bool skip = (it >= ntiles);
    if (MODE == 2 && lat_tile) skip = (kt < wlo) || (kt > whi);
    if (MODE == 0 && lat_tile) skip = (kt * 64 + 63 < s0w - 128) || (kt * 64 > s0w + 31 + 128);
    const int nsub = (MODE == 2 && lat_tile) ? 1 : 2;
    const int krb = (MODE == 2 && lat_tile) ? csw : 0;
    if (!skip) {
      f32x16 S[2];
#pragma unroll
      for (int t = 0; t < 2; ++t)
#pragma unroll
        for (int r = 0; r < 16; ++r) S[t][r] = 0.f;
#pragma unroll
      for (int ks = 0; ks < NKS; ++ks) {
        const bf16x8 a0 = *(const bf16x8*)(kb + (krb + pr) * KSTR + ks * 32 + hh * 16);
        S[0] = MFMA32(a0, qf[ks], S[0]);
        if (nsub == 2) {
          const bf16x8 a1 = *(const bf16x8*)(kb + (32 + pr) * KSTR + ks * 32 + hh * 16);
          S[1] = MFMA32(a1, qf[ks], S[1]);
        }
      }
      if (MODE == 0 && lat_tile) {
        const int s = qt * QPB + w * 32 + l31;
#pragma unroll
        for (int t = 0; t < 2; ++t)
#pragma unroll
          for (int r = 0; r < 16; ++r) {
            const int kk = kt * 64 + t * 32 + 16 * (r >> 3) + 8 * hh + (r & 7);
            const int d = kk - s;
            if (d > 128 || d < -128) S[t][r] = MASKV;
          }
      }
      if (MODE == 2 && lat_tile) {
        int ri = kt - qr + 7; ri = ri < 0 ? 0 : (ri > 14 ? 14 : ri);
        const float* brow = rpbs + ri * 31;
        const bool rok = (kt >= rs0) && (kt <= rs0 + 7);
        float bv[16];
#pragma unroll
        for (int r = 0; r < 16; ++r) {
          const int kc = csw + 16 * (r >> 3) + 8 * hh + (r & 7);
          int bi = kc - qc + 15; bi = bi < 0 ? 0 : (bi > 30 ? 30 : bi);
          bv[r] = brow[bi];
        }
#pragma unroll
        for (int r = 0; r < 16; ++r) asm volatile("" : "+v"(bv[r]));
#pragma unroll
        for (int r = 0; r < 16; ++r) {
          const int kc = csw + 16 * (r >> 3) + 8 * hh + (r & 7);
          const bool ok = rok && (kc >= cs) && (kc < cs + 16);
          S[0][r] = ok ? S[0][r] + bv[r] : MASKV;
        }
      }
      float mx = S[0][0];
#pragma unroll
      for (int r = 0; r < 16; ++r) mx = fmaxf(mx, S[0][r]);
      if (nsub == 2) {
#pragma unroll
        for (int r = 0; r < 16; ++r) mx = fmaxf(mx, S[1][r]);
      }
      mx = pair_max(mx);
      if (__any(mx > m_ + 8.f)) {
        const float mnew = fmaxf(m_, mx);
        const float alpha = fexp2(m_ - mnew);
        m_ = mnew;
        l_ *= alpha;
#pragma unroll
        for (int dh = 0; dh < 2; ++dh)
#pragma unroll
          for (int r = 0; r < 16; ++r) O[dh][r] *= alpha;
      }
      float rsum = 0.f;
#pragma unroll
      for (int t = 0; t < 2; ++t)
        if (t < nsub) {
#pragma unroll
          for (int r = 0; r < 16; ++r) { const float e = fexp2(S[t][r] - m_); S[t][r] = e; rsum += e; }
        }
      l_ += rsum;
#pragma unroll
      for (int t = 0; t < 2; ++t)
       if (t < nsub)
#pragma unroll
        for (int s = 0; s < 2; ++s) {
          u32x4 u;
          u.x = pack_bf16(S[t][8 * s + 0], S[t][8 * s + 1]); u.y = pack_bf16(S[t][8 * s + 2], S[t][8 * s + 3]);
          u.z = pack_bf16(S[t][8 * s + 4], S[t][8 * s + 5]); u.w = pack_bf16(S[t][8 * s + 6], S[t][8 * s + 7]);
          const bf16x8 pf = __builtin_bit_cast(bf16x8, u);
#pragma unroll
          for (int dh = 0; dh < 2; ++dh) {
            const bf16x8 v = *(const bf16x8*)(vb + (dh * 32 + l31) * VSTR + (krb + t * 32 + s * 16 + hh * 8) * 2);
            O[dh] = MFMA32(v, pf, O[dh]);
          }
        }
    }
  };
  for (int j = 0; j < nsup; ++j) {
    const char* sb = lds + (j & 1) * 2 * STAGE;
    body(2 * j, sb);
    body(2 * j + 1, sb + STAGE);
    __builtin_amdgcn_sched_barrier(0);
    {
      const int so = ((j + 1) & 1) * 2;
      lstore(so, R0); lstore(so + 1, R1);
      gload(2 * j + 4, R0); gload(2 * j + 5, R1);
    }
    __syncthreads();
  }

  {
    const float lt = l_ + __shfl_xor(l_, 32);
    const float inv = 1.f / lt;
    char* orow = ostage + (w * 32) * OSTR;
#pragma unroll
    for (int dh = 0; dh < 2; ++dh)
#pragma unroll
      for (int g = 0; g < 4; ++g) {
        f32x4 v; v[0] = O[dh][4 * g] * inv; v[1] = O[dh][4 * g + 1] * inv; v[2] = O[dh][4 * g + 2] * inv; v[3] = O[dh][4 * g + 3] * inv;
        *(f32x4*)(orow + l31 * OSTR + (dh * 32 + 8 * g + 4 * hh) * 4) = v;
      }
    __builtin_amdgcn_s_waitcnt(0xc07f);
#pragma unroll
    for (int it = 0; it < 4; ++it) {
      const int cidx = lane + 64 * it, row = cidx >> 3, ch = cidx & 7;
      const f32x4 o0 = *(const f32x4*)(orow + row * OSTR + ch * 32), o1 = *(const f32x4*)(orow + row * OSTR + ch * 32 + 16);
      const int tok = tokmap(row);
      const u32x4 z = *(const u32x4*)(Zp + (size_t)tok * ldz + ch * 8);
      u32x4 wv;
      wv.x = pack_bf16(o0[0] * silu(bf_lo(z.x)), o0[1] * silu(bf_hi(z.x)));
      wv.y = pack_bf16(o0[2] * silu(bf_lo(z.y)), o0[3] * silu(bf_hi(z.y)));
      wv.z = pack_bf16(o1[0] * silu(bf_lo(z.z)), o1[1] * silu(bf_hi(z.z)));
      wv.w = pack_bf16(o1[2] * silu(bf_lo(z.w)), o1[3] * silu(bf_hi(z.w)));
      *(u32x4*)(UG + ablk(tok, gcol + ch * 8)) = wv;
    }
  }
}

DI void mla_item2(const Params& p, int layer, int b, int qt, int head, char* lds) {
  constexpr int DK = 96, NKS = 6, KSTR = DK * 2 + 16, VSTR = 144, KBYTES = 64 * KSTR, STAGE = KBYTES + 64 * VSTR;
  constexpr int NKC = 12, KCH = 64 * NKC, OSTR = 272, QG = 2, NTILES = 132;
  constexpr float MASKV = -1e30f;
  char* ostage = lds;
  const int tid = otid(), lane = tid & 63, w = tid >> 6, l31 = lane & 31, hh = lane >> 5;
  const bf16_t* Pb = (const bf16_t*)(p.ws + OFF_P);
  bf16_t* UG = (bf16_t*)(p.ws + OFF_UG);
  const bf16_t* Qp = (const bf16_t*)(p.ws + OFF_QB) + head * 96;
  const bf16_t* Kp = (const bf16_t*)(p.ws + OFF_KB) + head * 64;
  const bf16_t* Krp = Pb + 1920;
  const bf16_t* Vt = (const bf16_t*)(p.ws + OFF_VTB) + (size_t)(b * 8 + head) * 64 * NKEY;
  const bf16_t* Zp = Pb + 1952 + head * 64;
  const int gcol = 512 + head * 64;
  const int qtok0 = b * 8192 + qt * 512;
  bf16x8 qf[QG][NKS];
#pragma unroll
  for (int qg = 0; qg < QG; ++qg)
#pragma unroll
    for (int ks = 0; ks < NKS; ++ks) qf[qg][ks] = *(const bf16x8*)(Qp + (size_t)(qtok0 + qg * 256 + w * 32 + l31) * 768 + ks * 16 + hh * 8);
  float m_[QG], l_[QG];
  f32x16 O[QG][2];
#pragma unroll
  for (int qg = 0; qg < QG; ++qg) {
    m_[qg] = MASKV; l_[qg] = 0.f;
#pragma unroll
    for (int dh = 0; dh < 2; ++dh)
#pragma unroll
      for (int r = 0; r < 16; ++r) O[qg][dh][r] = 0.f;
  }
  const int k0row = tid / NKC, k0cc = tid % NKC;
  const int k1row = (tid + NT) / NKC, k1cc = (tid + NT) % NKC;
  const bool k1 = (tid + NT < KCH);
  struct Stg { u32x4 k0, k1, v; };
  Stg R0;
  R0.k1 = (u32x4){0u, 0u, 0u, 0u};
  auto kload = [&](int krow0, int row, int cc) -> u32x4 {
    if (cc >= 8) return *(const u32x4*)(Krp + (size_t)(krow0 + row) * 2560 + (cc - 8) * 8);
    return *(const u32x4*)(Kp + (size_t)(krow0 + row) * 512 + cc * 8);
  };
  auto gload = [&](int i, Stg& r) {
    const int kt = i < NTILES ? i : NTILES - 1;
    const int krow0 = kt < 128 ? b * 8192 + kt * 64 : T_LAT + b * 256 + (kt - 128) * 64;
    r.k0 = kload(krow0, k0row, k0cc);
    if (k1) r.k1 = kload(krow0, k1row, k1cc);
    r.v = *(const u32x4*)(Vt + (size_t)(tid >> 3) * NKEY + kt * 64 + (tid & 7) * 8);
  };
  auto lstore = [&](int st, const Stg& r) {
    char* kb = lds + st * STAGE;
    *(u32x4*)(kb + k0row * KSTR + k0cc * 16) = r.k0;
    if (k1) *(u32x4*)(kb + k1row * KSTR + k1cc * 16) = r.k1;
    *(u32x4*)(kb + KBYTES + (tid >> 3) * VSTR + (tid & 7) * 16) = r.v;
  };
  const int pr = (l31 & ~12) | ((l31 & 4) << 1) | ((l31 & 8) >> 1);
  __syncthreads();
  gload(0, R0); lstore(0, R0);
  gload(1, R0);
  __syncthreads();
  auto body = [&](const char* kb) {
    const char* vb = kb + KBYTES;
    f32x16 S[QG][2];
#pragma unroll
    for (int qg = 0; qg < QG; ++qg)
#pragma unroll
      for (int t = 0; t < 2; ++t)
#pragma unroll
        for (int r = 0; r < 16; ++r) S[qg][t][r] = 0.f;
#pragma unroll
    for (int ks = 0; ks < NKS; ++ks) {
      const bf16x8 a0 = *(const bf16x8*)(kb + pr * KSTR + ks * 32 + hh * 16);
      const bf16x8 a1 = *(const bf16x8*)(kb + (32 + pr) * KSTR + ks * 32 + hh * 16);
#pragma unroll
      for (int qg = 0; qg < QG; ++qg) { S[qg][0] = MFMA32(a0, qf[qg][ks], S[qg][0]); S[qg][1] = MFMA32(a1, qf[qg][ks], S[qg][1]); }
    }
#pragma unroll
    for (int qg = 0; qg < QG; ++qg) {
      float mx = S[qg][0][0];
#pragma unroll
      for (int t = 0; t < 2; ++t)
#pragma unroll
        for (int r = 0; r < 16; ++r) mx = fmaxf(mx, S[qg][t][r]);
      mx = pair_max(mx);
      if (__any(mx > m_[qg] + 8.f)) {
        const float mnew = fmaxf(m_[qg], mx);
        const float alpha = fexp2(m_[qg] - mnew);
        m_[qg] = mnew;
        l_[qg] *= alpha;
#pragma unroll
        for (int dh = 0; dh < 2; ++dh)
#pragma unroll
          for (int r = 0; r < 16; ++r) O[qg][dh][r] *= alpha;
      }
      float rsum = 0.f;
#pragma unroll
      for (int t = 0; t < 2; ++t)
#pragma unroll
        for (int r = 0; r < 16; ++r) { const float e = fexp2(S[qg][t][r] - m_[qg]); S[qg][t][r] = e; rsum += e; }
      l_[qg] += rsum;
    }
#pragma unroll
    for (int t = 0; t < 2; ++t)
#pragma unroll
      for (int s = 0; s < 2; ++s) {
        bf16x8 pf[QG];
#pragma unroll
        for (int qg = 0; qg < QG; ++qg) {
          u32x4 u;
          u.x = pack_bf16(S[qg][t][8 * s + 0], S[qg][t][8 * s + 1]); u.y = pack_bf16(S[qg][t][8 * s + 2], S[qg][t][8 * s + 3]);
          u.z = pack_bf16(S[qg][t][8 * s + 4], S[qg][t][8 * s + 5]); u.w = pack_bf16(S[qg][t][8 * s + 6], S[qg][t][8 * s + 7]);
          pf[qg] = __builtin_bit_cast(bf16x8, u);
        }
#pragma unroll
        for (int dh = 0; dh < 2; ++dh) {
          const bf16x8 v = *(const bf16x8*)(vb + (dh * 32 + l31) * VSTR + (t * 32 + s * 16 + hh * 8) * 2);
#pragma unroll
          for (int qg = 0; qg < QG; ++qg) O[qg][dh] = MFMA32(v, pf[qg], O[qg][dh]);
        }
      }
  };
  if (w >= 4) __builtin_amdgcn_s_setprio(2);
  for (int j = 0; j < NTILES; ++j) {
    body(lds + (j & 1) * STAGE);
    __builtin_amdgcn_sched_barrier(0);
    lstore((j + 1) & 1, R0);
    gload(j + 2, R0);
    __syncthreads();
  }
  __builtin_amdgcn_s_setprio(0);
#pragma unroll
  for (int qg = 0; qg < QG; ++qg) {
    const float lt = l_[qg] + __shfl_xor(l_[qg], 32);
    const float inv = 1.f / lt;
    char* orow = ostage + (w * 32) * OSTR;
#pragma unroll
    for (int dh = 0; dh < 2; ++dh)
#pragma unroll
      for (int g = 0; g < 4; ++g) {
        f32x4 v; v[0] = O[qg][dh][4 * g] * inv; v[1] = O[qg][dh][4 * g + 1] * inv; v[2] = O[qg][dh][4 * g + 2] * inv; v[3] = O[qg][dh][4 * g + 3] * inv;
        *(f32x4*)(orow + l31 * OSTR + (dh * 32 + 8 * g + 4 * hh) * 4) = v;
      }
    __builtin_amdgcn_s_waitcnt(0xc07f);
#pragma unroll
    for (int it = 0; it < 4; ++it) {
      const int cidx = lane + 64 * it, row = cidx >> 3, ch = cidx & 7;
      const f32x4 o0 = *(const f32x4*)(orow + row * OSTR + ch * 32), o1 = *(const f32x4*)(orow + row * OSTR + ch * 32 + 16);
      const int tok = qtok0 + qg * 256 + w * 32 + row;
      const u32x4 z = *(const u32x4*)(Zp + (size_t)tok * 2560 + ch * 8);
      u32x4 wv;
      wv.x = pack_bf16(o0[0] * silu(bf_lo(z.x)), o0[1] * silu(bf_hi(z.x)));
      wv.y = pack_bf16(o0[2] * silu(bf_lo(z.y)), o0[3] * silu(bf_hi(z.y)));
      wv.z = pack_bf16(o1[0] * silu(bf_lo(z.z)), o1[1] * silu(bf_hi(z.z)));
      wv.w = pack_bf16(o1[2] * silu(bf_lo(z.w)), o1[3] * silu(bf_hi(z.w)));
      *(u32x4*)(UG + ablk(tok, gcol + ch * 8)) = wv;
    }
    __builtin_amdgcn_s_waitcnt(0xc07f);
  }
}

DI void attn_phase_ab(const Params& p, int layer, char* lds) {
  const int G = ogrid();
  for (int v = obid(); v < 512; v += G) {
    const int xcd = v & 7, s = v >> 3;
    const int grp = (s >> 4) * 8 + xcd, qt = s & 15;
    mla_item2(p, layer, grp >> 3, qt, grp & 7, lds);
  }
  for (int v = obid(); v < 32; v += G) attn_item<1>(p, layer, v >> 3, 0, v & 7, true, lds);
  for (int v = obid(); v < 1024; v += G) {
    attn_item<0>(p, layer, v >> 8, v & 31, (v >> 5) & 7, false, lds);
  }
  for (int v = obid() - 32; v < 32; v += G) if (v >= 0) attn_item<0>(p, layer, v >> 3, 0, v & 7, true, lds);
}

DI void attn_phase_c(const Params& p, int layer, char* lds) {
  const int G = ogrid();
  const int nctx = (layer == 3) ? 0 : 64;
  for (int v = obid(); v < 2048 + nctx; v += G) {
    if (v < 2048) attn_item<2>(p, layer, v >> 9, v & 31, (v >> 5) & 15, false, lds);
    else { const int c = v - 2048; attn_item<2>(p, layer, c >> 4, 0, c & 15, true, lds); }
  }
}

__global__ void __launch_bounds__(512, 2) fwd_megakernel(Params p) {
  __shared__ __attribute__((aligned(16))) char lds[LDS_BYTES];
  __shared__ uint4 xb_words;
  if (threadIdx.x == 0) xb_words = make_uint4(0u, 0u, 0u, 0u);
  __syncthreads();
  if (obid() == 0) { unsigned* bw = (unsigned*)(p.ws + OFF_BAR); for (int i = otid(); i < 4096; i += NT) bw[i] = 0u; }
  XcdBarrier xb; xb.bar = (unsigned*)(p.ws + OFF_BAR); xb.x = 0; xb.st = (volatile LAS unsigned*)&xb_words;
  bool first = true, posted = false;
  for (int ph = p.ph_begin; ph < p.ph_end; ++ph) {
    const int layer = (ph - 1) / 5, s = (ph - 1) % 5;
    const bool even = (layer & 1) == 0;
    const int i2 = layer >> 1;
    if (ph >= 1 && ph <= 20 && s == 2 && !even) continue;
    if (!first) {
      if (!posted) { cg::this_grid().sync(); xb = xcd_barrier_post((unsigned*)(p.ws + OFF_BAR), (volatile LAS unsigned*)&xb_words); posted = true; }
      else xcd_barrier(xb);
    }
    first = false;
    if (ph == 0) prologue_phase(p, lds);
    else if (ph == 21) final_phase(p);
    else if (s == 0) norm_phase(p, layer);
    else if (s == 1) {
      const bf16_t* U = (const bf16_t*)(p.ws + OFF_UG);
      if (even) gemm_phase<EPI_AB_IN>(p, layer, U, 0, (const bf16_t*)(p.ws + OFF_W_IN) + (size_t)i2 * 2560 * 1024, 1024, 128, 10, true, false, lds);
      else if (layer == 3)
        gemm_phase<EPI_C_IN>(p, layer, U, 0, (const bf16_t*)(p.ws + OFF_W_CIN) + (size_t)i2 * 4096 * 1024, 1024, 128, 16, true, false, lds, 4, 8);
      else gemm_phase<EPI_C_IN>(p, layer, U, 0, (const bf16_t*)(p.ws + OFF_W_CIN) + (size_t)i2 * 4096 * 1024, 1024, 128, 16, true, false, lds);
    } else if (s == 2) {
      const bf16_t* Pb = (const bf16_t*)(p.ws + OFF_P);
      gemm_phase<EPI_QB>(p, layer, Pb + 1280, 2560, (const bf16_t*)(p.ws + OFF_W_UQ) + (size_t)i2 * 768 * 384, 384, 128, 3, true, false, lds);
      gemm_phase<EPI_KVB>(p, layer, Pb + 1664, 2560, (const bf16_t*)(p.ws + OFF_W_UKV) + (size_t)i2 * 1024 * 256, 256, 128, 4, true, true, lds);
      vta_phase(p, lds);
    } else if (s == 3) {
      if (even) attn_phase_ab(p, layer, lds); else attn_phase_c(p, layer, lds);
    } else {
      const bf16_t* Gm = (const bf16_t*)(p.ws + OFF_UG);
      const bf16_t* W = even ? (const bf16_t*)(p.ws + OFF_W_OUT) + (size_t)i2 * 1024 * 1024 : (const bf16_t*)(p.ws + OFF_W_COUT) + (size_t)i2 * 1024 * 1024;
      gemm_phase<EPI_OUT>(p, layer, Gm, 0, W, 1024, 128, 4, layer != 3, false, lds);
    }
  }
}

extern "C" void kernel_launch(void* const* d_in, const int* in_sizes, int n_in, void* d_out, int out_size, void* d_ws, size_t ws_size,
                              hipStream_t stream) {
  static int grid_blocks = 0;
  if (!grid_blocks) {
    int dev = 0, cus = 0, per_cu = 0;
    hipGetDevice(&dev);
    hipDeviceGetAttribute(&cus, hipDeviceAttributeMultiprocessorCount, dev);
    hipOccupancyMaxActiveBlocksPerMultiprocessor(&per_cu, fwd_megakernel, NT, 0);
    per_cu = 1;
    grid_blocks = cus * per_cu;
    if (ws_size < OFF_END) fprintf(stderr, "kernel_launch: workspace too small: %zu < %zu\n", ws_size, (size_t)OFF_END);
  }
  Params p{};
  const float** f = (const float**)&p;
  for (int i = 0; i < 18; ++i) f[i] = (const float*)d_in[i];
  p.out = (float*)d_out;
  p.ws = (char*)d_ws;
#if MK_MULTI_LAUNCH
  for (int ph = 0; ph < 22; ++ph) {
    if (ph >= 1 && ph <= 20 && ((ph - 1) % 5) == 2 && (((ph - 1) / 5) & 1)) continue;
    p.ph_begin = ph; p.ph_end = ph + 1;
    hipLaunchKernelGGL(fwd_megakernel, dim3(grid_blocks), dim3(NT), 0, stream, p);
  }
#else
  p.ph_begin = 0; p.ph_end = 22;
  void* args[] = {&p};
  hipError_t e = hipLaunchCooperativeKernel((void*)fwd_megakernel, dim3(grid_blocks), dim3(NT), args, 0, stream);
  if (e != hipSuccess) fprintf(stderr, "cooperative launch failed: %s (grid %d)\n", hipGetErrorString(e), grid_blocks);
#endif
}
```

```cpp
#include <hip/hip_runtime.h>
#include <hip/hip_cooperative_groups.h>
#include <stdint.h>
#include <stdio.h>
namespace cg = cooperative_groups;

#ifndef MK_MULTI_LAUNCH
#define MK_MULTI_LAUNCH 0
#endif

typedef unsigned short bf16_t;
typedef short bf16x8 __attribute__((ext_vector_type(8)));
typedef float f32x16 __attribute__((ext_vector_type(16)));
typedef float f32x4 __attribute__((ext_vector_type(4)));
typedef float f32x2 __attribute__((ext_vector_type(2)));
typedef unsigned u32x4 __attribute__((ext_vector_type(4)));
typedef unsigned u32x2 __attribute__((ext_vector_type(2)));

#define DI __device__ __forceinline__
#define MFMA32(a, b, c) __builtin_amdgcn_mfma_f32_32x32x16_bf16((a), (b), (c), 0, 0, 0)

constexpr int T_LAT = 32768, T_ALL = 33792, NKEY = 8448, NT = 512;
constexpr float LOG2E = 1.4426950408889634f;
constexpr float QSCALE_A = 0.125f * LOG2E;
constexpr float QSCALE_B = 0.10206207261596575f * LOG2E;

constexpr size_t OFF_HC   = 0;
constexpr size_t OFF_UG   = OFF_HC + 1024ull * 1024 * 4;
constexpr size_t OFF_P    = OFF_UG + (size_t)T_ALL * 1024 * 2;
constexpr size_t OFF_QB   = OFF_P + (size_t)T_ALL * 2560 * 2;
constexpr size_t OFF_KB   = OFF_QB + (size_t)T_ALL * 768 * 2;
constexpr size_t OFF_VT   = OFF_KB + (size_t)T_ALL * 512 * 2;
constexpr size_t OFF_VTB  = OFF_VT + 4ull * 2 * 64 * NKEY * 2;
constexpr size_t OFF_W    = OFF_VT + 4ull * 16 * 64 * NKEY * 2;
constexpr size_t OFF_W_IN   = OFF_W;
constexpr size_t OFF_W_OUT  = OFF_W_IN + 2ull * 2560 * 1024 * 2;
constexpr size_t OFF_W_UQ   = OFF_W_OUT + 2ull * 1024 * 1024 * 2;
constexpr size_t OFF_W_UKV  = OFF_W_UQ + 2ull * 768 * 384 * 2;
constexpr size_t OFF_W_CIN  = OFF_W_UKV + 2ull * 1024 * 256 * 2;
constexpr size_t OFF_W_COUT = OFF_W_CIN + 2ull * 4096 * 1024 * 2;
constexpr size_t OFF_MOD    = OFF_W_COUT + 2ull * 1024 * 1024 * 2;
constexpr size_t OFF_ROPE   = OFF_MOD + 4ull * 5 * 3072 * 4;
constexpr size_t OFF_BAR    = OFF_ROPE + 2ull * 8192 * 32 * 4 + 2ull * 8192 * 16 * 4;
constexpr size_t OFF_END    = OFF_BAR + 16384;

struct Params {
  const float *x, *c, *ctx, *c_ctx, *ada_w, *ada_b, *norm_g, *ab_in_w, *ab_out_w, *a_sink, *b_qn_g, *b_w_uq, *b_kvn_g, *b_w_ukv,
      *c_in_w, *c_out_w, *c_rpb, *final_g;
  float* out;
  char* ws;
  int ph_begin, ph_end;
};

DI int otid() { int t = threadIdx.x; asm volatile("" : "+v"(t)); return t; }
DI int obid() { int t = blockIdx.x; asm volatile("" : "+s"(t)); return t; }
DI int ogrid() { int t = gridDim.x; asm volatile("" : "+s"(t)); return t; }
DI unsigned pack_bf16(float lo, float hi) { unsigned r; asm("v_cvt_pk_bf16_f32 %0, %1, %2" : "=v"(r) : "v"(lo), "v"(hi)); return r; }
DI float bf_lo(unsigned u) { return __uint_as_float(u << 16); }
DI float bf_hi(unsigned u) { return __uint_as_float(u & 0xffff0000u); }
DI float fexp2(float x) { return __builtin_amdgcn_exp2f(x); }
DI float pair_max(float x) {
  const unsigned u = __float_as_uint(x);
  const auto r = __builtin_amdgcn_permlane32_swap(u, u, false, false);
  return fmaxf(__uint_as_float(r[0]), __uint_as_float(r[1]));
}
DI float silu(float z) { return z * __builtin_amdgcn_rcpf(1.f + __expf(-z)); }

DI size_t ablk(int tok, int k) { return ((size_t)((tok >> 8) * 16 + (k >> 6)) << 14) + ((tok & 255) << 6) + (k & 63); }
DI void tok_bk(int tok, int& b, int& key) {
  if (tok < T_LAT) { b = tok >> 13; key = tok & 8191; } else { int r = tok - T_LAT; b = r >> 8; key = 8192 + (r & 255); }
}
DI const float* h_src(const Params& p, int layer, int tok) {
  if (layer == 0) return tok < T_LAT ? p.x + (size_t)tok * 1024 : p.ctx + (size_t)(tok - T_LAT) * 1024;
  return tok < T_LAT ? p.out + (size_t)tok * 1024 : (const float*)(p.ws + OFF_HC) + (size_t)(tok - T_LAT) * 1024;
}
DI float* h_dst(const Params& p, int tok) {
  return tok < T_LAT ? p.out + (size_t)tok * 1024 : (float*)(p.ws + OFF_HC) + (size_t)(tok - T_LAT) * 1024;
}

#define XB_TMO      128
#define XB_XCNT(j)  (256  + 64 * (j))
#define XB_XSUB(j)  (1280 + 64 * (j))
#define XB_XGEN(j)  (2304 + 64 * (j))
#define XB_TOP      3328
#define XB_TOPGEN   3392
#define XCD_BAR_WORDS 3456
#define XB_SPIN_CAP (1u << 22)
#define LAS __attribute__((address_space(3)))
DI unsigned xb_ld(unsigned* p) { return __hip_atomic_load(p, __ATOMIC_RELAXED, __HIP_MEMORY_SCOPE_AGENT); }
DI unsigned xb_add(unsigned* p, unsigned v) { return __hip_atomic_fetch_add(p, v, __ATOMIC_RELAXED, __HIP_MEMORY_SCOPE_AGENT); }
DI unsigned xb_xcc_id() { return (unsigned)__builtin_amdgcn_s_getreg((3 << 11) | 20) & 0xFu; }
#define XB_SPIN(cond, bar) do { unsigned _sp = 0; while (cond) { __builtin_amdgcn_s_sleep(1); \
    if ((++_sp & 255u) == 0u) { if (xb_ld(&(bar)[XB_TMO])) break; if (_sp > XB_SPIN_CAP) { atomicAdd(&(bar)[XB_TMO], 1u); break; } } } } while (0)
struct XcdBarrier { unsigned* bar; unsigned x; volatile LAS unsigned* st; };
DI XcdBarrier xcd_barrier_post(unsigned* bar, volatile LAS unsigned* st) {
  XcdBarrier b; b.bar = bar; b.x = xb_xcc_id(); b.st = st;
  if (threadIdx.x == 0) (void)xb_add(&bar[XB_XCNT(b.x)], 1u);
  return b;
}
DI void xcd_barrier_complete(unsigned* bar, unsigned x, unsigned& nloc, unsigned& nx) {
  const unsigned G = gridDim.x * gridDim.y * gridDim.z;
  unsigned sum, cnt, mine, sp = 0u;
  for (;;) {
    sum = 0u; cnt = 0u; mine = 0u;
#pragma unroll
    for (unsigned j = 0; j < 16; ++j) { const unsigned c = xb_ld(&bar[XB_XCNT(j)]); sum += c; cnt += (c > 0u) ? 1u : 0u; mine = (j == x) ? c : mine; }
    if (sum == G) break;
    __builtin_amdgcn_s_sleep(1);
    if ((++sp & 255u) == 0u) { if (xb_ld(&bar[XB_TMO])) break; if (sp > XB_SPIN_CAP) { atomicAdd(&bar[XB_TMO], 1u); break; } }
  }
  nloc = mine > 0u ? mine : 1u; nx = cnt > 0u ? cnt : 1u;
}
DI void xcd_barrier(const XcdBarrier& b) {
  asm volatile("s_waitcnt vmcnt(0)" ::: "memory");
  __syncthreads();
  if (threadIdx.x == 0) {
    unsigned* bar = b.bar;
    __builtin_amdgcn_s_waitcnt(0);
    unsigned nloc = b.st[0], nx = b.st[1];
    if (nloc == 0u) { xcd_barrier_complete(bar, b.x, nloc, nx); b.st[0] = nloc; b.st[1] = nx; }
    const unsigned old = xb_add(&bar[XB_XSUB(b.x)], 1u);
    const unsigned gen = old / nloc;
    if (old + 1u == (gen + 1u) * nloc) {
      __builtin_amdgcn_fence(__ATOMIC_RELEASE, "agent");
      asm volatile("s_waitcnt vmcnt(0)" ::: "memory");
      const unsigned og = xb_add(&bar[XB_TOP], 1u);
      const unsigned tg = og / nx;
      if (og + 1u == (tg + 1u) * nx) xb_add(&bar[XB_TOPGEN], 1u);
      else XB_SPIN(xb_ld(&bar[XB_TOPGEN]) == tg, bar);
      __builtin_amdgcn_fence(__ATOMIC_ACQUIRE, "agent");
      xb_add(&bar[XB_XGEN(b.x)], 1u);
      asm volatile("s_waitcnt vmcnt(0)" ::: "memory");
    } else {
      XB_SPIN(xb_ld(&bar[XB_XGEN(b.x)]) == gen, bar);
      __builtin_amdgcn_fence(__ATOMIC_ACQUIRE, "agent");
      asm volatile("s_waitcnt vmcnt(0)" ::: "memory");
    }
  }
  __syncthreads();
}

struct TJob { const float* src; const float* rs; bf16_t* dst; int K, N, tk, tn, perm; };
DI TJob tr_job(const Params& p, int t) {
  TJob j; j.rs = nullptr; j.perm = 0;
  const int i2 = t / 2312; t -= i2 * 2312;
  if (t < 640) { j.src = p.ab_in_w + (size_t)i2 * 1024 * 2464; j.K = 1024; j.N = 2464; j.dst = (bf16_t*)(p.ws + OFF_W_IN) + (size_t)i2 * 2560 * 1024; j.tk = t / 40; j.tn = t % 40; }
  else if ((t -= 640) < 256) { j.src = p.ab_out_w + (size_t)i2 * 1024 * 1024; j.K = 1024; j.N = 1024; j.dst = (bf16_t*)(p.ws + OFF_W_OUT) + (size_t)i2 * 1024 * 1024; j.tk = t / 16; j.tn = t % 16; }
  else if ((t -= 256) < 72) { j.src = p.b_w_uq + (size_t)i2 * 384 * 768; j.K = 384; j.N = 768; j.dst = (bf16_t*)(p.ws + OFF_W_UQ) + (size_t)i2 * 768 * 384; j.rs = p.b_qn_g + i2 * 384; j.tk = t / 12; j.tn = t % 12; }
  else if ((t -= 72) < 64) { j.src = p.b_w_ukv + (size_t)i2 * 256 * 1024; j.K = 256; j.N = 1024; j.dst = (bf16_t*)(p.ws + OFF_W_UKV) + (size_t)i2 * 1024 * 256; j.rs = p.b_kvn_g + i2 * 256; j.tk = t / 16; j.tn = t % 16; j.perm = 1; }
  else if ((t -= 64) < 1024) { j.src = p.c_in_w + (size_t)i2 * 1024 * 4096; j.K = 1024; j.N = 4096; j.dst = (bf16_t*)(p.ws + OFF_W_CIN) + (size_t)i2 * 4096 * 1024; j.tk = t / 64; j.tn = t % 64; }
  else { t -= 1024; j.src = p.c_out_w + (size_t)i2 * 1024 * 1024; j.K = 1024; j.N = 1024; j.dst = (bf16_t*)(p.ws + OFF_W_COUT) + (size_t)i2 * 1024 * 1024; j.tk = t / 16; j.tn = t % 16; }
  return j;
}
DI void tr_load(const TJob& j, int tid, float (&v)[8]) {
#pragma unroll
  for (int i = 0; i < 8; ++i) {
    const int kk = (tid >> 6) + 8 * i, n = j.tn * 64 + (tid & 63);
    float x = (n < j.N) ? j.src[(size_t)(j.tk * 64 + kk) * j.N + n] : 0.f;
    if (j.rs) x *= j.rs[j.tk * 64 + kk];
    v[i] = x;
  }
}

DI void prologue_phase(const Params& p, char* lds) {
  const int tid = otid();
  constexpr int N_MOD = 192, N_TR = 4624, N_ROPE = 768;
  for (int u = obid(); u < N_MOD + N_TR + N_ROPE; u += ogrid()) {
    if (u < N_MOD) {
      const int layer = u / 48, cb = u % 48;
      float* sl = (float*)lds;
      for (int i = tid; i < 5120; i += NT) {
        const int bb = i >> 10, k = i & 1023;
        const float cv = bb < 4 ? p.c[bb * 1024 + k] : p.c_ctx[k];
        sl[i] = silu(cv);
      }
      __syncthreads();
      const int col = cb * 64 + (tid & 63), kg = tid >> 6;
      float a0 = 0, a1 = 0, a2 = 0, a3 = 0, a4 = 0;
      const float* wp = p.ada_w + (size_t)layer * 1024 * 3072 + col;
#pragma unroll 32
      for (int k = kg * 128; k < kg * 128 + 128; ++k) {
        const float wv = wp[(size_t)k * 3072];
        a0 += sl[k] * wv; a1 += sl[1024 + k] * wv; a2 += sl[2048 + k] * wv; a3 += sl[3072 + k] * wv; a4 += sl[4096 + k] * wv;
      }
      float* red = (float*)(lds + 20480);
      red[(kg * 5 + 0) * 64 + (tid & 63)] = a0; red[(kg * 5 + 1) * 64 + (tid & 63)] = a1; red[(kg * 5 + 2) * 64 + (tid & 63)] = a2;
      red[(kg * 5 + 3) * 64 + (tid & 63)] = a3; red[(kg * 5 + 4) * 64 + (tid & 63)] = a4;
      __syncthreads();
      if (tid < 64) {
        float* mod = (float*)(p.ws + OFF_MOD);
        const float bias = p.ada_b[layer * 3072 + col];
#pragma unroll
        for (int bb = 0; bb < 5; ++bb) {
          float s = bias;
#pragma unroll
          for (int g = 0; g < 8; ++g) s += red[(g * 5 + bb) * 64 + tid];
          mod[(size_t)(layer * 5 + bb) * 3072 + col] = s;
        }
      }
      __syncthreads();
    } else if (u < N_MOD + N_TR) {
    } else {
      const int idx = (u - N_MOD - N_TR) * NT + tid;
      float* ropeA = (float*)(p.ws + OFF_ROPE);
      float* ropeB = ropeA + 2 * 8192 * 32;
      if (idx < 8192 * 32) {
        const int pos = idx >> 5, pr = idx & 31;
        const float pv = pr < 16 ? (float)(pos >> 6) : (float)(pos & 63);
        const float inv = exp2f(-(float)(pr & 15) * (13.287712379549449f / 16.f));
        const float ang = pv * inv;
        ropeA[idx] = cosf(ang); ropeA[8192 * 32 + idx] = sinf(ang);
      } else {
        const int j = idx - 8192 * 32;
        const int pos = j >> 4, pr = j & 15;
        const float pv = pr < 8 ? (float)(pos >> 6) : (float)(pos & 63);
        const float inv = exp2f(-(float)(pr & 7) * (13.287712379549449f / 8.f));
        const float ang = pv * inv;
        ropeB[j] = cosf(ang); ropeB[8192 * 16 + j] = sinf(ang);
      }
    }
  }
  {
    const int G = ogrid();
    int t = obid();
    float v[8], nv[8];
    TJob cur, nxt;
    if (t < N_TR) { cur = tr_job(p, t); tr_load(cur, tid, v); }
    int buf = 0;
    for (; t < N_TR; t += G) {
      const bool more = t + G < N_TR;
      if (more) { nxt = tr_job(p, t + G); tr_load(nxt, tid, nv); }
      float* tile = (float*)(lds + buf * 16640);
#pragma unroll
      for (int i = 0; i < 8; ++i) tile[((tid >> 6) + 8 * i) * 65 + (tid & 63)] = v[i];
      __syncthreads();
      {
        const int nn = tid & 63, k8 = (tid >> 6) * 8;
        int n = cur.tn * 64 + nn;
        if (cur.perm) n = ((n & 64) ? 512 : 0) + (n >> 7) * 64 + (n & 63);
        u32x4 w;
        w.x = pack_bf16(tile[(k8 + 0) * 65 + nn], tile[(k8 + 1) * 65 + nn]); w.y = pack_bf16(tile[(k8 + 2) * 65 + nn], tile[(k8 + 3) * 65 + nn]);
        w.z = pack_bf16(tile[(k8 + 4) * 65 + nn], tile[(k8 + 5) * 65 + nn]); w.w = pack_bf16(tile[(k8 + 6) * 65 + nn], tile[(k8 + 7) * 65 + nn]);
        *(u32x4*)(cur.dst + ((size_t)((n >> 8) * (cur.K >> 6) + cur.tk) << 14) + ((n & 255) << 6) + k8) = w;
      }
      buf ^= 1;
      if (more) {
        cur = nxt;
#pragma unroll
        for (int i = 0; i < 8; ++i) v[i] = nv[i];
      }
    }
    __syncthreads();
  }
}

DI float wave_sum(float v) {
#pragma unroll
  for (int o = 32; o >= 1; o >>= 1) v += __shfl_xor(v, o);
  return v;
}

DI void norm_phase(const Params& p, int layer) {
  const int lane = otid() & 63;
  const int wave = obid() * 8 + (otid() >> 6), nw = ogrid() * 8;
  const float* g = p.norm_g + layer * 1024;
  const float* mod = (const float*)(p.ws + OFF_MOD) + (size_t)layer * 5 * 3072;
  bf16_t* U = (bf16_t*)(p.ws + OFF_UG);
  f32x4 gv[4];
#pragma unroll
  for (int i = 0; i < 4; ++i) gv[i] = *(const f32x4*)(g + lane * 4 + 256 * i);
  f32x4 nv[4];
  if (wave < T_ALL) {
    const float* s0 = h_src(p, layer, wave);
#pragma unroll
    for (int i = 0; i < 4; ++i) nv[i] = *(const f32x4*)(s0 + lane * 4 + 256 * i);
  }
  for (int row = wave; row < T_ALL; row += nw) {
    const int bb = row < T_LAT ? (row >> 13) : 4;
    f32x4 v[4];
#pragma unroll
    for (int i = 0; i < 4; ++i) v[i] = nv[i];
    if (row + nw < T_ALL) {
      const float* s1 = h_src(p, layer, row + nw);
#pragma unroll
      for (int i = 0; i < 4; ++i) nv[i] = *(const f32x4*)(s1 + lane * 4 + 256 * i);
    }
    float ss = 0.f;
#pragma unroll
    for (int i = 0; i < 4; ++i) ss += v[i][0] * v[i][0] + v[i][1] * v[i][1] + v[i][2] * v[i][2] + v[i][3] * v[i][3];
    ss = wave_sum(ss);
    const float rstd = rsqrtf(ss * (1.f / 1024.f) + 1e-6f);
    const float* mrow = mod + bb * 3072;
#pragma unroll
    for (int i = 0; i < 4; ++i) {
      const int cidx = lane * 4 + 256 * i;
      const f32x4 sh = *(const f32x4*)(mrow + cidx), sc = *(const f32x4*)(mrow + 1024 + cidx);
      f32x4 o = (v[i] * rstd) * gv[i] * (sc + 1.f) + sh;
      u32x2 w; w.x = pack_bf16(o[0], o[1]); w.y = pack_bf16(o[2], o[3]);
      *(u32x2*)(U + ablk(row, cidx)) = w;
    }
  }
}

DI void final_phase(const Params& p) {
  const int lane = otid() & 63;
  const int wave = obid() * 8 + (otid() >> 6), nw = ogrid() * 8;
  f32x4 gv[4];
#pragma unroll
  for (int i = 0; i < 4; ++i) gv[i] = *(const f32x4*)(p.final_g + lane * 4 + 256 * i);
  f32x4 nv[4];
  if (wave < T_LAT) {
#pragma unroll
    for (int i = 0; i < 4; ++i) nv[i] = *(const f32x4*)(p.out + (size_t)wave * 1024 + lane * 4 + 256 * i);
  }
  for (int row = wave; row < T_LAT; row += nw) {
    float* src = p.out + (size_t)row * 1024;
    f32x4 v[4];
#pragma unroll
    for (int i = 0; i < 4; ++i) v[i] = nv[i];
    if (row + nw < T_LAT) {
#pragma unroll
      for (int i = 0; i < 4; ++i) nv[i] = *(const f32x4*)(p.out + (size_t)(row + nw) * 1024 + lane * 4 + 256 * i);
    }
    float ss = 0.f;
#pragma unroll
    for (int i = 0; i < 4; ++i) ss += v[i][0] * v[i][0] + v[i][1] * v[i][1] + v[i][2] * v[i][2] + v[i][3] * v[i][3];
    ss = wave_sum(ss);
    const float rstd = rsqrtf(ss * (1.f / 1024.f) + 1e-6f);
#pragma unroll
    for (int i = 0; i < 4; ++i) *(f32x4*)(src + lane * 4 + 256 * i) = (v[i] * rstd) * gv[i];
  }
}

enum { EPI_AB_IN = 0, EPI_QB = 1, EPI_KVB = 2, EPI_C_IN = 3, EPI_OUT = 4 };
constexpr int G_STR = 144;
constexpr int G_OPER = 256 * G_STR;
constexpr int G_STAGE = 2 * G_OPER;
constexpr int OFF_RSTD = 2 * G_STAGE;
constexpr int LDS_BYTES = OFF_RSTD + 1024;

DI void rope2(float& v0, float& v1, float& v2, float& v3, const float* cs, const float* sn) {
  const f32x2 c = *(const f32x2*)cs, s = *(const f32x2*)sn;
  const float a0 = v0 * c.x - v1 * s.x, a1 = v0 * s.x + v1 * c.x, a2 = v2 * c.y - v3 * s.y, a3 = v2 * s.y + v3 * c.y;
  v0 = a0; v1 = a1; v2 = a2; v3 = a3;
}

template <int EPI>
DI void epi_math(const Params& p, int tok, int f0, float& v0, float& v1, float& v2, float& v3, float rs) {
  const float* ropeA = (const float*)(p.ws + OFF_ROPE);
  const float* ropeB = ropeA + 2 * 8192 * 32;
  const bool lat = tok < T_LAT;
  const int pos = tok & 8191;
  if (EPI == EPI_AB_IN) {
    if (f0 < 640) {
      if (lat) { const int p0 = (f0 & 63) >> 1; rope2(v0, v1, v2, v3, ropeA + pos * 32 + p0, ropeA + 8192 * 32 + pos * 32 + p0); }
      if (f0 < 512) { v0 *= QSCALE_A; v1 *= QSCALE_A; v2 *= QSCALE_A; v3 *= QSCALE_A; }
    } else if (f0 >= 1920 && f0 < 1952) {
      if (lat) { const int p0 = (f0 - 1920) >> 1; rope2(v0, v1, v2, v3, ropeB + pos * 16 + p0, ropeB + 8192 * 16 + pos * 16 + p0); }
    }
  } else if (EPI == EPI_QB) {
    const float s = rs * QSCALE_B;
    v0 *= s; v1 *= s; v2 *= s; v3 *= s;
    const int fh = f0 % 96;
    if (fh >= 64 && lat) { const int p0 = (fh - 64) >> 1; rope2(v0, v1, v2, v3, ropeB + pos * 16 + p0, ropeB + 8192 * 16 + pos * 16 + p0); }
  } else if (EPI == EPI_KVB) {
    v0 *= rs; v1 *= rs; v2 *= rs; v3 *= rs;
  } else if (EPI == EPI_C_IN) {
    if (f0 < 1024) { v0 *= QSCALE_A; v1 *= QSCALE_A; v2 *= QSCALE_A; v3 *= QSCALE_A; }
  }
}

template <int EPI>
DI bf16_t* dst_tr(const Params& p, int tok, int col) {
  if (EPI == EPI_AB_IN) return col < 2464 ? (bf16_t*)(p.ws + OFF_P) + (size_t)tok * 2560 + col : nullptr;
  if (EPI == EPI_QB) return (bf16_t*)(p.ws + OFF_QB) + (size_t)tok * 768 + col;
  if (EPI == EPI_KVB) return (bf16_t*)(p.ws + OFF_KB) + (size_t)tok * 512 + col;
  return (bf16_t*)(p.ws + OFF_P) + (size_t)tok * 3072 + (col >= 3072 ? col - 1024 : col);
}
template <int EPI>
DI bf16_t* dst_v(const Params& p, int t0, int col) {
  int b, key; tok_bk(t0, b, key);
  if (EPI == EPI_KVB) return (bf16_t*)(p.ws + OFF_VTB) + ((size_t)(b * 8 + ((col - 512) >> 6)) * 64 + (col & 63)) * NKEY + key;
  return (bf16_t*)(p.ws + OFF_VT) + ((size_t)(b * 16 + ((col - 2048) >> 6)) * 64 + (col & 63)) * NKEY + key;
}

struct TilePf { bool pre; bool has_next; int nm0, nnt; };
template <int EPI, int TM>
DI void gemm_tile(const Params& p, int layer, const bf16_t* __restrict__ A, int lda, const bf16_t* __restrict__ Bt, int K, int m0, int nt, char* lds,
                  u32x4 (&ra)[TM / 64], u32x4 (&rb)[4], const TilePf pf) {
  constexpr int NJ = TM == 256 ? 4 : 2, NI = TM == 256 ? 2 : 1, NA = TM / 64;
  const int tid = otid(), lane = tid & 63, w = tid >> 6;
  const int wm = TM == 256 ? (w >> 2) : 0, wn = TM == 256 ? (w & 3) : w;
  const int fb = TM == 256 ? wn * 64 : wn * 32, tb = TM == 256 ? wm * 128 : 0;
  const int l31 = lane & 31, hh = lane >> 5;
  const int n0 = nt * 256;
  float* rstd = (float*)(lds + OFF_RSTD);
  const int srow = tid >> 3, scc = tid & 7;
  const bool ablocked = (lda == 0);
  const int nkb = K >> 6;
  const bf16_t* ag = ablocked ? A + ((size_t)((m0 >> 8) * 16) << 14) + (m0 & 255) * 64 + tid * 8 : A + (size_t)(m0 + srow) * lda + scc * 8;
  const size_t a_i = ablocked ? 4096 : (size_t)64 * lda, a_k = ablocked ? 16384 : 64;
  const bf16_t* bg = Bt + ((size_t)(nt * nkb) << 14) + tid * 8;

  if (EPI == EPI_QB || EPI == EPI_KVB) {
    __syncthreads();
    if (tid < 2 * TM) {
      const int r = tid >> 1, half = tid & 1;
      const bf16_t* ap = A + (size_t)(m0 + r) * lda + half * (K / 2);
      float ss = 0.f;
#pragma unroll 8
      for (int cidx = 0; cidx < K / 2; cidx += 8) {
        const u32x4 v = *(const u32x4*)(ap + cidx);
#pragma unroll
        for (int e = 0; e < 4; ++e) { const float a = bf_lo(v[e]), b2 = bf_hi(v[e]); ss += a * a + b2 * b2; }
      }
      ss += __shfl_xor(ss, 1);
      if (half == 0) rstd[r] = rsqrtf(ss / (float)K + 1e-6f);
    }
  }

  f32x16 acc[NI][NJ];
#pragma unroll
  for (int i = 0; i < NI; ++i)
#pragma unroll
    for (int j = 0; j < NJ; ++j)
#pragma unroll
      for (int r = 0; r < 16; ++r) acc[i][j][r] = 0.f;

  const int nk = K >> 6;
  if (!pf.pre) {
#pragma unroll
    for (int i = 0; i < NA; ++i) ra[i] = *(const u32x4*)(ag + i * a_i);
#pragma unroll
    for (int i = 0; i < 4; ++i) rb[i] = *(const u32x4*)(bg + i * 4096);
  }
#pragma unroll
  for (int i = 0; i < NA; ++i) *(u32x4*)(lds + (srow + 64 * i) * G_STR + scc * 16) = ra[i];
#pragma unroll
  for (int i = 0; i < 4; ++i) *(u32x4*)(lds + G_OPER + (srow + 64 * i) * G_STR + scc * 16) = rb[i];
#pragma unroll
  for (int i = 0; i < NA; ++i) ra[i] = *(const u32x4*)(ag + i * a_i + a_k);
#pragma unroll
  for (int i = 0; i < 4; ++i) rb[i] = *(const u32x4*)(bg + i * 4096 + 16384);
  __syncthreads();
  for (int kt = 0; kt < nk; ++kt) {
    const char* as = lds + (kt & 1) * G_STAGE;
    char* st = lds + ((kt + 1) & 1) * G_STAGE;
    const char* fp = as + G_OPER + (fb + l31) * G_STR + hh * 16;
    const char* sp = as + (tb + l31) * G_STR + hh * 16;
    const bool more = kt + 2 < nk;
#pragma unroll
    for (int ks = 0; ks < 4; ++ks) {
      bf16x8 f[NI], s[NJ];
#pragma unroll
      for (int i = 0; i < NI; ++i) f[i] = *(const bf16x8*)(fp + i * 32 * G_STR + ks * 32);
#pragma unroll
      for (int j = 0; j < NJ; ++j) s[j] = *(const bf16x8*)(sp + j * 32 * G_STR + ks * 32);
#pragma unroll
      for (int j = 0; j < NJ / 2; ++j)
#pragma unroll
        for (int i = 0; i < NI; ++i) acc[i][j] = MFMA32(f[i], s[j], acc[i][j]);
      if (ks < NA && kt + 1 < nk) *(u32x4*)(st + (srow + 64 * ks) * G_STR + scc * 16) = ra[ks < NA ? ks : 0];
      if (more && ks < NA) ra[ks < NA ? ks : 0] = *(const u32x4*)(ag + (ks < NA ? ks : 0) * a_i + (size_t)(kt + 2) * a_k);
      __builtin_amdgcn_sched_barrier(0);
#pragma unroll
      for (int j = NJ / 2; j < NJ; ++j)
#pragma unroll
        for (int i = 0; i < NI; ++i) acc[i][j] = MFMA32(f[i], s[j], acc[i][j]);
      if (kt + 1 < nk) *(u32x4*)(st + G_OPER + (srow + 64 * ks) * G_STR + scc * 16) = rb[ks];
      if (more) rb[ks] = *(const u32x4*)(bg + ks * 4096 + ((size_t)(kt + 2) << 14));
      __builtin_amdgcn_sched_barrier(0);
    }
    __syncthreads();
  }

  auto prefetch_next = [&]() {
    if (TM == 256 && pf.has_next) {
      const bf16_t* nag = ablocked ? A + ((size_t)((pf.nm0 >> 8) * 16) << 14) + (pf.nm0 & 255) * 64 + tid * 8 : A + (size_t)(pf.nm0 + srow) * lda + scc * 8;
      const bf16_t* nbg = Bt + ((size_t)(pf.nnt * nkb) << 14) + tid * 8;
#pragma unroll
      for (int i = 0; i < NA; ++i) ra[i] = *(const u32x4*)(nag + i * a_i);
#pragma unroll
      for (int i = 0; i < 4; ++i) rb[i] = *(const u32x4*)(nbg + i * 4096);
      __builtin_amdgcn_sched_barrier(0);
    }
  };
  constexpr int SB = 528;
  constexpr int SV = TM * 2 + 16;
  constexpr int NIT = TM * 32 / NT;
  if (EPI == EPI_OUT) {
    const int bb = m0 < T_LAT ? (m0 >> 13) : 4;
    constexpr int SF = 1040;
    constexpr int JH = NJ / 2;
    constexpr int NITO = (TM / 2) * 64 / NT;
    const float* gate = (const float*)(p.ws + OFF_MOD) + (size_t)(layer * 5 + bb) * 3072 + 2048 + n0;
#pragma unroll
    for (int h = 0; h < 2; ++h) {
#pragma unroll
      for (int jj = 0; jj < JH; ++jj)
#pragma unroll
        for (int i = 0; i < NI; ++i)
#pragma unroll
          for (int g = 0; g < 4; ++g) {
            const int j = h * JH + jj;
            f32x4 v; v[0] = acc[i][j][4 * g]; v[1] = acc[i][j][4 * g + 1]; v[2] = acc[i][j][4 * g + 2]; v[3] = acc[i][j][4 * g + 3];
            *(f32x4*)(lds + ((TM == 256 ? wm * 64 : 0) + jj * 32 + l31) * SF + (fb + i * 32 + 8 * g + 4 * hh) * 4) = v;
          }
      if (h == 1) prefetch_next();
      __syncthreads();
      const f32x4 gt = *(const f32x4*)(gate + (tid & 63) * 4);
#pragma unroll
      for (int i0 = 0; i0 < NITO; i0 += 8) {
        f32x4 oldv[8];
#pragma unroll
        for (int k = 0; k < 8; ++k)
          if (i0 + k < NITO) {
            const int cidx = tid + NT * (i0 + k), row = cidx >> 6, ch = cidx & 63;
            const int tok = m0 + (TM == 256 ? (row >> 6) * 128 + h * 64 + (row & 63) : h * 32 + row);
            oldv[k] = *(const f32x4*)(h_src(p, layer, tok) + n0 + ch * 4);
          }
#pragma unroll
        for (int k = 0; k < 8; ++k)
          if (i0 + k < NITO) {
            const int cidx = tid + NT * (i0 + k), row = cidx >> 6, ch = cidx & 63;
            const int tok = m0 + (TM == 256 ? (row >> 6) * 128 + h * 64 + (row & 63) : h * 32 + row);
            const f32x4 y = *(const f32x4*)(lds + row * SF + ch * 16);
            *(f32x4*)(h_dst(p, tok) + n0 + ch * 4) = oldv[k] + gt * y;
          }
      }
      __syncthreads();
    }
  } else {
    const bool vt = (EPI == EPI_KVB && nt >= 2) || (EPI == EPI_C_IN && nt >= 8 && nt < 12);
#pragma unroll
    for (int j = 0; j < NJ; ++j) {
      const int rl = tb + j * 32 + l31;
      float rs = 1.f;
      if (EPI == EPI_QB || EPI == EPI_KVB) rs = rstd[rl];
#pragma unroll
      for (int i = 0; i < NI; ++i)
#pragma unroll
        for (int g = 0; g < 4; ++g) {
          const int fl = fb + i * 32 + 8 * g + 4 * hh;
          float v0 = acc[i][j][4 * g], v1 = acc[i][j][4 * g + 1], v2 = acc[i][j][4 * g + 2], v3 = acc[i][j][4 * g + 3];
          epi_math<EPI>(p, m0 + rl, n0 + fl, v0, v1, v2, v3, rs);
          const unsigned w01 = pack_bf16(v0, v1), w23 = pack_bf16(v2, v3);
          if (!vt) {
            u32x2 wv; wv.x = w01; wv.y = w23;
            *(u32x2*)(lds + rl * SB + fl * 2) = wv;
          } else {
            *(bf16_t*)(lds + (fl + 0) * SV + rl * 2) = (bf16_t)(w01 & 0xffffu);
            *(bf16_t*)(lds + (fl + 1) * SV + rl * 2) = (bf16_t)(w01 >> 16);
            *(bf16_t*)(lds + (fl + 2) * SV + rl * 2) = (bf16_t)(w23 & 0xffffu);
            *(bf16_t*)(lds + (fl + 3) * SV + rl * 2) = (bf16_t)(w23 >> 16);
          }
        }
    }
    prefetch_next();
    __syncthreads();
#pragma unroll 4
    for (int it = 0; it < NIT; ++it) {
      const int cidx = tid + NT * it;
      if (vt) {
        const int row = cidx / (TM / 8), ch = cidx % (TM / 8);
        *(u32x4*)dst_v<EPI>(p, m0 + ch * 8, n0 + row) = *(const u32x4*)(lds + row * SV + ch * 16);
      } else {
        const int row = cidx >> 5, ch = cidx & 31;
        bf16_t* d = dst_tr<EPI>(p, m0 + row, n0 + ch * 8);
        if (d) *(u32x4*)d = *(const u32x4*)(lds + row * SB + ch * 16);
      }
    }
    __syncthreads();
  }
}

template <int EPI>
DI void gemm_phase(const Params& p, int layer, const bf16_t* A, int lda, const bf16_t* Bt, int K, int mtiles, int ntiles, bool ctx, bool reverse, char* lds,
                   int ctx_nt0 = 0, int ctx_ntn = -1) {
  const int G = ogrid();
  const int bid = reverse ? (G - 1 - obid()) : obid();
  u32x4 ra[4], rb[4];
  const bool simple = (G & 7) != 0;
  const int xcd = bid & 7, local = simple ? bid : (bid >> 3), nlocal = simple ? G : (G >> 3);
  const int mlo = simple ? 0 : ((xcd * mtiles) >> 3), cnt = simple ? mtiles : ((((xcd + 1) * mtiles) >> 3) - mlo);
  const int total = cnt * ntiles, gsize = 4 * ntiles;
  auto tile_of = [&](int j, int& m0, int& nt) {
    const int g = j / gsize, r = j - g * gsize;
    int gm = cnt - g * 4; gm = gm > 4 ? 4 : gm;
    m0 = (mlo + g * 4 + (r % gm)) * 256; nt = r / gm;
  };
  bool pre = false;
  for (int j = local; j < total; j += nlocal) {
    int m0, nt; tile_of(j, m0, nt);
    TilePf pf; pf.pre = pre; pf.has_next = (j + nlocal < total); pf.nm0 = 0; pf.nnt = 0;
    if (pf.has_next) tile_of(j + nlocal, pf.nm0, pf.nnt);
    gemm_tile<EPI, 256>(p, layer, A, lda, Bt, K, m0, nt, lds, ra, rb, pf);
    pre = pf.has_next;
  }
  if (ctx) {
    const int b2 = G - 1 - bid;
    u32x4 ra1[1];
    TilePf pf; pf.pre = false; pf.has_next = false; pf.nm0 = 0; pf.nnt = 0;
    const int cn = ctx_ntn < 0 ? ntiles : ctx_ntn;
    for (int u = b2; u < 16 * cn; u += G) gemm_tile<EPI, 64>(p, layer, A, lda, Bt, K, T_LAT + (u & 15) * 64, ctx_nt0 + (u >> 4), lds, ra1, rb, pf);
  }
}

DI void vta_phase(const Params& p, char* lds) {
  const int tid = otid();
  const bf16_t* Pb = (const bf16_t*)(p.ws + OFF_P);
  for (int u = ogrid() - 1 - obid(); u < T_ALL / 64; u += ogrid()) {
    const int t0 = u * 64;
#pragma unroll
    for (int it = 0; it < 2; ++it) {
      const int cidx = tid + NT * it, row = cidx >> 4, ch = cidx & 15;
      *(u32x4*)(lds + row * 272 + ch * 16) = *(const u32x4*)(Pb + (size_t)(t0 + row) * 2560 + 640 + ch * 8);
    }
    __syncthreads();
    int b, key; tok_bk(t0, b, key);
#pragma unroll
    for (int it = 0; it < 2; ++it) {
      const int cidx = tid + NT * it, f = cidx & 127, tc = cidx >> 7;
      unsigned short e[8];
#pragma unroll
      for (int k = 0; k < 8; ++k) e[k] = *(const bf16_t*)(lds + (tc * 8 + k) * 272 + f * 2);
      u32x4 v; v.x = e[0] | ((unsigned)e[1] << 16); v.y = e[2] | ((unsigned)e[3] << 16); v.z = e[4] | ((unsigned)e[5] << 16); v.w = e[6] | ((unsigned)e[7] << 16);
      *(u32x4*)((bf16_t*)(p.ws + OFF_VT) + ((size_t)(b * 2 + (f >> 6)) * 64 + (f & 63)) * NKEY + key + tc * 8) = v;
    }
    __syncthreads();
  }
}

template <int MODE>
DI void attn_item(const Params& p, int layer, int b, int qt, int head, bool is_ctx, char* lds) {
  constexpr int DK = (MODE == 1) ? 96 : 64;
  constexpr int NKS = DK / 16;
  constexpr int KSTR = DK * 2 + 16;
  constexpr int VSTR = 144;
  constexpr int KBYTES = 64 * KSTR;
  constexpr int STAGE = KBYTES + 64 * VSTR;
  constexpr int QPB = 256;
  constexpr int NKC = DK / 8;
  constexpr int KCH = 64 * NKC;
  constexpr int OSTR = 272;
  constexpr float MASKV = -1e30f;
  float* rpbs = (float*)(lds + 4 * STAGE);
  char* ostage = lds;

  const int tid = otid(), lane = tid & 63, w = tid >> 6, l31 = lane & 31, hh = lane >> 5;
  const int i2 = layer >> 1;
  const bf16_t* Pb = (const bf16_t*)(p.ws + OFF_P);
  bf16_t* UG = (bf16_t*)(p.ws + OFF_UG);
  const bf16_t *Qp, *Kp, *Krp = nullptr, *Zp, *Vt;
  int ldq, ldk, ldz, gcol;
  if (MODE == 0) {
    Qp = Pb + head * 64; ldq = 2560; Kp = Pb + 512 + (head >> 2) * 64; ldk = 2560;
    Vt = (const bf16_t*)(p.ws + OFF_VT) + (size_t)(b * 2 + (head >> 2)) * 64 * NKEY;
    Zp = Pb + 768 + head * 64; ldz = 2560; gcol = head * 64;
  } else if (MODE == 1) {
    Qp = (const bf16_t*)(p.ws + OFF_QB) + head * 96; ldq = 768; Kp = (const bf16_t*)(p.ws + OFF_KB) + head * 64; ldk = 512; Krp = Pb + 1920;
    Vt = (const bf16_t*)(p.ws + OFF_VTB) + (size_t)(b * 8 + head) * 64 * NKEY;
    Zp = Pb + 1952 + head * 64; ldz = 2560; gcol = 512 + head * 64;
  } else {
    Qp = Pb + head * 64; ldq = 3072; Kp = Pb + 1024 + head * 64; ldk = 3072;
    Vt = (const bf16_t*)(p.ws + OFF_VT) + (size_t)(b * 16 + head) * 64 * NKEY;
    Zp = Pb + 2048 + head * 64; ldz = 3072; gcol = head * 64;
  }
  const int qtok0 = is_ctx ? T_LAT + b * 256 : b * 8192 + qt * QPB;

  int lat_lo = 0, nlat = 0;
  if (!is_ctx) {
    if (MODE == 0) {
      int lo = 4 * qt - 2; if (lo < 0) lo = 0;
      int hi = 4 * qt + 5; if (hi > 127) hi = 127;
      lat_lo = lo; nlat = hi - lo + 1;
    } else if (MODE == 1) { lat_lo = 0; nlat = 128; }
    else {
      int lo = 4 * qt - 4; lo = lo < 0 ? 0 : (lo > 120 ? 120 : lo);
      int hi = 4 * qt + 3 - 4; hi = hi < 0 ? 0 : (hi > 120 ? 120 : hi); hi += 7;
      lat_lo = lo; nlat = hi - lo + 1;
    }
  }
  const int ntiles = nlat + 4;

  const bool nat2 = (MODE == 2) && !is_ctx;
  auto tokmap = [&](int row) { return nat2 ? qtok0 + ((w >> 2) * 2 + (row >> 4)) * 64 + (w & 3) * 16 + (row & 15) : qtok0 + w * 32 + row; };
  const int qtok = tokmap(l31);
  bf16x8 qf[NKS];
#pragma unroll
  for (int ks = 0; ks < NKS; ++ks) qf[ks] = *(const bf16x8*)(Qp + (size_t)qtok * ldq + ks * 16 + hh * 8);
  if (MODE == 2 && !is_ctx) {
    for (int i = tid; i < 465; i += NT) rpbs[i] = p.c_rpb[(size_t)(i2 * 16 + head) * 465 + i] * LOG2E;
  }
  float m_ = (MODE == 0) ? p.a_sink[i2 * 8 + head] * LOG2E : MASKV;
  float l_ = (MODE == 0 && hh == 0) ? 1.f : 0.f;
  f32x16 O[2];
#pragma unroll
  for (int dh = 0; dh < 2; ++dh)
#pragma unroll
    for (int r = 0; r < 16; ++r) O[dh][r] = 0.f;

  const int k0row = tid / NKC, k0cc = tid % NKC;
  const int k1row = (tid + NT) / NKC, k1cc = (tid + NT) % NKC;
  const bool k1 = (KCH > NT) && (tid + NT < KCH);
  struct Stg { u32x4 k0, k1, v; };
  Stg R0, R1;
  R0.k1 = (u32x4){0u, 0u, 0u, 0u}; R1.k1 = R0.k1;
  auto tile_kt = [&](int i) { return i < nlat ? lat_lo + i : 128 + (i - nlat); };
  auto kload = [&](int krow0, int row, int cc) -> u32x4 {
    if (MODE == 1 && cc >= 8) return *(const u32x4*)(Krp + (size_t)(krow0 + row) * 2560 + (cc - 8) * 8);
    return *(const u32x4*)(Kp + (size_t)(krow0 + row) * ldk + cc * 8);
  };
  auto gload = [&](int i, Stg& r) {
    const int kt = tile_kt(i < ntiles ? i : ntiles - 1);
    const int krow0 = kt < 128 ? b * 8192 + kt * 64 : T_LAT + b * 256 + (kt - 128) * 64;
    r.k0 = kload(krow0, k0row, k0cc);
    if (k1) r.k1 = kload(krow0, k1row, k1cc);
    r.v = *(const u32x4*)(Vt + (size_t)(tid >> 3) * NKEY + kt * 64 + (tid & 7) * 8);
  };
  auto lstore = [&](int st, const Stg& r) {
    char* kb = lds + st * STAGE;
    *(u32x4*)(kb + k0row * KSTR + k0cc * 16) = r.k0;
    if (k1) *(u32x4*)(kb + k1row * KSTR + k1cc * 16) = r.k1;
    *(u32x4*)(kb + KBYTES + (tid >> 3) * VSTR + (tid & 7) * 16) = r.v;
  };

  const int pr = (l31 & ~12) | ((l31 & 4) << 1) | ((l31 & 8) >> 1);
  int qr = 0, qc = 0, rs0 = 0, cs = 0, csw = 0, wlo = 0, whi = 0;
  if (MODE == 2) {
    qr = qt * 4 + (w >> 2) * 2 + (l31 >> 4); qc = (w & 3) * 16 + (l31 & 15);
    rs0 = qr - 4; rs0 = rs0 < 0 ? 0 : (rs0 > 120 ? 120 : rs0);
    cs = qc - 8; cs = cs < 0 ? 0 : (cs > 48 ? 48 : cs);
    csw = (w & 3) * 16 - 8; csw = csw < 0 ? 0 : (csw > 32 ? 32 : csw);
    const int r_lo = qt * 4 + (w >> 2) * 2;
    wlo = r_lo - 4; wlo = wlo < 0 ? 0 : (wlo > 120 ? 120 : wlo);
    whi = r_lo + 1 - 4; whi = whi < 0 ? 0 : (whi > 120 ? 120 : whi); whi += 7;
  }
  const int s0w = qt * QPB + w * 32;
  const int nsup = (ntiles + 1) >> 1;
  __syncthreads();
  gload(0, R0); gload(1, R1);
  lstore(0, R0); lstore(1, R1);
  gload(2, R0); gload(3, R1);
  __syncthreads();
  auto body = [&](int it, const char* kb) {
    const char* vb = kb + KBYTES;
    const int kt = tile_kt(it);
    const bool lat_tile = it < nlat;
    bool skip = (it >= ntiles);
    if (MODE == 2 && lat_tile) skip = (kt < wlo) || (kt > whi);
    if (MODE == 0 && lat_tile) skip = (kt * 64 + 63 < s0w - 128) || (kt * 64 > s0w + 31 + 128);
    const int nsub = (MODE == 2 && lat_tile) ? 1 : 2;
    const int krb = (MODE == 2 && lat_tile) ? csw : 0;
    if (!skip) {
      f32x16 S[2];
#pragma unroll
      for (int t = 0; t < 2; ++t)
#pragma unroll
        for (int r = 0; r < 16; ++r) S[t][r] = 0.f;
#pragma unroll
      for (int ks = 0; ks < NKS; ++ks) {
        const bf16x8 a0 = *(const bf16x8*)(kb + (krb + pr) * KSTR + ks * 32 + hh * 16);
        S[0] = MFMA32(a0, qf[ks], S[0]);
        if (nsub == 2) {
          const bf16x8 a1 = *(const bf16x8*)(kb + (32 + pr) * KSTR + ks * 32 + hh * 16);
          S[1] = MFMA32(a1, qf[ks], S[1]);
        }
      }
      if (MODE == 0 && lat_tile) {
        const int s = qt * QPB + w * 32 + l31;
#pragma unroll
        for (int t = 0; t < 2; ++t)
#pragma unroll
          for (int r = 0; r < 16; ++r) {
            const int kk = kt * 64 + t * 32 + 16 * (r >> 3) + 8 * hh + (r & 7);
            const int d = kk - s;
            if (d > 128 || d < -128) S[t][r] = MASKV;
          }
      }
      if (MODE == 2 && lat_tile) {
        int ri = kt - qr + 7; ri = ri < 0 ? 0 : (ri > 14 ? 14 : ri);
        const float* brow = rpbs + ri * 31;
        const bool rok = (kt >= rs0) && (kt <= rs0 + 7);
        float bv[16];
#pragma unroll
        for (int r = 0; r < 16; ++r) {
          const int kc = csw + 16 * (r >> 3) + 8 * hh + (r & 7);
          int bi = kc - qc + 15; bi = bi < 0 ? 0 : (bi > 30 ? 30 : bi);
          bv[r] = brow[bi];
        }
#pragma unroll
        for (int r = 0; r < 16; ++r) asm volatile("" : "+v"(bv[r]));
#pragma unroll
        for (int r = 0; r < 16; ++r) {
          const int kc = csw + 16 * (r >> 3) + 8 * hh + (r & 7);
          const bool ok = rok && (kc >= cs) && (kc < cs + 16);
          S[0][r] = ok ? S[0][r] + bv[r] : MASKV;
        }
      }
      float mx = S[0][0];
#pragma unroll
      for (int r = 0; r < 16; ++r) mx = fmaxf(mx, S[0][r]);
      if (nsub == 2) {
#pragma unroll
        for (int r = 0; r < 16; ++r) mx = fmaxf(mx, S[1][r]);
      }
      mx = pair_max(mx);
      if (__any(mx > m_ + 8.f)) {
        const float mnew = fmaxf(m_, mx);
        const float alpha = fexp2(m_ - mnew);
        m_ = mnew;
        l_ *= alpha;
#pragma unroll
        for (int dh = 0; dh < 2; ++dh)
#pragma unroll
          for (int r = 0; r < 16; ++r) O[dh][r] *= alpha;
      }
      float rsum = 0.f;
#pragma unroll
      for (int t = 0; t < 2; ++t)
        if (t < nsub) {
#pragma unroll
          for (int r = 0; r < 16; ++r) { const float e = fexp2(S[t][r] - m_); S[t][r] = e; rsum += e; }
        }
      l_ += rsum;
#pragma unroll
      for (int t = 0; t < 2; ++t)
       if (t < nsub)
#pragma unroll
        for (int s = 0; s < 2; ++s) {
          u32x4 u;
          u.x = pack_bf16(S[t][8 * s + 0], S[t][8 * s + 1]); u.y = pack_bf16(S[t][8 * s + 2], S[t][8 * s + 3]);
          u.z = pack_bf16(S[t][8 * s + 4], S[t][8 * s + 5]); u.w = pack_bf16(S[t][8 * s + 6], S[t][8 * s + 7]);
          const bf16x8 pf = __builtin_bit_cast(bf16x8, u);
#pragma unroll
          for (int dh = 0; dh < 2; ++dh) {
            const bf16x8 v = *(const bf16x8*)(vb + (dh * 32 + l31) * VSTR + (krb + t * 32 + s * 16 + hh * 8) * 2);
            O[dh] = MFMA32(v, pf, O[dh]);
          }
        }
    }
  };
  for (int j = 0; j < nsup; ++j) {
    const char* sb = lds + (j & 1) * 2 * STAGE;
    body(2 * j, sb);
    body(2 * j + 1, sb + STAGE);
    __builtin_amdgcn_sched_barrier(0);
    {
      const int so = ((j + 1) & 1) * 2;
      lstore(so, R0); lstore(so + 1, R1);
      gload(2 * j + 4, R0); gload(2 * j + 5, R1);
    }
    __syncthreads();
  }

  {
    const float lt = l_ + __shfl_xor(l_, 32);
    const float inv = 1.f / lt;
    char* orow = ostage + (w * 32) * OSTR;
#pragma unroll
    for (int dh = 0; dh < 2; ++dh)
#pragma unroll
      for (int g = 0; g < 4; ++g) {
        f32x4 v; v[0] = O[dh][4 * g] * inv; v[1] = O[dh][4 * g + 1] * inv; v[2] = O[dh][4 * g + 2] * inv; v[3] = O[dh][4 * g + 3] * inv;
        *(f32x4*)(orow + l31 * OSTR + (dh * 32 + 8 * g + 4 * hh) * 4) = v;
      }
    __builtin_amdgcn_s_waitcnt(0xc07f);
#pragma unroll
    for (int it = 0; it < 4; ++it) {
      const int cidx = lane + 64 * it, row = cidx >> 3, ch = cidx & 7;
      const f32x4 o0 = *(const f32x4*)(orow + row * OSTR + ch * 32), o1 = *(const f32x4*)(orow + row * OSTR + ch * 32 + 16);
      const int tok = tokmap(row);
      const u32x4 z = *(const u32x4*)(Zp + (size_t)tok * ldz + ch * 8);
      u32x4 wv;
      wv.x = pack_bf16(o0[0] * silu(bf_lo(z.x)), o0[1] * silu(bf_hi(z.x)));
      wv.y = pack_bf16(o0[2] * silu(bf_lo(z.y)), o0[3] * silu(bf_hi(z.y)));
      wv.z = pack_bf16(o1[0] * silu(bf_lo(z.z)), o1[1] * silu(bf_hi(z.z)));
      wv.w = pack_bf16(o1[2] * silu(bf_lo(z.w)), o1[3] * silu(bf_hi(z.w)));
      *(u32x4*)(UG + ablk(tok, gcol + ch * 8)) = wv;
    }
  }
}

DI void mla_item2(const Params& p, int layer, int b, int qt, int head, char* lds) {
  constexpr int DK = 96, NKS = 6, KSTR = DK * 2 + 16, VSTR = 144, KBYTES = 64 * KSTR, STAGE = KBYTES + 64 * VSTR;
  constexpr int NKC = 12, KCH = 64 * NKC, OSTR = 272, QG = 2, NTILES = 132;
  constexpr float MASKV = -1e30f;
  char* ostage = lds;
  const int tid = otid(), lane = tid & 63, w = tid >> 6, l31 = lane & 31, hh = lane >> 5;
  const bf16_t* Pb = (const bf16_t*)(p.ws + OFF_P);
  bf16_t* UG = (bf16_t*)(p.ws + OFF_UG);
  const bf16_t* Qp = (const bf16_t*)(p.ws + OFF_QB) + head * 96;
  const bf16_t* Kp = (const bf16_t*)(p.ws + OFF_KB) + head * 64;
  const bf16_t* Krp = Pb + 1920;
  const bf16_t* Vt = (const bf16_t*)(p.ws + OFF_VTB) + (size_t)(b * 8 + head) * 64 * NKEY;
  const bf16_t* Zp = Pb + 1952 + head * 64;
  const int gcol = 512 + head * 64;
  const int qtok0 = b * 8192 + qt * 512;
  bf16x8 qf[QG][NKS];
#pragma unroll
  for (int qg = 0; qg < QG; ++qg)
#pragma unroll
    for (int ks = 0; ks < NKS; ++ks) qf[qg][ks] = *(const bf16x8*)(Qp + (size_t)(qtok0 + qg * 256 + w * 32 + l31) * 768 + ks * 16 + hh * 8);
  float m_[QG], l_[QG];
  f32x16 O[QG][2];
#pragma unroll
  for (int qg = 0; qg < QG; ++qg) {
    m_[qg] = MASKV; l_[qg] = 0.f;
#pragma unroll
    for (int dh = 0; dh < 2; ++dh)
#pragma unroll
      for (int r = 0; r < 16; ++r) O[qg][dh][r] = 0.f;
  }
  const int k0row = tid / NKC, k0cc = tid % NKC;
  const int k1row = (tid + NT) / NKC, k1cc = (tid + NT) % NKC;
  const bool k1 = (tid + NT < KCH);
  struct Stg { u32x4 k0, k1, v; };
  Stg R0;
  R0.k1 = (u32x4){0u, 0u, 0u, 0u};
  auto kload = [&](int krow0, int row, int cc) -> u32x4 {
    if (cc >= 8) return *(const u32x4*)(Krp + (size_t)(krow0 + row) * 2560 + (cc - 8) * 8);
    return *(const u32x4*)(Kp + (size_t)(krow0 + row) * 512 + cc * 8);
  };
  auto gload = [&](int i, Stg& r) {
    const int kt = i < NTILES ? i : NTILES - 1;
    const int krow0 = kt < 128 ? b * 8192 + kt * 64 : T_LAT + b * 256 + (kt - 128) * 64;
    r.k0 = kload(krow0, k0row, k0cc);
    if (k1) r.k1 = kload(krow0, k1row, k1cc);
    r.v = *(const u32x4*)(Vt + (size_t)(tid >> 3) * NKEY + kt * 64 + (tid & 7) * 8);
  };
  auto lstore = [&](int st, const Stg& r) {
    char* kb = lds + st * STAGE;
    *(u32x4*)(kb + k0row * KSTR + k0cc * 16) = r.k0;
    if (k1) *(u32x4*)(kb + k1row * KSTR + k1cc * 16) = r.k1;
    *(u32x4*)(kb + KBYTES + (tid >> 3) * VSTR + (tid & 7) * 16) = r.v;
  };
  const int pr = (l31 & ~12) | ((l31 & 4) << 1) | ((l31 & 8) >> 1);
  __syncthreads();
  gload(0, R0); lstore(0, R0);
  gload(1, R0);
  __syncthreads();
  auto body = [&](const char* kb) {
    const char* vb = kb + KBYTES;
    f32x16 S[QG][2];
#pragma unroll
    for (int qg = 0; qg < QG; ++qg)
#pragma unroll
      for (int t = 0; t < 2; ++t)
#pragma unroll
        for (int r = 0; r < 16; ++r) S[qg][t][r] = 0.f;
#pragma unroll
    for (int ks = 0; ks < NKS; ++ks) {
      const bf16x8 a0 = *(const bf16x8*)(kb + pr * KSTR + ks * 32 + hh * 16);
      const bf16x8 a1 = *(const bf16x8*)(kb + (32 + pr) * KSTR + ks * 32 + hh * 16);
#pragma unroll
      for (int qg = 0; qg < QG; ++qg) { S[qg][0] = MFMA32(a0, qf[qg][ks], S[qg][0]); S[qg][1] = MFMA32(a1, qf[qg][ks], S[qg][1]); }
    }
#pragma unroll
    for (int qg = 0; qg < QG; ++qg) {
      float mx = S[qg][0][0];
#pragma unroll
      for (int t = 0; t < 2; ++t)
#pragma unroll
        for (int r = 0; r < 16; ++r) mx = fmaxf(mx, S[qg][t][r]);
      mx = pair_max(mx);
      if (__any(mx > m_[qg] + 8.f)) {
        const float mnew = fmaxf(m_[qg], mx);
        const float alpha = fexp2(m_[qg] - mnew);
        m_[qg] = mnew;
        l_[qg] *= alpha;
#pragma unroll
        for (int dh = 0; dh < 2; ++dh)
#pragma unroll
          for (int r = 0; r < 16; ++r) O[qg][dh][r] *= alpha;
      }
      float rsum = 0.f;
#pragma unroll
      for (int t = 0; t < 2; ++t)
#pragma unroll
        for (int r = 0; r < 16; ++r) { const float e = fexp2(S[qg][t][r] - m_[qg]); S[qg][t][r] = e; rsum += e; }
      l_[qg] += rsum;
    }
#pragma unroll
    for (int t = 0; t < 2; ++t)
#pragma unroll
      for (int s = 0; s < 2; ++s) {
        bf16x8 pf[QG];
#pragma unroll
        for (int qg = 0; qg < QG; ++qg) {
          u32x4 u;
          u.x = pack_bf16(S[qg][t][8 * s + 0], S[qg][t][8 * s + 1]); u.y = pack_bf16(S[qg][t][8 * s + 2], S[qg][t][8 * s + 3]);
          u.z = pack_bf16(S[qg][t][8 * s + 4], S[qg][t][8 * s + 5]); u.w = pack_bf16(S[qg][t][8 * s + 6], S[qg][t][8 * s + 7]);
          pf[qg] = __builtin_bit_cast(bf16x8, u);
        }
#pragma unroll
        for (int dh = 0; dh < 2; ++dh) {
          const bf16x8 v = *(const bf16x8*)(vb + (dh * 32 + l31) * VSTR + (t * 32 + s * 16 + hh * 8) * 2);
#pragma unroll
          for (int qg = 0; qg < QG; ++qg) O[qg][dh] = MFMA32(v, pf[qg], O[qg][dh]);
        }
      }
  };
  if (w >= 4) __builtin_amdgcn_s_setprio(2);
  for (int j = 0; j < NTILES; ++j) {
    body(lds + (j & 1) * STAGE);
    __builtin_amdgcn_sched_barrier(0);
    lstore((j + 1) & 1, R0);
    gload(j + 2, R0);
    __syncthreads();
  }
  __builtin_amdgcn_s_setprio(0);
#pragma unroll
  for (int qg = 0; qg < QG; ++qg) {
    const float lt = l_[qg] + __shfl_xor(l_[qg], 32);
    const float inv = 1.f / lt;
    char* orow = ostage + (w * 32) * OSTR;
#pragma unroll
    for (int dh = 0; dh < 2; ++dh)
#pragma unroll
      for (int g = 0; g < 4; ++g) {
        f32x4 v; v[0] = O[qg][dh][4 * g] * inv; v[1] = O[qg][dh][4 * g + 1] * inv; v[2] = O[qg][dh][4 * g + 2] * inv; v[3] = O[qg][dh][4 * g + 3] * inv;
        *(f32x4*)(orow + l31 * OSTR + (dh * 32 + 8 * g + 4 * hh) * 4) = v;
      }
    __builtin_amdgcn_s_waitcnt(0xc07f);
#pragma unroll
    for (int it = 0; it < 4; ++it) {
      const int cidx = lane + 64 * it, row = cidx >> 3, ch = cidx & 7;
      const f32x4 o0 = *(const f32x4*)(orow + row * OSTR + ch * 32), o1 = *(const f32x4*)(orow + row * OSTR + ch * 32 + 16);
      const int tok = qtok0 + qg * 256 + w * 32 + row;
      const u32x4 z = *(const u32x4*)(Zp + (size_t)tok * 2560 + ch * 8);
      u32x4 wv;
      wv.x = pack_bf16(o0[0] * silu(bf_lo(z.x)), o0[1] * silu(bf_hi(z.x)));
      wv.y = pack_bf16(o0[2] * silu(bf_lo(z.y)), o0[3] * silu(bf_hi(z.y)));
      wv.z = pack_bf16(o1[0] * silu(bf_lo(z.z)), o1[1] * silu(bf_hi(z.z)));
      wv.w = pack_bf16(o1[2] * silu(bf_lo(z.w)), o1[3] * silu(bf_hi(z.w)));
      *(u32x4*)(UG + ablk(tok, gcol + ch * 8)) = wv;
    }
    __builtin_amdgcn_s_waitcnt(0xc07f);
  }
}

DI void attn_phase_ab(const Params& p, int layer, char* lds) {
  const int G = ogrid();
  for (int v = obid(); v < 512; v += G) {
    const int xcd = v & 7, s = v >> 3;
    const int grp = (s >> 4) * 8 + xcd, qt = s & 15;
    mla_item2(p, layer, grp >> 3, qt, grp & 7, lds);
  }
  for (int v = obid(); v < 32; v += G) attn_item<1>(p, layer, v >> 3, 0, v & 7, true, lds);
  for (int v = obid(); v < 1024; v += G) {
    attn_item<0>(p, layer, v >> 8, v & 31, (v >> 5) & 7, false, lds);
  }
  for (int v = obid() - 32; v < 32; v += G) if (v >= 0) attn_item<0>(p, layer, v >> 3, 0, v & 7, true, lds);
}

DI void attn_phase_c(const Params& p, int layer, char* lds) {
  const int G = ogrid();
  const int nctx = (layer == 3) ? 0 : 64;
  for (int v = obid(); v < 2048 + nctx; v += G) {
    if (v < 2048) attn_item<2>(p, layer, v >> 9, v & 31, (v >> 5) & 15, false, lds);
    else { const int c = v - 2048; attn_item<2>(p, layer, c >> 4, 0, c & 15, true, lds); }
  }
}

__global__ void __launch_bounds__(512, 2) fwd_megakernel(Params p) {
  __shared__ __attribute__((aligned(16))) char lds[LDS_BYTES];
  __shared__ uint4 xb_words;
  if (threadIdx.x == 0) xb_words = make_uint4(0u, 0u, 0u, 0u);
  __syncthreads();
  if (obid() == 0) { unsigned* bw = (unsigned*)(p.ws + OFF_BAR); for (int i = otid(); i < 4096; i += NT) bw[i] = 0u; }
  XcdBarrier xb; xb.bar = (unsigned*)(p.ws + OFF_BAR); xb.x = 0; xb.st = (volatile LAS unsigned*)&xb_words;
  bool first = true, posted = false;
  for (int ph = p.ph_begin; ph < p.ph_end; ++ph) {
    const int layer = (ph - 1) / 5, s = (ph - 1) % 5;
    const bool even = (layer & 1) == 0;
    const int i2 = layer >> 1;
    if (ph >= 1 && ph <= 20 && s == 2 && !even) continue;
    if (!first) {
      if (!posted) { cg::this_grid().sync(); xb = xcd_barrier_post((unsigned*)(p.ws + OFF_BAR), (volatile LAS unsigned*)&xb_words); posted = true; }
      else xcd_barrier(xb);
    }
    first = false;
    if (ph == 0) prologue_phase(p, lds);
    else if (ph == 21) final_phase(p);
    else if (s == 0) norm_phase(p, layer);
    else if (s == 1) {
      const bf16_t* U = (const bf16_t*)(p.ws + OFF_UG);
      if (even) gemm_phase<EPI_AB_IN>(p, layer, U, 0, (const bf16_t*)(p.ws + OFF_W_IN) + (size_t)i2 * 2560 * 1024, 1024, 128, 10, true, false, lds);
      else if (layer == 3)
        gemm_phase<EPI_C_IN>(p, layer, U, 0, (const bf16_t*)(p.ws + OFF_W_CIN) + (size_t)i2 * 4096 * 1024, 1024, 128, 16, true, false, lds, 4, 8);
      else gemm_phase<EPI_C_IN>(p, layer, U, 0, (const bf16_t*)(p.ws + OFF_W_CIN) + (size_t)i2 * 4096 * 1024, 1024, 128, 16, true, false, lds);
    } else if (s == 2) {
      const bf16_t* Pb = (const bf16_t*)(p.ws + OFF_P);
      gemm_phase<EPI_QB>(p, layer, Pb + 1280, 2560, (const bf16_t*)(p.ws + OFF_W_UQ) + (size_t)i2 * 768 * 384, 384, 128, 3, true, false, lds);
      gemm_phase<EPI_KVB>(p, layer, Pb + 1664, 2560, (const bf16_t*)(p.ws + OFF_W_UKV) + (size_t)i2 * 1024 * 256, 256, 128, 4, true, true, lds);
      vta_phase(p, lds);
    } else if (s == 3) {
      if (even) attn_phase_ab(p, layer, lds); else attn_phase_c(p, layer, lds);
    } else {
      const bf16_t* Gm = (const bf16_t*)(p.ws + OFF_UG);
      const bf16_t* W = even ? (const bf16_t*)(p.ws + OFF_W_OUT) + (size_t)i2 * 1024 * 1024 : (const bf16_t*)(p.ws + OFF_W_COUT) + (size_t)i2 * 1024 * 1024;
      gemm_phase<EPI_OUT>(p, layer, Gm, 0, W, 1024, 128, 4, layer != 3, false, lds);
    }
  }
}

extern "C" void kernel_launch(void* const* d_in, const int* in_sizes, int n_in, void* d_out, int out_size, void* d_ws, size_t ws_size,
                              hipStream_t stream) {
  static int grid_blocks = 0;
  if (!grid_blocks) {
    int dev = 0, cus = 0, per_cu = 0;
    hipGetDevice(&dev);
    hipDeviceGetAttribute(&cus, hipDeviceAttributeMultiprocessorCount, dev);
    hipOccupancyMaxActiveBlocksPerMultiprocessor(&per_cu, fwd_megakernel, NT, 0);
    per_cu = 1;
    grid_blocks = cus * per_cu;
    if (ws_size < OFF_END) fprintf(stderr, "kernel_launch: workspace too small: %zu < %zu\n", ws_size, (size_t)OFF_END);
  }
  Params p{};
  const float** f = (const float**)&p;
  for (int i = 0; i < 18; ++i) f[i] = (const float*)d_in[i];
  p.out = (float*)d_out;
  p.ws = (char*)d_ws;
#if MK_MULTI_LAUNCH
  for (int ph = 0; ph < 22; ++ph) {
    if (ph >= 1 && ph <= 20 && ((ph - 1) % 5) == 2 && (((ph - 1) / 5) & 1)) continue;
    p.ph_begin = ph; p.ph_end = ph + 1;
    hipLaunchKernelGGL(fwd_megakernel, dim3(grid_blocks), dim3(NT), 0, stream, p);
  }
#else
  p.ph_begin = 0; p.ph_end = 22;
  void* args[] = {&p};
  hipError_t e = hipLaunchCooperativeKernel((void*)fwd_megakernel, dim3(grid_blocks), dim3(NT), args, 0, stream);
  if (e != hipSuccess) fprintf(stderr, "cooperative launch failed: %s (grid %d)\n", hipGetErrorString(e), grid_blocks);
#endif
}
```
